# Optimizing an MI355X kernel written in HIP

```python
import jax, jax.numpy as jnp
from jax import lax
import numpy as np

D_MODEL = 1024
BATCH = 2
SEQ = 16384
DEPTH = 4

D_FF = 2816
LRU_WIDTH = 1024
LRU_HEADS = 4
LRU_HEAD_DIM = LRU_WIDTH // LRU_HEADS
LRU_CONV = 4
LRU_PAD = (2, 1)
LRU_C = 8.0
SC_WIDTH = 512
SC_CONV = 3
SC_PAD = (1, 1)
SGU_WIDTH = 512
SGU_HEADS = 4
SGU_HEAD_DIM = SGU_WIDTH // SGU_HEADS
CHUNK = 128
N_BRANCH = 3
EPS = 1e-6

_PART = (LRU_WIDTH, LRU_WIDTH, SC_WIDTH, SC_WIDTH, SC_WIDTH,
         SGU_WIDTH, SGU_WIDTH, N_BRANCH * D_MODEL)
D_IN = sum(_PART)
SPLIT_POINTS = tuple(int(p) for p in np.cumsum(_PART)[:-1])

kernel_name = "hybrid_rglru_shortconv_sgu_encoder"


def rmsnorm(x, g):
    xf = x.astype(jnp.float32)
    y = xf * lax.rsqrt(jnp.mean(xf * xf, axis=-1, keepdims=True) + EPS)
    return y.astype(x.dtype) * g


def layernorm(x, g, b):
    xf = x.astype(jnp.float32)
    mu = jnp.mean(xf, axis=-1, keepdims=True)
    var = jnp.mean(jnp.square(xf - mu), axis=-1, keepdims=True)
    return ((xf - mu) * lax.rsqrt(var + EPS)).astype(x.dtype) * g + b


def swiglu(h, w_gate, w_up, w_down):
    return (jax.nn.silu(h @ w_gate) * (h @ w_up)) @ w_down


def depthwise_conv(x, w, pad):
    c = x.shape[-1]
    return lax.conv_general_dilated(
        x, w[:, None, :], window_strides=(1,), padding=[pad],
        dimension_numbers=("NWC", "WIO", "NWC"), feature_group_count=c)


def _lin_combine(left, right):
    a_l, b_l = left
    a_r, b_r = right
    return a_l * a_r, a_r * b_l + b_r


def rg_lru(x, w_a, b_a, w_x, b_x, lam, reverse):
    bsz, s, wdt = x.shape
    xh = x.reshape(bsz, s, LRU_HEADS, LRU_HEAD_DIM)
    r = jax.nn.sigmoid(jnp.einsum("bshd,hde->bshe", xh, w_a).reshape(bsz, s, wdt) + b_a)
    i = jax.nn.sigmoid(jnp.einsum("bshd,hde->bshe", xh, w_x).reshape(bsz, s, wdt) + b_x)
    log_a = (-LRU_C * jax.nn.softplus(-lam.astype(jnp.float32))) * r.astype(jnp.float32)
    a = jnp.exp(log_a)
    u = (i * x).astype(jnp.float32) * jnp.sqrt(-jnp.expm1(2.0 * log_a))
    _, h = lax.associative_scan(_lin_combine, (a, u), reverse=reverse, axis=1)
    return h.astype(x.dtype)


def spatial_gating(u, v, ln_g, ln_b, w_s, b_s):
    u = jax.nn.gelu(u)
    v = layernorm(jax.nn.gelu(v), ln_g, ln_b)
    bsz, s, _ = v.shape
    vc = v.reshape(bsz, s // CHUNK, CHUNK, SGU_HEADS, SGU_HEAD_DIM)
    mixed = jnp.einsum("gpq,bnqgc->bnpgc", w_s, vc) + b_s.T[:, :, None]
    return u * mixed.reshape(bsz, s, SGU_WIDTH)


def mixer_block(h, w_in, lru_conv_w, lru_conv_b, lru_wa, lru_ba, lru_wx, lru_bx,
                lru_lambda, lru_w_out, sc_conv_w, sc_w_out, sgu_ln_g, sgu_ln_b,
                sgu_w_s, sgu_b, sgu_w_out, w_o):
    z = h @ w_in
    lru_gate, lru_x, sc_b, sc_c, sc_x, sgu_u, sgu_v, merge = jnp.split(z, SPLIT_POINTS, axis=-1)
    xc = depthwise_conv(lru_x, lru_conv_w, LRU_PAD) + lru_conv_b
    h_fwd = rg_lru(xc, lru_wa[0], lru_ba[0], lru_wx[0], lru_bx[0], lru_lambda[0], reverse=False)
    h_bwd = rg_lru(xc, lru_wa[1], lru_ba[1], lru_wx[1], lru_bx[1], lru_lambda[1], reverse=True)
    y_a = ((h_fwd + h_bwd) * jax.nn.gelu(lru_gate)) @ lru_w_out
    y_b = (sc_b * depthwise_conv(sc_c * sc_x, sc_conv_w, SC_PAD)) @ sc_w_out
    y_c = spatial_gating(sgu_u, sgu_v, sgu_ln_g, sgu_ln_b, sgu_w_s, sgu_b) @ sgu_w_out
    g = jax.nn.sigmoid(merge).reshape(*merge.shape[:-1], N_BRANCH, D_MODEL)
    m = g[..., 0, :] * y_a + g[..., 1, :] * y_b + g[..., 2, :] * y_c
    return m @ w_o


def setup_inputs(seed: int = 0) -> dict:
    key = jax.random.key(seed)
    ks = iter(jax.random.split(key, 32))
    L, D, F = DEPTH, D_MODEL, D_FF

    def w(shape, fan_in):
        return jax.random.normal(next(ks), shape, jnp.float32) * (fan_in ** -0.5)

    def gain(shape):
        return 1.0 + 0.02 * jax.random.normal(next(ks), shape, jnp.float32)

    def bias(shape):
        return 0.02 * jax.random.normal(next(ks), shape, jnp.float32)

    a0 = jax.random.uniform(next(ks), (L, 2, LRU_WIDTH), jnp.float32, 0.9, 0.999)
    s0 = a0 ** (1.0 / LRU_C)
    lru_lambda = jnp.log(s0) - jnp.log1p(-s0)
    return {
        "x": jax.random.normal(next(ks), (BATCH, SEQ, D), jnp.float32),
        "ffn1_pre_g": gain((L, D)),
        "ffn1_w_gate": w((L, D, F), D),
        "ffn1_w_up": w((L, D, F), D),
        "ffn1_w_down": w((L, F, D), F),
        "ffn1_post_g": gain((L, D)),
        "mix_pre_g": gain((L, D)),
        "w_in": w((L, D, D_IN), D),
        "lru_conv_w": w((L, LRU_CONV, LRU_WIDTH), LRU_CONV),
        "lru_conv_b": bias((L, LRU_WIDTH)),
        "lru_wa": w((L, 2, LRU_HEADS, LRU_HEAD_DIM, LRU_HEAD_DIM), LRU_HEAD_DIM),
        "lru_ba": bias((L, 2, LRU_WIDTH)),
        "lru_wx": w((L, 2, LRU_HEADS, LRU_HEAD_DIM, LRU_HEAD_DIM), LRU_HEAD_DIM),
        "lru_bx": bias((L, 2, LRU_WIDTH)),
        "lru_lambda": lru_lambda,
        "lru_w_out": w((L, LRU_WIDTH, D), LRU_WIDTH),
        "sc_conv_w": w((L, SC_CONV, SC_WIDTH), SC_CONV),
        "sc_w_out": w((L, SC_WIDTH, D), SC_WIDTH),
        "sgu_ln_g": gain((L, SGU_WIDTH)),
        "sgu_ln_b": bias((L, SGU_WIDTH)),
        "sgu_w_s": w((L, SGU_HEADS, CHUNK, CHUNK), CHUNK),
        "sgu_b": bias((L, SGU_HEADS, CHUNK)),
        "sgu_w_out": w((L, SGU_WIDTH, D), SGU_WIDTH),
        "w_o": w((L, D, D), D),
        "mix_post_g": gain((L, D)),
        "ffn2_pre_g": gain((L, D)),
        "ffn2_w_gate": w((L, D, F), D),
        "ffn2_w_up": w((L, D, F), D),
        "ffn2_w_down": w((L, F, D), F),
        "ffn2_post_g": gain((L, D)),
    }


def reference(x, ffn1_pre_g, ffn1_w_gate, ffn1_w_up, ffn1_w_down, ffn1_post_g,
              mix_pre_g, w_in, lru_conv_w, lru_conv_b, lru_wa, lru_ba, lru_wx, lru_bx,
              lru_lambda, lru_w_out, sc_conv_w, sc_w_out, sgu_ln_g, sgu_ln_b,
              sgu_w_s, sgu_b, sgu_w_out, w_o, mix_post_g,
              ffn2_pre_g, ffn2_w_gate, ffn2_w_up, ffn2_w_down, ffn2_post_g):
    for l in range(DEPTH):
        f1 = swiglu(rmsnorm(x, ffn1_pre_g[l]), ffn1_w_gate[l], ffn1_w_up[l], ffn1_w_down[l])
        x = x + 0.5 * rmsnorm(f1, ffn1_post_g[l])
        mx = mixer_block(rmsnorm(x, mix_pre_g[l]), w_in[l], lru_conv_w[l], lru_conv_b[l],
                         lru_wa[l], lru_ba[l], lru_wx[l], lru_bx[l], lru_lambda[l],
                         lru_w_out[l], sc_conv_w[l], sc_w_out[l], sgu_ln_g[l], sgu_ln_b[l],
                         sgu_w_s[l], sgu_b[l], sgu_w_out[l], w_o[l])
        x = x + rmsnorm(mx, mix_post_g[l])
        f2 = swiglu(rmsnorm(x, ffn2_pre_g[l]), ffn2_w_gate[l], ffn2_w_up[l], ffn2_w_down[l])
        x = x + 0.5 * rmsnorm(f2, ffn2_post_g[l])
    return x
```

```cpp
#include <hip/hip_runtime.h>
#include <hip/hip_cooperative_groups.h>
#include <cstdio>
#include <cstdint>
namespace cg = cooperative_groups;

#define LAS __attribute__((address_space(3)))
typedef unsigned short bf16_t;
typedef short bf16x8 __attribute__((ext_vector_type(8)));
typedef float f32x4 __attribute__((ext_vector_type(4)));
typedef float f32x2 __attribute__((ext_vector_type(2)));
typedef unsigned u32x4 __attribute__((ext_vector_type(4)));
typedef unsigned u32x2 __attribute__((ext_vector_type(2)));

constexpr int NB = 2, S = 16384, T = NB * S, D = 1024, FF = 2816, DIN = 7680, ZN = 4608, DEPTH = 4;
constexpr float EPS = 1e-6f;
constexpr int NTHR = 512, NWAVES = 8;

constexpr size_t MiB = 1u << 20;
constexpr size_t WS_LC = 0;
constexpr size_t WS_TAB = 65536;
constexpr size_t WS_SUM = 1 * MiB;
constexpr size_t WS_W = 4 * MiB;
constexpr size_t W_UP1 = WS_W, W_DN1 = W_UP1 + 11 * MiB, W_IN = W_DN1 + 11 * MiB / 2, W_LRU = W_IN + 15 * MiB, W_CAT = W_LRU + 2 * MiB,
                 W_O = W_CAT + 4 * MiB, W_UP2 = W_O + 2 * MiB, W_DN2 = W_UP2 + 11 * MiB, W_END = W_DN2 + 11 * MiB / 2;
static_assert(W_END == 60 * MiB, "weight map");
constexpr size_t WS_XN = 60 * MiB;
constexpr size_t WS_ZG = 124 * MiB, WS_ZX = 188 * MiB, WS_ZSC = 252 * MiB, WS_ZSGU = 348 * MiB, WS_XC = 412 * MiB, WS_YBC = 476 * MiB, WS_END = 540 * MiB;
constexpr size_t WS_U = 188 * MiB, WS_R = 316 * MiB;
constexpr size_t WS_G = 188 * MiB;
constexpr size_t WS_MG = 380 * MiB;
constexpr size_t WS_MX = 124 * MiB;
constexpr size_t WS_H = 124 * MiB;
constexpr size_t WS_F = 316 * MiB;

constexpr int LDS_BYTES = 147456;
#ifndef PHM
#define PHM 0xFFFF
#define NLAYER_RUN DEPTH
#define STOP_AT 11
#define DBG_MASK ((1u << 9) | (1u << 11))
#define DBG_LAYER 1
#define DBG_F 0
#define DBG_G 1
#define DBG_GL 0
#ifndef ABL
#define ABL 0
#endif
#endif
#define PH(b) if constexpr ((PHM >> (b)) & 1)
#define GSYNC() do { asm volatile("s_waitcnt vmcnt(0)" ::: "memory"); __threadfence(); grid.sync(); } while (0)

struct Args { const float* in[30]; float* out; unsigned char* ws; };

typedef _Float16 h16x2 __attribute__((ext_vector_type(2)));
typedef _Float16 h16x8 __attribute__((ext_vector_type(8)));
__device__ __forceinline__ unsigned cvt_pk_bf16(float lo, float hi) { h16x2 v; v.x = (_Float16)lo; v.y = (_Float16)hi; return __builtin_bit_cast(unsigned, v); }
__device__ __forceinline__ float bflo(unsigned u) { return (float)__builtin_bit_cast(h16x2, u).x; }
__device__ __forceinline__ float bfhi(unsigned u) { return (float)__builtin_bit_cast(h16x2, u).y; }
__device__ __forceinline__ float rcpf_(float x) { return __builtin_amdgcn_rcpf(x); }
__device__ __forceinline__ float sigm(float x) { return rcpf_(1.f + __expf(-x)); }
__device__ __forceinline__ float silu_(float x) { return x * sigm(x); }
__device__ __forceinline__ float gelu_(float x) { const float u = 1.5957691216057308f * (x + 0.044715f * x * x * x); return x * sigm(u); }
#define GAS __attribute__((address_space(1)))
__device__ __forceinline__ const float* in_ptr(const float* const* tab, int i) {
    unsigned long long v = *(const unsigned long long*)(tab + i);
    const unsigned lo = __builtin_amdgcn_readfirstlane((unsigned)v), hi = __builtin_amdgcn_readfirstlane((unsigned)(v >> 32));
    v = ((unsigned long long)hi << 32) | lo;
    return (const float*)(GAS const float*)v;
}
__device__ __forceinline__ float wave_sum(float v, int lane) {
#pragma unroll
    for (int o = 1; o < 64; o <<= 1) v += __int_as_float(__builtin_amdgcn_ds_bpermute((lane ^ o) << 2, __float_as_int(v)));
    return v;
}

namespace pg8 {
constexpr int BM = 256, BK = 64, HALF = 128, HTB = HALF * BK * 2, STAGE_BYTES = 8 * HTB, NXCD = 8, WGM = 8;
__host__ __device__ __forceinline__ int lds_byte(int r, int c) { const int st = (r >> 4) * 2 + (c >> 5), rr = r & 15, cc = c & 31, ob = rr * 64 + cc * 2; return st * 1024 + (ob ^ (((ob >> 9) & 1) << 5)); }
__host__ __device__ __forceinline__ void stage_rc(int b, int& R, int& C) { const int st = b / 1024, sb = b % 1024, swz = sb ^ (((sb >> 9) & 1) << 5); R = (st >> 1) * 16 + swz / 64; C = (st & 1) * 32 + (swz % 64) / 2; }
__host__ __device__ __forceinline__ int perm32(int rho) { const int n = rho >> 4, i = rho & 15; return 8 * (i >> 2) + 4 * n + (i & 3); }

struct Unit { int pm, pn; };
struct Gemm { const bf16_t* A; const bf16_t* A2; const bf16_t* Bt; int M, N, K, lda, ksplit, apn_shift, apn_bytes; };

struct StaticOrder {
    int nM, nN, nwg, G, c;
    __device__ void init(int M, int N, int G_, int c_) { nM = M / BM; nN = N / BM; nwg = nM * nN; G = G_; c = c_; }
    __device__ bool next(int i, Unit& u) const {
        const long L = (long)i * G + c; if (L >= nwg) return false;
        int wgid = (int)L; { const int q = nwg / NXCD, r = nwg % NXCD, xcd = wgid % NXCD, off = wgid / NXCD; wgid = (xcd < r ? xcd * (q + 1) : r * (q + 1) + (xcd - r) * q) + off; }
        const int nig = WGM * nN, gid = wgid / nig, fm = gid * WGM, gsz = (nM - fm) < WGM ? (nM - fm) : WGM;
        u.pm = fm + ((wgid % nig) % gsz); u.pn = (wgid % nig) / gsz; return true;
    }
};

template <class Epi, bool ALIGN_EPI>
__device__ __forceinline__ void gemm_phase(LAS unsigned char* lds, const Gemm g, const StaticOrder& S, const Epi& E) {
    int tid_ = threadIdx.x; asm volatile("" : "+v"(tid_));
    const int tid = tid_, wid = __builtin_amdgcn_readfirstlane(tid >> 6), lane = tid & 63, wr = wid >> 2, wc = wid & 3, fr = lane & 15, fq = lane >> 4;
    const int K = g.K, nt = K / BK, lda = g.lda;
    unsigned voffA[2], voffB[2];
#pragma unroll
    for (int i = 0; i < 2; ++i) { int R, C; stage_rc(tid * 16 + i * 8192, R, C); const int Rb = Epi::PERM ? ((R & ~31) + perm32(R & 31)) : R;
        voffA[i] = (unsigned)(R * lda + C) * 2u; voffB[i] = (unsigned)(Rb * K + C) * 2u; }
    const size_t kstep = (size_t)(BK * 2);
    const size_t hstepA = (size_t)HALF * lda * 2, tstepA = 2 * hstepA;
    const size_t hstepB = (size_t)HALF * K * 2, tstepB = 2 * hstepB;
    const unsigned ldsw = (unsigned)wid * 1024u;
    const int aoff = lds_byte(wr * 64 + fr, fq * 8), boff = lds_byte(wc * 32 + fr, fq * 8);
#define PG8_SA(b, h) (((b) * 2 + (h)) * HTB)
#define PG8_SB(b, h) ((4 + (b) * 2 + (h)) * HTB)
#define PG8_STAGE(bufoff, gbase, voff) do { _Pragma("unroll") for (int _i = 0; _i < 2; ++_i) \
        __builtin_amdgcn_global_load_lds((const unsigned*)((const char*)(gbase) + (voff)[_i]), (LAS unsigned*)(lds + (bufoff) + ldsw + _i * 8192), 16, 0, 0); } while (0)
#define PG8_LDA(dst, b, h) do { _Pragma("unroll") for (int m = 0; m < 4; ++m) _Pragma("unroll") for (int k = 0; k < 2; ++k) dst[m][k] = *(const LAS bf16x8*)(lds + PG8_SA(b, h) + aoff + m * 2048 + k * 1024); } while (0)
#define PG8_LDB(dst, b, h) do { _Pragma("unroll") for (int n = 0; n < 2; ++n) _Pragma("unroll") for (int k = 0; k < 2; ++k) dst[n][k] = *(const LAS bf16x8*)(lds + PG8_SB(b, h) + boff + n * 2048 + k * 1024); } while (0)
#define PG8_MMA(ai, bj, At, Bt) do { __builtin_amdgcn_s_setprio(1); _Pragma("unroll") for (int m = 0; m < 4; ++m) _Pragma("unroll") for (int n = 0; n < 2; ++n) _Pragma("unroll") for (int k = 0; k < 2; ++k) \
        acc[ai][bj][m][n] = __builtin_amdgcn_mfma_f32_16x16x32_f16(__builtin_bit_cast(h16x8, Bt[n][k]), __builtin_bit_cast(h16x8, At[m][k]), acc[ai][bj][m][n], 0, 0, 0); __builtin_amdgcn_s_setprio(0); } while (0)
#define PG8_WAIT_V(n) asm volatile("s_waitcnt vmcnt(" #n ")" ::: "memory")
#define PG8_WAIT_L(n) asm volatile("s_waitcnt lgkmcnt(" #n ")" ::: "memory")
#define PG8_BAR __builtin_amdgcn_s_barrier()
#define PG8_SCHED __builtin_amdgcn_sched_barrier(0)
    Unit cur, nxt; int ui = 0;
    if (!S.next(0, cur)) return;
    f32x4 acc[2][2][4][2];
#pragma unroll
    for (int a = 0; a < 2; ++a)
#pragma unroll
        for (int b = 0; b < 2; ++b)
#pragma unroll
            for (int m = 0; m < 4; ++m)
#pragma unroll
                for (int n = 0; n < 2; ++n) acc[a][b][m][n] = (f32x4){0.f, 0.f, 0.f, 0.f};
    bf16x8 At[4][2], B0[2][2], B1[2][2];
    const char* cA = (const char*)g.A + (size_t)cur.pm * tstepA + (size_t)(cur.pn >> g.apn_shift) * g.apn_bytes;
    const char* cA2 = (const char*)g.A2 + (size_t)cur.pm * tstepA;
    const char* cB = (const char*)g.Bt + (size_t)cur.pn * tstepB;
    PG8_STAGE(PG8_SB(0, 0), cB, voffB); PG8_STAGE(PG8_SB(0, 1), cB + hstepB, voffB); PG8_STAGE(PG8_SA(0, 0), cA, voffA); PG8_STAGE(PG8_SA(0, 1), cA + hstepA, voffA);
    if (wr == 1) PG8_BAR;
    PG8_WAIT_V(2); PG8_BAR;
    PG8_STAGE(PG8_SB(1, 0), cB + kstep, voffB); PG8_STAGE(PG8_SA(1, 0), cA + kstep, voffA); PG8_STAGE(PG8_SB(1, 1), cB + hstepB + kstep, voffB);
    PG8_WAIT_V(6); PG8_BAR;
    for (;;) {
        const bool has_next = S.next(ui + 1, nxt);
        const char* nA = has_next ? (const char*)g.A + (size_t)nxt.pm * tstepA + (size_t)(nxt.pn >> g.apn_shift) * g.apn_bytes : cA;
        const char* nA2 = has_next ? (const char*)g.A2 + (size_t)nxt.pm * tstepA : cA2;
        const char* nB = has_next ? (const char*)g.Bt + (size_t)nxt.pn * tstepB : cB;
        for (int t = 0; t < nt; t += 2) {
            const bool last = (t == nt - 2);
            const char* a1 = ((t < g.ksplit) ? cA : cA2) + (size_t)(t + 1) * kstep;
            const char* a2 = last ? nA : ((t + 2 < g.ksplit) ? cA : cA2) + (size_t)(t + 2) * kstep;
            const char* b2 = last ? nB : cB + (size_t)(t + 2) * kstep;
            const char* a3 = a2 + kstep; const char* b3 = b2 + kstep;
            if constexpr (Epi::HOOK) { if (t == g.ksplit || t == g.ksplit + 8) E.hook(acc, cur, (t - g.ksplit) >> 3, wr, wc, fr, fq); }
            PG8_LDB(B0, 0, 0); PG8_LDB(B1, 0, 1); PG8_SCHED; PG8_LDA(At, 0, 0); PG8_STAGE(PG8_SA(1, 1), a1 + hstepA, voffA);
            PG8_WAIT_V(8); PG8_WAIT_L(0); PG8_BAR; PG8_MMA(0, 0, At, B0); PG8_MMA(0, 1, At, B1); PG8_BAR; PG8_SCHED;
            PG8_LDA(At, 0, 1); PG8_STAGE(PG8_SB(0, 0), b2, voffB); PG8_STAGE(PG8_SB(0, 1), b2 + hstepB, voffB); PG8_STAGE(PG8_SA(0, 0), a2, voffA);
            PG8_WAIT_V(8); PG8_WAIT_L(0); PG8_BAR; PG8_MMA(1, 0, At, B0); PG8_MMA(1, 1, At, B1); PG8_BAR; PG8_SCHED;
            PG8_LDB(B0, 1, 0); PG8_LDB(B1, 1, 1); PG8_SCHED; PG8_LDA(At, 1, 0); PG8_STAGE(PG8_SA(0, 1), a2 + hstepA, voffA);
            PG8_WAIT_V(8); PG8_WAIT_L(0); PG8_BAR; PG8_MMA(0, 0, At, B0); PG8_MMA(0, 1, At, B1); PG8_BAR; PG8_SCHED;
            PG8_LDA(At, 1, 1); PG8_STAGE(PG8_SB(1, 0), b3, voffB); PG8_STAGE(PG8_SB(1, 1), b3 + hstepB, voffB); PG8_STAGE(PG8_SA(1, 0), a3, voffA);
            PG8_WAIT_V(8); PG8_WAIT_L(0); PG8_BAR; PG8_MMA(1, 0, At, B0); PG8_MMA(1, 1, At, B1); PG8_BAR; PG8_SCHED;
        }
        if constexpr (ALIGN_EPI) { if (wr == 0) PG8_BAR; }
        E(acc, cur, wr, wc, fr, fq);
        if (!has_next) break;
#pragma unroll
        for (int a = 0; a < 2; ++a)
#pragma unroll
            for (int b = 0; b < 2; ++b)
#pragma unroll
                for (int m = 0; m < 4; ++m)
#pragma unroll
                    for (int n = 0; n < 2; ++n) acc[a][b][m][n] = (f32x4){0.f, 0.f, 0.f, 0.f};
        cur = nxt; cA = nA; cA2 = nA2; cB = nB; ++ui;
        if constexpr (ALIGN_EPI) { if (wr == 1) PG8_BAR; }
    }
    PG8_WAIT_V(0);
    if constexpr (!ALIGN_EPI) { if (wr == 0) PG8_BAR; }
    PG8_BAR;
#undef PG8_SA
#undef PG8_SB
#undef PG8_STAGE
#undef PG8_LDA
#undef PG8_LDB
#undef PG8_MMA
#undef PG8_WAIT_V
#undef PG8_WAIT_L
#undef PG8_BAR
#undef PG8_SCHED
}

template <int MODE> struct EpiBf {
    static constexpr bool PERM = true, HOOK = false;
    bf16_t* O; int ldc; bf16_t* O1; bf16_t* O2; bf16_t* O3;
    __device__ __forceinline__ void operator()(const f32x4 (&acc)[2][2][4][2], const Unit& u, int wr, int wc, int fr, int fq) const {
        bf16_t* base = O; int ld = ldc; int colt = u.pn * BM;
        if (MODE == 2) { const int pn = u.pn;
            if (pn < 4) { base = O; ld = 1024; colt = pn * 256; } else if (pn < 8) { base = O1; ld = 1024; colt = (pn - 4) * 256; }
            else if (pn < 14) { base = O2; ld = 1536; colt = (pn - 8) * 256; } else { base = O3; ld = 1024; colt = (pn - 14) * 256; } }
        const int row0 = u.pm * BM + wr * 64 + fr, col0 = colt + wc * 32 + 8 * fq;
#pragma unroll
        for (int ai = 0; ai < 2; ++ai)
#pragma unroll
            for (int m = 0; m < 4; ++m) { bf16_t* rowp = base + (size_t)(row0 + ai * HALF + m * 16) * ld + col0;
#pragma unroll
                for (int bj = 0; bj < 2; ++bj) { f32x4 v0 = acc[ai][bj][m][0], v1 = acc[ai][bj][m][1];
                    if (MODE == 1) {
#pragma unroll
                        for (int j = 0; j < 4; ++j) { v0[j] = sigm(v0[j]); v1[j] = sigm(v1[j]); } }
                    u32x4 w; w.x = cvt_pk_bf16(v0[0], v0[1]); w.y = cvt_pk_bf16(v0[2], v0[3]); w.z = cvt_pk_bf16(v1[0], v1[1]); w.w = cvt_pk_bf16(v1[2], v1[3]);
                    *(u32x4*)(rowp + bj * HALF) = w; } }
    }
};
struct EpiSwiGLU {
    static constexpr bool PERM = true, HOOK = false;
    bf16_t* O; int ldc;
    __device__ __forceinline__ void operator()(const f32x4 (&acc)[2][2][4][2], const Unit& u, int wr, int wc, int fr, int fq) const {
        const int row0 = u.pm * BM + wr * 64 + fr, col0 = u.pn * HALF + wc * 32 + 8 * fq;
#pragma unroll
        for (int ai = 0; ai < 2; ++ai)
#pragma unroll
            for (int m = 0; m < 4; ++m) { bf16_t* rowp = O + (size_t)(row0 + ai * HALF + m * 16) * ldc + col0;
                f32x4 h0, h1;
#pragma unroll
                for (int j = 0; j < 4; ++j) { h0[j] = silu_(acc[ai][0][m][0][j]) * acc[ai][1][m][0][j]; h1[j] = silu_(acc[ai][0][m][1][j]) * acc[ai][1][m][1][j]; }
                u32x4 w; w.x = cvt_pk_bf16(h0[0], h0[1]); w.y = cvt_pk_bf16(h0[2], h0[3]); w.z = cvt_pk_bf16(h1[0], h1[1]); w.w = cvt_pk_bf16(h1[2], h1[3]);
                *(u32x4*)rowp = w; }
    }
};
struct EpiMerge {
    static constexpr bool PERM = true, HOOK = true;
    const bf16_t* G; bf16_t* O;
    __device__ __forceinline__ void hook(f32x4 (&acc)[2][2][4][2], const Unit& u, int which, int wr, int wc, int fr, int fq) const {
        int row0 = u.pm * BM + wr * 64 + fr, col0 = u.pn * BM + wc * 32 + 8 * fq + which * 1024;
        asm volatile("" : "+v"(row0), "+v"(col0));
#pragma unroll
        for (int ai = 0; ai < 2; ++ai)
#pragma unroll
            for (int m = 0; m < 4; ++m) { const bf16_t* gp = G + (size_t)(row0 + ai * HALF + m * 16) * 3072 + col0;
#pragma unroll
                for (int bj = 0; bj < 2; ++bj)
#pragma unroll
                    for (int n = 0; n < 2; ++n) { const u32x2 ga = *(const u32x2*)(gp + bj * HALF + 4 * n), gb = *(const u32x2*)(gp + 1024 + bj * HALF + 4 * n);
                        f32x4 r; r[0] = bflo(ga.x) * rcpf_(bflo(gb.x)); r[1] = bfhi(ga.x) * rcpf_(bfhi(gb.x)); r[2] = bflo(ga.y) * rcpf_(bflo(gb.y)); r[3] = bfhi(ga.y) * rcpf_(bfhi(gb.y));
                        acc[ai][bj][m][n] *= r; asm volatile("" ::: "memory"); } }
    }
    __device__ __forceinline__ void operator()(const f32x4 (&acc)[2][2][4][2], const Unit& u, int wr, int wc, int fr, int fq) const {
        const int row0 = u.pm * BM + wr * 64 + fr, col0 = u.pn * BM + wc * 32 + 8 * fq;
#pragma unroll
        for (int ai = 0; ai < 2; ++ai)
#pragma unroll
            for (int m = 0; m < 4; ++m) { const size_t r = (size_t)(row0 + ai * HALF + m * 16);
#pragma unroll
                for (int bj = 0; bj < 2; ++bj) { const u32x4 gc = *(const u32x4*)(G + r * 3072 + 2048 + col0 + bj * HALF);
                    const f32x4 v0 = acc[ai][bj][m][0], v1 = acc[ai][bj][m][1];
                    u32x4 w; w.x = cvt_pk_bf16(v0[0] * bflo(gc.x), v0[1] * bfhi(gc.x)); w.y = cvt_pk_bf16(v0[2] * bflo(gc.y), v0[3] * bfhi(gc.y));
                    w.z = cvt_pk_bf16(v1[0] * bflo(gc.z), v1[1] * bfhi(gc.z)); w.w = cvt_pk_bf16(v1[2] * bflo(gc.w), v1[3] * bfhi(gc.w));
                    *(u32x4*)(O + r * 1024 + col0 + bj * HALF) = w; }
                asm volatile("" ::: "memory"); }
    }
};
struct EpiGates {
    static constexpr bool PERM = false, HOOK = false;
    const bf16_t* XC; bf16_t* U; unsigned char* R; const float* ba; const float* bx; const float* lc;
    __device__ __forceinline__ void operator()(const f32x4 (&acc)[2][2][4][2], const Unit& u, int wr, int wc, int fr, int fq) const {
        int ch0 = 64 * u.pn + 16 * wc + 4 * fq, row0 = u.pm * BM + wr * 64 + fr;
        asm volatile("" : "+v"(row0), "+v"(ch0));
#pragma unroll
        for (int ai = 0; ai < 2; ++ai)
#pragma unroll
            for (int m = 0; m < 4; ++m) { const unsigned off = (unsigned)(row0 + ai * HALF + m * 16) * 1024u + (unsigned)ch0;
                const u32x2 xw = *(const u32x2*)((const char*)XC + (size_t)(off * 2u));
#pragma unroll
                for (int d = 0; d < 2; ++d) {
                    const f32x4 ba4 = *(const f32x4*)(ba + d * 1024 + ch0), bx4 = *(const f32x4*)(bx + d * 1024 + ch0);
                    f32x4 xc; xc[0] = bflo(xw.x); xc[1] = bfhi(xw.x); xc[2] = bflo(xw.y); xc[3] = bfhi(xw.y);
                    f32x4 uv; unsigned rq = 0;
#pragma unroll
                    for (int j = 0; j < 4; ++j) { const float rr = sigm(acc[ai][d][m][0][j] + ba4[j]), ig = sigm(acc[ai][d][m][1][j] + bx4[j]);
                        uv[j] = ig * xc[j];
                        rq |= ((unsigned)__builtin_rintf(rr * 255.f)) << (8 * j); }
                    u32x2 w; w.x = cvt_pk_bf16(uv[0], uv[1]); w.y = cvt_pk_bf16(uv[2], uv[3]);
                    *(u32x2*)((char*)(U + (size_t)d * T * 1024) + (size_t)(off * 2u)) = w;
                    *(unsigned*)((char*)(R + (size_t)d * T * 1024) + (size_t)off) = rq;
                    asm volatile("" ::: "memory"); } }
    }
};
}

__device__ __forceinline__ int w_rowmap(int mode, int n, int p0) {
    if (mode == 0) return n;
    if (mode == 1) return 256 * (n >> 7) + p0 + (n & 127);
    const int dir = p0 >> 3, head = (p0 >> 1) & 3, ri = p0 & 1, ch = 256 * head + n;
    return 256 * (ch >> 6) + 128 * dir + 32 * ((ch >> 4) & 3) + 16 * ri + (ch & 15);
}
__device__ __forceinline__ void tr_item(const float* W, int N, int item, bf16_t* WT, int ldk, int koff, int mode, int p0, LAS float* scr, int lane) {
    const int nblk = N / 32, kb = item / nblk, nb = item % nblk, k0 = 64 * kb, n0 = 32 * nb;
#pragma unroll 8
    for (int i = 0; i < 32; ++i) { const int kk = 2 * i + (lane >> 5); scr[kk * 33 + (lane & 31)] = W[(size_t)(k0 + kk) * N + n0 + (lane & 31)]; }
    asm volatile("s_waitcnt lgkmcnt(0)" ::: "memory");
    const int c = lane & 7;
#pragma unroll
    for (int j = 0; j < 4; ++j) { const int nn = (lane >> 3) + 8 * j; const LAS float* s = scr + (8 * c) * 33 + nn;
        u32x4 o; o.x = cvt_pk_bf16(s[0 * 33], s[1 * 33]); o.y = cvt_pk_bf16(s[2 * 33], s[3 * 33]); o.z = cvt_pk_bf16(s[4 * 33], s[5 * 33]); o.w = cvt_pk_bf16(s[6 * 33], s[7 * 33]);
        *(u32x4*)(WT + (size_t)w_rowmap(mode, n0 + nn, p0) * ldk + koff + k0 + 8 * c) = o; }
    asm volatile("s_waitcnt lgkmcnt(0)" ::: "memory");
}
__device__ __forceinline__ void convert_layer(const float* const* tab, unsigned char* ws, int l, LAS unsigned char* lds) {
    int tid_ = threadIdx.x; asm volatile("" : "+v"(tid_));
    const int tid = tid_, lane = tid & 63, wave = tid >> 6;
    LAS float* scr = (LAS float*)(lds + wave * 8448);
    const int gw = blockIdx.x * NWAVES + wave, NGW = gridDim.x * NWAVES;
    constexpr int I_UP = 16 * 88, I_DN = 44 * 32, I_IN = 16 * 240, I_LRU = 256, I_SQ = 512, I_HALF = 256;
    constexpr int NITEMS = 6 * I_UP + I_IN + 2 * I_LRU + 2 * I_SQ + 2 * I_HALF;
    const size_t oUP = (size_t)l * D * FF, oSQ = (size_t)l * D * D, oHF = (size_t)l * 512 * D, oLRU = (size_t)l * 2 * 4 * 256 * 256;
    for (int it = gw; it < NITEMS; it += NGW) {
        int r = it;
        if (r < I_UP) { tr_item(in_ptr(tab, 2) + oUP, FF, r, (bf16_t*)(ws + W_UP1), 1024, 0, 1, 0, scr, lane); continue; } r -= I_UP;
        if (r < I_UP) { tr_item(in_ptr(tab, 3) + oUP, FF, r, (bf16_t*)(ws + W_UP1), 1024, 0, 1, 128, scr, lane); continue; } r -= I_UP;
        if (r < I_DN) { tr_item(in_ptr(tab, 4) + oUP, D, r, (bf16_t*)(ws + W_DN1), FF, 0, 0, 0, scr, lane); continue; } r -= I_DN;
        if (r < I_IN) { tr_item(in_ptr(tab, 7) + (size_t)l * D * DIN, DIN, r, (bf16_t*)(ws + W_IN), 1024, 0, 0, 0, scr, lane); continue; } r -= I_IN;
        if (r < I_LRU) { const int mat = r >> 5; tr_item(in_ptr(tab, 10) + oLRU + (size_t)mat * 65536, 256, r & 31, (bf16_t*)(ws + W_LRU), 256, 0, 2, ((mat >> 2) << 3) | ((mat & 3) << 1) | 0, scr, lane); continue; } r -= I_LRU;
        if (r < I_LRU) { const int mat = r >> 5; tr_item(in_ptr(tab, 12) + oLRU + (size_t)mat * 65536, 256, r & 31, (bf16_t*)(ws + W_LRU), 256, 0, 2, ((mat >> 2) << 3) | ((mat & 3) << 1) | 1, scr, lane); continue; } r -= I_LRU;
        if (r < I_SQ) { tr_item(in_ptr(tab, 15) + oSQ, D, r, (bf16_t*)(ws + W_CAT), 2048, 0, 0, 0, scr, lane); continue; } r -= I_SQ;
        if (r < I_HALF) { tr_item(in_ptr(tab, 17) + oHF, D, r, (bf16_t*)(ws + W_CAT), 2048, 1024, 0, 0, scr, lane); continue; } r -= I_HALF;
        if (r < I_HALF) { tr_item(in_ptr(tab, 22) + oHF, D, r, (bf16_t*)(ws + W_CAT), 2048, 1536, 0, 0, scr, lane); continue; } r -= I_HALF;
        if (r < I_SQ) { tr_item(in_ptr(tab, 23) + oSQ, D, r, (bf16_t*)(ws + W_O), 1024, 0, 0, 0, scr, lane); continue; } r -= I_SQ;
        if (r < I_UP) { tr_item(in_ptr(tab, 26) + oUP, FF, r, (bf16_t*)(ws + W_UP2), 1024, 0, 1, 0, scr, lane); continue; } r -= I_UP;
        if (r < I_UP) { tr_item(in_ptr(tab, 27) + oUP, FF, r, (bf16_t*)(ws + W_UP2), 1024, 0, 1, 128, scr, lane); continue; } r -= I_UP;
        tr_item(in_ptr(tab, 28) + oUP, D, r, (bf16_t*)(ws + W_DN2), FF, 0, 0, 0, scr, lane);
    }
}
__device__ __forceinline__ void lc_all(const float* const* tab, unsigned char* ws) {
    float* LC = (float*)(ws + WS_LC); const float* lam = in_ptr(tab, 14);
    for (int i = blockIdx.x * NTHR + threadIdx.x; i < DEPTH * 2048; i += gridDim.x * NTHR) LC[i] = -8.f * log1pf(expf(-lam[i]));
}

template <bool HASF>
__device__ __forceinline__ void ew_phase(const float* xin, float* xout, const bf16_t* Fb, float scale, const float* post_g, const float* pre_g, bf16_t* XN) {
    int tid_ = threadIdx.x; asm volatile("" : "+v"(tid_));
    const int tid = tid_, lane = tid & 63, wave = tid >> 6;
    const int gw = blockIdx.x * NWAVES + wave, NGW = gridDim.x * NWAVES;
    for (int m = gw; m < T; m += NGW) {
        const f32x4* xr = (const f32x4*)(xin + (size_t)m * D) + lane;
        f32x4 v[4];
#pragma unroll
        for (int j = 0; j < 4; ++j) v[j] = xr[64 * j];
        if (HASF) {
            const u32x2* fr_ = (const u32x2*)(Fb + (size_t)m * D) + lane;
            f32x4 f[4]; float ss = 0.f;
#pragma unroll
            for (int j = 0; j < 4; ++j) { const u32x2 w = fr_[64 * j]; f[j][0] = bflo(w.x); f[j][1] = bfhi(w.x); f[j][2] = bflo(w.y); f[j][3] = bfhi(w.y);
                ss += (f[j][0] * f[j][0] + f[j][1] * f[j][1]) + (f[j][2] * f[j][2] + f[j][3] * f[j][3]); }
            const float rs = scale * __builtin_amdgcn_rsqf(wave_sum(ss, lane) * (1.f / D) + EPS);
#pragma unroll
            for (int j = 0; j < 4; ++j) { const f32x4 pg = *((const f32x4*)post_g + 64 * j + lane); v[j] += f[j] * rs * pg; }
        }
        if (HASF || xin != xout) {
            f32x4* xo = (f32x4*)(xout + (size_t)m * D) + lane;
#pragma unroll
            for (int j = 0; j < 4; ++j) xo[64 * j] = v[j];
        }
        if (pre_g) {
            float s2 = 0.f;
#pragma unroll
            for (int j = 0; j < 4; ++j) s2 += (v[j][0] * v[j][0] + v[j][1] * v[j][1]) + (v[j][2] * v[j][2] + v[j][3] * v[j][3]);
            const float rs2 = __builtin_amdgcn_rsqf(wave_sum(s2, lane) * (1.f / D) + EPS);
            u32x2* o = (u32x2*)(XN + (size_t)m * D) + lane;
#pragma unroll
            for (int j = 0; j < 4; ++j) { const f32x4 g = *((const f32x4*)pre_g + 64 * j + lane); const f32x4 y = v[j] * rs2 * g;
                u32x2 w; w.x = cvt_pk_bf16(y[0], y[1]); w.y = cvt_pk_bf16(y[2], y[3]); o[64 * j] = w; }
        }
    }
}

constexpr int VT_PITCH = 272;
__device__ __forceinline__ void prep_phase(const float* const* tab, unsigned char* ws, int l, LAS unsigned char* lds) {
    int tid_ = threadIdx.x; asm volatile("" : "+v"(tid_));
    const int tid = tid_, lane = tid & 63, wave = tid >> 6;
    const bf16_t* ZX = (const bf16_t*)(ws + WS_ZX); const bf16_t* ZSC = (const bf16_t*)(ws + WS_ZSC); const bf16_t* ZSGU = (const bf16_t*)(ws + WS_ZSGU);
    bf16_t* XC = (bf16_t*)(ws + WS_XC); bf16_t* YBC = (bf16_t*)(ws + WS_YBC);
    for (int item = blockIdx.x; item < T / 128; item += gridDim.x) {
        const int b = item >> 7, n = item & 127, t0 = n * 128; const size_t rb = (size_t)b * S;
        {
            const int c = 2 * tid; const float* cw = in_ptr(tab, 8) + (size_t)l * 4096; const float* cb = in_ptr(tab, 9) + (size_t)l * 1024;
            const f32x2 w0 = *(const f32x2*)(cw + c), w1 = *(const f32x2*)(cw + 1024 + c), w2 = *(const f32x2*)(cw + 2048 + c), w3 = *(const f32x2*)(cw + 3072 + c), bb = *(const f32x2*)(cb + c);
            const bf16_t* src = ZX + rb * 1024 + c;
#define LDX(t) (((t) >= 0 && (t) < S) ? *(const unsigned*)(src + (size_t)(t) * 1024) : 0u)
            unsigned xm2 = LDX(t0 - 2), xm1 = LDX(t0 - 1), x0 = LDX(t0), xp1 = LDX(t0 + 1);
            for (int i = 0; i < 128; ++i) { const int t = t0 + i; const unsigned xn = LDX(t + 2);
                const float o0 = bb[0] + w0[0] * bflo(xm2) + w1[0] * bflo(xm1) + w2[0] * bflo(x0) + w3[0] * bflo(xp1);
                const float o1 = bb[1] + w0[1] * bfhi(xm2) + w1[1] * bfhi(xm1) + w2[1] * bfhi(x0) + w3[1] * bfhi(xp1);
                *(unsigned*)(XC + (rb + t) * 1024 + c) = cvt_pk_bf16(o0, o1);
                xm2 = xm1; xm1 = x0; x0 = xp1; xp1 = xn; }
#undef LDX
        }
        {
            const int half = tid >> 8, c = 2 * (tid & 255), tb = t0 + 64 * half; const float* cw = in_ptr(tab, 16) + (size_t)l * 1536;
            const f32x2 w0 = *(const f32x2*)(cw + c), w1 = *(const f32x2*)(cw + 512 + c), w2 = *(const f32x2*)(cw + 1024 + c);
            const bf16_t* src = ZSC + rb * 1536 + c;
#define LDP(t, p0_, p1_) do { if ((t) >= 0 && (t) < S) { const unsigned c_ = *(const unsigned*)(src + (size_t)(t) * 1536 + 512), x_ = *(const unsigned*)(src + (size_t)(t) * 1536 + 1024); p0_ = bflo(c_) * bflo(x_); p1_ = bfhi(c_) * bfhi(x_); } else { p0_ = 0.f; p1_ = 0.f; } } while (0)
            float pm0, pm1, pc0, pc1, pp0, pp1; LDP(tb - 1, pm0, pm1); LDP(tb, pc0, pc1); LDP(tb + 1, pp0, pp1);
            for (int i = 0; i < 64; ++i) { const int t = tb + i; float pn0, pn1; LDP(t + 2, pn0, pn1);
                const unsigned bw = *(const unsigned*)(src + (size_t)t * 1536);
                const float o0 = bflo(bw) * (w0[0] * pm0 + w1[0] * pc0 + w2[0] * pp0), o1 = bfhi(bw) * (w0[1] * pm1 + w1[1] * pc1 + w2[1] * pp1);
                *(unsigned*)(YBC + (rb + t) * 1024 + c) = (ABL == 2) ? 0u : cvt_pk_bf16(o0, o1);
                pm0 = pc0; pm1 = pc1; pc0 = pp0; pc1 = pp1; pp0 = pn0; pp1 = pn1; }
#undef LDP
        }
        {
            const float* lg = in_ptr(tab, 18) + (size_t)l * 512; const float* lb = in_ptr(tab, 19) + (size_t)l * 512;
            f32x4 g0 = *(const f32x4*)(lg + 8 * lane), g1 = *(const f32x4*)(lg + 8 * lane + 4), b0 = *(const f32x4*)(lb + 8 * lane), b1 = *(const f32x4*)(lb + 8 * lane + 4);
            for (int q = wave; q < 128; q += NWAVES) {
                const u32x4 w = *(const u32x4*)(ZSGU + (rb + t0 + q) * 1024 + 512 + 8 * lane);
                float v[8]; v[0] = bflo(w.x); v[1] = bfhi(w.x); v[2] = bflo(w.y); v[3] = bfhi(w.y); v[4] = bflo(w.z); v[5] = bfhi(w.z); v[6] = bflo(w.w); v[7] = bfhi(w.w);
                float s = 0.f;
#pragma unroll
                for (int j = 0; j < 8; ++j) { v[j] = gelu_(v[j]); s += v[j]; }
                const float mu = wave_sum(s, lane) * (1.f / 512.f); float s2 = 0.f;
#pragma unroll
                for (int j = 0; j < 8; ++j) { v[j] -= mu; s2 += v[j] * v[j]; }
                const float rstd = __builtin_amdgcn_rsqf(wave_sum(s2, lane) * (1.f / 512.f) + EPS);
#pragma unroll
                for (int j = 0; j < 8; ++j) { const float y = v[j] * rstd * (j < 4 ? g0[j & 3] : g1[j & 3]) + (j < 4 ? b0[j & 3] : b1[j & 3]);
                    *(LAS bf16_t*)(lds + (8 * lane + j) * VT_PITCH + 2 * q) = (bf16_t)(cvt_pk_bf16(y, 0.f) & 0xffffu); }
            }
            __syncthreads();
            const int g = wave >> 1, p0 = 64 * (wave & 1), fr = lane & 15, fq = lane >> 4;
            const float* Wg = in_ptr(tab, 20) + (size_t)l * 65536 + (size_t)g * 16384; const float* bs = in_ptr(tab, 21) + (size_t)l * 512 + g * 128;
            bf16x8 Wf[4][4];
#pragma unroll
            for (int m = 0; m < 4; ++m)
#pragma unroll
                for (int kk = 0; kk < 4; ++kk) { const float* p = Wg + (size_t)(p0 + 16 * m + fr) * 128 + 32 * kk + 8 * fq; const f32x4 x0 = *(const f32x4*)p, x1 = *(const f32x4*)(p + 4);
                    u32x4 w; w.x = cvt_pk_bf16(x0[0], x0[1]); w.y = cvt_pk_bf16(x0[2], x0[3]); w.z = cvt_pk_bf16(x1[0], x1[1]); w.w = cvt_pk_bf16(x1[2], x1[3]);
                    Wf[m][kk] = __builtin_bit_cast(bf16x8, w); }
            float bsv[4];
#pragma unroll
            for (int m = 0; m < 4; ++m) bsv[m] = bs[p0 + 16 * m + fr];
            for (int nn = 0; nn < 8; ++nn) {
                f32x4 acc[4];
#pragma unroll
                for (int m = 0; m < 4; ++m) acc[m] = (f32x4){0.f, 0.f, 0.f, 0.f};
#pragma unroll
                for (int kk = 0; kk < 4; ++kk) { const bf16x8 vf = *(const LAS bf16x8*)(lds + (g * 128 + 16 * nn + fr) * VT_PITCH + (32 * kk + 8 * fq) * 2);
#pragma unroll
                    for (int m = 0; m < 4; ++m) acc[m] = __builtin_amdgcn_mfma_f32_16x16x32_f16(__builtin_bit_cast(h16x8, vf), __builtin_bit_cast(h16x8, Wf[m][kk]), acc[m], 0, 0, 0); }
                const int cc = g * 128 + 16 * nn + 4 * fq;
#pragma unroll
                for (int m = 0; m < 4; ++m) { const size_t row = rb + t0 + p0 + 16 * m + fr;
                    const u32x2 uw = *(const u32x2*)(ZSGU + row * 1024 + cc);
                    const float o0 = gelu_(bflo(uw.x)) * (acc[m][0] + bsv[m]), o1 = gelu_(bfhi(uw.x)) * (acc[m][1] + bsv[m]), o2 = gelu_(bflo(uw.y)) * (acc[m][2] + bsv[m]), o3 = gelu_(bfhi(uw.y)) * (acc[m][3] + bsv[m]);
                    u32x2 w; w.x = cvt_pk_bf16(o0, o1); w.y = cvt_pk_bf16(o2, o3); if (ABL == 3) { w.x = 0u; w.y = 0u; }
                    *(u32x2*)(YBC + row * 1024 + 512 + cc) = w; }
            }
            __syncthreads();
        }
    }
}

__device__ __forceinline__ void scan_pass1(unsigned char* ws, int l, LAS unsigned char* lds) {
    int tid_ = threadIdx.x; asm volatile("" : "+v"(tid_));
    const int tid = tid_, lane = tid & 63, seg = tid >> 6;
    const float* LC = (const float*)(ws + WS_LC) + l * 2048; f32x2* SUM = (f32x2*)(ws + WS_SUM);
    LAS f32x4* SEG = (LAS f32x4*)lds;
    for (int item = blockIdx.x; item < 2048; item += gridDim.x) {
        const int dir = item & 1, grp = (item >> 1) & 7, chunk = (item >> 4) & 63, b = item >> 10;
        const int ch = grp * 128 + 2 * lane;
        const float l0 = LC[dir * 1024 + ch] * (1.f / 255.f), l1 = LC[dir * 1024 + ch + 1] * (1.f / 255.f);
        const bf16_t* U = (const bf16_t*)(ws + WS_U) + (size_t)dir * T * 1024 + ((size_t)b * S + chunk * 256) * 1024 + ch;
        const unsigned char* R = ws + WS_R + (size_t)dir * T * 1024 + ((size_t)b * S + chunk * 256) * 1024 + ch;
        float A0 = 1.f, A1 = 1.f, H0 = 0.f, H1 = 0.f;
#pragma unroll 8
        for (int k = 0; k < 32; ++k) { const int p = seg * 32 + k, to = dir ? 255 - p : p;
            const unsigned uw = *(const unsigned*)(U + (size_t)to * 1024); const unsigned rw = *(const unsigned short*)(R + (size_t)to * 1024);
            const float a0 = __expf(l0 * (float)(rw & 255u)), a1 = __expf(l1 * (float)(rw >> 8));
            H0 = a0 * H0 + bflo(uw) * __builtin_sqrtf(1.f - a0 * a0); H1 = a1 * H1 + bfhi(uw) * __builtin_sqrtf(1.f - a1 * a1); A0 *= a0; A1 *= a1; }
        SEG[seg * 64 + lane] = (f32x4){A0, H0, A1, H1};
        __syncthreads();
        if (tid < 64) { float cA0 = 1.f, cA1 = 1.f, cH0 = 0.f, cH1 = 0.f;
#pragma unroll
            for (int s = 0; s < 8; ++s) { const f32x4 v = SEG[s * 64 + tid]; cH0 = v[0] * cH0 + v[1]; cA0 *= v[0]; cH1 = v[2] * cH1 + v[3]; cA1 *= v[2]; }
            f32x4* o = (f32x4*)(SUM + ((size_t)((dir * 2 + b) * 64 + chunk)) * 1024 + grp * 128 + 2 * tid); *o = (f32x4){cA0, cH0, cA1, cH1}; }
        __syncthreads();
    }
}
__device__ __forceinline__ void scan_pass2(unsigned char* ws, int l, LAS unsigned char* lds) {
    int tid_ = threadIdx.x; asm volatile("" : "+v"(tid_));
    const int tid = tid_, lane = tid & 63, seg = tid >> 6;
    const float* LC = (const float*)(ws + WS_LC) + l * 2048; const f32x2* SUM = (const f32x2*)(ws + WS_SUM);
    LAS f32x2* HF = (LAS f32x2*)lds;
    LAS f32x4* SEG = (LAS f32x4*)(lds + 131072);
    LAS f32x2* CAR = (LAS f32x2*)(lds + 131072 + 8192);
    for (int item = blockIdx.x; item < 1024; item += gridDim.x) {
        const int grp = item & 7, chunk = (item >> 3) & 63, b = item >> 9;
        const int ch = grp * 128 + 2 * lane;
        bf16_t* ZG = (bf16_t*)(ws + WS_ZG) + ((size_t)b * S + chunk * 256) * 1024 + ch;
#pragma unroll 1
        for (int dir = 0; dir < 2; ++dir) {
            const float l0 = LC[dir * 1024 + ch] * (1.f / 255.f), l1 = LC[dir * 1024 + ch + 1] * (1.f / 255.f);
            const bf16_t* U = (const bf16_t*)(ws + WS_U) + (size_t)dir * T * 1024 + ((size_t)b * S + chunk * 256) * 1024 + ch;
            const unsigned char* R = ws + WS_R + (size_t)dir * T * 1024 + ((size_t)b * S + chunk * 256) * 1024 + ch;
            { float A0 = 1.f, A1 = 1.f, H0 = 0.f, H1 = 0.f;
#pragma unroll 8
              for (int k = 0; k < 32; ++k) { const int p = seg * 32 + k, to = dir ? 255 - p : p;
                  const unsigned uw = *(const unsigned*)(U + (size_t)to * 1024); const unsigned rw = *(const unsigned short*)(R + (size_t)to * 1024);
                  const float a0 = __expf(l0 * (float)(rw & 255u)), a1 = __expf(l1 * (float)(rw >> 8));
                  H0 = a0 * H0 + bflo(uw) * __builtin_sqrtf(1.f - a0 * a0); H1 = a1 * H1 + bfhi(uw) * __builtin_sqrtf(1.f - a1 * a1); A0 *= a0; A1 *= a1; }
              SEG[seg * 64 + lane] = (f32x4){A0, H0, A1, H1}; }
            if (tid < 64) { const f32x4* sp = (const f32x4*)(SUM + ((size_t)((dir * 2 + b) * 64)) * 1024 + grp * 128 + 2 * tid);
                float h0 = 0.f, h1 = 0.f;
                if (dir == 0) { for (int j = 0; j < chunk; ++j) { const f32x4 v = sp[(size_t)j * 512]; h0 = v[0] * h0 + v[1]; h1 = v[2] * h1 + v[3]; } }
                else { for (int j = 63; j > chunk; --j) { const f32x4 v = sp[(size_t)j * 512]; h0 = v[0] * h0 + v[1]; h1 = v[2] * h1 + v[3]; } }
                CAR[tid] = (f32x2){h0, h1}; }
            __syncthreads();
            float h0, h1; { const f32x2 c = CAR[lane]; h0 = c[0]; h1 = c[1]; }
            for (int s = 0; s < seg; ++s) { const f32x4 v = SEG[s * 64 + lane]; h0 = v[0] * h0 + v[1]; h1 = v[2] * h1 + v[3]; }
#pragma unroll 8
            for (int k = 0; k < 32; ++k) { const int p = seg * 32 + k, to = dir ? 255 - p : p;
                const unsigned uw = *(const unsigned*)(U + (size_t)to * 1024); const unsigned rw = *(const unsigned short*)(R + (size_t)to * 1024);
                const float a0 = __expf(l0 * (float)(rw & 255u)), a1 = __expf(l1 * (float)(rw >> 8));
                h0 = a0 * h0 + bflo(uw) * __builtin_sqrtf(1.f - a0 * a0); h1 = a1 * h1 + bfhi(uw) * __builtin_sqrtf(1.f - a1 * a1);
                if (dir == 0) HF[to * 64 + lane] = (f32x2){h0, h1};
                else { const f32x2 hf = HF[to * 64 + lane]; const unsigned gw = *(const unsigned*)(ZG + (size_t)to * 1024);
                    *(unsigned*)(ZG + (size_t)to * 1024) = (ABL == 1) ? 0u : cvt_pk_bf16((hf[0] + h0) * gelu_(bflo(gw)), (hf[1] + h1) * gelu_(bfhi(gw))); } }
            __syncthreads();
        }
    }
}

#ifdef DBG
constexpr size_t WS_DBG = 70000;
__device__ __forceinline__ float bfv(const bf16_t* p) { return bflo((unsigned)*p); }
__device__ __forceinline__ float dotA(const bf16_t* arow, const float* W, int K, int N, int col) { float s = 0.f; for (int k = 0; k < K; ++k) s += bfv(arow + k) * W[(size_t)k * N + col]; return s; }
__device__ __forceinline__ void dbg_cmp(unsigned* dbg, unsigned code, float got, float ref, float tol_rel, float tol_abs) {
    const float e = fabsf(got - ref); if (!(e <= tol_rel * fabsf(ref) + tol_abs)) atomicMin(dbg, code); }
__device__ __forceinline__ void dbg_check(int stage, const float* const* tab, unsigned char* ws, float* X) {
    unsigned* dbg = (unsigned*)(ws + WS_DBG); const int t = blockIdx.x * 64 + threadIdx.x;
    int r = (int)(((long)t * 5273 + 17) % T); const bf16_t* XN = (const bf16_t*)(ws + WS_XN);
    { const int q = t >> 1; const int base = (q & 1) ? S : 0;
      if (t < 40) { const int k = q >> 1; const int off = (k == 0) ? 0 : (k == 1) ? 1 : (k == 2) ? 2 : (k == 3) ? 127 : (k == 4) ? 128 : (k == 5) ? 255 : (k == 6) ? 256 : (k == 7) ? S - 1 : (k == 8) ? S - 2 : S - 3; r = base + off; } }
    if (stage == 2) { const int c = (int)((long)t * 911 + 3) % FF; const float g = dotA(XN + (size_t)r * D, (in_ptr(tab, DBG_F ? 26 : 2) + (size_t)DBG_LAYER * (D*FF)), D, FF, c), u = dotA(XN + (size_t)r * D, (in_ptr(tab, DBG_F ? 27 : 3) + (size_t)DBG_LAYER * (D*FF)), D, FF, c);
        dbg_cmp(dbg, 2, bfv((const bf16_t*)(ws + WS_H) + (size_t)r * FF + c), g / (1.f + expf(-g)) * u, 0.03f, 0.03f); }
    if (stage == 3) { const int c = (int)((long)t * 911 + 3) % D; dbg_cmp(dbg, 3, bfv((const bf16_t*)(ws + WS_F) + (size_t)r * D + c), dotA((const bf16_t*)(ws + WS_H) + (size_t)r * FF, (in_ptr(tab, DBG_F ? 28 : 4) + (size_t)DBG_LAYER * (D*FF)), FF, D, c), 0.03f, 0.03f); }
    if (stage == 4) { const int c = (int)((long)t * 911 + 3) % D; const bf16_t* F = (const bf16_t*)(ws + WS_F) + (size_t)r * D; float ss = 0.f; for (int k = 0; k < D; ++k) ss += bfv(F + k) * bfv(F + k);
        const float* x0 = in_ptr(tab, 0) + (size_t)r * D; float s2 = 0.f;
        for (int k = 0; k < D; ++k) { const float xv = x0[k] + 0.5f * bfv(F + k) * rsqrtf(ss / D + EPS) * (in_ptr(tab, 5) + (size_t)DBG_LAYER * (D))[k]; s2 += xv * xv; if (k == c) dbg_cmp(dbg, 4, X[(size_t)r * D + c], xv, 0.001f, 0.001f); }
        dbg_cmp(dbg, 4, bfv(XN + (size_t)r * D + c), X[(size_t)r * D + c] * rsqrtf(s2 / D + EPS) * (in_ptr(tab, 6) + (size_t)DBG_LAYER * (D))[c], 0.01f, 0.01f); }
    if (stage == 5) { const int c = (int)((long)t * 911 + 3) % ZN; const float z = dotA(XN + (size_t)r * D, (in_ptr(tab, 7) + (size_t)DBG_LAYER * (D*DIN)), D, DIN, c); float got;
        if (c < 1024) got = bfv((const bf16_t*)(ws + WS_ZG) + (size_t)r * 1024 + c); else if (c < 2048) got = bfv((const bf16_t*)(ws + WS_ZX) + (size_t)r * 1024 + c - 1024);
        else if (c < 3584) got = bfv((const bf16_t*)(ws + WS_ZSC) + (size_t)r * 1536 + c - 2048); else got = bfv((const bf16_t*)(ws + WS_ZSGU) + (size_t)r * 1024 + c - 3584);
        dbg_cmp(dbg, 5, got, z, 0.03f, 0.03f); }
    if (stage == 6) { const int b = r / S, tt = r % S; const size_t rb = (size_t)b * S;
        { const int c = (int)((long)t * 911 + 3) % 1024; float o = (in_ptr(tab, 9) + (size_t)DBG_LAYER * (1024))[c]; for (int k = 0; k < 4; ++k) { const int q = tt + k - 2; if (q >= 0 && q < S) o += (in_ptr(tab, 8) + (size_t)DBG_LAYER * (4096))[k * 1024 + c] * bfv((const bf16_t*)(ws + WS_ZX) + (rb + q) * 1024 + c); }
          dbg_cmp(dbg, 6, bfv((const bf16_t*)(ws + WS_XC) + (size_t)r * 1024 + c), o, 0.02f, 0.02f); }
        { const int c = (int)((long)t * 911 + 3) % 512; const bf16_t* Z = (const bf16_t*)(ws + WS_ZSC); float o = 0.f; for (int k = 0; k < 3; ++k) { const int q = tt + k - 1; if (q >= 0 && q < S) o += (in_ptr(tab, 16) + (size_t)DBG_LAYER * (1536))[k * 512 + c] * bfv(Z + (rb + q) * 1536 + 512 + c) * bfv(Z + (rb + q) * 1536 + 1024 + c); }
          dbg_cmp(dbg, 7, bfv((const bf16_t*)(ws + WS_YBC) + (size_t)r * 1024 + c), o * bfv(Z + (size_t)r * 1536 + c), 0.02f, 0.02f); }
        { const int c = (int)((long)t * 911 + 3) % 512, g = c >> 7, p = tt & 127, t0 = tt - p; const bf16_t* Z = (const bf16_t*)(ws + WS_ZSGU); float mix = (in_ptr(tab, 21) + (size_t)DBG_LAYER * (512))[g * 128 + p];
          for (int q = 0; q < 128; ++q) { const bf16_t* vr = Z + (rb + t0 + q) * 1024 + 512; float mu = 0.f, var = 0.f; for (int k = 0; k < 512; ++k) mu += gelu_(bfv(vr + k)); mu /= 512.f;
              for (int k = 0; k < 512; ++k) { const float d = gelu_(bfv(vr + k)) - mu; var += d * d; } var /= 512.f;
              const float vn = (gelu_(bfv(vr + c)) - mu) * rsqrtf(var + EPS) * (in_ptr(tab, 18) + (size_t)DBG_LAYER * (512))[c] + (in_ptr(tab, 19) + (size_t)DBG_LAYER * (512))[c]; mix += (in_ptr(tab, 20) + (size_t)DBG_LAYER * (65536))[(size_t)g * 16384 + p * 128 + q] * vn; }
          dbg_cmp(dbg, 8, bfv((const bf16_t*)(ws + WS_YBC) + (size_t)r * 1024 + 512 + c), gelu_(bfv(Z + (size_t)r * 1024 + c)) * mix, 0.03f, 0.03f); } }
    if (stage == 9) { const int c = (int)((long)t * 911 + 3) % 1024, dir = t & 1, head = c >> 8, e = c & 255; const bf16_t* xr = (const bf16_t*)(ws + WS_XC) + (size_t)r * 1024 + head * 256;
        const float pa = dotA(xr, (in_ptr(tab, 10) + (size_t)DBG_LAYER * (524288)) + (size_t)(dir * 4 + head) * 65536, 256, 256, e) + (in_ptr(tab, 11) + (size_t)DBG_LAYER * (2048))[dir * 1024 + c], px = dotA(xr, (in_ptr(tab, 12) + (size_t)DBG_LAYER * (524288)) + (size_t)(dir * 4 + head) * 65536, 256, 256, e) + (in_ptr(tab, 13) + (size_t)DBG_LAYER * (2048))[dir * 1024 + c];
        const float rr = 1.f / (1.f + expf(-pa)), ii = 1.f / (1.f + expf(-px));
        dbg_cmp(dbg, 9, (float)*(ws + WS_R + (size_t)dir * T * 1024 + (size_t)r * 1024 + c), rr * 255.f, 0.02f, 1.5f);
        dbg_cmp(dbg, 10, bfv((const bf16_t*)(ws + WS_U) + (size_t)dir * T * 1024 + (size_t)r * 1024 + c), ii * bfv(xr + e), 0.03f, 0.03f); }
    if (stage == 11) { const int c = (int)((long)t * 911 + 3) % 1024, b = r / S, tt = r % S; const size_t rb = (size_t)b * S; const float* LC = (const float*)(ws + WS_LC) + DBG_LAYER * 2048; float hs = 0.f;
        for (int dir = 0; dir < 2; ++dir) { const bf16_t* U = (const bf16_t*)(ws + WS_U) + (size_t)dir * T * 1024; const unsigned char* R = ws + WS_R + (size_t)dir * T * 1024; float h = 0.f;
            if (dir == 0) { for (int q = 0; q <= tt; ++q) { const float a = expf(LC[c] * (float)R[(rb + q) * 1024 + c] / 255.f); h = a * h + bfv(U + (rb + q) * 1024 + c) * sqrtf(1.f - a * a); } }
            else { for (int q = S - 1; q >= tt; --q) { const float a = expf(LC[1024 + c] * (float)R[(rb + q) * 1024 + c] / 255.f); h = a * h + bfv(U + (rb + q) * 1024 + c) * sqrtf(1.f - a * a); } }
            hs += h; }
        const float gate = dotA(XN + (size_t)r * D, (in_ptr(tab, 7) + (size_t)DBG_LAYER * (D*DIN)), D, DIN, c);
        dbg_cmp(dbg, 11, bfv((const bf16_t*)(ws + WS_ZG) + (size_t)r * 1024 + c), hs * gelu_(gate), 0.03f, 0.03f); }
    if (stage == 10) { const int c = (int)((long)t * 911 + 3) % 1024; ((float*)(ws + WS_DBG + 1024))[t] = bfv((const bf16_t*)(ws + WS_ZG) + (size_t)r * 1024 + c); }
    if (stage == 12) { const int c = (int)((long)t * 911 + 3) % 3072; const float z = dotA(XN + (size_t)r * D, (in_ptr(tab, 7) + (size_t)DBG_LAYER * (D*DIN)), D, DIN, ZN + c);
        dbg_cmp(dbg, 12, bfv((const bf16_t*)(ws + WS_G) + (size_t)r * 3072 + c), 1.f / (1.f + expf(-z)), 0.02f, 0.01f); }
    if (stage == 13) { const int c = (int)((long)t * 911 + 3) % 1024; const bf16_t* G = (const bf16_t*)(ws + WS_G) + (size_t)r * 3072;
        const float ya = dotA((const bf16_t*)(ws + WS_ZG) + (size_t)r * 1024, (in_ptr(tab, 15) + (size_t)DBG_LAYER * (D*D)), 1024, 1024, c), yb = dotA((const bf16_t*)(ws + WS_YBC) + (size_t)r * 1024, (in_ptr(tab, 17) + (size_t)DBG_LAYER * (512*D)), 512, 1024, c), yc = dotA((const bf16_t*)(ws + WS_YBC) + (size_t)r * 1024 + 512, (in_ptr(tab, 22) + (size_t)DBG_LAYER * (512*D)), 512, 1024, c);
        dbg_cmp(dbg, 13, bfv((const bf16_t*)(ws + WS_MG) + (size_t)r * 1024 + c), bfv(G + c) * ya + bfv(G + 1024 + c) * yb + bfv(G + 2048 + c) * yc, 0.03f, 0.05f); }
    if (stage == 15) { const int c = (int)((long)t * 911 + 3) % D; float s2 = 0.f; for (int k = 0; k < D; ++k) s2 += X[(size_t)r * D + k] * X[(size_t)r * D + k];
        dbg_cmp(dbg, 15, bfv(XN + (size_t)r * D + c), X[(size_t)r * D + c] * rsqrtf(s2 / D + EPS) * (in_ptr(tab, DBG_G) + (size_t)DBG_GL * D)[c], 0.01f, 0.01f); }
    if (stage == 16) { const int c = (int)((long)t * 911 + 3) % D; const bf16_t* F = (const bf16_t*)(ws + WS_MX) + (size_t)r * D; float ss = 0.f; for (int k = 0; k < D; ++k) ss += bfv(F + k) * bfv(F + k);
        const float xb = X[(size_t)r * D + c];
        dbg_cmp(dbg, 16, ((const float*)(ws + WS_G))[(size_t)r * D + c], xb + bfv(F + c) * rsqrtf(ss / D + EPS) * (in_ptr(tab, 24) + (size_t)DBG_LAYER * D)[c], 0.001f, 0.001f); }
    if (stage == 17) { const int c = (int)((long)t * 911 + 3) % D; const bf16_t* F = (const bf16_t*)(ws + WS_F) + (size_t)r * D; float ss = 0.f; for (int k = 0; k < D; ++k) ss += bfv(F + k) * bfv(F + k);
        const float xb = X[(size_t)r * D + c];
        dbg_cmp(dbg, 17, ((const float*)(ws + WS_G))[(size_t)r * D + c], xb + 0.5f * bfv(F + c) * rsqrtf(ss / D + EPS) * (in_ptr(tab, 29) + (size_t)DBG_LAYER * D)[c], 0.001f, 0.001f); }
    if (stage == 14) { const int c = (int)((long)t * 911 + 3) % 1024; dbg_cmp(dbg, 14, bfv((const bf16_t*)(ws + WS_MX) + (size_t)r * 1024 + c), dotA((const bf16_t*)(ws + WS_MG) + (size_t)r * 1024, (in_ptr(tab, 23) + (size_t)DBG_LAYER * (D*D)), 1024, 1024, c), 0.03f, 0.03f); }
}
__global__ void __launch_bounds__(64) dbg_kernel(Args a, unsigned mask) {
    unsigned char* ws = a.ws; const float* const* tab = (const float* const*)(ws + WS_TAB);
    for (int st = 2; st <= 17; ++st) if ((mask >> st) & 1u) dbg_check(st, tab, ws, a.out);
}
__global__ void dbg_final(Args a) { const unsigned cde = *(volatile unsigned*)(a.ws + WS_DBG); a.out[0] = (cde != 99u) ? 1000.f + 100.f * (float)cde : 0.f; }
#define DBGCHK(st) do { if (l == DBG_LAYER && (st) == STOP_AT) return; } while (0)
#else
#define DBGCHK(st) do { } while (0)
#endif

__global__ void __launch_bounds__(NTHR, 2) fwd_kernel(Args a) {
    extern __shared__ __attribute__((aligned(16))) unsigned char lds_raw[];
    LAS unsigned char* lds = (LAS unsigned char*)lds_raw;
    cg::grid_group grid = cg::this_grid();
    unsigned char* ws = a.ws;
    { const float** tw = (const float**)(ws + WS_TAB);
      if (threadIdx.x == 0) {
#pragma unroll
          for (int i = 0; i < 30; ++i) tw[i] = a.in[i];
          __threadfence(); }
      __syncthreads(); }
    const float* const* tab = (const float* const*)(ws + WS_TAB);
    const int G = gridDim.x, c = blockIdx.x;
    bf16_t* XN = (bf16_t*)(ws + WS_XN);
    float* X = a.out;
    unsigned char* const ws0 = ws; const int G0 = G, c0 = c; float* const X0 = X;
    constexpr int BIG = 1 << 28;

#ifdef SKEL
    { const float* xin = a.in[0]; for (size_t i = (size_t)blockIdx.x * NTHR + threadIdx.x; i < (size_t)T * D; i += (size_t)gridDim.x * NTHR) a.out[i] = xin[i];
      GSYNC();
#if SKEL >= 2
      convert_layer(tab, ws, 0, lds); GSYNC();
#endif
#if SKEL >= 3
      lc_all(tab, ws); GSYNC();
#endif
#if SKEL >= 4
      ew_phase<false>(in_ptr(tab, 0), X, nullptr, 0.f, nullptr, in_ptr(tab, 1), XN); GSYNC();
#endif
#if SKEL >= 5
      ew_phase<true>(X, X, (const bf16_t*)(ws + WS_F), 0.5f, in_ptr(tab, 5), in_ptr(tab, 6), XN); GSYNC();
#endif
#if SKEL >= 6
      convert_layer(tab, ws, 1, lds); GSYNC();
#endif
      return; }
#endif
#ifdef DBG
    if (blockIdx.x == 0 && threadIdx.x == 0) *(unsigned*)(ws + WS_DBG) = 99u;
#endif
    PH(0) { convert_layer(tab, ws, 0, lds); lc_all(tab, ws); }
    PH(1) ew_phase<false>(in_ptr(tab, 0), X, nullptr, 0.f, nullptr, in_ptr(tab, 1), XN);
    GSYNC();
#ifdef DBG
    if (STOP_AT == 20) return;
#endif

#pragma unroll 1
    for (int l = 0; l < NLAYER_RUN; ++l) {
#pragma unroll 1
        for (int f = 0; f < 2; ++f) {
            unsigned long long wsv = (unsigned long long)ws0, xv = (unsigned long long)X0; int G = G0, c = c0;
#ifndef NOASM
            asm volatile("" : "+s"(wsv), "+s"(G), "+s"(c), "+s"(xv));
#endif
            unsigned char* ws = (unsigned char*)(GAS unsigned char*)wsv; float* X = (float*)(GAS float*)xv;
            const float* const* tab = (const float* const*)(ws + WS_TAB); bf16_t* XN = (bf16_t*)(ws + WS_XN);
            if (f == 1) {
                PH(2) { pg8::Gemm g{XN, XN, (const bf16_t*)(ws + W_IN), T, ZN, D, D, BIG, 0, 0}; pg8::StaticOrder So; So.init(T, ZN, G, c);
                  pg8::EpiBf<2> E{(bf16_t*)(ws + WS_ZG), 1024, (bf16_t*)(ws + WS_ZX), (bf16_t*)(ws + WS_ZSC), (bf16_t*)(ws + WS_ZSGU)};
                  pg8::gemm_phase<pg8::EpiBf<2>, true>(lds, g, So, E); }
                GSYNC();
                DBGCHK(5);
                PH(3) prep_phase(tab, ws, l, lds);
                GSYNC();
                DBGCHK(6);
                PH(4) { const bf16_t* XC = (const bf16_t*)(ws + WS_XC);
                  pg8::Gemm g{XC, XC, (const bf16_t*)(ws + W_LRU), T, 4096, 256, 1024, BIG, 2, 512}; pg8::StaticOrder So; So.init(T, 4096, G, c);
                  pg8::EpiGates E{XC, (bf16_t*)(ws + WS_U), ws + WS_R, in_ptr(tab, 11) + (size_t)l * 2048, in_ptr(tab, 13) + (size_t)l * 2048, (const float*)(ws + WS_LC)};
                  pg8::gemm_phase<pg8::EpiGates, true>(lds, g, So, E); }
                GSYNC();
                DBGCHK(9);
                PH(5) scan_pass1(ws, l, lds);
                GSYNC();
                PH(6) scan_pass2(ws, l, lds);
                GSYNC();
                DBGCHK(11);
                PH(7) { pg8::Gemm g{XN, XN, (const bf16_t*)(ws + W_IN) + (size_t)ZN * D, T, 3072, D, D, BIG, 0, 0}; pg8::StaticOrder So; So.init(T, 3072, G, c);
                  pg8::EpiBf<1> E{(bf16_t*)(ws + WS_G), 3072, nullptr, nullptr, nullptr};
                  pg8::gemm_phase<pg8::EpiBf<1>, true>(lds, g, So, E); }
                GSYNC();
                DBGCHK(12);
                PH(8) { pg8::Gemm g{(const bf16_t*)(ws + WS_ZG), (const bf16_t*)(ws + WS_YBC) - 16 * 64, (const bf16_t*)(ws + W_CAT), T, D, 2048, 1024, 16, 0, 0}; pg8::StaticOrder So; So.init(T, D, G, c);
                  pg8::EpiMerge E{(const bf16_t*)(ws + WS_G), (bf16_t*)(ws + WS_MG)};
                  pg8::gemm_phase<pg8::EpiMerge, true>(lds, g, So, E); }
                GSYNC();
                DBGCHK(13);
                PH(9) { const bf16_t* MG = (const bf16_t*)(ws + WS_MG);
                  pg8::Gemm g{MG, MG, (const bf16_t*)(ws + W_O), T, D, D, D, BIG, 0, 0}; pg8::StaticOrder So; So.init(T, D, G, c);
                  pg8::EpiBf<0> E{(bf16_t*)(ws + WS_MX), 1024, nullptr, nullptr, nullptr};
                  pg8::gemm_phase<pg8::EpiBf<0>, true>(lds, g, So, E); }
                GSYNC();
                DBGCHK(14);
#if defined(DBG) && STOP_AT == 21
                PH(10) ew_phase<true>(X, (float*)(ws + WS_G), (const bf16_t*)(ws + WS_MX), 1.f, in_ptr(tab, 24) + (size_t)l * D, in_ptr(tab, 25) + (size_t)l * D, XN);
#else
                PH(10) ew_phase<true>(X, X, (const bf16_t*)(ws + WS_MX), 1.f, in_ptr(tab, 24) + (size_t)l * D, in_ptr(tab, 25) + (size_t)l * D, XN);
#endif
                GSYNC();
                DBGCHK(21);
            }
            PH(11) { pg8::Gemm g{XN, XN, (const bf16_t*)(ws + (f ? W_UP2 : W_UP1)), T, 2 * FF, D, D, BIG, 0, 0}; pg8::StaticOrder So; So.init(T, 2 * FF, G, c);
              pg8::EpiSwiGLU E{(bf16_t*)(ws + WS_H), FF};
              pg8::gemm_phase<pg8::EpiSwiGLU, true>(lds, g, So, E); }
            GSYNC();
            if (f == DBG_F) DBGCHK(2);
            PH(12) { const bf16_t* H = (const bf16_t*)(ws + WS_H);
              pg8::Gemm g{H, H, (const bf16_t*)(ws + (f ? W_DN2 : W_DN1)), T, D, FF, FF, BIG, 0, 0}; pg8::StaticOrder So; So.init(T, D, G, c);
              pg8::EpiBf<0> E{(bf16_t*)(ws + WS_F), 1024, nullptr, nullptr, nullptr};
              pg8::gemm_phase<pg8::EpiBf<0>, true>(lds, g, So, E); }
            GSYNC();
            if (f == DBG_F) DBGCHK(3);
            if (f == 0) {
                ew_phase<true>(X, X, (const bf16_t*)(ws + WS_F), 0.5f, in_ptr(tab, 5) + (size_t)l * D, in_ptr(tab, 6) + (size_t)l * D, XN);
            } else {
                if (l + 1 < DEPTH) convert_layer(tab, ws, l + 1, lds);
#if defined(DBG) && STOP_AT == 22
                ew_phase<true>(X, (l == DBG_LAYER) ? (float*)(ws + WS_G) : X, (const bf16_t*)(ws + WS_F), 0.5f, in_ptr(tab, 29) + (size_t)l * D, (l + 1 < DEPTH) ? in_ptr(tab, 1) + (size_t)(l + 1) * D : nullptr, XN);
#else
                ew_phase<true>(X, X, (const bf16_t*)(ws + WS_F), 0.5f, in_ptr(tab, 29) + (size_t)l * D, (l + 1 < DEPTH) ? in_ptr(tab, 1) + (size_t)(l + 1) * D : nullptr, XN);
#endif
            }
            GSYNC();
            if (f == 0) DBGCHK(4);
            if (f == 1) DBGCHK(22);
        }
    }
}

extern "C" void kernel_launch(void* const* d_in, const int* in_sizes, int n_in, void* d_out, int out_size, void* d_ws, size_t ws_size, hipStream_t stream) {
    static int grid = 0;
    if (grid == 0) {
        if (n_in != 30 || in_sizes[0] != T * D || out_size != T * D || ws_size < WS_END) { fprintf(stderr, "kernel_launch: unexpected problem geometry (n_in %d, ws %zu)\n", n_in, ws_size); grid = -1; return; }
        int dev = 0, cus = 0, per_cu = 0;
        if (hipGetDevice(&dev) != hipSuccess || hipDeviceGetAttribute(&cus, hipDeviceAttributeMultiprocessorCount, dev) != hipSuccess) { grid = -1; return; }
        if (hipFuncSetAttribute((const void*)fwd_kernel, hipFuncAttributeMaxDynamicSharedMemorySize, LDS_BYTES) != hipSuccess) { fprintf(stderr, "kernel_launch: hipFuncSetAttribute failed\n"); grid = -1; return; }
        if (hipOccupancyMaxActiveBlocksPerMultiprocessor(&per_cu, (const void*)fwd_kernel, NTHR, LDS_BYTES) != hipSuccess || per_cu < 1) { fprintf(stderr, "kernel_launch: occupancy query failed (%d)\n", per_cu); (void)hipGetLastError(); grid = -1; return; }
        grid = cus * per_cu;
    }
    if (grid < 0) return;
    Args a{};
    for (int i = 0; i < 30; ++i) a.in[i] = (const float*)d_in[i];
    a.out = (float*)d_out; a.ws = (unsigned char*)d_ws;
    void* args[] = {&a};
    hipError_t e = hipLaunchCooperativeKernel((const void*)fwd_kernel, dim3(grid), dim3(NTHR), args, LDS_BYTES, stream);
    if (e != hipSuccess) fprintf(stderr, "kernel_launch: cooperative launch failed: %s (grid %d)\n", hipGetErrorString(e), grid);
#ifdef DBG
    dbg_kernel<<<128, 64, 0, stream>>>(a, (unsigned)DBG_MASK);
    dbg_final<<<1, 1, 0, stream>>>(a);
#endif
}
```

```cpp
#include <hip/hip_runtime.h>
#include <hip/hip_cooperative_groups.h>
#include <cstdio>
#include <cstdint>
namespace cg = cooperative_groups;

#define LAS __attribute__((address_space(3)))
typedef unsigned short bf16_t;
typedef short bf16x8 __attribute__((ext_vector_type(8)));
typedef float f32x4 __attribute__((ext_vector_type(4)));
typedef float f32x2 __attribute__((ext_vector_type(2)));
typedef unsigned u32x4 __attribute__((ext_vector_type(4)));
typedef unsigned u32x2 __attribute__((ext_vector_type(2)));

constexpr int NB = 2, S = 16384, T = NB * S, D = 1024, FF = 2816, DIN = 7680, ZN = 4608, DEPTH = 4;
constexpr float EPS = 1e-6f;
constexpr int NTHR = 512, NWAVES = 8;

constexpr size_t MiB = 1u << 20;
constexpr size_t WS_LC = 0;
constexpr size_t WS_TAB = 65536;
constexpr size_t WS_SUM = 1 * MiB;
constexpr size_t WS_W = 4 * MiB;
constexpr size_t W_UP1 = WS_W, W_DN1 = W_UP1 + 11 * MiB, W_IN = W_DN1 + 11 * MiB / 2, W_LRU = W_IN + 15 * MiB, W_CAT = W_LRU + 2 * MiB,
                 W_O = W_CAT + 4 * MiB, W_UP2 = W_O + 2 * MiB, W_DN2 = W_UP2 + 11 * MiB, W_END = W_DN2 + 11 * MiB / 2;
static_assert(W_END == 60 * MiB, "weight map");
constexpr size_t WS_XN = 60 * MiB;
constexpr size_t WS_ZG = 124 * MiB, WS_ZX = 188 * MiB, WS_ZSC = 252 * MiB, WS_ZSGU = 348 * MiB, WS_XC = 412 * MiB, WS_YBC = 476 * MiB, WS_END = 540 * MiB;
constexpr size_t WS_U = 188 * MiB, WS_R = 316 * MiB;
constexpr size_t WS_G = 188 * MiB;
constexpr size_t WS_MG = 380 * MiB;
constexpr size_t WS_MX = 124 * MiB;
constexpr size_t WS_H = 124 * MiB;
constexpr size_t WS_F = 316 * MiB;

constexpr int LDS_BYTES = 147456;
#ifndef PHM
#define PHM 0xFFFF
#define NLAYER_RUN DEPTH
#define STOP_AT 11
#define DBG_MASK ((1u << 9) | (1u << 11))
#define DBG_LAYER 1
#define DBG_F 0
#define DBG_G 1
#define DBG_GL 0
#ifndef ABL
#define ABL 0
#endif
#endif
#define PH(b) if constexpr ((PHM >> (b)) & 1)
#define GSYNC_CG() do { asm volatile("s_waitcnt vmcnt(0)" ::: "memory"); __threadfence(); grid.sync(); } while (0)
#define GSYNC() xsync(ws, lds)

struct Args { const float* in[30]; float* out; unsigned char* ws; };

typedef _Float16 h16x2 __attribute__((ext_vector_type(2)));
typedef _Float16 h16x8 __attribute__((ext_vector_type(8)));
__device__ __forceinline__ unsigned cvt_pk_bf16(float lo, float hi) { h16x2 v; v.x = (_Float16)lo; v.y = (_Float16)hi; return __builtin_bit_cast(unsigned, v); }
__device__ __forceinline__ float bflo(unsigned u) { return (float)__builtin_bit_cast(h16x2, u).x; }
__device__ __forceinline__ float bfhi(unsigned u) { return (float)__builtin_bit_cast(h16x2, u).y; }
__device__ __forceinline__ float rcpf_(float x) { return __builtin_amdgcn_rcpf(x); }
__device__ __forceinline__ float sigm(float x) { return rcpf_(1.f + __expf(-x)); }
__device__ __forceinline__ float silu_(float x) { return x * sigm(x); }
__device__ __forceinline__ float gelu_(float x) { const float u = 1.5957691216057308f * (x + 0.044715f * x * x * x); return x * sigm(u); }
#define GAS __attribute__((address_space(1)))
__device__ __forceinline__ const float* in_ptr(const float* const* tab, int i) {
    unsigned long long v = *(const unsigned long long*)(tab + i);
    const unsigned lo = __builtin_amdgcn_readfirstlane((unsigned)v), hi = __builtin_amdgcn_readfirstlane((unsigned)(v >> 32));
    v = ((unsigned long long)hi << 32) | lo;
    return (const float*)(GAS const float*)v;
}
__device__ __forceinline__ float wave_sum(float v, int lane) {
#pragma unroll
    for (int o = 1; o < 64; o <<= 1) v += __int_as_float(__builtin_amdgcn_ds_bpermute((lane ^ o) << 2, __float_as_int(v)));
    return v;
}

constexpr size_t WS_BAR = 131072;
constexpr int LDS_BAR_ST = LDS_BYTES - 64;
#define XB_TMO      128
#define XB_XCNT(j)  (256  + 64 * (j))
#define XB_XSUB(j)  (1280 + 64 * (j))
#define XB_XGEN(j)  (2304 + 64 * (j))
#define XB_TOP      3328
#define XB_TOPGEN   3392
#define XCD_BAR_WORDS 3456
#define XB_SPIN_CAP (1u << 20)
__device__ __forceinline__ unsigned xb_ld(unsigned* p)              { return __hip_atomic_load(p, __ATOMIC_RELAXED, __HIP_MEMORY_SCOPE_AGENT); }
__device__ __forceinline__ unsigned xb_add(unsigned* p, unsigned v) { return __hip_atomic_fetch_add(p, v, __ATOMIC_RELAXED, __HIP_MEMORY_SCOPE_AGENT); }
__device__ __forceinline__ unsigned xb_xcc_id() { return (unsigned)__builtin_amdgcn_s_getreg((3 << 11) | 20) & 0xFu; }
#define XB_SPIN(cond, bar) do { unsigned _sp = 0; while (cond) { __builtin_amdgcn_s_sleep(1); \
    if ((++_sp & 255u) == 0u) { if (xb_ld(&(bar)[XB_TMO])) break; if (_sp > XB_SPIN_CAP) { atomicAdd(&(bar)[XB_TMO], 1u); break; } } } } while (0)
__device__ __forceinline__ void xcd_barrier_complete(unsigned* bar, unsigned x, unsigned& nloc, unsigned& nx) {
    const unsigned G = gridDim.x * gridDim.y * gridDim.z;
    unsigned sum, cnt, mine, sp = 0u;
    for (;;) {
        sum = 0u; cnt = 0u; mine = 0u;
#pragma unroll
        for (unsigned j = 0; j < 16; ++j) { const unsigned c = xb_ld(&bar[XB_XCNT(j)]); sum += c; cnt += (c > 0u) ? 1u : 0u; mine = (j == x) ? c : mine; }
        if (sum == G) break;
        __builtin_amdgcn_s_sleep(1);
        if ((++sp & 255u) == 0u) { if (xb_ld(&bar[XB_TMO])) break; if (sp > XB_SPIN_CAP) { atomicAdd(&bar[XB_TMO], 1u); break; } }
    }
    nloc = mine > 0u ? mine : 1u; nx = cnt > 0u ? cnt : 1u;
}
__device__ __forceinline__ void xsync(unsigned char* ws, LAS unsigned char* lds) {
    asm volatile("s_waitcnt vmcnt(0)" ::: "memory");
    __syncthreads();
    if (threadIdx.x == 0) {
        unsigned* bar = (unsigned*)(ws + WS_BAR); const unsigned x = xb_xcc_id();
        volatile LAS unsigned* st = (volatile LAS unsigned*)(lds + LDS_BAR_ST);
        __builtin_amdgcn_s_waitcnt(0);
        unsigned nloc = st[0], nx = st[1];
        if (nloc == 0u) { xcd_barrier_complete(bar, x, nloc, nx); st[0] = nloc; st[1] = nx; }
        const unsigned old = xb_add(&bar[XB_XSUB(x)], 1u);
        const unsigned gen = old / nloc;
        if (old + 1u == (gen + 1u) * nloc) {
            __builtin_amdgcn_fence(__ATOMIC_RELEASE, "agent");
            asm volatile("s_waitcnt vmcnt(0)" ::: "memory");
            const unsigned og = xb_add(&bar[XB_TOP], 1u);
            const unsigned tg = og / nx;
            if (og + 1u == (tg + 1u) * nx) xb_add(&bar[XB_TOPGEN], 1u);
            else XB_SPIN(xb_ld(&bar[XB_TOPGEN]) == tg, bar);
            __builtin_amdgcn_fence(__ATOMIC_ACQUIRE, "agent");
            xb_add(&bar[XB_XGEN(x)], 1u);
            asm volatile("s_waitcnt vmcnt(0)" ::: "memory");
        } else {
            XB_SPIN(xb_ld(&bar[XB_XGEN(x)]) == gen, bar);
            __builtin_amdgcn_fence(__ATOMIC_ACQUIRE, "agent");
            asm volatile("s_waitcnt vmcnt(0)" ::: "memory");
        }
    }
    __syncthreads();
}

namespace pg8 {
constexpr int BM = 256, BK = 64, HALF = 128, HTB = HALF * BK * 2, STAGE_BYTES = 8 * HTB, NXCD = 8, WGM = 8;
__host__ __device__ __forceinline__ int lds_byte(int r, int c) { const int st = (r >> 4) * 2 + (c >> 5), rr = r & 15, cc = c & 31, ob = rr * 64 + cc * 2; return st * 1024 + (ob ^ (((ob >> 9) & 1) << 5)); }
__host__ __device__ __forceinline__ void stage_rc(int b, int& R, int& C) { const int st = b / 1024, sb = b % 1024, swz = sb ^ (((sb >> 9) & 1) << 5); R = (st >> 1) * 16 + swz / 64; C = (st & 1) * 32 + (swz % 64) / 2; }
__host__ __device__ __forceinline__ int perm32(int rho) { const int n = rho >> 4, i = rho & 15; return 8 * (i >> 2) + 4 * n + (i & 3); }

struct Unit { int pm, pn; };
struct Gemm { const bf16_t* A; const bf16_t* A2; const bf16_t* Bt; int M, N, K, lda, ksplit, apn_shift, apn_bytes; };

struct StaticOrder {
    int nM, nN, nwg, G, c;
    __device__ void init(int M, int N, int G_, int c_) { nM = M / BM; nN = N / BM; nwg = nM * nN; G = G_; c = c_; }
    __device__ bool next(int i, Unit& u) const {
        const long L = (long)i * G + c; if (L >= nwg) return false;
        int wgid = (int)L; { const int q = nwg / NXCD, r = nwg % NXCD, xcd = wgid % NXCD, off = wgid / NXCD; wgid = (xcd < r ? xcd * (q + 1) : r * (q + 1) + (xcd - r) * q) + off; }
        const int nig = WGM * nN, gid = wgid / nig, fm = gid * WGM, gsz = (nM - fm) < WGM ? (nM - fm) : WGM;
        u.pm = fm + ((wgid % nig) % gsz); u.pn = (wgid % nig) / gsz; return true;
    }
};

template <class Epi, bool ALIGN_EPI>
__device__ __forceinline__ void gemm_phase(LAS unsigned char* lds, const Gemm g, const StaticOrder& S, const Epi& E) {
    int tid_ = threadIdx.x; asm volatile("" : "+v"(tid_));
    const int tid = tid_, wid = __builtin_amdgcn_readfirstlane(tid >> 6), lane = tid & 63, wr = wid >> 2, wc = wid & 3, fr = lane & 15, fq = lane >> 4;
    const int K = g.K, nt = K / BK, lda = g.lda;
    unsigned voffA[2], voffB[2];
#pragma unroll
    for (int i = 0; i < 2; ++i) { int R, C; stage_rc(tid * 16 + i * 8192, R, C); const int Rb = Epi::PERM ? ((R & ~31) + perm32(R & 31)) : R;
        voffA[i] = (unsigned)(R * lda + C) * 2u; voffB[i] = (unsigned)(Rb * K + C) * 2u; }
    const size_t kstep = (size_t)(BK * 2);
    const size_t hstepA = (size_t)HALF * lda * 2, tstepA = 2 * hstepA;
    const size_t hstepB = (size_t)HALF * K * 2, tstepB = 2 * hstepB;
    const unsigned ldsw = (unsigned)wid * 1024u;
    const int aoff = lds_byte(wr * 64 + fr, fq * 8), boff = lds_byte(wc * 32 + fr, fq * 8);
#define PG8_SA(b, h) (((b) * 2 + (h)) * HTB)
#define PG8_SB(b, h) ((4 + (b) * 2 + (h)) * HTB)
#define PG8_STAGE(bufoff, gbase, voff) do { _Pragma("unroll") for (int _i = 0; _i < 2; ++_i) \
        __builtin_amdgcn_global_load_lds((const unsigned*)((const char*)(gbase) + (voff)[_i]), (LAS unsigned*)(lds + (bufoff) + ldsw + _i * 8192), 16, 0, 0); } while (0)
#define PG8_LDA(dst, b, h) do { _Pragma("unroll") for (int m = 0; m < 4; ++m) _Pragma("unroll") for (int k = 0; k < 2; ++k) dst[m][k] = *(const LAS bf16x8*)(lds + PG8_SA(b, h) + aoff + m * 2048 + k * 1024); } while (0)
#define PG8_LDB(dst, b, h) do { _Pragma("unroll") for (int n = 0; n < 2; ++n) _Pragma("unroll") for (int k = 0; k < 2; ++k) dst[n][k] = *(const LAS bf16x8*)(lds + PG8_SB(b, h) + boff + n * 2048 + k * 1024); } while (0)
#define PG8_MMA(ai, bj, At, Bt) do { __builtin_amdgcn_s_setprio(1); _Pragma("unroll") for (int m = 0; m < 4; ++m) _Pragma("unroll") for (int n = 0; n < 2; ++n) _Pragma("unroll") for (int k = 0; k < 2; ++k) \
        acc[ai][bj][m][n] = __builtin_amdgcn_mfma_f32_16x16x32_f16(__builtin_bit_cast(h16x8, Bt[n][k]), __builtin_bit_cast(h16x8, At[m][k]), acc[ai][bj][m][n], 0, 0, 0); __builtin_amdgcn_s_setprio(0); } while (0)
#define PG8_WAIT_V(n) asm volatile("s_waitcnt vmcnt(" #n ")" ::: "memory")
#define PG8_WAIT_L(n) asm volatile("s_waitcnt lgkmcnt(" #n ")" ::: "memory")
#define PG8_BAR __builtin_amdgcn_s_barrier()
#define PG8_SCHED __builtin_amdgcn_sched_barrier(0)
    Unit cur, nxt; int ui = 0;
    if (!S.next(0, cur)) return;
    f32x4 acc[2][2][4][2];
#pragma unroll
    for (int a = 0; a < 2; ++a)
#pragma unroll
        for (int b = 0; b < 2; ++b)
#pragma unroll
            for (int m = 0; m < 4; ++m)
#pragma unroll
                for (int n = 0; n < 2; ++n) acc[a][b][m][n] = (f32x4){0.f, 0.f, 0.f, 0.f};
    bf16x8 At[4][2], B0[2][2], B1[2][2];
    const char* cA = (const char*)g.A + (size_t)cur.pm * tstepA + (size_t)(cur.pn >> g.apn_shift) * g.apn_bytes;
    const char* cA2 = (const char*)g.A2 + (size_t)cur.pm * tstepA;
    const char* cB = (const char*)g.Bt + (size_t)cur.pn * tstepB;
    PG8_STAGE(PG8_SB(0, 0), cB, voffB); PG8_STAGE(PG8_SB(0, 1), cB + hstepB, voffB); PG8_STAGE(PG8_SA(0, 0), cA, voffA); PG8_STAGE(PG8_SA(0, 1), cA + hstepA, voffA);
    if (wr == 1) PG8_BAR;
    PG8_WAIT_V(2); PG8_BAR;
    PG8_STAGE(PG8_SB(1, 0), cB + kstep, voffB); PG8_STAGE(PG8_SA(1, 0), cA + kstep, voffA); PG8_STAGE(PG8_SB(1, 1), cB + hstepB + kstep, voffB);
    PG8_WAIT_V(6); PG8_BAR;
    for (;;) {
        const bool has_next = S.next(ui + 1, nxt);
        const char* nA = has_next ? (const char*)g.A + (size_t)nxt.pm * tstepA + (size_t)(nxt.pn >> g.apn_shift) * g.apn_bytes : cA;
        const char* nA2 = has_next ? (const char*)g.A2 + (size_t)nxt.pm * tstepA : cA2;
        const char* nB = has_next ? (const char*)g.Bt + (size_t)nxt.pn * tstepB : cB;
        for (int t = 0; t < nt; t += 2) {
            const bool last = (t == nt - 2);
            const char* a1 = ((t < g.ksplit) ? cA : cA2) + (size_t)(t + 1) * kstep;
            const char* a2 = last ? nA : ((t + 2 < g.ksplit) ? cA : cA2) + (size_t)(t + 2) * kstep;
            const char* b2 = last ? nB : cB + (size_t)(t + 2) * kstep;
            const char* a3 = a2 + kstep; const char* b3 = b2 + kstep;
            if constexpr (Epi::HOOK) { if (t == g.ksplit || t == g.ksplit + 8) E.hook(acc, cur, (t - g.ksplit) >> 3, wr, wc, fr, fq); }
            PG8_LDB(B0, 0, 0); PG8_LDB(B1, 0, 1); PG8_SCHED; PG8_LDA(At, 0, 0); PG8_STAGE(PG8_SA(1, 1), a1 + hstepA, voffA);
            PG8_WAIT_V(8); PG8_WAIT_L(0); PG8_BAR; PG8_MMA(0, 0, At, B0); PG8_MMA(0, 1, At, B1); PG8_BAR; PG8_SCHED;
            PG8_LDA(At, 0, 1); PG8_STAGE(PG8_SB(0, 0), b2, voffB); PG8_STAGE(PG8_SB(0, 1), b2 + hstepB, voffB); PG8_STAGE(PG8_SA(0, 0), a2, voffA);
            PG8_WAIT_V(8); PG8_WAIT_L(0); PG8_BAR; PG8_MMA(1, 0, At, B0); PG8_MMA(1, 1, At, B1); PG8_BAR; PG8_SCHED;
            PG8_LDB(B0, 1, 0); PG8_LDB(B1, 1, 1); PG8_SCHED; PG8_LDA(At, 1, 0); PG8_STAGE(PG8_SA(0, 1), a2 + hstepA, voffA);
            PG8_WAIT_V(8); PG8_WAIT_L(0); PG8_BAR; PG8_MMA(0, 0, At, B0); PG8_MMA(0, 1, At, B1); PG8_BAR; PG8_SCHED;
            PG8_LDA(At, 1, 1); PG8_STAGE(PG8_SB(1, 0), b3, voffB); PG8_STAGE(PG8_SB(1, 1), b3 + hstepB, voffB); PG8_STAGE(PG8_SA(1, 0), a3, voffA);
            PG8_WAIT_V(8); PG8_WAIT_L(0); PG8_BAR; PG8_MMA(1, 0, At, B0); PG8_MMA(1, 1, At, B1); PG8_BAR; PG8_SCHED;
        }
        if constexpr (ALIGN_EPI) { if (wr == 0) PG8_BAR; }
        E(acc, cur, wr, wc, fr, fq);
        if (!has_next) break;
#pragma unroll
        for (int a = 0; a < 2; ++a)
#pragma unroll
            for (int b = 0; b < 2; ++b)
#pragma unroll
                for (int m = 0; m < 4; ++m)
#pragma unroll
                    for (int n = 0; n < 2; ++n) acc[a][b][m][n] = (f32x4){0.f, 0.f, 0.f, 0.f};
        cur = nxt; cA = nA; cA2 = nA2; cB = nB; ++ui;
        if constexpr (ALIGN_EPI) { if (wr == 1) PG8_BAR; }
    }
    PG8_WAIT_V(0);
    if constexpr (!ALIGN_EPI) { if (wr == 0) PG8_BAR; }
    PG8_BAR;
#undef PG8_SA
#undef PG8_SB
#undef PG8_STAGE
#undef PG8_LDA
#undef PG8_LDB
#undef PG8_MMA
#undef PG8_WAIT_V
#undef PG8_WAIT_L
#undef PG8_BAR
#undef PG8_SCHED
}

template <int MODE> struct EpiBf {
    static constexpr bool PERM = true, HOOK = false;
    bf16_t* O; int ldc; bf16_t* O1; bf16_t* O2; bf16_t* O3;
    __device__ __forceinline__ void operator()(const f32x4 (&acc)[2][2][4][2], const Unit& u, int wr, int wc, int fr, int fq) const {
        bf16_t* base = O; int ld = ldc; int colt = u.pn * BM;
        if (MODE == 2) { const int pn = u.pn;
            if (pn < 4) { base = O; ld = 1024; colt = pn * 256; } else if (pn < 8) { base = O1; ld = 1024; colt = (pn - 4) * 256; }
            else if (pn < 14) { base = O2; ld = 1536; colt = (pn - 8) * 256; } else { base = O3; ld = 1024; colt = (pn - 14) * 256; } }
        const int row0 = u.pm * BM + wr * 64 + fr, col0 = colt + wc * 32 + 8 * fq;
#pragma unroll
        for (int ai = 0; ai < 2; ++ai)
#pragma unroll
            for (int m = 0; m < 4; ++m) { bf16_t* rowp = base + (size_t)(row0 + ai * HALF + m * 16) * ld + col0;
#pragma unroll
                for (int bj = 0; bj < 2; ++bj) { f32x4 v0 = acc[ai][bj][m][0], v1 = acc[ai][bj][m][1];
                    if (MODE == 1) {
#pragma unroll
                        for (int j = 0; j < 4; ++j) { v0[j] = sigm(v0[j]); v1[j] = sigm(v1[j]); } }
                    u32x4 w; w.x = cvt_pk_bf16(v0[0], v0[1]); w.y = cvt_pk_bf16(v0[2], v0[3]); w.z = cvt_pk_bf16(v1[0], v1[1]); w.w = cvt_pk_bf16(v1[2], v1[3]);
                    *(u32x4*)(rowp + bj * HALF) = w; } }
    }
};
struct EpiSwiGLU {
    static constexpr bool PERM = true, HOOK = false;
    bf16_t* O; int ldc;
    __device__ __forceinline__ void operator()(const f32x4 (&acc)[2][2][4][2], const Unit& u, int wr, int wc, int fr, int fq) const {
        const int row0 = u.pm * BM + wr * 64 + fr, col0 = u.pn * HALF + wc * 32 + 8 * fq;
#pragma unroll
        for (int ai = 0; ai < 2; ++ai)
#pragma unroll
            for (int m = 0; m < 4; ++m) { bf16_t* rowp = O + (size_t)(row0 + ai * HALF + m * 16) * ldc + col0;
                f32x4 h0, h1;
#pragma unroll
                for (int j = 0; j < 4; ++j) { h0[j] = silu_(acc[ai][0][m][0][j]) * acc[ai][1][m][0][j]; h1[j] = silu_(acc[ai][0][m][1][j]) * acc[ai][1][m][1][j]; }
                u32x4 w; w.x = cvt_pk_bf16(h0[0], h0[1]); w.y = cvt_pk_bf16(h0[2], h0[3]); w.z = cvt_pk_bf16(h1[0], h1[1]); w.w = cvt_pk_bf16(h1[2], h1[3]);
                *(u32x4*)rowp = w; }
    }
};
struct EpiMerge {
    static constexpr bool PERM = true, HOOK = true;
    const bf16_t* G; bf16_t* O;
    __device__ __forceinline__ void hook(f32x4 (&acc)[2][2][4][2], const Unit& u, int which, int wr, int wc, int fr, int fq) const {
        int row0 = u.pm * BM + wr * 64 + fr, col0 = u.pn * BM + wc * 32 + 8 * fq + which * 1024;
        asm volatile("" : "+v"(row0), "+v"(col0));
#pragma unroll
        for (int ai = 0; ai < 2; ++ai)
#pragma unroll
            for (int m = 0; m < 4; ++m) { const bf16_t* gp = G + (size_t)(row0 + ai * HALF + m * 16) * 3072 + col0;
#pragma unroll
                for (int bj = 0; bj < 2; ++bj)
#pragma unroll
                    for (int n = 0; n < 2; ++n) { const u32x2 ga = *(const u32x2*)(gp + bj * HALF + 4 * n), gb = *(const u32x2*)(gp + 1024 + bj * HALF + 4 * n);
                        f32x4 r; r[0] = bflo(ga.x) * rcpf_(bflo(gb.x)); r[1] = bfhi(ga.x) * rcpf_(bfhi(gb.x)); r[2] = bflo(ga.y) * rcpf_(bflo(gb.y)); r[3] = bfhi(ga.y) * rcpf_(bfhi(gb.y));
                        acc[ai][bj][m][n] *= r; asm volatile("" ::: "memory"); } }
    }
    __device__ __forceinline__ void operator()(const f32x4 (&acc)[2][2][4][2], const Unit& u, int wr, int wc, int fr, int fq) const {
        const int row0 = u.pm * BM + wr * 64 + fr, col0 = u.pn * BM + wc * 32 + 8 * fq;
#pragma unroll
        for (int ai = 0; ai < 2; ++ai)
#pragma unroll
            for (int m = 0; m < 4; ++m) { const size_t r = (size_t)(row0 + ai * HALF + m * 16);
#pragma unroll
                for (int bj = 0; bj < 2; ++bj) { const u32x4 gc = *(const u32x4*)(G + r * 3072 + 2048 + col0 + bj * HALF);
                    const f32x4 v0 = acc[ai][bj][m][0], v1 = acc[ai][bj][m][1];
                    u32x4 w; w.x = cvt_pk_bf16(v0[0] * bflo(gc.x), v0[1] * bfhi(gc.x)); w.y = cvt_pk_bf16(v0[2] * bflo(gc.y), v0[3] * bfhi(gc.y));
                    w.z = cvt_pk_bf16(v1[0] * bflo(gc.z), v1[1] * bfhi(gc.z)); w.w = cvt_pk_bf16(v1[2] * bflo(gc.w), v1[3] * bfhi(gc.w));
                    *(u32x4*)(O + r * 1024 + col0 + bj * HALF) = w; }
                asm volatile("" ::: "memory"); }
    }
};
struct EpiGates {
    static constexpr bool PERM = false, HOOK = false;
    const bf16_t* XC; bf16_t* U; unsigned char* R; const float* ba; const float* bx; const float* lc;
    __device__ __forceinline__ void operator()(const f32x4 (&acc)[2][2][4][2], const Unit& u, int wr, int wc, int fr, int fq) const {
        int ch0 = 64 * u.pn + 16 * wc + 4 * fq, row0 = u.pm * BM + wr * 64 + fr;
        asm volatile("" : "+v"(row0), "+v"(ch0));
#pragma unroll
        for (int ai = 0; ai < 2; ++ai)
#pragma unroll
            for (int m = 0; m < 4; ++m) { const unsigned off = (unsigned)(row0 + ai * HALF + m * 16) * 1024u + (unsigned)ch0;
                const u32x2 xw = *(const u32x2*)((const char*)XC + (size_t)(off * 2u));
#pragma unroll
                for (int d = 0; d < 2; ++d) {
                    const f32x4 ba4 = *(const f32x4*)(ba + d * 1024 + ch0), bx4 = *(const f32x4*)(bx + d * 1024 + ch0);
                    f32x4 xc; xc[0] = bflo(xw.x); xc[1] = bfhi(xw.x); xc[2] = bflo(xw.y); xc[3] = bfhi(xw.y);
                    f32x4 uv; unsigned rq = 0;
#pragma unroll
                    for (int j = 0; j < 4; ++j) { const float rr = sigm(acc[ai][d][m][0][j] + ba4[j]), ig = sigm(acc[ai][d][m][1][j] + bx4[j]);
                        uv[j] = ig * xc[j];
                        rq |= ((unsigned)__builtin_rintf(rr * 255.f)) << (8 * j); }
                    u32x2 w; w.x = cvt_pk_bf16(uv[0], uv[1]); w.y = cvt_pk_bf16(uv[2], uv[3]);
                    *(u32x2*)((char*)(U + (size_t)d * T * 1024) + (size_t)(off * 2u)) = w;
                    *(unsigned*)((char*)(R + (size_t)d * T * 1024) + (size_t)off) = rq;
                    asm volatile("" ::: "memory"); } }
    }
};
}

__device__ __forceinline__ int w_rowmap(int mode, int n, int p0) {
    if (mode == 0) return n;
    if (mode == 1) return 256 * (n >> 7) + p0 + (n & 127);
    const int dir = p0 >> 3, head = (p0 >> 1) & 3, ri = p0 & 1, ch = 256 * head + n;
    return 256 * (ch >> 6) + 128 * dir + 32 * ((ch >> 4) & 3) + 16 * ri + (ch & 15);
}
__device__ __forceinline__ void tr_item(const float* W, int N, int item, bf16_t* WT, int ldk, int koff, int mode, int p0, LAS float* scr, int lane) {
    const int nblk = N / 32, kb = item / nblk, nb = item % nblk, k0 = 64 * kb, n0 = 32 * nb;
#pragma unroll 8
    for (int i = 0; i < 32; ++i) { const int kk = 2 * i + (lane >> 5); scr[kk * 33 + (lane & 31)] = W[(size_t)(k0 + kk) * N + n0 + (lane & 31)]; }
    asm volatile("s_waitcnt lgkmcnt(0)" ::: "memory");
    const int c = lane & 7;
#pragma unroll
    for (int j = 0; j < 4; ++j) { const int nn = (lane >> 3) + 8 * j; const LAS float* s = scr + (8 * c) * 33 + nn;
        u32x4 o; o.x = cvt_pk_bf16(s[0 * 33], s[1 * 33]); o.y = cvt_pk_bf16(s[2 * 33], s[3 * 33]); o.z = cvt_pk_bf16(s[4 * 33], s[5 * 33]); o.w = cvt_pk_bf16(s[6 * 33], s[7 * 33]);
        *(u32x4*)(WT + (size_t)w_rowmap(mode, n0 + nn, p0) * ldk + koff + k0 + 8 * c) = o; }
    asm volatile("s_waitcnt lgkmcnt(0)" ::: "memory");
}
__device__ __forceinline__ void convert_layer(const float* const* tab, unsigned char* ws, int l, LAS unsigned char* lds) {
    int tid_ = threadIdx.x; asm volatile("" : "+v"(tid_));
    const int tid = tid_, lane = tid & 63, wave = tid >> 6;
    LAS float* scr = (LAS float*)(lds + wave * 8448);
    const int gw = blockIdx.x * NWAVES + wave, NGW = gridDim.x * NWAVES;
    constexpr int I_UP = 16 * 88, I_DN = 44 * 32, I_IN = 16 * 240, I_LRU = 256, I_SQ = 512, I_HALF = 256;
    constexpr int NITEMS = 6 * I_UP + I_IN + 2 * I_LRU + 2 * I_SQ + 2 * I_HALF;
    const size_t oUP = (size_t)l * D * FF, oSQ = (size_t)l * D * D, oHF = (size_t)l * 512 * D, oLRU = (size_t)l * 2 * 4 * 256 * 256;
    for (int it = gw; it < NITEMS; it += NGW) {
        int r = it;
        if (r < I_UP) { tr_item(in_ptr(tab, 2) + oUP, FF, r, (bf16_t*)(ws + W_UP1), 1024, 0, 1, 0, scr, lane); continue; } r -= I_UP;
        if (r < I_UP) { tr_item(in_ptr(tab, 3) + oUP, FF, r, (bf16_t*)(ws + W_UP1), 1024, 0, 1, 128, scr, lane); continue; } r -= I_UP;
        if (r < I_DN) { tr_item(in_ptr(tab, 4) + oUP, D, r, (bf16_t*)(ws + W_DN1), FF, 0, 0, 0, scr, lane); continue; } r -= I_DN;
        if (r < I_IN) { tr_item(in_ptr(tab, 7) + (size_t)l * D * DIN, DIN, r, (bf16_t*)(ws + W_IN), 1024, 0, 0, 0, scr, lane); continue; } r -= I_IN;
        if (r < I_LRU) { const int mat = r >> 5; tr_item(in_ptr(tab, 10) + oLRU + (size_t)mat * 65536, 256, r & 31, (bf16_t*)(ws + W_LRU), 256, 0, 2, ((mat >> 2) << 3) | ((mat & 3) << 1) | 0, scr, lane); continue; } r -= I_LRU;
        if (r < I_LRU) { const int mat = r >> 5; tr_item(in_ptr(tab, 12) + oLRU + (size_t)mat * 65536, 256, r & 31, (bf16_t*)(ws + W_LRU), 256, 0, 2, ((mat >> 2) << 3) | ((mat & 3) << 1) | 1, scr, lane); continue; } r -= I_LRU;
        if (r < I_SQ) { tr_item(in_ptr(tab, 15) + oSQ, D, r, (bf16_t*)(ws + W_CAT), 2048, 0, 0, 0, scr, lane); continue; } r -= I_SQ;
        if (r < I_HALF) { tr_item(in_ptr(tab, 17) + oHF, D, r, (bf16_t*)(ws + W_CAT), 2048, 1024, 0, 0, scr, lane); continue; } r -= I_HALF;
        if (r < I_HALF) { tr_item(in_ptr(tab, 22) + oHF, D, r, (bf16_t*)(ws + W_CAT), 2048, 1536, 0, 0, scr, lane); continue; } r -= I_HALF;
        if (r < I_SQ) { tr_item(in_ptr(tab, 23) + oSQ, D, r, (bf16_t*)(ws + W_O), 1024, 0, 0, 0, scr, lane); continue; } r -= I_SQ;
        if (r < I_UP) { tr_item(in_ptr(tab, 26) + oUP, FF, r, (bf16_t*)(ws + W_UP2), 1024, 0, 1, 0, scr, lane); continue; } r -= I_UP;
        if (r < I_UP) { tr_item(in_ptr(tab, 27) + oUP, FF, r, (bf16_t*)(ws + W_UP2), 1024, 0, 1, 128, scr, lane); continue; } r -= I_UP;
        tr_item(in_ptr(tab, 28) + oUP, D, r, (bf16_t*)(ws + W_DN2), FF, 0, 0, 0, scr, lane);
    }
}
__device__ __forceinline__ void lc_all(const float* const* tab, unsigned char* ws) {
    float* LC = (float*)(ws + WS_LC); const float* lam = in_ptr(tab, 14);
    for (int i = blockIdx.x * NTHR + threadIdx.x; i < DEPTH * 2048; i += gridDim.x * NTHR) LC[i] = -8.f * log1pf(expf(-lam[i]));
}

template <bool HASF>
__device__ __forceinline__ void ew_phase(const float* xin, float* xout, const bf16_t* Fb, float scale, const float* post_g, const float* pre_g, bf16_t* XN) {
    int tid_ = threadIdx.x; asm volatile("" : "+v"(tid_));
    const int tid = tid_, lane = tid & 63, wave = tid >> 6;
    const int gw = blockIdx.x * NWAVES + wave, NGW = gridDim.x * NWAVES;
    for (int m = gw; m < T; m += NGW) {
        const f32x4* xr = (const f32x4*)(xin + (size_t)m * D) + lane;
        f32x4 v[4];
#pragma unroll
        for (int j = 0; j < 4; ++j) v[j] = xr[64 * j];
        if (HASF) {
            const u32x2* fr_ = (const u32x2*)(Fb + (size_t)m * D) + lane;
            f32x4 f[4]; float ss = 0.f;
#pragma unroll
            for (int j = 0; j < 4; ++j) { const u32x2 w = fr_[64 * j]; f[j][0] = bflo(w.x); f[j][1] = bfhi(w.x); f[j][2] = bflo(w.y); f[j][3] = bfhi(w.y);
                ss += (f[j][0] * f[j][0] + f[j][1] * f[j][1]) + (f[j][2] * f[j][2] + f[j][3] * f[j][3]); }
            const float rs = scale * __builtin_amdgcn_rsqf(wave_sum(ss, lane) * (1.f / D) + EPS);
#pragma unroll
            for (int j = 0; j < 4; ++j) { const f32x4 pg = *((const f32x4*)post_g + 64 * j + lane); v[j] += f[j] * rs * pg; }
        }
        if (HASF || xin != xout) {
            f32x4* xo = (f32x4*)(xout + (size_t)m * D) + lane;
#pragma unroll
            for (int j = 0; j < 4; ++j) xo[64 * j] = v[j];
        }
        if (pre_g) {
            float s2 = 0.f;
#pragma unroll
            for (int j = 0; j < 4; ++j) s2 += (v[j][0] * v[j][0] + v[j][1] * v[j][1]) + (v[j][2] * v[j][2] + v[j][3] * v[j][3]);
            const float rs2 = __builtin_amdgcn_rsqf(wave_sum(s2, lane) * (1.f / D) + EPS);
            u32x2* o = (u32x2*)(XN + (size_t)m * D) + lane;
#pragma unroll
            for (int j = 0; j < 4; ++j) { const f32x4 g = *((const f32x4*)pre_g + 64 * j + lane); const f32x4 y = v[j] * rs2 * g;
                u32x2 w; w.x = cvt_pk_bf16(y[0], y[1]); w.y = cvt_pk_bf16(y[2], y[3]); o[64 * j] = w; }
        }
    }
}

constexpr int VT_PITCH = 272;
__device__ __forceinline__ void prep_phase(const float* const* tab, unsigned char* ws, int l, LAS unsigned char* lds) {
    int tid_ = threadIdx.x; asm volatile("" : "+v"(tid_));
    const int tid = tid_, lane = tid & 63, wave = tid >> 6;
    const bf16_t* ZX = (const bf16_t*)(ws + WS_ZX); const bf16_t* ZSC = (const bf16_t*)(ws + WS_ZSC); const bf16_t* ZSGU = (const bf16_t*)(ws + WS_ZSGU);
    bf16_t* XC = (bf16_t*)(ws + WS_XC); bf16_t* YBC = (bf16_t*)(ws + WS_YBC);
    for (int item = blockIdx.x; item < T / 128; item += gridDim.x) {
        const int b = item >> 7, n = item & 127, t0 = n * 128; const size_t rb = (size_t)b * S;
        {
            const int c = 2 * tid; const float* cw = in_ptr(tab, 8) + (size_t)l * 4096; const float* cb = in_ptr(tab, 9) + (size_t)l * 1024;
            const f32x2 w0 = *(const f32x2*)(cw + c), w1 = *(const f32x2*)(cw + 1024 + c), w2 = *(const f32x2*)(cw + 2048 + c), w3 = *(const f32x2*)(cw + 3072 + c), bb = *(const f32x2*)(cb + c);
            const bf16_t* src = ZX + rb * 1024 + c;
#define LDX(t) (((t) >= 0 && (t) < S) ? *(const unsigned*)(src + (size_t)(t) * 1024) : 0u)
            unsigned xm2 = LDX(t0 - 2), xm1 = LDX(t0 - 1), x0 = LDX(t0), xp1 = LDX(t0 + 1);
            for (int i = 0; i < 128; ++i) { const int t = t0 + i; const unsigned xn = LDX(t + 2);
                const float o0 = bb[0] + w0[0] * bflo(xm2) + w1[0] * bflo(xm1) + w2[0] * bflo(x0) + w3[0] * bflo(xp1);
                const float o1 = bb[1] + w0[1] * bfhi(xm2) + w1[1] * bfhi(xm1) + w2[1] * bfhi(x0) + w3[1] * bfhi(xp1);
                *(unsigned*)(XC + (rb + t) * 1024 + c) = cvt_pk_bf16(o0, o1);
                xm2 = xm1; xm1 = x0; x0 = xp1; xp1 = xn; }
#undef LDX
        }
        {
            const int half = tid >> 8, c = 2 * (tid & 255), tb = t0 + 64 * half; const float* cw = in_ptr(tab, 16) + (size_t)l * 1536;
            const f32x2 w0 = *(const f32x2*)(cw + c), w1 = *(const f32x2*)(cw + 512 + c), w2 = *(const f32x2*)(cw + 1024 + c);
            const bf16_t* src = ZSC + rb * 1536 + c;
#define LDP(t, p0_, p1_) do { if ((t) >= 0 && (t) < S) { const unsigned c_ = *(const unsigned*)(src + (size_t)(t) * 1536 + 512), x_ = *(const unsigned*)(src + (size_t)(t) * 1536 + 1024); p0_ = bflo(c_) * bflo(x_); p1_ = bfhi(c_) * bfhi(x_); } else { p0_ = 0.f; p1_ = 0.f; } } while (0)
            float pm0, pm1, pc0, pc1, pp0, pp1; LDP(tb - 1, pm0, pm1); LDP(tb, pc0, pc1); LDP(tb + 1, pp0, pp1);
            for (int i = 0; i < 64; ++i) { const int t = tb + i; float pn0, pn1; LDP(t + 2, pn0, pn1);
                const unsigned bw = *(const unsigned*)(src + (size_t)t * 1536);
                const float o0 = bflo(bw) * (w0[0] * pm0 + w1[0] * pc0 + w2[0] * pp0), o1 = bfhi(bw) * (w0[1] * pm1 + w1[1] * pc1 + w2[1] * pp1);
                *(unsigned*)(YBC + (rb + t) * 1024 + c) = (ABL == 2) ? 0u : cvt_pk_bf16(o0, o1);
                pm0 = pc0; pm1 = pc1; pc0 = pp0; pc1 = pp1; pp0 = pn0; pp1 = pn1; }
#undef LDP
        }
        {
            const float* lg = in_ptr(tab, 18) + (size_t)l * 512; const float* lb = in_ptr(tab, 19) + (size_t)l * 512;
            f32x4 g0 = *(const f32x4*)(lg + 8 * lane), g1 = *(const f32x4*)(lg + 8 * lane + 4), b0 = *(const f32x4*)(lb + 8 * lane), b1 = *(const f32x4*)(lb + 8 * lane + 4);
            for (int q = wave; q < 128; q += NWAVES) {
                const u32x4 w = *(const u32x4*)(ZSGU + (rb + t0 + q) * 1024 + 512 + 8 * lane);
                float v[8]; v[0] = bflo(w.x); v[1] = bfhi(w.x); v[2] = bflo(w.y); v[3] = bfhi(w.y); v[4] = bflo(w.z); v[5] = bfhi(w.z); v[6] = bflo(w.w); v[7] = bfhi(w.w);
                float s = 0.f;
#pragma unroll
                for (int j = 0; j < 8; ++j) { v[j] = gelu_(v[j]); s += v[j]; }
                const float mu = wave_sum(s, lane) * (1.f / 512.f); float s2 = 0.f;
#pragma unroll
                for (int j = 0; j < 8; ++j) { v[j] -= mu; s2 += v[j] * v[j]; }
                const float rstd = __builtin_amdgcn_rsqf(wave_sum(s2, lane) * (1.f / 512.f) + EPS);
#pragma unroll
                for (int j = 0; j < 8; ++j) { const float y = v[j] * rstd * (j < 4 ? g0[j & 3] : g1[j & 3]) + (j < 4 ? b0[j & 3] : b1[j & 3]);
                    *(LAS bf16_t*)(lds + (8 * lane + j) * VT_PITCH + 2 * q) = (bf16_t)(cvt_pk_bf16(y, 0.f) & 0xffffu); }
            }
            __syncthreads();
            const int g = wave >> 1, p0 = 64 * (wave & 1), fr = lane & 15, fq = lane >> 4;
            const float* Wg = in_ptr(tab, 20) + (size_t)l * 65536 + (size_t)g * 16384; const float* bs = in_ptr(tab, 21) + (size_t)l * 512 + g * 128;
            bf16x8 Wf[4][4];
#pragma unroll
            for (int m = 0; m < 4; ++m)
#pragma unroll
                for (int kk = 0; kk < 4; ++kk) { const float* p = Wg + (size_t)(p0 + 16 * m + fr) * 128 + 32 * kk + 8 * fq; const f32x4 x0 = *(const f32x4*)p, x1 = *(const f32x4*)(p + 4);
                    u32x4 w; w.x = cvt_pk_bf16(x0[0], x0[1]); w.y = cvt_pk_bf16(x0[2], x0[3]); w.z = cvt_pk_bf16(x1[0], x1[1]); w.w = cvt_pk_bf16(x1[2], x1[3]);
                    Wf[m][kk] = __builtin_bit_cast(bf16x8, w); }
            float bsv[4];
#pragma unroll
            for (int m = 0; m < 4; ++m) bsv[m] = bs[p0 + 16 * m + fr];
            for (int nn = 0; nn < 8; ++nn) {
                f32x4 acc[4];
#pragma unroll
                for (int m = 0; m < 4; ++m) acc[m] = (f32x4){0.f, 0.f, 0.f, 0.f};
#pragma unroll
                for (int kk = 0; kk < 4; ++kk) { const bf16x8 vf = *(const LAS bf16x8*)(lds + (g * 128 + 16 * nn + fr) * VT_PITCH + (32 * kk + 8 * fq) * 2);
#pragma unroll
                    for (int m = 0; m < 4; ++m) acc[m] = __builtin_amdgcn_mfma_f32_16x16x32_f16(__builtin_bit_cast(h16x8, vf), __builtin_bit_cast(h16x8, Wf[m][kk]), acc[m], 0, 0, 0); }
                const int cc = g * 128 + 16 * nn + 4 * fq;
#pragma unroll
                for (int m = 0; m < 4; ++m) { const size_t row = rb + t0 + p0 + 16 * m + fr;
                    const u32x2 uw = *(const u32x2*)(ZSGU + row * 1024 + cc);
                    const float o0 = gelu_(bflo(uw.x)) * (acc[m][0] + bsv[m]), o1 = gelu_(bfhi(uw.x)) * (acc[m][1] + bsv[m]), o2 = gelu_(bflo(uw.y)) * (acc[m][2] + bsv[m]), o3 = gelu_(bfhi(uw.y)) * (acc[m][3] + bsv[m]);
                    u32x2 w; w.x = cvt_pk_bf16(o0, o1); w.y = cvt_pk_bf16(o2, o3); if (ABL == 3) { w.x = 0u; w.y = 0u; }
                    *(u32x2*)(YBC + row * 1024 + 512 + cc) = w; }
            }
            __syncthreads();
        }
    }
}

__device__ __forceinline__ void scan_pass1(unsigned char* ws, int l, LAS unsigned char* lds) {
    int tid_ = threadIdx.x; asm volatile("" : "+v"(tid_));
    const int tid = tid_, lane = tid & 63, seg = tid >> 6;
    const float* LC = (const float*)(ws + WS_LC) + l * 2048; f32x2* SUM = (f32x2*)(ws + WS_SUM);
    LAS f32x4* SEG = (LAS f32x4*)lds;
    for (int item = blockIdx.x; item < 2048; item += gridDim.x) {
        const int dir = item & 1, grp = (item >> 1) & 7, chunk = (item >> 4) & 63, b = item >> 10;
        const int ch = grp * 128 + 2 * lane;
        const float l0 = LC[dir * 1024 + ch] * (1.f / 255.f), l1 = LC[dir * 1024 + ch + 1] * (1.f / 255.f);
        const bf16_t* U = (const bf16_t*)(ws + WS_U) + (size_t)dir * T * 1024 + ((size_t)b * S + chunk * 256) * 1024 + ch;
        const unsigned char* R = ws + WS_R + (size_t)dir * T * 1024 + ((size_t)b * S + chunk * 256) * 1024 + ch;
        float A0 = 1.f, A1 = 1.f, H0 = 0.f, H1 = 0.f;
#pragma unroll 8
        for (int k = 0; k < 32; ++k) { const int p = seg * 32 + k, to = dir ? 255 - p : p;
            const unsigned uw = *(const unsigned*)(U + (size_t)to * 1024); const unsigned rw = *(const unsigned short*)(R + (size_t)to * 1024);
            const float a0 = __expf(l0 * (float)(rw & 255u)), a1 = __expf(l1 * (float)(rw >> 8));
            H0 = a0 * H0 + bflo(uw) * __builtin_sqrtf(1.f - a0 * a0); H1 = a1 * H1 + bfhi(uw) * __builtin_sqrtf(1.f - a1 * a1); A0 *= a0; A1 *= a1; }
        SEG[seg * 64 + lane] = (f32x4){A0, H0, A1, H1};
        __syncthreads();
        if (tid < 64) { float cA0 = 1.f, cA1 = 1.f, cH0 = 0.f, cH1 = 0.f;
#pragma unroll
            for (int s = 0; s < 8; ++s) { const f32x4 v = SEG[s * 64 + tid]; cH0 = v[0] * cH0 + v[1]; cA0 *= v[0]; cH1 = v[2] * cH1 + v[3]; cA1 *= v[2]; }
            f32x4* o = (f32x4*)(SUM + ((size_t)((dir * 2 + b) * 64 + chunk)) * 1024 + grp * 128 + 2 * tid); *o = (f32x4){cA0, cH0, cA1, cH1}; }
        __syncthreads();
    }
}
__device__ __forceinline__ void scan_pass2(unsigned char* ws, int l, LAS unsigned char* lds) {
    int tid_ = threadIdx.x; asm volatile("" : "+v"(tid_));
    const int tid = tid_, lane = tid & 63, seg = tid >> 6;
    const float* LC = (const float*)(ws + WS_LC) + l * 2048; const f32x2* SUM = (const f32x2*)(ws + WS_SUM);
    LAS f32x2* HF = (LAS f32x2*)lds;
    LAS f32x4* SEG = (LAS f32x4*)(lds + 131072);
    LAS f32x2* CAR = (LAS f32x2*)(lds + 131072 + 8192);
    for (int item = blockIdx.x; item < 1024; item += gridDim.x) {
        const int grp = item & 7, chunk = (item >> 3) & 63, b = item >> 9;
        const int ch = grp * 128 + 2 * lane;
        bf16_t* ZG = (bf16_t*)(ws + WS_ZG) + ((size_t)b * S + chunk * 256) * 1024 + ch;
#pragma unroll 1
        for (int dir = 0; dir < 2; ++dir) {
            const float l0 = LC[dir * 1024 + ch] * (1.f / 255.f), l1 = LC[dir * 1024 + ch + 1] * (1.f / 255.f);
            const bf16_t* U = (const bf16_t*)(ws + WS_U) + (size_t)dir * T * 1024 + ((size_t)b * S + chunk * 256) * 1024 + ch;
            const unsigned char* R = ws + WS_R + (size_t)dir * T * 1024 + ((size_t)b * S + chunk * 256) * 1024 + ch;
            { float A0 = 1.f, A1 = 1.f, H0 = 0.f, H1 = 0.f;
#pragma unroll 8
              for (int k = 0; k < 32; ++k) { const int p = seg * 32 + k, to = dir ? 255 - p : p;
                  const unsigned uw = *(const unsigned*)(U + (size_t)to * 1024); const unsigned rw = *(const unsigned short*)(R + (size_t)to * 1024);
                  const float a0 = __expf(l0 * (float)(rw & 255u)), a1 = __expf(l1 * (float)(rw >> 8));
                  H0 = a0 * H0 + bflo(uw) * __builtin_sqrtf(1.f - a0 * a0); H1 = a1 * H1 + bfhi(uw) * __builtin_sqrtf(1.f - a1 * a1); A0 *= a0; A1 *= a1; }
              SEG[seg * 64 + lane] = (f32x4){A0, H0, A1, H1}; }
            if (tid < 64) { const f32x4* sp = (const f32x4*)(SUM + ((size_t)((dir * 2 + b) * 64)) * 1024 + grp * 128 + 2 * tid);
                float h0 = 0.f, h1 = 0.f;
                if (dir == 0) { for (int j = 0; j < chunk; ++j) { const f32x4 v = sp[(size_t)j * 512]; h0 = v[0] * h0 + v[1]; h1 = v[2] * h1 + v[3]; } }
                else { for (int j = 63; j > chunk; --j) { const f32x4 v = sp[(size_t)j * 512]; h0 = v[0] * h0 + v[1]; h1 = v[2] * h1 + v[3]; } }
                CAR[tid] = (f32x2){h0, h1}; }
            __syncthreads();
            float h0, h1; { const f32x2 c = CAR[lane]; h0 = c[0]; h1 = c[1]; }
            for (int s = 0; s < seg; ++s) { const f32x4 v = SEG[s * 64 + lane]; h0 = v[0] * h0 + v[1]; h1 = v[2] * h1 + v[3]; }
#pragma unroll 8
            for (int k = 0; k < 32; ++k) { const int p = seg * 32 + k, to = dir ? 255 - p : p;
                const unsigned uw = *(const unsigned*)(U + (size_t)to * 1024); const unsigned rw = *(const unsigned short*)(R + (size_t)to * 1024);
                const float a0 = __expf(l0 * (float)(rw & 255u)), a1 = __expf(l1 * (float)(rw >> 8));
                h0 = a0 * h0 + bflo(uw) * __builtin_sqrtf(1.f - a0 * a0); h1 = a1 * h1 + bfhi(uw) * __builtin_sqrtf(1.f - a1 * a1);
                if (dir == 0) HF[to * 64 + lane] = (f32x2){h0, h1};
                else { const f32x2 hf = HF[to * 64 + lane]; const unsigned gw = *(const unsigned*)(ZG + (size_t)to * 1024);
                    *(unsigned*)(ZG + (size_t)to * 1024) = (ABL == 1) ? 0u : cvt_pk_bf16((hf[0] + h0) * gelu_(bflo(gw)), (hf[1] + h1) * gelu_(bfhi(gw))); } }
            __syncthreads();
        }
    }
}

#ifdef DBG
constexpr size_t WS_DBG = 70000;
__device__ __forceinline__ float bfv(const bf16_t* p) { return bflo((unsigned)*p); }
__device__ __forceinline__ float dotA(const bf16_t* arow, const float* W, int K, int N, int col) { float s = 0.f; for (int k = 0; k < K; ++k) s += bfv(arow + k) * W[(size_t)k * N + col]; return s; }
__device__ __forceinline__ void dbg_cmp(unsigned* dbg, unsigned code, float got, float ref, float tol_rel, float tol_abs) {
    const float e = fabsf(got - ref); if (!(e <= tol_rel * fabsf(ref) + tol_abs)) atomicMin(dbg, code); }
__device__ __forceinline__ void dbg_check(int stage, const float* const* tab, unsigned char* ws, float* X) {
    unsigned* dbg = (unsigned*)(ws + WS_DBG); const int t = blockIdx.x * 64 + threadIdx.x;
    int r = (int)(((long)t * 5273 + 17) % T); const bf16_t* XN = (const bf16_t*)(ws + WS_XN);
    { const int q = t >> 1; const int base = (q & 1) ? S : 0;
      if (t < 40) { const int k = q >> 1; const int off = (k == 0) ? 0 : (k == 1) ? 1 : (k == 2) ? 2 : (k == 3) ? 127 : (k == 4) ? 128 : (k == 5) ? 255 : (k == 6) ? 256 : (k == 7) ? S - 1 : (k == 8) ? S - 2 : S - 3; r = base + off; } }
    if (stage == 2) { const int c = (int)((long)t * 911 + 3) % FF; const float g = dotA(XN + (size_t)r * D, (in_ptr(tab, DBG_F ? 26 : 2) + (size_t)DBG_LAYER * (D*FF)), D, FF, c), u = dotA(XN + (size_t)r * D, (in_ptr(tab, DBG_F ? 27 : 3) + (size_t)DBG_LAYER * (D*FF)), D, FF, c);
        dbg_cmp(dbg, 2, bfv((const bf16_t*)(ws + WS_H) + (size_t)r * FF + c), g / (1.f + expf(-g)) * u, 0.03f, 0.03f); }
    if (stage == 3) { const int c = (int)((long)t * 911 + 3) % D; dbg_cmp(dbg, 3, bfv((const bf16_t*)(ws + WS_F) + (size_t)r * D + c), dotA((const bf16_t*)(ws + WS_H) + (size_t)r * FF, (in_ptr(tab, DBG_F ? 28 : 4) + (size_t)DBG_LAYER * (D*FF)), FF, D, c), 0.03f, 0.03f); }
    if (stage == 4) { const int c = (int)((long)t * 911 + 3) % D; const bf16_t* F = (const bf16_t*)(ws + WS_F) + (size_t)r * D; float ss = 0.f; for (int k = 0; k < D; ++k) ss += bfv(F + k) * bfv(F + k);
        const float* x0 = in_ptr(tab, 0) + (size_t)r * D; float s2 = 0.f;
        for (int k = 0; k < D; ++k) { const float xv = x0[k] + 0.5f * bfv(F + k) * rsqrtf(ss / D + EPS) * (in_ptr(tab, 5) + (size_t)DBG_LAYER * (D))[k]; s2 += xv * xv; if (k == c) dbg_cmp(dbg, 4, X[(size_t)r * D + c], xv, 0.001f, 0.001f); }
        dbg_cmp(dbg, 4, bfv(XN + (size_t)r * D + c), X[(size_t)r * D + c] * rsqrtf(s2 / D + EPS) * (in_ptr(tab, 6) + (size_t)DBG_LAYER * (D))[c], 0.01f, 0.01f); }
    if (stage == 5) { const int c = (int)((long)t * 911 + 3) % ZN; const float z = dotA(XN + (size_t)r * D, (in_ptr(tab, 7) + (size_t)DBG_LAYER * (D*DIN)), D, DIN, c); float got;
        if (c < 1024) got = bfv((const bf16_t*)(ws + WS_ZG) + (size_t)r * 1024 + c); else if (c < 2048) got = bfv((const bf16_t*)(ws + WS_ZX) + (size_t)r * 1024 + c - 1024);
        else if (c < 3584) got = bfv((const bf16_t*)(ws + WS_ZSC) + (size_t)r * 1536 + c - 2048); else got = bfv((const bf16_t*)(ws + WS_ZSGU) + (size_t)r * 1024 + c - 3584);
        dbg_cmp(dbg, 5, got, z, 0.03f, 0.03f); }
    if (stage == 6) { const int b = r / S, tt = r % S; const size_t rb = (size_t)b * S;
        { const int c = (int)((long)t * 911 + 3) % 1024; float o = (in_ptr(tab, 9) + (size_t)DBG_LAYER * (1024))[c]; for (int k = 0; k < 4; ++k) { const int q = tt + k - 2; if (q >= 0 && q < S) o += (in_ptr(tab, 8) + (size_t)DBG_LAYER * (4096))[k * 1024 + c] * bfv((const bf16_t*)(ws + WS_ZX) + (rb + q) * 1024 + c); }
          dbg_cmp(dbg, 6, bfv((const bf16_t*)(ws + WS_XC) + (size_t)r * 1024 + c), o, 0.02f, 0.02f); }
        { const int c = (int)((long)t * 911 + 3) % 512; const bf16_t* Z = (const bf16_t*)(ws + WS_ZSC); float o = 0.f; for (int k = 0; k < 3; ++k) { const int q = tt + k - 1; if (q >= 0 && q < S) o += (in_ptr(tab, 16) + (size_t)DBG_LAYER * (1536))[k * 512 + c] * bfv(Z + (rb + q) * 1536 + 512 + c) * bfv(Z + (rb + q) * 1536 + 1024 + c); }
          dbg_cmp(dbg, 7, bfv((const bf16_t*)(ws + WS_YBC) + (size_t)r * 1024 + c), o * bfv(Z + (size_t)r * 1536 + c), 0.02f, 0.02f); }
        { const int c = (int)((long)t * 911 + 3) % 512, g = c >> 7, p = tt & 127, t0 = tt - p; const bf16_t* Z = (const bf16_t*)(ws + WS_ZSGU); float mix = (in_ptr(tab, 21) + (size_t)DBG_LAYER * (512))[g * 128 + p];
          for (int q = 0; q < 128; ++q) { const bf16_t* vr = Z + (rb + t0 + q) * 1024 + 512; float mu = 0.f, var = 0.f; for (int k = 0; k < 512; ++k) mu += gelu_(bfv(vr + k)); mu /= 512.f;
              for (int k = 0; k < 512; ++k) { const float d = gelu_(bfv(vr + k)) - mu; var += d * d; } var /= 512.f;
              const float vn = (gelu_(bfv(vr + c)) - mu) * rsqrtf(var + EPS) * (in_ptr(tab, 18) + (size_t)DBG_LAYER * (512))[c] + (in_ptr(tab, 19) + (size_t)DBG_LAYER * (512))[c]; mix += (in_ptr(tab, 20) + (size_t)DBG_LAYER * (65536))[(size_t)g * 16384 + p * 128 + q] * vn; }
          dbg_cmp(dbg, 8, bfv((const bf16_t*)(ws + WS_YBC) + (size_t)r * 1024 + 512 + c), gelu_(bfv(Z + (size_t)r * 1024 + c)) * mix, 0.03f, 0.03f); } }
    if (stage == 9) { const int c = (int)((long)t * 911 + 3) % 1024, dir = t & 1, head = c >> 8, e = c & 255; const bf16_t* xr = (const bf16_t*)(ws + WS_XC) + (size_t)r * 1024 + head * 256;
        const float pa = dotA(xr, (in_ptr(tab, 10) + (size_t)DBG_LAYER * (524288)) + (size_t)(dir * 4 + head) * 65536, 256, 256, e) + (in_ptr(tab, 11) + (size_t)DBG_LAYER * (2048))[dir * 1024 + c], px = dotA(xr, (in_ptr(tab, 12) + (size_t)DBG_LAYER * (524288)) + (size_t)(dir * 4 + head) * 65536, 256, 256, e) + (in_ptr(tab, 13) + (size_t)DBG_LAYER * (2048))[dir * 1024 + c];
        const float rr = 1.f / (1.f + expf(-pa)), ii = 1.f / (1.f + expf(-px));
        dbg_cmp(dbg, 9, (float)*(ws + WS_R + (size_t)dir * T * 1024 + (size_t)r * 1024 + c), rr * 255.f, 0.02f, 1.5f);
        dbg_cmp(dbg, 10, bfv((const bf16_t*)(ws + WS_U) + (size_t)dir * T * 1024 + (size_t)r * 1024 + c), ii * bfv(xr + e), 0.03f, 0.03f); }
    if (stage == 11) { const int c = (int)((long)t * 911 + 3) % 1024, b = r / S, tt = r % S; const size_t rb = (size_t)b * S; const float* LC = (const float*)(ws + WS_LC) + DBG_LAYER * 2048; float hs = 0.f;
        for (int dir = 0; dir < 2; ++dir) { const bf16_t* U = (const bf16_t*)(ws + WS_U) + (size_t)dir * T * 1024; const unsigned char* R = ws + WS_R + (size_t)dir * T * 1024; float h = 0.f;
            if (dir == 0) { for (int q = 0; q <= tt; ++q) { const float a = expf(LC[c] * (float)R[(rb + q) * 1024 + c] / 255.f); h = a * h + bfv(U + (rb + q) * 1024 + c) * sqrtf(1.f - a * a); } }
            else { for (int q = S - 1; q >= tt; --q) { const float a = expf(LC[1024 + c] * (float)R[(rb + q) * 1024 + c] / 255.f); h = a * h + bfv(U + (rb + q) * 1024 + c) * sqrtf(1.f - a * a); } }
            hs += h; }
        const float gate = dotA(XN + (size_t)r * D, (in_ptr(tab, 7) + (size_t)DBG_LAYER * (D*DIN)), D, DIN, c);
        dbg_cmp(dbg, 11, bfv((const bf16_t*)(ws + WS_ZG) + (size_t)r * 1024 + c), hs * gelu_(gate), 0.03f, 0.03f); }
    if (stage == 10) { const int c = (int)((long)t * 911 + 3) % 1024; ((float*)(ws + WS_DBG + 1024))[t] = bfv((const bf16_t*)(ws + WS_ZG) + (size_t)r * 1024 + c); }
    if (stage == 12) { const int c = (int)((long)t * 911 + 3) % 3072; const float z = dotA(XN + (size_t)r * D, (in_ptr(tab, 7) + (size_t)DBG_LAYER * (D*DIN)), D, DIN, ZN + c);
        dbg_cmp(dbg, 12, bfv((const bf16_t*)(ws + WS_G) + (size_t)r * 3072 + c), 1.f / (1.f + expf(-z)), 0.02f, 0.01f); }
    if (stage == 13) { const int c = (int)((long)t * 911 + 3) % 1024; const bf16_t* G = (const bf16_t*)(ws + WS_G) + (size_t)r * 3072;
        const float ya = dotA((const bf16_t*)(ws + WS_ZG) + (size_t)r * 1024, (in_ptr(tab, 15) + (size_t)DBG_LAYER * (D*D)), 1024, 1024, c), yb = dotA((const bf16_t*)(ws + WS_YBC) + (size_t)r * 1024, (in_ptr(tab, 17) + (size_t)DBG_LAYER * (512*D)), 512, 1024, c), yc = dotA((const bf16_t*)(ws + WS_YBC) + (size_t)r * 1024 + 512, (in_ptr(tab, 22) + (size_t)DBG_LAYER * (512*D)), 512, 1024, c);
        dbg_cmp(dbg, 13, bfv((const bf16_t*)(ws + WS_MG) + (size_t)r * 1024 + c), bfv(G + c) * ya + bfv(G + 1024 + c) * yb + bfv(G + 2048 + c) * yc, 0.03f, 0.05f); }
    if (stage == 15) { const int c = (int)((long)t * 911 + 3) % D; float s2 = 0.f; for (int k = 0; k < D; ++k) s2 += X[(size_t)r * D + k] * X[(size_t)r * D + k];
        dbg_cmp(dbg, 15, bfv(XN + (size_t)r * D + c), X[(size_t)r * D + c] * rsqrtf(s2 / D + EPS) * (in_ptr(tab, DBG_G) + (size_t)DBG_GL * D)[c], 0.01f, 0.01f); }
    if (stage == 16) { const int c = (int)((long)t * 911 + 3) % D; const bf16_t* F = (const bf16_t*)(ws + WS_MX) + (size_t)r * D; float ss = 0.f; for (int k = 0; k < D; ++k) ss += bfv(F + k) * bfv(F + k);
        const float xb = X[(size_t)r * D + c];
        dbg_cmp(dbg, 16, ((const float*)(ws + WS_G))[(size_t)r * D + c], xb + bfv(F + c) * rsqrtf(ss / D + EPS) * (in_ptr(tab, 24) + (size_t)DBG_LAYER * D)[c], 0.001f, 0.001f); }
    if (stage == 17) { const int c = (int)((long)t * 911 + 3) % D; const bf16_t* F = (const bf16_t*)(ws + WS_F) + (size_t)r * D; float ss = 0.f; for (int k = 0; k < D; ++k) ss += bfv(F + k) * bfv(F + k);
        const float xb = X[(size_t)r * D + c];
        dbg_cmp(dbg, 17, ((const float*)(ws + WS_G))[(size_t)r * D + c], xb + 0.5f * bfv(F + c) * rsqrtf(ss / D + EPS) * (in_ptr(tab, 29) + (size_t)DBG_LAYER * D)[c], 0.001f, 0.001f); }
    if (stage == 14) { const int c = (int)((long)t * 911 + 3) % 1024; dbg_cmp(dbg, 14, bfv((const bf16_t*)(ws + WS_MX) + (size_t)r * 1024 + c), dotA((const bf16_t*)(ws + WS_MG) + (size_t)r * 1024, (in_ptr(tab, 23) + (size_t)DBG_LAYER * (D*D)), 1024, 1024, c), 0.03f, 0.03f); }
}
__global__ void __launch_bounds__(64) dbg_kernel(Args a, unsigned mask) {
    unsigned char* ws = a.ws; const float* const* tab = (const float* const*)(ws + WS_TAB);
    for (int st = 2; st <= 17; ++st) if ((mask >> st) & 1u) dbg_check(st, tab, ws, a.out);
}
__global__ void dbg_final(Args a) { const unsigned cde = *(volatile unsigned*)(a.ws + WS_DBG); a.out[0] = (cde != 99u) ? 1000.f + 100.f * (float)cde : 0.f; }
#define DBGCHK(st) do { if (l == DBG_LAYER && (st) == STOP_AT) return; } while (0)
#else
#define DBGCHK(st) do { } while (0)
#endif

__global__ void __launch_bounds__(NTHR, 2) fwd_kernel(Args a) {
    extern __shared__ __attribute__((aligned(16))) unsigned char lds_raw[];
    LAS unsigned char* lds = (LAS unsigned char*)lds_raw;
    cg::grid_group grid = cg::this_grid();
    unsigned char* ws = a.ws;
    { const float** tw = (const float**)(ws + WS_TAB);
      if (threadIdx.x == 0) {
#pragma unroll
          for (int i = 0; i < 30; ++i) tw[i] = a.in[i];
          volatile LAS unsigned* st = (volatile LAS unsigned*)(lds + LDS_BAR_ST); st[0] = 0u; st[1] = 0u;
          (void)xb_add((unsigned*)(ws + WS_BAR) + XB_XCNT(xb_xcc_id()), 1u);
          __threadfence(); }
      __syncthreads(); }
    const float* const* tab = (const float* const*)(ws + WS_TAB);
    const int G = gridDim.x, c = blockIdx.x;
    bf16_t* XN = (bf16_t*)(ws + WS_XN);
    float* X = a.out;
    unsigned char* const ws0 = ws; const int G0 = G, c0 = c; float* const X0 = X;
    constexpr int BIG = 1 << 28;

#ifdef SKEL
    { const float* xin = a.in[0]; for (size_t i = (size_t)blockIdx.x * NTHR + threadIdx.x; i < (size_t)T * D; i += (size_t)gridDim.x * NTHR) a.out[i] = xin[i];
      GSYNC();
#if SKEL >= 2
      convert_layer(tab, ws, 0, lds); GSYNC();
#endif
#if SKEL >= 3
      lc_all(tab, ws); GSYNC();
#endif
#if SKEL >= 4
      ew_phase<false>(in_ptr(tab, 0), X, nullptr, 0.f, nullptr, in_ptr(tab, 1), XN); GSYNC();
#endif
#if SKEL >= 5
      ew_phase<true>(X, X, (const bf16_t*)(ws + WS_F), 0.5f, in_ptr(tab, 5), in_ptr(tab, 6), XN); GSYNC();
#endif
#if SKEL >= 6
      convert_layer(tab, ws, 1, lds); GSYNC();
#endif
      return; }
#endif
#ifdef DBG
    if (blockIdx.x == 0 && threadIdx.x == 0) *(unsigned*)(ws + WS_DBG) = 99u;
#endif
    PH(0) { convert_layer(tab, ws, 0, lds); lc_all(tab, ws); }
    PH(1) ew_phase<false>(in_ptr(tab, 0), X, nullptr, 0.f, nullptr, in_ptr(tab, 1), XN);
    GSYNC_CG();
#ifdef DBG
    if (STOP_AT == 20) return;
#endif

#pragma unroll 1
    for (int l = 0; l < NLAYER_RUN; ++l) {
#pragma unroll 1
        for (int f = 0; f < 2; ++f) {
            unsigned long long wsv = (unsigned long long)ws0, xv = (unsigned long long)X0; int G = G0, c = c0;
#ifndef NOASM
            asm volatile("" : "+s"(wsv), "+s"(G), "+s"(c), "+s"(xv));
#endif
            unsigned char* ws = (unsigned char*)(GAS unsigned char*)wsv; float* X = (float*)(GAS float*)xv;
            const float* const* tab = (const float* const*)(ws + WS_TAB); bf16_t* XN = (bf16_t*)(ws + WS_XN);
            if (f == 1) {
                PH(2) { pg8::Gemm g{XN, XN, (const bf16_t*)(ws + W_IN), T, ZN, D, D, BIG, 0, 0}; pg8::StaticOrder So; So.init(T, ZN, G, c);
                  pg8::EpiBf<2> E{(bf16_t*)(ws + WS_ZG), 1024, (bf16_t*)(ws + WS_ZX), (bf16_t*)(ws + WS_ZSC), (bf16_t*)(ws + WS_ZSGU)};
                  pg8::gemm_phase<pg8::EpiBf<2>, true>(lds, g, So, E); }
                GSYNC();
                DBGCHK(5);
                PH(3) prep_phase(tab, ws, l, lds);
                GSYNC();
                DBGCHK(6);
                PH(4) { const bf16_t* XC = (const bf16_t*)(ws + WS_XC);
                  pg8::Gemm g{XC, XC, (const bf16_t*)(ws + W_LRU), T, 4096, 256, 1024, BIG, 2, 512}; pg8::StaticOrder So; So.init(T, 4096, G, c);
                  pg8::EpiGates E{XC, (bf16_t*)(ws + WS_U), ws + WS_R, in_ptr(tab, 11) + (size_t)l * 2048, in_ptr(tab, 13) + (size_t)l * 2048, (const float*)(ws + WS_LC)};
                  pg8::gemm_phase<pg8::EpiGates, true>(lds, g, So, E); }
                GSYNC();
                DBGCHK(9);
                PH(5) scan_pass1(ws, l, lds);
                GSYNC();
                PH(6) scan_pass2(ws, l, lds);
                GSYNC();
                DBGCHK(11);
                PH(7) { pg8::Gemm g{XN, XN, (const bf16_t*)(ws + W_IN) + (size_t)ZN * D, T, 3072, D, D, BIG, 0, 0}; pg8::StaticOrder So; So.init(T, 3072, G, c);
                  pg8::EpiBf<1> E{(bf16_t*)(ws + WS_G), 3072, nullptr, nullptr, nullptr};
                  pg8::gemm_phase<pg8::EpiBf<1>, true>(lds, g, So, E); }
                GSYNC();
                DBGCHK(12);
                PH(8) { pg8::Gemm g{(const bf16_t*)(ws + WS_ZG), (const bf16_t*)(ws + WS_YBC) - 16 * 64, (const bf16_t*)(ws + W_CAT), T, D, 2048, 1024, 16, 0, 0}; pg8::StaticOrder So; So.init(T, D, G, c);
                  pg8::EpiMerge E{(const bf16_t*)(ws + WS_G), (bf16_t*)(ws + WS_MG)};
                  pg8::gemm_phase<pg8::EpiMerge, true>(lds, g, So, E); }
                GSYNC();
                DBGCHK(13);
                PH(9) { const bf16_t* MG = (const bf16_t*)(ws + WS_MG);
                  pg8::Gemm g{MG, MG, (const bf16_t*)(ws + W_O), T, D, D, D, BIG, 0, 0}; pg8::StaticOrder So; So.init(T, D, G, c);
                  pg8::EpiBf<0> E{(bf16_t*)(ws + WS_MX), 1024, nullptr, nullptr, nullptr};
                  pg8::gemm_phase<pg8::EpiBf<0>, true>(lds, g, So, E); }
                GSYNC();
                DBGCHK(14);
#if defined(DBG) && STOP_AT == 21
                PH(10) ew_phase<true>(X, (float*)(ws + WS_G), (const bf16_t*)(ws + WS_MX), 1.f, in_ptr(tab, 24) + (size_t)l * D, in_ptr(tab, 25) + (size_t)l * D, XN);
#else
                PH(10) ew_phase<true>(X, X, (const bf16_t*)(ws + WS_MX), 1.f, in_ptr(tab, 24) + (size_t)l * D, in_ptr(tab, 25) + (size_t)l * D, XN);
#endif
                GSYNC();
                DBGCHK(21);
            }
            PH(11) { pg8::Gemm g{XN, XN, (const bf16_t*)(ws + (f ? W_UP2 : W_UP1)), T, 2 * FF, D, D, BIG, 0, 0}; pg8::StaticOrder So; So.init(T, 2 * FF, G, c);
              pg8::EpiSwiGLU E{(bf16_t*)(ws + WS_H), FF};
              pg8::gemm_phase<pg8::EpiSwiGLU, true>(lds, g, So, E); }
            GSYNC();
            if (f == DBG_F) DBGCHK(2);
            PH(12) { const bf16_t* H = (const bf16_t*)(ws + WS_H);
              pg8::Gemm g{H, H, (const bf16_t*)(ws + (f ? W_DN2 : W_DN1)), T, D, FF, FF, BIG, 0, 0}; pg8::StaticOrder So; So.init(T, D, G, c);
              pg8::EpiBf<0> E{(bf16_t*)(ws + WS_F), 1024, nullptr, nullptr, nullptr};
              pg8::gemm_phase<pg8::EpiBf<0>, true>(lds, g, So, E); }
            GSYNC();
            if (f == DBG_F) DBGCHK(3);
            if (f == 0) {
                ew_phase<true>(X, X, (const bf16_t*)(ws + WS_F), 0.5f, in_ptr(tab, 5) + (size_t)l * D, in_ptr(tab, 6) + (size_t)l * D, XN);
            } else {
                if (l + 1 < DEPTH) convert_layer(tab, ws, l + 1, lds);
#if defined(DBG) && STOP_AT == 22
                ew_phase<true>(X, (l == DBG_LAYER) ? (float*)(ws + WS_G) : X, (const bf16_t*)(ws + WS_F), 0.5f, in_ptr(tab, 29) + (size_t)l * D, (l + 1 < DEPTH) ? in_ptr(tab, 1) + (size_t)(l + 1) * D : nullptr, XN);
#else
                ew_phase<true>(X, X, (const bf16_t*)(ws + WS_F), 0.5f, in_ptr(tab, 29) + (size_t)l * D, (l + 1 < DEPTH) ? in_ptr(tab, 1) + (size_t)(l + 1) * D : nullptr, XN);
#endif
            }
            GSYNC();
            if (f == 0) DBGCHK(4);
            if (f == 1) DBGCHK(22);
        }
    }
}

extern "C" void kernel_launch(void* const* d_in, const int* in_sizes, int n_in, void* d_out, int out_size, void* d_ws, size_t ws_size, hipStream_t stream) {
    static int grid = 0;
    if (grid == 0) {
        if (n_in != 30 || in_sizes[0] != T * D || out_size != T * D || ws_size < WS_END) { fprintf(stderr, "kernel_launch: unexpected problem geometry (n_in %d, ws %zu)\n", n_in, ws_size); grid = -1; return; }
        int dev = 0, cus = 0, per_cu = 0;
        if (hipGetDevice(&dev) != hipSuccess || hipDeviceGetAttribute(&cus, hipDeviceAttributeMultiprocessorCount, dev) != hipSuccess) { grid = -1; return; }
        if (hipFuncSetAttribute((const void*)fwd_kernel, hipFuncAttributeMaxDynamicSharedMemorySize, LDS_BYTES) != hipSuccess) { fprintf(stderr, "kernel_launch: hipFuncSetAttribute failed\n"); grid = -1; return; }
        if (hipOccupancyMaxActiveBlocksPerMultiprocessor(&per_cu, (const void*)fwd_kernel, NTHR, LDS_BYTES) != hipSuccess || per_cu < 1) { fprintf(stderr, "kernel_launch: occupancy query failed (%d)\n", per_cu); (void)hipGetLastError(); grid = -1; return; }
        grid = cus * per_cu;
    }
    if (grid < 0) return;
    Args a{};
    for (int i = 0; i < 30; ++i) a.in[i] = (const float*)d_in[i];
    a.out = (float*)d_out; a.ws = (unsigned char*)d_ws;
    if (hipMemsetAsync((char*)d_ws + WS_BAR, 0, 16384, stream) != hipSuccess) { fprintf(stderr, "kernel_launch: hipMemsetAsync failed\n"); return; }
    void* args[] = {&a};
    hipError_t e = hipLaunchCooperativeKernel((const void*)fwd_kernel, dim3(grid), dim3(NTHR), args, LDS_BYTES, stream);
    if (e != hipSuccess) fprintf(stderr, "kernel_launch: cooperative launch failed: %s (grid %d)\n", hipGetErrorString(e), grid);
#ifdef DBG
    dbg_kernel<<<128, 64, 0, stream>>>(a, (unsigned)DBG_MASK);
    dbg_final<<<1, 1, 0, stream>>>(a);
#endif
}
```

```cpp
#include <hip/hip_runtime.h>
#include <hip/hip_cooperative_groups.h>
#include <cstdio>
#include <cstdint>
namespace cg = cooperative_groups;

#define LAS __attribute__((address_space(3)))
typedef unsigned short bf16_t;
typedef short bf16x8 __attribute__((ext_vector_type(8)));
typedef float f32x4 __attribute__((ext_vector_type(4)));
typedef float f32x2 __attribute__((ext_vector_type(2)));
typedef unsigned u32x4 __attribute__((ext_vector_type(4)));
typedef unsigned u32x2 __attribute__((ext_vector_type(2)));

constexpr int NB = 2, S = 16384, T = NB * S, D = 1024, FF = 2816, DIN = 7680, ZN = 4608, DEPTH = 4;
constexpr float EPS = 1e-6f;
constexpr int NTHR = 512, NWAVES = 8;

constexpr size_t MiB = 1u << 20;
constexpr size_t WS_LC = 0;
constexpr size_t WS_TAB = 65536;
constexpr size_t WS_SUM = 1 * MiB;
constexpr size_t WS_W = 4 * MiB;
constexpr size_t W_UP1 = WS_W, W_DN1 = W_UP1 + 11 * MiB, W_IN = W_DN1 + 11 * MiB / 2, W_LRU = W_IN + 15 * MiB, W_CAT = W_LRU + 2 * MiB,
                 W_O = W_CAT + 4 * MiB, W_UP2 = W_O + 2 * MiB, W_DN2 = W_UP2 + 11 * MiB, W_END = W_DN2 + 11 * MiB / 2;
static_assert(W_END == 60 * MiB, "weight map");
constexpr size_t WS_XN = 60 * MiB;
constexpr size_t WS_ZG = 124 * MiB, WS_ZX = 188 * MiB, WS_ZSC = 252 * MiB, WS_ZSGU = 348 * MiB, WS_XC = 412 * MiB, WS_YBC = 476 * MiB, WS_END = 540 * MiB;
constexpr size_t WS_U = 188 * MiB, WS_R = 316 * MiB;
constexpr size_t WS_G = 188 * MiB;
constexpr size_t WS_MG = 380 * MiB;
constexpr size_t WS_MX = 124 * MiB;
constexpr size_t WS_H = 124 * MiB;
constexpr size_t WS_F = 316 * MiB;

constexpr int LDS_BYTES = 147456;
#ifndef PHM
#define PHM 0xFFFF
#define NLAYER_RUN DEPTH
#define STOP_AT 11
#define DBG_MASK ((1u << 9) | (1u << 11))
#define DBG_LAYER 1
#define DBG_F 0
#define DBG_G 1
#define DBG_GL 0
#ifndef ABL
#define ABL 0
#endif
#endif
#define PH(b) if constexpr ((PHM >> (b)) & 1)
#define GSYNC_CG() do { asm volatile("s_waitcnt vmcnt(0)" ::: "memory"); __threadfence(); grid.sync(); } while (0)
#define GSYNC() xsync(ws, lds)

struct Args { const float* in[30]; float* out; unsigned char* ws; };

typedef _Float16 h16x2 __attribute__((ext_vector_type(2)));
typedef _Float16 h16x8 __attribute__((ext_vector_type(8)));
__device__ __forceinline__ unsigned cvt_pk_bf16(float lo, float hi) { h16x2 v; v.x = (_Float16)lo; v.y = (_Float16)hi; return __builtin_bit_cast(unsigned, v); }
__device__ __forceinline__ float bflo(unsigned u) { return (float)__builtin_bit_cast(h16x2, u).x; }
__device__ __forceinline__ float bfhi(unsigned u) { return (float)__builtin_bit_cast(h16x2, u).y; }
__device__ __forceinline__ float h8(const u32x4& v, int j) { const unsigned w = (j >> 1) == 0 ? v.x : (j >> 1) == 1 ? v.y : (j >> 1) == 2 ? v.z : v.w; return (j & 1) ? bfhi(w) : bflo(w); }
__device__ __forceinline__ float rcpf_(float x) { return __builtin_amdgcn_rcpf(x); }
__device__ __forceinline__ float sigm(float x) { return rcpf_(1.f + __expf(-x)); }
__device__ __forceinline__ float silu_(float x) { return x * sigm(x); }
__device__ __forceinline__ float gelu_(float x) { const float u = 1.5957691216057308f * (x + 0.044715f * x * x * x); return x * sigm(u); }
#define GAS __attribute__((address_space(1)))
__device__ __forceinline__ const float* in_ptr(const float* const* tab, int i) {
    unsigned long long v = *(const unsigned long long*)(tab + i);
    const unsigned lo = __builtin_amdgcn_readfirstlane((unsigned)v), hi = __builtin_amdgcn_readfirstlane((unsigned)(v >> 32));
    v = ((unsigned long long)hi << 32) | lo;
    return (const float*)(GAS const float*)v;
}
__device__ __forceinline__ float wave_sum(float v, int lane) {
#pragma unroll
    for (int o = 1; o < 64; o <<= 1) v += __int_as_float(__builtin_amdgcn_ds_bpermute((lane ^ o) << 2, __float_as_int(v)));
    return v;
}

constexpr size_t WS_BAR = 131072;
constexpr int LDS_BAR_ST = LDS_BYTES - 64;
#define XB_TMO      128
#define XB_XCNT(j)  (256  + 64 * (j))
#define XB_XSUB(j)  (1280 + 64 * (j))
#define XB_XGEN(j)  (2304 + 64 * (j))
#define XB_TOP      3328
#define XB_TOPGEN   3392
#define XCD_BAR_WORDS 3456
#define XB_SPIN_CAP (1u << 20)
__device__ __forceinline__ unsigned xb_ld(unsigned* p)              { return __hip_atomic_load(p, __ATOMIC_RELAXED, __HIP_MEMORY_SCOPE_AGENT); }
__device__ __forceinline__ unsigned xb_add(unsigned* p, unsigned v) { return __hip_atomic_fetch_add(p, v, __ATOMIC_RELAXED, __HIP_MEMORY_SCOPE_AGENT); }
__device__ __forceinline__ unsigned xb_xcc_id() { return (unsigned)__builtin_amdgcn_s_getreg((3 << 11) | 20) & 0xFu; }
#define XB_SPIN(cond, bar) do { unsigned _sp = 0; while (cond) { __builtin_amdgcn_s_sleep(1); \
    if ((++_sp & 255u) == 0u) { if (xb_ld(&(bar)[XB_TMO])) break; if (_sp > XB_SPIN_CAP) { atomicAdd(&(bar)[XB_TMO], 1u); break; } } } } while (0)
__device__ __forceinline__ void xcd_barrier_complete(unsigned* bar, unsigned x, unsigned& nloc, unsigned& nx) {
    const unsigned G = gridDim.x * gridDim.y * gridDim.z;
    unsigned sum, cnt, mine, sp = 0u;
    for (;;) {
        sum = 0u; cnt = 0u; mine = 0u;
#pragma unroll
        for (unsigned j = 0; j < 16; ++j) { const unsigned c = xb_ld(&bar[XB_XCNT(j)]); sum += c; cnt += (c > 0u) ? 1u : 0u; mine = (j == x) ? c : mine; }
        if (sum == G) break;
        __builtin_amdgcn_s_sleep(1);
        if ((++sp & 255u) == 0u) { if (xb_ld(&bar[XB_TMO])) break; if (sp > XB_SPIN_CAP) { atomicAdd(&bar[XB_TMO], 1u); break; } }
    }
    nloc = mine > 0u ? mine : 1u; nx = cnt > 0u ? cnt : 1u;
}
__device__ __forceinline__ void xsync(unsigned char* ws, LAS unsigned char* lds) {
    asm volatile("s_waitcnt vmcnt(0)" ::: "memory");
    __syncthreads();
    if (threadIdx.x == 0) {
        unsigned* bar = (unsigned*)(ws + WS_BAR); const unsigned x = xb_xcc_id();
        volatile LAS unsigned* st = (volatile LAS unsigned*)(lds + LDS_BAR_ST);
        __builtin_amdgcn_s_waitcnt(0);
        unsigned nloc = st[0], nx = st[1];
        if (nloc == 0u) { xcd_barrier_complete(bar, x, nloc, nx); st[0] = nloc; st[1] = nx; }
        const unsigned old = xb_add(&bar[XB_XSUB(x)], 1u);
        const unsigned gen = old / nloc;
        if (old + 1u == (gen + 1u) * nloc) {
            __builtin_amdgcn_fence(__ATOMIC_RELEASE, "agent");
            asm volatile("s_waitcnt vmcnt(0)" ::: "memory");
            const unsigned og = xb_add(&bar[XB_TOP], 1u);
            const unsigned tg = og / nx;
            if (og + 1u == (tg + 1u) * nx) xb_add(&bar[XB_TOPGEN], 1u);
            else XB_SPIN(xb_ld(&bar[XB_TOPGEN]) == tg, bar);
            __builtin_amdgcn_fence(__ATOMIC_ACQUIRE, "agent");
            xb_add(&bar[XB_XGEN(x)], 1u);
            asm volatile("s_waitcnt vmcnt(0)" ::: "memory");
        } else {
            XB_SPIN(xb_ld(&bar[XB_XGEN(x)]) == gen, bar);
            __builtin_amdgcn_fence(__ATOMIC_ACQUIRE, "agent");
            asm volatile("s_waitcnt vmcnt(0)" ::: "memory");
        }
    }
    __syncthreads();
}

namespace pg8 {
constexpr int BM = 256, BK = 64, HALF = 128, HTB = HALF * BK * 2, STAGE_BYTES = 8 * HTB, NXCD = 8, WGM = 8;
__host__ __device__ __forceinline__ int lds_byte(int r, int c) { const int st = (r >> 4) * 2 + (c >> 5), rr = r & 15, cc = c & 31, ob = rr * 64 + cc * 2; return st * 1024 + (ob ^ (((ob >> 9) & 1) << 5)); }
__host__ __device__ __forceinline__ void stage_rc(int b, int& R, int& C) { const int st = b / 1024, sb = b % 1024, swz = sb ^ (((sb >> 9) & 1) << 5); R = (st >> 1) * 16 + swz / 64; C = (st & 1) * 32 + (swz % 64) / 2; }
__host__ __device__ __forceinline__ int perm32(int rho) { const int n = rho >> 4, i = rho & 15; return 8 * (i >> 2) + 4 * n + (i & 3); }

struct Unit { int pm, pn; };
struct Gemm { const bf16_t* A; const bf16_t* A2; const bf16_t* Bt; int M, N, K, lda, ksplit, apn_shift, apn_bytes; };

struct StaticOrder {
    int nM, nN, nwg, G, c;
    __device__ void init(int M, int N, int G_, int c_) { nM = M / BM; nN = N / BM; nwg = nM * nN; G = G_; c = c_; }
    __device__ bool next(int i, Unit& u) const {
        const long L = (long)i * G + c; if (L >= nwg) return false;
        int wgid = (int)L; { const int q = nwg / NXCD, r = nwg % NXCD, xcd = wgid % NXCD, off = wgid / NXCD; wgid = (xcd < r ? xcd * (q + 1) : r * (q + 1) + (xcd - r) * q) + off; }
        const int nig = WGM * nN, gid = wgid / nig, fm = gid * WGM, gsz = (nM - fm) < WGM ? (nM - fm) : WGM;
        u.pm = fm + ((wgid % nig) % gsz); u.pn = (wgid % nig) / gsz; return true;
    }
};

template <class Epi, bool ALIGN_EPI>
__device__ __forceinline__ void gemm_phase(LAS unsigned char* lds, const Gemm g, const StaticOrder& S, const Epi& E) {
    int tid_ = threadIdx.x; asm volatile("" : "+v"(tid_));
    const int tid = tid_, wid = __builtin_amdgcn_readfirstlane(tid >> 6), lane = tid & 63, wr = wid >> 2, wc = wid & 3, fr = lane & 15, fq = lane >> 4;
    const int K = g.K, nt = K / BK, lda = g.lda;
    unsigned voffA[2], voffB[2];
#pragma unroll
    for (int i = 0; i < 2; ++i) { int R, C; stage_rc(tid * 16 + i * 8192, R, C); const int Rb = Epi::PERM ? ((R & ~31) + perm32(R & 31)) : R;
        voffA[i] = (unsigned)(R * lda + C) * 2u; voffB[i] = (unsigned)(Rb * K + C) * 2u; }
    const size_t kstep = (size_t)(BK * 2);
    const size_t hstepA = (size_t)HALF * lda * 2, tstepA = 2 * hstepA;
    const size_t hstepB = (size_t)HALF * K * 2, tstepB = 2 * hstepB;
    const unsigned ldsw = (unsigned)wid * 1024u;
    const int aoff = lds_byte(wr * 64 + fr, fq * 8), boff = lds_byte(wc * 32 + fr, fq * 8);
#define PG8_SA(b, h) (((b) * 2 + (h)) * HTB)
#define PG8_SB(b, h) ((4 + (b) * 2 + (h)) * HTB)
#define PG8_STAGE(bufoff, gbase, voff) do { _Pragma("unroll") for (int _i = 0; _i < 2; ++_i) \
        __builtin_amdgcn_global_load_lds((const unsigned*)((const char*)(gbase) + (voff)[_i]), (LAS unsigned*)(lds + (bufoff) + ldsw + _i * 8192), 16, 0, 0); } while (0)
#define PG8_LDA(dst, b, h) do { _Pragma("unroll") for (int m = 0; m < 4; ++m) _Pragma("unroll") for (int k = 0; k < 2; ++k) dst[m][k] = *(const LAS bf16x8*)(lds + PG8_SA(b, h) + aoff + m * 2048 + k * 1024); } while (0)
#define PG8_LDB(dst, b, h) do { _Pragma("unroll") for (int n = 0; n < 2; ++n) _Pragma("unroll") for (int k = 0; k < 2; ++k) dst[n][k] = *(const LAS bf16x8*)(lds + PG8_SB(b, h) + boff + n * 2048 + k * 1024); } while (0)
#define PG8_MMA(ai, bj, At, Bt) do { __builtin_amdgcn_s_setprio(1); _Pragma("unroll") for (int m = 0; m < 4; ++m) _Pragma("unroll") for (int n = 0; n < 2; ++n) _Pragma("unroll") for (int k = 0; k < 2; ++k) \
        acc[ai][bj][m][n] = __builtin_amdgcn_mfma_f32_16x16x32_f16(__builtin_bit_cast(h16x8, Bt[n][k]), __builtin_bit_cast(h16x8, At[m][k]), acc[ai][bj][m][n], 0, 0, 0); __builtin_amdgcn_s_setprio(0); } while (0)
#define PG8_WAIT_V(n) asm volatile("s_waitcnt vmcnt(" #n ")" ::: "memory")
#define PG8_WAIT_L(n) asm volatile("s_waitcnt lgkmcnt(" #n ")" ::: "memory")
#define PG8_BAR __builtin_amdgcn_s_barrier()
#define PG8_SCHED __builtin_amdgcn_sched_barrier(0)
    Unit cur, nxt; int ui = 0;
    if (!S.next(0, cur)) return;
    f32x4 acc[2][2][4][2];
#pragma unroll
    for (int a = 0; a < 2; ++a)
#pragma unroll
        for (int b = 0; b < 2; ++b)
#pragma unroll
            for (int m = 0; m < 4; ++m)
#pragma unroll
                for (int n = 0; n < 2; ++n) acc[a][b][m][n] = (f32x4){0.f, 0.f, 0.f, 0.f};
    bf16x8 At[4][2], B0[2][2], B1[2][2];
    const char* cA = (const char*)g.A + (size_t)cur.pm * tstepA + (size_t)(cur.pn >> g.apn_shift) * g.apn_bytes;
    const char* cA2 = (const char*)g.A2 + (size_t)cur.pm * tstepA;
    const char* cB = (const char*)g.Bt + (size_t)cur.pn * tstepB;
    PG8_STAGE(PG8_SB(0, 0), cB, voffB); PG8_STAGE(PG8_SB(0, 1), cB + hstepB, voffB); PG8_STAGE(PG8_SA(0, 0), cA, voffA); PG8_STAGE(PG8_SA(0, 1), cA + hstepA, voffA);
    if (wr == 1) PG8_BAR;
    PG8_WAIT_V(2); PG8_BAR;
    PG8_STAGE(PG8_SB(1, 0), cB + kstep, voffB); PG8_STAGE(PG8_SA(1, 0), cA + kstep, voffA); PG8_STAGE(PG8_SB(1, 1), cB + hstepB + kstep, voffB);
    PG8_WAIT_V(6); PG8_BAR;
    for (;;) {
        const bool has_next = S.next(ui + 1, nxt);
        const char* nA = has_next ? (const char*)g.A + (size_t)nxt.pm * tstepA + (size_t)(nxt.pn >> g.apn_shift) * g.apn_bytes : cA;
        const char* nA2 = has_next ? (const char*)g.A2 + (size_t)nxt.pm * tstepA : cA2;
        const char* nB = has_next ? (const char*)g.Bt + (size_t)nxt.pn * tstepB : cB;
        for (int t = 0; t < nt; t += 2) {
            const bool last = (t == nt - 2);
            const char* a1 = ((t < g.ksplit) ? cA : cA2) + (size_t)(t + 1) * kstep;
            const char* a2 = last ? nA : ((t + 2 < g.ksplit) ? cA : cA2) + (size_t)(t + 2) * kstep;
            const char* b2 = last ? nB : cB + (size_t)(t + 2) * kstep;
            const char* a3 = a2 + kstep; const char* b3 = b2 + kstep;
            if constexpr (Epi::HOOK) { if (t == g.ksplit || t == g.ksplit + 8) E.hook(acc, cur, (t - g.ksplit) >> 3, wr, wc, fr, fq); }
            PG8_LDB(B0, 0, 0); PG8_LDB(B1, 0, 1); PG8_SCHED; PG8_LDA(At, 0, 0); PG8_STAGE(PG8_SA(1, 1), a1 + hstepA, voffA);
            PG8_WAIT_V(8); PG8_WAIT_L(0); PG8_BAR; PG8_MMA(0, 0, At, B0); PG8_MMA(0, 1, At, B1); PG8_BAR; PG8_SCHED;
            PG8_LDA(At, 0, 1); PG8_STAGE(PG8_SB(0, 0), b2, voffB); PG8_STAGE(PG8_SB(0, 1), b2 + hstepB, voffB); PG8_STAGE(PG8_SA(0, 0), a2, voffA);
            PG8_WAIT_V(8); PG8_WAIT_L(0); PG8_BAR; PG8_MMA(1, 0, At, B0); PG8_MMA(1, 1, At, B1); PG8_BAR; PG8_SCHED;
            PG8_LDB(B0, 1, 0); PG8_LDB(B1, 1, 1); PG8_SCHED; PG8_LDA(At, 1, 0); PG8_STAGE(PG8_SA(0, 1), a2 + hstepA, voffA);
            PG8_WAIT_V(8); PG8_WAIT_L(0); PG8_BAR; PG8_MMA(0, 0, At, B0); PG8_MMA(0, 1, At, B1); PG8_BAR; PG8_SCHED;
            PG8_LDA(At, 1, 1); PG8_STAGE(PG8_SB(1, 0), b3, voffB); PG8_STAGE(PG8_SB(1, 1), b3 + hstepB, voffB); PG8_STAGE(PG8_SA(1, 0), a3, voffA);
            PG8_WAIT_V(8); PG8_WAIT_L(0); PG8_BAR; PG8_MMA(1, 0, At, B0); PG8_MMA(1, 1, At, B1); PG8_BAR; PG8_SCHED;
        }
        if constexpr (ALIGN_EPI) { if (wr == 0) PG8_BAR; }
        E(acc, cur, wr, wc, fr, fq);
        if (!has_next) break;
#pragma unroll
        for (int a = 0; a < 2; ++a)
#pragma unroll
            for (int b = 0; b < 2; ++b)
#pragma unroll
                for (int m = 0; m < 4; ++m)
#pragma unroll
                    for (int n = 0; n < 2; ++n) acc[a][b][m][n] = (f32x4){0.f, 0.f, 0.f, 0.f};
        cur = nxt; cA = nA; cA2 = nA2; cB = nB; ++ui;
        if constexpr (ALIGN_EPI) { if (wr == 1) PG8_BAR; }
    }
    PG8_WAIT_V(0);
    if constexpr (!ALIGN_EPI) { if (wr == 0) PG8_BAR; }
    PG8_BAR;
#undef PG8_SA
#undef PG8_SB
#undef PG8_STAGE
#undef PG8_LDA
#undef PG8_LDB
#undef PG8_MMA
#undef PG8_WAIT_V
#undef PG8_WAIT_L
#undef PG8_BAR
#undef PG8_SCHED
}

template <int MODE> struct EpiBf {
    static constexpr bool PERM = true, HOOK = false;
    bf16_t* O; int ldc; bf16_t* O1; bf16_t* O2; bf16_t* O3;
    __device__ __forceinline__ void operator()(const f32x4 (&acc)[2][2][4][2], const Unit& u, int wr, int wc, int fr, int fq) const {
        bf16_t* base = O; int ld = ldc; int colt = u.pn * BM;
        if (MODE == 2) { const int pn = u.pn;
            if (pn < 4) { base = O; ld = 1024; colt = pn * 256; } else if (pn < 8) { base = O1; ld = 1024; colt = (pn - 4) * 256; }
            else if (pn < 14) { base = O2; ld = 1536; colt = (pn - 8) * 256; } else { base = O3; ld = 1024; colt = (pn - 14) * 256; } }
        const int row0 = u.pm * BM + wr * 64 + fr, col0 = colt + wc * 32 + 8 * fq;
#pragma unroll
        for (int ai = 0; ai < 2; ++ai)
#pragma unroll
            for (int m = 0; m < 4; ++m) { bf16_t* rowp = base + (size_t)(row0 + ai * HALF + m * 16) * ld + col0;
#pragma unroll
                for (int bj = 0; bj < 2; ++bj) { f32x4 v0 = acc[ai][bj][m][0], v1 = acc[ai][bj][m][1];
                    if (MODE == 1) {
#pragma unroll
                        for (int j = 0; j < 4; ++j) { v0[j] = sigm(v0[j]); v1[j] = sigm(v1[j]); } }
                    u32x4 w; w.x = cvt_pk_bf16(v0[0], v0[1]); w.y = cvt_pk_bf16(v0[2], v0[3]); w.z = cvt_pk_bf16(v1[0], v1[1]); w.w = cvt_pk_bf16(v1[2], v1[3]);
                    *(u32x4*)(rowp + bj * HALF) = w; } }
    }
};
struct EpiSwiGLU {
    static constexpr bool PERM = true, HOOK = false;
    bf16_t* O; int ldc;
    __device__ __forceinline__ void operator()(const f32x4 (&acc)[2][2][4][2], const Unit& u, int wr, int wc, int fr, int fq) const {
        const int row0 = u.pm * BM + wr * 64 + fr, col0 = u.pn * HALF + wc * 32 + 8 * fq;
#pragma unroll
        for (int ai = 0; ai < 2; ++ai)
#pragma unroll
            for (int m = 0; m < 4; ++m) { bf16_t* rowp = O + (size_t)(row0 + ai * HALF + m * 16) * ldc + col0;
                f32x4 h0, h1;
#pragma unroll
                for (int j = 0; j < 4; ++j) { h0[j] = silu_(acc[ai][0][m][0][j]) * acc[ai][1][m][0][j]; h1[j] = silu_(acc[ai][0][m][1][j]) * acc[ai][1][m][1][j]; }
                u32x4 w; w.x = cvt_pk_bf16(h0[0], h0[1]); w.y = cvt_pk_bf16(h0[2], h0[3]); w.z = cvt_pk_bf16(h1[0], h1[1]); w.w = cvt_pk_bf16(h1[2], h1[3]);
                *(u32x4*)rowp = w; }
    }
};
struct EpiMerge {
    static constexpr bool PERM = true, HOOK = true;
    const bf16_t* G; bf16_t* O;
    __device__ __forceinline__ void hook(f32x4 (&acc)[2][2][4][2], const Unit& u, int which, int wr, int wc, int fr, int fq) const {
        int row0 = u.pm * BM + wr * 64 + fr, col0 = u.pn * BM + wc * 32 + 8 * fq + which * 1024;
        asm volatile("" : "+v"(row0), "+v"(col0));
#pragma unroll
        for (int ai = 0; ai < 2; ++ai)
#pragma unroll
            for (int m = 0; m < 4; ++m) { const bf16_t* gp = G + (size_t)(row0 + ai * HALF + m * 16) * 3072 + col0;
#pragma unroll
                for (int bj = 0; bj < 2; ++bj)
#pragma unroll
                    for (int n = 0; n < 2; ++n) { const u32x2 ga = *(const u32x2*)(gp + bj * HALF + 4 * n), gb = *(const u32x2*)(gp + 1024 + bj * HALF + 4 * n);
                        f32x4 r; r[0] = bflo(ga.x) * rcpf_(bflo(gb.x)); r[1] = bfhi(ga.x) * rcpf_(bfhi(gb.x)); r[2] = bflo(ga.y) * rcpf_(bflo(gb.y)); r[3] = bfhi(ga.y) * rcpf_(bfhi(gb.y));
                        acc[ai][bj][m][n] *= r; asm volatile("" ::: "memory"); } }
    }
    __device__ __forceinline__ void operator()(const f32x4 (&acc)[2][2][4][2], const Unit& u, int wr, int wc, int fr, int fq) const {
        const int row0 = u.pm * BM + wr * 64 + fr, col0 = u.pn * BM + wc * 32 + 8 * fq;
#pragma unroll
        for (int ai = 0; ai < 2; ++ai)
#pragma unroll
            for (int m = 0; m < 4; ++m) { const size_t r = (size_t)(row0 + ai * HALF + m * 16);
#pragma unroll
                for (int bj = 0; bj < 2; ++bj) { const u32x4 gc = *(const u32x4*)(G + r * 3072 + 2048 + col0 + bj * HALF);
                    const f32x4 v0 = acc[ai][bj][m][0], v1 = acc[ai][bj][m][1];
                    u32x4 w; w.x = cvt_pk_bf16(v0[0] * bflo(gc.x), v0[1] * bfhi(gc.x)); w.y = cvt_pk_bf16(v0[2] * bflo(gc.y), v0[3] * bfhi(gc.y));
                    w.z = cvt_pk_bf16(v1[0] * bflo(gc.z), v1[1] * bfhi(gc.z)); w.w = cvt_pk_bf16(v1[2] * bflo(gc.w), v1[3] * bfhi(gc.w));
                    *(u32x4*)(O + r * 1024 + col0 + bj * HALF) = w; }
                asm volatile("" ::: "memory"); }
    }
};
struct EpiGates {
    static constexpr bool PERM = false, HOOK = false;
    const bf16_t* XC; bf16_t* U; unsigned char* R; const float* ba; const float* bx; const float* lc;
    __device__ __forceinline__ void operator()(const f32x4 (&acc)[2][2][4][2], const Unit& u, int wr, int wc, int fr, int fq) const {
        int ch0 = 64 * u.pn + 16 * wc + 4 * fq, row0 = u.pm * BM + wr * 64 + fr;
        asm volatile("" : "+v"(row0), "+v"(ch0));
#pragma unroll
        for (int ai = 0; ai < 2; ++ai)
#pragma unroll
            for (int m = 0; m < 4; ++m) { const unsigned off = (unsigned)(row0 + ai * HALF + m * 16) * 1024u + (unsigned)ch0;
                const u32x2 xw = *(const u32x2*)((const char*)XC + (size_t)(off * 2u));
#pragma unroll
                for (int d = 0; d < 2; ++d) {
                    const f32x4 ba4 = *(const f32x4*)(ba + d * 1024 + ch0), bx4 = *(const f32x4*)(bx + d * 1024 + ch0);
                    f32x4 xc; xc[0] = bflo(xw.x); xc[1] = bfhi(xw.x); xc[2] = bflo(xw.y); xc[3] = bfhi(xw.y);
                    f32x4 uv; unsigned rq = 0;
#pragma unroll
                    for (int j = 0; j < 4; ++j) { const float rr = sigm(acc[ai][d][m][0][j] + ba4[j]), ig = sigm(acc[ai][d][m][1][j] + bx4[j]);
                        uv[j] = ig * xc[j];
                        rq |= ((unsigned)__builtin_rintf(rr * 255.f)) << (8 * j); }
                    u32x2 w; w.x = cvt_pk_bf16(uv[0], uv[1]); w.y = cvt_pk_bf16(uv[2], uv[3]);
                    *(u32x2*)((char*)(U + (size_t)d * T * 1024) + (size_t)(off * 2u)) = w;
                    *(unsigned*)((char*)(R + (size_t)d * T * 1024) + (size_t)off) = rq;
                    asm volatile("" ::: "memory"); } }
    }
};
}

__device__ __forceinline__ int w_rowmap(int mode, int n, int p0) {
    if (mode == 0) return n;
    if (mode == 1) return 256 * (n >> 7) + p0 + (n & 127);
    const int dir = p0 >> 3, head = (p0 >> 1) & 3, ri = p0 & 1, ch = 256 * head + n;
    return 256 * (ch >> 6) + 128 * dir + 32 * ((ch >> 4) & 3) + 16 * ri + (ch & 15);
}
__device__ __forceinline__ void tr_item(const float* W, int N, int item, bf16_t* WT, int ldk, int koff, int mode, int p0, LAS float* scr, int lane) {
    const int nblk = N / 32, kb = item / nblk, nb = item % nblk, k0 = 64 * kb, n0 = 32 * nb;
#pragma unroll 8
    for (int i = 0; i < 32; ++i) { const int kk = 2 * i + (lane >> 5); scr[kk * 33 + (lane & 31)] = W[(size_t)(k0 + kk) * N + n0 + (lane & 31)]; }
    asm volatile("s_waitcnt lgkmcnt(0)" ::: "memory");
    const int c = lane & 7;
#pragma unroll
    for (int j = 0; j < 4; ++j) { const int nn = (lane >> 3) + 8 * j; const LAS float* s = scr + (8 * c) * 33 + nn;
        u32x4 o; o.x = cvt_pk_bf16(s[0 * 33], s[1 * 33]); o.y = cvt_pk_bf16(s[2 * 33], s[3 * 33]); o.z = cvt_pk_bf16(s[4 * 33], s[5 * 33]); o.w = cvt_pk_bf16(s[6 * 33], s[7 * 33]);
        *(u32x4*)(WT + (size_t)w_rowmap(mode, n0 + nn, p0) * ldk + koff + k0 + 8 * c) = o; }
    asm volatile("s_waitcnt lgkmcnt(0)" ::: "memory");
}
__device__ __forceinline__ void convert_layer(const float* const* tab, unsigned char* ws, int l, LAS unsigned char* lds) {
    int tid_ = threadIdx.x; asm volatile("" : "+v"(tid_));
    const int tid = tid_, lane = tid & 63, wave = tid >> 6;
    LAS float* scr = (LAS float*)(lds + wave * 8448);
    const int gw = blockIdx.x * NWAVES + wave, NGW = gridDim.x * NWAVES;
    constexpr int I_UP = 16 * 88, I_DN = 44 * 32, I_IN = 16 * 240, I_LRU = 256, I_SQ = 512, I_HALF = 256;
    constexpr int NITEMS = 6 * I_UP + I_IN + 2 * I_LRU + 2 * I_SQ + 2 * I_HALF;
    const size_t oUP = (size_t)l * D * FF, oSQ = (size_t)l * D * D, oHF = (size_t)l * 512 * D, oLRU = (size_t)l * 2 * 4 * 256 * 256;
    for (int it = gw; it < NITEMS; it += NGW) {
        int r = it;
        if (r < I_UP) { tr_item(in_ptr(tab, 2) + oUP, FF, r, (bf16_t*)(ws + W_UP1), 1024, 0, 1, 0, scr, lane); continue; } r -= I_UP;
        if (r < I_UP) { tr_item(in_ptr(tab, 3) + oUP, FF, r, (bf16_t*)(ws + W_UP1), 1024, 0, 1, 128, scr, lane); continue; } r -= I_UP;
        if (r < I_DN) { tr_item(in_ptr(tab, 4) + oUP, D, r, (bf16_t*)(ws + W_DN1), FF, 0, 0, 0, scr, lane); continue; } r -= I_DN;
        if (r < I_IN) { tr_item(in_ptr(tab, 7) + (size_t)l * D * DIN, DIN, r, (bf16_t*)(ws + W_IN), 1024, 0, 0, 0, scr, lane); continue; } r -= I_IN;
        if (r < I_LRU) { const int mat = r >> 5; tr_item(in_ptr(tab, 10) + oLRU + (size_t)mat * 65536, 256, r & 31, (bf16_t*)(ws + W_LRU), 256, 0, 2, ((mat >> 2) << 3) | ((mat & 3) << 1) | 0, scr, lane); continue; } r -= I_LRU;
        if (r < I_LRU) { const int mat = r >> 5; tr_item(in_ptr(tab, 12) + oLRU + (size_t)mat * 65536, 256, r & 31, (bf16_t*)(ws + W_LRU), 256, 0, 2, ((mat >> 2) << 3) | ((mat & 3) << 1) | 1, scr, lane); continue; } r -= I_LRU;
        if (r < I_SQ) { tr_item(in_ptr(tab, 15) + oSQ, D, r, (bf16_t*)(ws + W_CAT), 2048, 0, 0, 0, scr, lane); continue; } r -= I_SQ;
        if (r < I_HALF) { tr_item(in_ptr(tab, 17) + oHF, D, r, (bf16_t*)(ws + W_CAT), 2048, 1024, 0, 0, scr, lane); continue; } r -= I_HALF;
        if (r < I_HALF) { tr_item(in_ptr(tab, 22) + oHF, D, r, (bf16_t*)(ws + W_CAT), 2048, 1536, 0, 0, scr, lane); continue; } r -= I_HALF;
        if (r < I_SQ) { tr_item(in_ptr(tab, 23) + oSQ, D, r, (bf16_t*)(ws + W_O), 1024, 0, 0, 0, scr, lane); continue; } r -= I_SQ;
        if (r < I_UP) { tr_item(in_ptr(tab, 26) + oUP, FF, r, (bf16_t*)(ws + W_UP2), 1024, 0, 1, 0, scr, lane); continue; } r -= I_UP;
        if (r < I_UP) { tr_item(in_ptr(tab, 27) + oUP, FF, r, (bf16_t*)(ws + W_UP2), 1024, 0, 1, 128, scr, lane); continue; } r -= I_UP;
        tr_item(in_ptr(tab, 28) + oUP, D, r, (bf16_t*)(ws + W_DN2), FF, 0, 0, 0, scr, lane);
    }
}
__device__ __forceinline__ void lc_all(const float* const* tab, unsigned char* ws) {
    float* LC = (float*)(ws + WS_LC); const float* lam = in_ptr(tab, 14);
    for (int i = blockIdx.x * NTHR + threadIdx.x; i < DEPTH * 2048; i += gridDim.x * NTHR) LC[i] = -8.f * log1pf(expf(-lam[i]));
}

template <bool HASF>
__device__ __forceinline__ void ew_phase(const float* xin, float* xout, const bf16_t* Fb, float scale, const float* post_g, const float* pre_g, bf16_t* XN) {
    int tid_ = threadIdx.x; asm volatile("" : "+v"(tid_));
    const int tid = tid_, lane = tid & 63, wave = tid >> 6;
    const int gw = blockIdx.x * NWAVES + wave, NGW = gridDim.x * NWAVES;
    for (int m = gw; m < T; m += NGW) {
        const f32x4* xr = (const f32x4*)(xin + (size_t)m * D) + lane;
        f32x4 v[4];
#pragma unroll
        for (int j = 0; j < 4; ++j) v[j] = xr[64 * j];
        if (HASF) {
            const u32x2* fr_ = (const u32x2*)(Fb + (size_t)m * D) + lane;
            f32x4 f[4]; float ss = 0.f;
#pragma unroll
            for (int j = 0; j < 4; ++j) { const u32x2 w = fr_[64 * j]; f[j][0] = bflo(w.x); f[j][1] = bfhi(w.x); f[j][2] = bflo(w.y); f[j][3] = bfhi(w.y);
                ss += (f[j][0] * f[j][0] + f[j][1] * f[j][1]) + (f[j][2] * f[j][2] + f[j][3] * f[j][3]); }
            const float rs = scale * __builtin_amdgcn_rsqf(wave_sum(ss, lane) * (1.f / D) + EPS);
#pragma unroll
            for (int j = 0; j < 4; ++j) { const f32x4 pg = *((const f32x4*)post_g + 64 * j + lane); v[j] += f[j] * rs * pg; }
        }
        if (HASF || xin != xout) {
            f32x4* xo = (f32x4*)(xout + (size_t)m * D) + lane;
#pragma unroll
            for (int j = 0; j < 4; ++j) xo[64 * j] = v[j];
        }
        if (pre_g) {
            float s2 = 0.f;
#pragma unroll
            for (int j = 0; j < 4; ++j) s2 += (v[j][0] * v[j][0] + v[j][1] * v[j][1]) + (v[j][2] * v[j][2] + v[j][3] * v[j][3]);
            const float rs2 = __builtin_amdgcn_rsqf(wave_sum(s2, lane) * (1.f / D) + EPS);
            u32x2* o = (u32x2*)(XN + (size_t)m * D) + lane;
#pragma unroll
            for (int j = 0; j < 4; ++j) { const f32x4 g = *((const f32x4*)pre_g + 64 * j + lane); const f32x4 y = v[j] * rs2 * g;
                u32x2 w; w.x = cvt_pk_bf16(y[0], y[1]); w.y = cvt_pk_bf16(y[2], y[3]); o[64 * j] = w; }
        }
    }
}

constexpr int VT_PITCH = 272;
__device__ __forceinline__ void prep_phase(const float* const* tab, unsigned char* ws, int l, LAS unsigned char* lds) {
    int tid_ = threadIdx.x; asm volatile("" : "+v"(tid_));
    const int tid = tid_, lane = tid & 63, wave = tid >> 6;
    const bf16_t* ZX = (const bf16_t*)(ws + WS_ZX); const bf16_t* ZSC = (const bf16_t*)(ws + WS_ZSC); const bf16_t* ZSGU = (const bf16_t*)(ws + WS_ZSGU);
    bf16_t* XC = (bf16_t*)(ws + WS_XC); bf16_t* YBC = (bf16_t*)(ws + WS_YBC);
    for (int item = blockIdx.x; item < T / 128; item += gridDim.x) {
        const int b = item >> 7, n = item & 127, t0 = n * 128; const size_t rb = (size_t)b * S;
        {
            const int c = 8 * (tid & 127), sg = tid >> 7; const float* cw = in_ptr(tab, 8) + (size_t)l * 4096 + c; const float* cb = in_ptr(tab, 9) + (size_t)l * 1024 + c;
            float wk[4][8], bb[8];
#pragma unroll
            for (int k = 0; k < 4; ++k) { const f32x4 a0 = *(const f32x4*)(cw + k * 1024), a1 = *(const f32x4*)(cw + k * 1024 + 4);
#pragma unroll
                for (int j = 0; j < 4; ++j) { wk[k][j] = a0[j]; wk[k][4 + j] = a1[j]; } }
            { const f32x4 a0 = *(const f32x4*)cb, a1 = *(const f32x4*)(cb + 4);
#pragma unroll
              for (int j = 0; j < 4; ++j) { bb[j] = a0[j]; bb[4 + j] = a1[j]; } }
            const bf16_t* src = ZX + rb * 1024 + c;
#pragma unroll 1
            for (int blk = 0; blk < 4; ++blk) { const int tb = t0 + sg * 32 + blk * 8;
                u32x4 xr[11];
#pragma unroll
                for (int i = 0; i < 11; ++i) { const int t = tb - 2 + i; xr[i] = (t >= 0 && t < S) ? *(const u32x4*)(src + (size_t)t * 1024) : (u32x4){0u, 0u, 0u, 0u}; }
#pragma unroll
                for (int o = 0; o < 8; ++o) { float y[8];
#pragma unroll
                    for (int j = 0; j < 8; ++j) y[j] = bb[j] + wk[0][j] * h8(xr[o], j) + wk[1][j] * h8(xr[o + 1], j) + wk[2][j] * h8(xr[o + 2], j) + wk[3][j] * h8(xr[o + 3], j);
                    u32x4 w; w.x = cvt_pk_bf16(y[0], y[1]); w.y = cvt_pk_bf16(y[2], y[3]); w.z = cvt_pk_bf16(y[4], y[5]); w.w = cvt_pk_bf16(y[6], y[7]);
                    *(u32x4*)(XC + (rb + tb + o) * 1024 + c) = w; } }
        }
        {
            const int c = 8 * (tid & 63), sg = tid >> 6; const float* cw = in_ptr(tab, 16) + (size_t)l * 1536 + c;
            float wk[3][8];
#pragma unroll
            for (int k = 0; k < 3; ++k) { const f32x4 a0 = *(const f32x4*)(cw + k * 512), a1 = *(const f32x4*)(cw + k * 512 + 4);
#pragma unroll
                for (int j = 0; j < 4; ++j) { wk[k][j] = a0[j]; wk[k][4 + j] = a1[j]; } }
            const bf16_t* src = ZSC + rb * 1536 + c;
#pragma unroll 1
            for (int blk = 0; blk < 4; ++blk) { const int tb = t0 + sg * 16 + blk * 4;
                u32x4 cr[6], xr[6], br[4];
#pragma unroll
                for (int i = 0; i < 6; ++i) { const int t = tb - 1 + i; const bool in = (t >= 0 && t < S);
                    cr[i] = in ? *(const u32x4*)(src + (size_t)t * 1536 + 512) : (u32x4){0u, 0u, 0u, 0u}; xr[i] = in ? *(const u32x4*)(src + (size_t)t * 1536 + 1024) : (u32x4){0u, 0u, 0u, 0u}; }
#pragma unroll
                for (int o = 0; o < 4; ++o) br[o] = *(const u32x4*)(src + (size_t)(tb + o) * 1536);
                float p[6][8];
#pragma unroll
                for (int i = 0; i < 6; ++i)
#pragma unroll
                    for (int j = 0; j < 8; ++j) p[i][j] = h8(cr[i], j) * h8(xr[i], j);
#pragma unroll
                for (int o = 0; o < 4; ++o) { float y[8];
#pragma unroll
                    for (int j = 0; j < 8; ++j) y[j] = h8(br[o], j) * (wk[0][j] * p[o][j] + wk[1][j] * p[o + 1][j] + wk[2][j] * p[o + 2][j]);
                    u32x4 w; w.x = cvt_pk_bf16(y[0], y[1]); w.y = cvt_pk_bf16(y[2], y[3]); w.z = cvt_pk_bf16(y[4], y[5]); w.w = cvt_pk_bf16(y[6], y[7]);
                    *(u32x4*)(YBC + (rb + tb + o) * 1024 + c) = w; } }
        }
        {
            const float* lg = in_ptr(tab, 18) + (size_t)l * 512; const float* lb = in_ptr(tab, 19) + (size_t)l * 512;
            f32x4 g0 = *(const f32x4*)(lg + 8 * lane), g1 = *(const f32x4*)(lg + 8 * lane + 4), b0 = *(const f32x4*)(lb + 8 * lane), b1 = *(const f32x4*)(lb + 8 * lane + 4);
            u32x4 wrow[16];
#pragma unroll
            for (int qi = 0; qi < 16; ++qi) wrow[qi] = *(const u32x4*)(ZSGU + (rb + t0 + wave + 8 * qi) * 1024 + 512 + 8 * lane);
#pragma unroll
            for (int qi = 0; qi < 16; ++qi) { const int q = wave + 8 * qi; const u32x4 w = wrow[qi];
                float v[8]; v[0] = bflo(w.x); v[1] = bfhi(w.x); v[2] = bflo(w.y); v[3] = bfhi(w.y); v[4] = bflo(w.z); v[5] = bfhi(w.z); v[6] = bflo(w.w); v[7] = bfhi(w.w);
                float s = 0.f;
#pragma unroll
                for (int j = 0; j < 8; ++j) { v[j] = gelu_(v[j]); s += v[j]; }
                const float mu = wave_sum(s, lane) * (1.f / 512.f); float s2 = 0.f;
#pragma unroll
                for (int j = 0; j < 8; ++j) { v[j] -= mu; s2 += v[j] * v[j]; }
                const float rstd = __builtin_amdgcn_rsqf(wave_sum(s2, lane) * (1.f / 512.f) + EPS);
#pragma unroll
                for (int j = 0; j < 8; ++j) { const float y = v[j] * rstd * (j < 4 ? g0[j & 3] : g1[j & 3]) + (j < 4 ? b0[j & 3] : b1[j & 3]);
                    *(LAS bf16_t*)(lds + (8 * lane + j) * VT_PITCH + 2 * q) = (bf16_t)(cvt_pk_bf16(y, 0.f) & 0xffffu); }
            }
            __syncthreads();
            const int g = wave >> 1, p0 = 64 * (wave & 1), fr = lane & 15, fq = lane >> 4;
            const float* Wg = in_ptr(tab, 20) + (size_t)l * 65536 + (size_t)g * 16384; const float* bs = in_ptr(tab, 21) + (size_t)l * 512 + g * 128;
            bf16x8 Wf[4][4];
#pragma unroll
            for (int m = 0; m < 4; ++m)
#pragma unroll
                for (int kk = 0; kk < 4; ++kk) { const float* p = Wg + (size_t)(p0 + 16 * m + fr) * 128 + 32 * kk + 8 * fq; const f32x4 x0 = *(const f32x4*)p, x1 = *(const f32x4*)(p + 4);
                    u32x4 w; w.x = cvt_pk_bf16(x0[0], x0[1]); w.y = cvt_pk_bf16(x0[2], x0[3]); w.z = cvt_pk_bf16(x1[0], x1[1]); w.w = cvt_pk_bf16(x1[2], x1[3]);
                    Wf[m][kk] = __builtin_bit_cast(bf16x8, w); }
            float bsv[4];
#pragma unroll
            for (int m = 0; m < 4; ++m) bsv[m] = bs[p0 + 16 * m + fr];
            for (int nn = 0; nn < 8; ++nn) {
                f32x4 acc[4];
#pragma unroll
                for (int m = 0; m < 4; ++m) acc[m] = (f32x4){0.f, 0.f, 0.f, 0.f};
#pragma unroll
                for (int kk = 0; kk < 4; ++kk) { const bf16x8 vf = *(const LAS bf16x8*)(lds + (g * 128 + 16 * nn + fr) * VT_PITCH + (32 * kk + 8 * fq) * 2);
#pragma unroll
                    for (int m = 0; m < 4; ++m) acc[m] = __builtin_amdgcn_mfma_f32_16x16x32_f16(__builtin_bit_cast(h16x8, vf), __builtin_bit_cast(h16x8, Wf[m][kk]), acc[m], 0, 0, 0); }
                const int cc = g * 128 + 16 * nn + 4 * fq;
#pragma unroll
                for (int m = 0; m < 4; ++m) { const size_t row = rb + t0 + p0 + 16 * m + fr;
                    const u32x2 uw = *(const u32x2*)(ZSGU + row * 1024 + cc);
                    const float o0 = gelu_(bflo(uw.x)) * (acc[m][0] + bsv[m]), o1 = gelu_(bfhi(uw.x)) * (acc[m][1] + bsv[m]), o2 = gelu_(bflo(uw.y)) * (acc[m][2] + bsv[m]), o3 = gelu_(bfhi(uw.y)) * (acc[m][3] + bsv[m]);
                    u32x2 w; w.x = cvt_pk_bf16(o0, o1); w.y = cvt_pk_bf16(o2, o3); if (ABL == 3) { w.x = 0u; w.y = 0u; }
                    *(u32x2*)(YBC + row * 1024 + 512 + cc) = w; }
            }
            __syncthreads();
        }
    }
}

__device__ __forceinline__ void scan_pass1(unsigned char* ws, int l, LAS unsigned char* lds) {
    int tid_ = threadIdx.x; asm volatile("" : "+v"(tid_));
    const int tid = tid_, lane = tid & 63, seg = tid >> 6;
    const float* LC = (const float*)(ws + WS_LC) + l * 2048; f32x2* SUM = (f32x2*)(ws + WS_SUM);
    LAS f32x4* SEG = (LAS f32x4*)lds;
    for (int item = blockIdx.x; item < 2048; item += gridDim.x) {
        const int dir = item & 1, grp = (item >> 1) & 7, chunk = (item >> 4) & 63, b = item >> 10;
        const int ch = grp * 128 + 2 * lane;
        const float l0 = LC[dir * 1024 + ch] * (1.f / 255.f), l1 = LC[dir * 1024 + ch + 1] * (1.f / 255.f);
        const bf16_t* U = (const bf16_t*)(ws + WS_U) + (size_t)dir * T * 1024 + ((size_t)b * S + chunk * 256) * 1024 + ch;
        const unsigned char* R = ws + WS_R + (size_t)dir * T * 1024 + ((size_t)b * S + chunk * 256) * 1024 + ch;
        float A0 = 1.f, A1 = 1.f, H0 = 0.f, H1 = 0.f;
#pragma unroll 8
        for (int k = 0; k < 32; ++k) { const int p = seg * 32 + k, to = dir ? 255 - p : p;
            const unsigned uw = *(const unsigned*)(U + (size_t)to * 1024); const unsigned rw = *(const unsigned short*)(R + (size_t)to * 1024);
            const float a0 = __expf(l0 * (float)(rw & 255u)), a1 = __expf(l1 * (float)(rw >> 8));
            H0 = a0 * H0 + bflo(uw) * __builtin_sqrtf(1.f - a0 * a0); H1 = a1 * H1 + bfhi(uw) * __builtin_sqrtf(1.f - a1 * a1); A0 *= a0; A1 *= a1; }
        SEG[seg * 64 + lane] = (f32x4){A0, H0, A1, H1};
        __syncthreads();
        if (tid < 64) { float cA0 = 1.f, cA1 = 1.f, cH0 = 0.f, cH1 = 0.f;
#pragma unroll
            for (int s = 0; s < 8; ++s) { const f32x4 v = SEG[s * 64 + tid]; cH0 = v[0] * cH0 + v[1]; cA0 *= v[0]; cH1 = v[2] * cH1 + v[3]; cA1 *= v[2]; }
            f32x4* o = (f32x4*)(SUM + ((size_t)((dir * 2 + b) * 64 + chunk)) * 1024 + grp * 128 + 2 * tid); *o = (f32x4){cA0, cH0, cA1, cH1}; }
        __syncthreads();
    }
}
__device__ __forceinline__ void scan_pass2(unsigned char* ws, int l, LAS unsigned char* lds) {
    int tid_ = threadIdx.x; asm volatile("" : "+v"(tid_));
    const int tid = tid_, lane = tid & 63, seg = tid >> 6;
    const float* LC = (const float*)(ws + WS_LC) + l * 2048; const f32x2* SUM = (const f32x2*)(ws + WS_SUM);
    LAS f32x2* HF = (LAS f32x2*)lds;
    LAS f32x4* SEG = (LAS f32x4*)(lds + 131072);
    LAS f32x2* CAR = (LAS f32x2*)(lds + 131072 + 8192);
    for (int item = blockIdx.x; item < 1024; item += gridDim.x) {
        const int grp = item & 7, chunk = (item >> 3) & 63, b = item >> 9;
        const int ch = grp * 128 + 2 * lane;
        bf16_t* ZG = (bf16_t*)(ws + WS_ZG) + ((size_t)b * S + chunk * 256) * 1024 + ch;
#pragma unroll 1
        for (int dir = 0; dir < 2; ++dir) {
            const float l0 = LC[dir * 1024 + ch] * (1.f / 255.f), l1 = LC[dir * 1024 + ch + 1] * (1.f / 255.f);
            const bf16_t* U = (const bf16_t*)(ws + WS_U) + (size_t)dir * T * 1024 + ((size_t)b * S + chunk * 256) * 1024 + ch;
            const unsigned char* R = ws + WS_R + (size_t)dir * T * 1024 + ((size_t)b * S + chunk * 256) * 1024 + ch;
            { float A0 = 1.f, A1 = 1.f, H0 = 0.f, H1 = 0.f;
#pragma unroll 8
              for (int k = 0; k < 32; ++k) { const int p = seg * 32 + k, to = dir ? 255 - p : p;
                  const unsigned uw = *(const unsigned*)(U + (size_t)to * 1024); const unsigned rw = *(const unsigned short*)(R + (size_t)to * 1024);
                  const float a0 = __expf(l0 * (float)(rw & 255u)), a1 = __expf(l1 * (float)(rw >> 8));
                  H0 = a0 * H0 + bflo(uw) * __builtin_sqrtf(1.f - a0 * a0); H1 = a1 * H1 + bfhi(uw) * __builtin_sqrtf(1.f - a1 * a1); A0 *= a0; A1 *= a1; }
              SEG[seg * 64 + lane] = (f32x4){A0, H0, A1, H1}; }
            if (tid < 64) { const f32x4* sp = (const f32x4*)(SUM + ((size_t)((dir * 2 + b) * 64)) * 1024 + grp * 128 + 2 * tid);
                float h0 = 0.f, h1 = 0.f;
                const int nprev = dir ? 63 - chunk : chunk;
                for (int j0 = 0; j0 < nprev; j0 += 8) { f32x4 v[8];
#pragma unroll
                    for (int u = 0; u < 8; ++u) { const int jj = j0 + u; const int cj = dir ? 63 - jj : jj; const int cl = jj < nprev ? cj : chunk;
                        v[u] = sp[(size_t)cl * 512]; if (jj >= nprev) v[u] = (f32x4){1.f, 0.f, 1.f, 0.f}; }
#pragma unroll
                    for (int u = 0; u < 8; ++u) { h0 = v[u][0] * h0 + v[u][1]; h1 = v[u][2] * h1 + v[u][3]; } }
                CAR[tid] = (f32x2){h0, h1}; }
            __syncthreads();
            float h0, h1; { const f32x2 c = CAR[lane]; h0 = c[0]; h1 = c[1]; }
            for (int s = 0; s < seg; ++s) { const f32x4 v = SEG[s * 64 + lane]; h0 = v[0] * h0 + v[1]; h1 = v[2] * h1 + v[3]; }
#pragma unroll 1
            for (int kb = 0; kb < 4; ++kb) { unsigned uw8[8], rw8[8], gw8[8];
#pragma unroll
                for (int u = 0; u < 8; ++u) { const int p = seg * 32 + kb * 8 + u, to = dir ? 255 - p : p;
                    uw8[u] = *(const unsigned*)(U + (size_t)to * 1024); rw8[u] = *(const unsigned short*)(R + (size_t)to * 1024);
                    gw8[u] = dir ? *(const unsigned*)(ZG + (size_t)to * 1024) : 0u; }
#pragma unroll
                for (int u = 0; u < 8; ++u) { const int p = seg * 32 + kb * 8 + u, to = dir ? 255 - p : p; const unsigned uw = uw8[u], rw = rw8[u];
                    const float a0 = __expf(l0 * (float)(rw & 255u)), a1 = __expf(l1 * (float)(rw >> 8));
                    h0 = a0 * h0 + bflo(uw) * __builtin_sqrtf(1.f - a0 * a0); h1 = a1 * h1 + bfhi(uw) * __builtin_sqrtf(1.f - a1 * a1);
                    if (dir == 0) HF[to * 64 + lane] = (f32x2){h0, h1};
                    else { const f32x2 hf = HF[to * 64 + lane]; const unsigned gw = gw8[u];
                        *(unsigned*)(ZG + (size_t)to * 1024) = cvt_pk_bf16((hf[0] + h0) * gelu_(bflo(gw)), (hf[1] + h1) * gelu_(bfhi(gw))); } } }
            __syncthreads();
        }
    }
}

#ifdef DBG
constexpr size_t WS_DBG = 70000;
__device__ __forceinline__ float bfv(const bf16_t* p) { return bflo((unsigned)*p); }
__device__ __forceinline__ float dotA(const bf16_t* arow, const float* W, int K, int N, int col) { float s = 0.f; for (int k = 0; k < K; ++k) s += bfv(arow + k) * W[(size_t)k * N + col]; return s; }
__device__ __forceinline__ void dbg_cmp(unsigned* dbg, unsigned code, float got, float ref, float tol_rel, float tol_abs) {
    const float e = fabsf(got - ref); if (!(e <= tol_rel * fabsf(ref) + tol_abs)) atomicMin(dbg, code); }
__device__ __forceinline__ void dbg_check(int stage, const float* const* tab, unsigned char* ws, float* X) {
    unsigned* dbg = (unsigned*)(ws + WS_DBG); const int t = blockIdx.x * 64 + threadIdx.x;
    int r = (int)(((long)t * 5273 + 17) % T); const bf16_t* XN = (const bf16_t*)(ws + WS_XN);
    { const int q = t >> 1; const int base = (q & 1) ? S : 0;
      if (t < 40) { const int k = q >> 1; const int off = (k == 0) ? 0 : (k == 1) ? 1 : (k == 2) ? 2 : (k == 3) ? 127 : (k == 4) ? 128 : (k == 5) ? 255 : (k == 6) ? 256 : (k == 7) ? S - 1 : (k == 8) ? S - 2 : S - 3; r = base + off; } }
    if (stage == 2) { const int c = (int)((long)t * 911 + 3) % FF; const float g = dotA(XN + (size_t)r * D, (in_ptr(tab, DBG_F ? 26 : 2) + (size_t)DBG_LAYER * (D*FF)), D, FF, c), u = dotA(XN + (size_t)r * D, (in_ptr(tab, DBG_F ? 27 : 3) + (size_t)DBG_LAYER * (D*FF)), D, FF, c);
        dbg_cmp(dbg, 2, bfv((const bf16_t*)(ws + WS_H) + (size_t)r * FF + c), g / (1.f + expf(-g)) * u, 0.03f, 0.03f); }
    if (stage == 3) { const int c = (int)((long)t * 911 + 3) % D; dbg_cmp(dbg, 3, bfv((const bf16_t*)(ws + WS_F) + (size_t)r * D + c), dotA((const bf16_t*)(ws + WS_H) + (size_t)r * FF, (in_ptr(tab, DBG_F ? 28 : 4) + (size_t)DBG_LAYER * (D*FF)), FF, D, c), 0.03f, 0.03f); }
    if (stage == 4) { const int c = (int)((long)t * 911 + 3) % D; const bf16_t* F = (const bf16_t*)(ws + WS_F) + (size_t)r * D; float ss = 0.f; for (int k = 0; k < D; ++k) ss += bfv(F + k) * bfv(F + k);
        const float* x0 = in_ptr(tab, 0) + (size_t)r * D; float s2 = 0.f;
        for (int k = 0; k < D; ++k) { const float xv = x0[k] + 0.5f * bfv(F + k) * rsqrtf(ss / D + EPS) * (in_ptr(tab, 5) + (size_t)DBG_LAYER * (D))[k]; s2 += xv * xv; if (k == c) dbg_cmp(dbg, 4, X[(size_t)r * D + c], xv, 0.001f, 0.001f); }
        dbg_cmp(dbg, 4, bfv(XN + (size_t)r * D + c), X[(size_t)r * D + c] * rsqrtf(s2 / D + EPS) * (in_ptr(tab, 6) + (size_t)DBG_LAYER * (D))[c], 0.01f, 0.01f); }
    if (stage == 5) { const int c = (int)((long)t * 911 + 3) % ZN; const float z = dotA(XN + (size_t)r * D, (in_ptr(tab, 7) + (size_t)DBG_LAYER * (D*DIN)), D, DIN, c); float got;
        if (c < 1024) got = bfv((const bf16_t*)(ws + WS_ZG) + (size_t)r * 1024 + c); else if (c < 2048) got = bfv((const bf16_t*)(ws + WS_ZX) + (size_t)r * 1024 + c - 1024);
        else if (c < 3584) got = bfv((const bf16_t*)(ws + WS_ZSC) + (size_t)r * 1536 + c - 2048); else got = bfv((const bf16_t*)(ws + WS_ZSGU) + (size_t)r * 1024 + c - 3584);
        dbg_cmp(dbg, 5, got, z, 0.03f, 0.03f); }
    if (stage == 6) { const int b = r / S, tt = r % S; const size_t rb = (size_t)b * S;
        { const int c = (int)((long)t * 911 + 3) % 1024; float o = (in_ptr(tab, 9) + (size_t)DBG_LAYER * (1024))[c]; for (int k = 0; k < 4; ++k) { const int q = tt + k - 2; if (q >= 0 && q < S) o += (in_ptr(tab, 8) + (size_t)DBG_LAYER * (4096))[k * 1024 + c] * bfv((const bf16_t*)(ws + WS_ZX) + (rb + q) * 1024 + c); }
          dbg_cmp(dbg, 6, bfv((const bf16_t*)(ws + WS_XC) + (size_t)r * 1024 + c), o, 0.02f, 0.02f); }
        { const int c = (int)((long)t * 911 + 3) % 512; const bf16_t* Z = (const bf16_t*)(ws + WS_ZSC); float o = 0.f; for (int k = 0; k < 3; ++k) { const int q = tt + k - 1; if (q >= 0 && q < S) o += (in_ptr(tab, 16) + (size_t)DBG_LAYER * (1536))[k * 512 + c] * bfv(Z + (rb + q) * 1536 + 512 + c) * bfv(Z + (rb + q) * 1536 + 1024 + c); }
          dbg_cmp(dbg, 7, bfv((const bf16_t*)(ws + WS_YBC) + (size_t)r * 1024 + c), o * bfv(Z + (size_t)r * 1536 + c), 0.02f, 0.02f); }
        { const int c = (int)((long)t * 911 + 3) % 512, g = c >> 7, p = tt & 127, t0 = tt - p; const bf16_t* Z = (const bf16_t*)(ws + WS_ZSGU); float mix = (in_ptr(tab, 21) + (size_t)DBG_LAYER * (512))[g * 128 + p];
          for (int q = 0; q < 128; ++q) { const bf16_t* vr = Z + (rb + t0 + q) * 1024 + 512; float mu = 0.f, var = 0.f; for (int k = 0; k < 512; ++k) mu += gelu_(bfv(vr + k)); mu /= 512.f;
              for (int k = 0; k < 512; ++k) { const float d = gelu_(bfv(vr + k)) - mu; var += d * d; } var /= 512.f;
              const float vn = (gelu_(bfv(vr + c)) - mu) * rsqrtf(var + EPS) * (in_ptr(tab, 18) + (size_t)DBG_LAYER * (512))[c] + (in_ptr(tab, 19) + (size_t)DBG_LAYER * (512))[c]; mix += (in_ptr(tab, 20) + (size_t)DBG_LAYER * (65536))[(size_t)g * 16384 + p * 128 + q] * vn; }
          dbg_cmp(dbg, 8, bfv((const bf16_t*)(ws + WS_YBC) + (size_t)r * 1024 + 512 + c), gelu_(bfv(Z + (size_t)r * 1024 + c)) * mix, 0.03f, 0.03f); } }
    if (stage == 9) { const int c = (int)((long)t * 911 + 3) % 1024, dir = t & 1, head = c >> 8, e = c & 255; const bf16_t* xr = (const bf16_t*)(ws + WS_XC) + (size_t)r * 1024 + head * 256;
        const float pa = dotA(xr, (in_ptr(tab, 10) + (size_t)DBG_LAYER * (524288)) + (size_t)(dir * 4 + head) * 65536, 256, 256, e) + (in_ptr(tab, 11) + (size_t)DBG_LAYER * (2048))[dir * 1024 + c], px = dotA(xr, (in_ptr(tab, 12) + (size_t)DBG_LAYER * (524288)) + (size_t)(dir * 4 + head) * 65536, 256, 256, e) + (in_ptr(tab, 13) + (size_t)DBG_LAYER * (2048))[dir * 1024 + c];
        const float rr = 1.f / (1.f + expf(-pa)), ii = 1.f / (1.f + expf(-px));
        dbg_cmp(dbg, 9, (float)*(ws + WS_R + (size_t)dir * T * 1024 + (size_t)r * 1024 + c), rr * 255.f, 0.02f, 1.5f);
        dbg_cmp(dbg, 10, bfv((const bf16_t*)(ws + WS_U) + (size_t)dir * T * 1024 + (size_t)r * 1024 + c), ii * bfv(xr + e), 0.03f, 0.03f); }
    if (stage == 11) { const int c = (int)((long)t * 911 + 3) % 1024, b = r / S, tt = r % S; const size_t rb = (size_t)b * S; const float* LC = (const float*)(ws + WS_LC) + DBG_LAYER * 2048; float hs = 0.f;
        for (int dir = 0; dir < 2; ++dir) { const bf16_t* U = (const bf16_t*)(ws + WS_U) + (size_t)dir * T * 1024; const unsigned char* R = ws + WS_R + (size_t)dir * T * 1024; float h = 0.f;
            if (dir == 0) { for (int q = 0; q <= tt; ++q) { const float a = expf(LC[c] * (float)R[(rb + q) * 1024 + c] / 255.f); h = a * h + bfv(U + (rb + q) * 1024 + c) * sqrtf(1.f - a * a); } }
            else { for (int q = S - 1; q >= tt; --q) { const float a = expf(LC[1024 + c] * (float)R[(rb + q) * 1024 + c] / 255.f); h = a * h + bfv(U + (rb + q) * 1024 + c) * sqrtf(1.f - a * a); } }
            hs += h; }
        const float gate = dotA(XN + (size_t)r * D, (in_ptr(tab, 7) + (size_t)DBG_LAYER * (D*DIN)), D, DIN, c);
        dbg_cmp(dbg, 11, bfv((const bf16_t*)(ws + WS_ZG) + (size_t)r * 1024 + c), hs * gelu_(gate), 0.03f, 0.03f); }
    if (stage == 10) { const int c = (int)((long)t * 911 + 3) % 1024; ((float*)(ws + WS_DBG + 1024))[t] = bfv((const bf16_t*)(ws + WS_ZG) + (size_t)r * 1024 + c); }
    if (stage == 12) { const int c = (int)((long)t * 911 + 3) % 3072; const float z = dotA(XN + (size_t)r * D, (in_ptr(tab, 7) + (size_t)DBG_LAYER * (D*DIN)), D, DIN, ZN + c);
        dbg_cmp(dbg, 12, bfv((const bf16_t*)(ws + WS_G) + (size_t)r * 3072 + c), 1.f / (1.f + expf(-z)), 0.02f, 0.01f); }
    if (stage == 13) { const int c = (int)((long)t * 911 + 3) % 1024; const bf16_t* G = (const bf16_t*)(ws + WS_G) + (size_t)r * 3072;
        const float ya = dotA((const bf16_t*)(ws + WS_ZG) + (size_t)r * 1024, (in_ptr(tab, 15) + (size_t)DBG_LAYER * (D*D)), 1024, 1024, c), yb = dotA((const bf16_t*)(ws + WS_YBC) + (size_t)r * 1024, (in_ptr(tab, 17) + (size_t)DBG_LAYER * (512*D)), 512, 1024, c), yc = dotA((const bf16_t*)(ws + WS_YBC) + (size_t)r * 1024 + 512, (in_ptr(tab, 22) + (size_t)DBG_LAYER * (512*D)), 512, 1024, c);
        dbg_cmp(dbg, 13, bfv((const bf16_t*)(ws + WS_MG) + (size_t)r * 1024 + c), bfv(G + c) * ya + bfv(G + 1024 + c) * yb + bfv(G + 2048 + c) * yc, 0.03f, 0.05f); }
    if (stage == 15) { const int c = (int)((long)t * 911 + 3) % D; float s2 = 0.f; for (int k = 0; k < D; ++k) s2 += X[(size_t)r * D + k] * X[(size_t)r * D + k];
        dbg_cmp(dbg, 15, bfv(XN + (size_t)r * D + c), X[(size_t)r * D + c] * rsqrtf(s2 / D + EPS) * (in_ptr(tab, DBG_G) + (size_t)DBG_GL * D)[c], 0.01f, 0.01f); }
    if (stage == 16) { const int c = (int)((long)t * 911 + 3) % D; const bf16_t* F = (const bf16_t*)(ws + WS_MX) + (size_t)r * D; float ss = 0.f; for (int k = 0; k < D; ++k) ss += bfv(F + k) * bfv(F + k);
        const float xb = X[(size_t)r * D + c];
        dbg_cmp(dbg, 16, ((const float*)(ws + WS_G))[(size_t)r * D + c], xb + bfv(F + c) * rsqrtf(ss / D + EPS) * (in_ptr(tab, 24) + (size_t)DBG_LAYER * D)[c], 0.001f, 0.001f); }
    if (stage == 17) { const int c = (int)((long)t * 911 + 3) % D; const bf16_t* F = (const bf16_t*)(ws + WS_F) + (size_t)r * D; float ss = 0.f; for (int k = 0; k < D; ++k) ss += bfv(F + k) * bfv(F + k);
        const float xb = X[(size_t)r * D + c];
        dbg_cmp(dbg, 17, ((const float*)(ws + WS_G))[(size_t)r * D + c], xb + 0.5f * bfv(F + c) * rsqrtf(ss / D + EPS) * (in_ptr(tab, 29) + (size_t)DBG_LAYER * D)[c], 0.001f, 0.001f); }
    if (stage == 14) { const int c = (int)((long)t * 911 + 3) % 1024; dbg_cmp(dbg, 14, bfv((const bf16_t*)(ws + WS_MX) + (size_t)r * 1024 + c), dotA((const bf16_t*)(ws + WS_MG) + (size_t)r * 1024, (in_ptr(tab, 23) + (size_t)DBG_LAYER * (D*D)), 1024, 1024, c), 0.03f, 0.03f); }
}
__global__ void __launch_bounds__(64) dbg_kernel(Args a, unsigned mask) {
    unsigned char* ws = a.ws; const float* const* tab = (const float* const*)(ws + WS_TAB);
    for (int st = 2; st <= 17; ++st) if ((mask >> st) & 1u) dbg_check(st, tab, ws, a.out);
}
__global__ void dbg_final(Args a) { const unsigned cde = *(volatile unsigned*)(a.ws + WS_DBG); a.out[0] = (cde != 99u) ? 1000.f + 100.f * (float)cde : 0.f; }
#define DBGCHK(st) do { if (l == DBG_LAYER && (st) == STOP_AT) return; } while (0)
#else
#define DBGCHK(st) do { } while (0)
#endif

__global__ void __launch_bounds__(NTHR, 2) fwd_kernel(Args a) {
    extern __shared__ __attribute__((aligned(16))) unsigned char lds_raw[];
    LAS unsigned char* lds = (LAS unsigned char*)lds_raw;
    cg::grid_group grid = cg::this_grid();
    unsigned char* ws = a.ws;
    { const float** tw = (const float**)(ws + WS_TAB);
      if (threadIdx.x == 0) {
#pragma unroll
          for (int i = 0; i < 30; ++i) tw[i] = a.in[i];
          volatile LAS unsigned* st = (volatile LAS unsigned*)(lds + LDS_BAR_ST); st[0] = 0u; st[1] = 0u;
          (void)xb_add((unsigned*)(ws + WS_BAR) + XB_XCNT(xb_xcc_id()), 1u);
          __threadfence(); }
      __syncthreads(); }
    const float* const* tab = (const float* const*)(ws + WS_TAB);
    const int G = gridDim.x, c = blockIdx.x;
    bf16_t* XN = (bf16_t*)(ws + WS_XN);
    float* X = a.out;
    unsigned char* const ws0 = ws; const int G0 = G, c0 = c; float* const X0 = X;
    constexpr int BIG = 1 << 28;

#ifdef SKEL
    { const float* xin = a.in[0]; for (size_t i = (size_t)blockIdx.x * NTHR + threadIdx.x; i < (size_t)T * D; i += (size_t)gridDim.x * NTHR) a.out[i] = xin[i];
      GSYNC();
#if SKEL >= 2
      convert_layer(tab, ws, 0, lds); GSYNC();
#endif
#if SKEL >= 3
      lc_all(tab, ws); GSYNC();
#endif
#if SKEL >= 4
      ew_phase<false>(in_ptr(tab, 0), X, nullptr, 0.f, nullptr, in_ptr(tab, 1), XN); GSYNC();
#endif
#if SKEL >= 5
      ew_phase<true>(X, X, (const bf16_t*)(ws + WS_F), 0.5f, in_ptr(tab, 5), in_ptr(tab, 6), XN); GSYNC();
#endif
#if SKEL >= 6
      convert_layer(tab, ws, 1, lds); GSYNC();
#endif
      return; }
#endif
#ifdef DBG
    if (blockIdx.x == 0 && threadIdx.x == 0) *(unsigned*)(ws + WS_DBG) = 99u;
#endif
    PH(0) { convert_layer(tab, ws, 0, lds); lc_all(tab, ws); }
    PH(1) ew_phase<false>(in_ptr(tab, 0), X, nullptr, 0.f, nullptr, in_ptr(tab, 1), XN);
    GSYNC_CG();
#ifdef DBG
    if (STOP_AT == 20) return;
#endif

#pragma unroll 1
    for (int l = 0; l < NLAYER_RUN; ++l) {
#pragma unroll 1
        for (int f = 0; f < 2; ++f) {
            unsigned long long wsv = (unsigned long long)ws0, xv = (unsigned long long)X0; int G = G0, c = c0;
#ifndef NOASM
            asm volatile("" : "+s"(wsv), "+s"(G), "+s"(c), "+s"(xv));
#endif
            unsigned char* ws = (unsigned char*)(GAS unsigned char*)wsv; float* X = (float*)(GAS float*)xv;
            const float* const* tab = (const float* const*)(ws + WS_TAB); bf16_t* XN = (bf16_t*)(ws + WS_XN);
            if (f == 1) {
                PH(2) { pg8::Gemm g{XN, XN, (const bf16_t*)(ws + W_IN), T, ZN, D, D, BIG, 0, 0}; pg8::StaticOrder So; So.init(T, ZN, G, c);
                  pg8::EpiBf<2> E{(bf16_t*)(ws + WS_ZG), 1024, (bf16_t*)(ws + WS_ZX), (bf16_t*)(ws + WS_ZSC), (bf16_t*)(ws + WS_ZSGU)};
                  pg8::gemm_phase<pg8::EpiBf<2>, true>(lds, g, So, E); }
                GSYNC();
                DBGCHK(5);
                PH(3) prep_phase(tab, ws, l, lds);
                GSYNC();
                DBGCHK(6);
                PH(4) { const bf16_t* XC = (const bf16_t*)(ws + WS_XC);
                  pg8::Gemm g{XC, XC, (const bf16_t*)(ws + W_LRU), T, 4096, 256, 1024, BIG, 2, 512}; pg8::StaticOrder So; So.init(T, 4096, G, c);
                  pg8::EpiGates E{XC, (bf16_t*)(ws + WS_U), ws + WS_R, in_ptr(tab, 11) + (size_t)l * 2048, in_ptr(tab, 13) + (size_t)l * 2048, (const float*)(ws + WS_LC)};
                  pg8::gemm_phase<pg8::EpiGates, true>(lds, g, So, E); }
                GSYNC();
                DBGCHK(9);
                PH(5) scan_pass1(ws, l, lds);
                GSYNC();
                PH(6) scan_pass2(ws, l, lds);
                GSYNC();
                DBGCHK(11);
                PH(7) { pg8::Gemm g{XN, XN, (const bf16_t*)(ws + W_IN) + (size_t)ZN * D, T, 3072, D, D, BIG, 0, 0}; pg8::StaticOrder So; So.init(T, 3072, G, c);
                  pg8::EpiBf<1> E{(bf16_t*)(ws + WS_G), 3072, nullptr, nullptr, nullptr};
                  pg8::gemm_phase<pg8::EpiBf<1>, true>(lds, g, So, E); }
                GSYNC();
                DBGCHK(12);
                PH(8) { pg8::Gemm g{(const bf16_t*)(ws + WS_ZG), (const bf16_t*)(ws + WS_YBC) - 16 * 64, (const bf16_t*)(ws + W_CAT), T, D, 2048, 1024, 16, 0, 0}; pg8::StaticOrder So; So.init(T, D, G, c);
                  pg8::EpiMerge E{(const bf16_t*)(ws + WS_G), (bf16_t*)(ws + WS_MG)};
                  pg8::gemm_phase<pg8::EpiMerge, true>(lds, g, So, E); }
                GSYNC();
                DBGCHK(13);
                PH(9) { const bf16_t* MG = (const bf16_t*)(ws + WS_MG);
                  pg8::Gemm g{MG, MG, (const bf16_t*)(ws + W_O), T, D, D, D, BIG, 0, 0}; pg8::StaticOrder So; So.init(T, D, G, c);
                  pg8::EpiBf<0> E{(bf16_t*)(ws + WS_MX), 1024, nullptr, nullptr, nullptr};
                  pg8::gemm_phase<pg8::EpiBf<0>, true>(lds, g, So, E); }
                GSYNC();
                DBGCHK(14);
#if defined(DBG) && STOP_AT == 21
                PH(10) ew_phase<true>(X, (float*)(ws + WS_G), (const bf16_t*)(ws + WS_MX), 1.f, in_ptr(tab, 24) + (size_t)l * D, in_ptr(tab, 25) + (size_t)l * D, XN);
#else
                PH(10) ew_phase<true>(X, X, (const bf16_t*)(ws + WS_MX), 1.f, in_ptr(tab, 24) + (size_t)l * D, in_ptr(tab, 25) + (size_t)l * D, XN);
#endif
                GSYNC();
                DBGCHK(21);
            }
            PH(11) { pg8::Gemm g{XN, XN, (const bf16_t*)(ws + (f ? W_UP2 : W_UP1)), T, 2 * FF, D, D, BIG, 0, 0}; pg8::StaticOrder So; So.init(T, 2 * FF, G, c);
              pg8::EpiSwiGLU E{(bf16_t*)(ws + WS_H), FF};
              pg8::gemm_phase<pg8::EpiSwiGLU, true>(lds, g, So, E); }
            GSYNC();
            if (f == DBG_F) DBGCHK(2);
            PH(12) { const bf16_t* H = (const bf16_t*)(ws + WS_H);
              pg8::Gemm g{H, H, (const bf16_t*)(ws + (f ? W_DN2 : W_DN1)), T, D, FF, FF, BIG, 0, 0}; pg8::StaticOrder So; So.init(T, D, G, c);
              pg8::EpiBf<0> E{(bf16_t*)(ws + WS_F), 1024, nullptr, nullptr, nullptr};
              pg8::gemm_phase<pg8::EpiBf<0>, true>(lds, g, So, E); }
            GSYNC();
            if (f == DBG_F) DBGCHK(3);
            if (f == 0) {
                ew_phase<true>(X, X, (const bf16_t*)(ws + WS_F), 0.5f, in_ptr(tab, 5) + (size_t)l * D, in_ptr(tab, 6) + (size_t)l * D, XN);
            } else {
                if (l + 1 < DEPTH) convert_layer(tab, ws, l + 1, lds);
#if defined(DBG) && STOP_AT == 22
                ew_phase<true>(X, (l == DBG_LAYER) ? (float*)(ws + WS_G) : X, (const bf16_t*)(ws + WS_F), 0.5f, in_ptr(tab, 29) + (size_t)l * D, (l + 1 < DEPTH) ? in_ptr(tab, 1) + (size_t)(l + 1) * D : nullptr, XN);
#else
                ew_phase<true>(X, X, (const bf16_t*)(ws + WS_F), 0.5f, in_ptr(tab, 29) + (size_t)l * D, (l + 1 < DEPTH) ? in_ptr(tab, 1) + (size_t)(l + 1) * D : nullptr, XN);
#endif
            }
            GSYNC();
            if (f == 0) DBGCHK(4);
            if (f == 1) DBGCHK(22);
        }
    }
}

extern "C" void kernel_launch(void* const* d_in, const int* in_sizes, int n_in, void* d_out, int out_size, void* d_ws, size_t ws_size, hipStream_t stream) {
    static int grid = 0;
    if (grid == 0) {
        if (n_in != 30 || in_sizes[0] != T * D || out_size != T * D || ws_size < WS_END) { fprintf(stderr, "kernel_launch: unexpected problem geometry (n_in %d, ws %zu)\n", n_in, ws_size); grid = -1; return; }
        int dev = 0, cus = 0, per_cu = 0;
        if (hipGetDevice(&dev) != hipSuccess || hipDeviceGetAttribute(&cus, hipDeviceAttributeMultiprocessorCount, dev) != hipSuccess) { grid = -1; return; }
        if (hipFuncSetAttribute((const void*)fwd_kernel, hipFuncAttributeMaxDynamicSharedMemorySize, LDS_BYTES) != hipSuccess) { fprintf(stderr, "kernel_launch: hipFuncSetAttribute failed\n"); grid = -1; return; }
        if (hipOccupancyMaxActiveBlocksPerMultiprocessor(&per_cu, (const void*)fwd_kernel, NTHR, LDS_BYTES) != hipSuccess || per_cu < 1) { fprintf(stderr, "kernel_launch: occupancy query failed (%d)\n", per_cu); (void)hipGetLastError(); grid = -1; return; }
        grid = cus * per_cu;
    }
    if (grid < 0) return;
    Args a{};
    for (int i = 0; i < 30; ++i) a.in[i] = (const float*)d_in[i];
    a.out = (float*)d_out; a.ws = (unsigned char*)d_ws;
    if (hipMemsetAsync((char*)d_ws + WS_BAR, 0, 16384, stream) != hipSuccess) { fprintf(stderr, "kernel_launch: hipMemsetAsync failed\n"); return; }
    void* args[] = {&a};
    hipError_t e = hipLaunchCooperativeKernel((const void*)fwd_kernel, dim3(grid), dim3(NTHR), args, LDS_BYTES, stream);
    if (e != hipSuccess) fprintf(stderr, "kernel_launch: cooperative launch failed: %s (grid %d)\n", hipGetErrorString(e), grid);
#ifdef DBG
    dbg_kernel<<<128, 64, 0, stream>>>(a, (unsigned)DBG_MASK);
    dbg_final<<<1, 1, 0, stream>>>(a);
#endif
}
```

```cpp
#include <hip/hip_runtime.h>
#include <hip/hip_cooperative_groups.h>
#include <cstdio>
#include <cstdint>
namespace cg = cooperative_groups;

#define LAS __attribute__((address_space(3)))
typedef unsigned short bf16_t;
typedef short bf16x8 __attribute__((ext_vector_type(8)));
typedef float f32x4 __attribute__((ext_vector_type(4)));
typedef float f32x2 __attribute__((ext_vector_type(2)));
typedef unsigned u32x4 __attribute__((ext_vector_type(4)));
typedef unsigned u32x2 __attribute__((ext_vector_type(2)));

constexpr int NB = 2, S = 16384, T = NB * S, D = 1024, FF = 2816, DIN = 7680, ZN = 4608, DEPTH = 4;
constexpr float EPS = 1e-6f;
constexpr int NTHR = 512, NWAVES = 8;

constexpr size_t MiB = 1u << 20;
constexpr size_t WS_LC = 0;
constexpr size_t WS_TAB = 65536;
constexpr size_t WS_SUM = 1 * MiB;
constexpr size_t WS_W = 4 * MiB;
constexpr size_t W_UP1 = WS_W, W_DN1 = W_UP1 + 11 * MiB, W_IN = W_DN1 + 11 * MiB / 2, W_LRU = W_IN + 15 * MiB, W_CAT = W_LRU + 2 * MiB,
                 W_O = W_CAT + 4 * MiB, W_UP2 = W_O + 2 * MiB, W_DN2 = W_UP2 + 11 * MiB, W_END = W_DN2 + 11 * MiB / 2;
static_assert(W_END == 60 * MiB, "weight map");
constexpr size_t WS_XN = 60 * MiB;
constexpr size_t WS_ZG = 124 * MiB, WS_ZX = 188 * MiB, WS_ZSC = 252 * MiB, WS_ZSGU = 348 * MiB, WS_XC = 412 * MiB, WS_YBC = 476 * MiB, WS_END = 540 * MiB;
constexpr size_t WS_U = 188 * MiB, WS_R = 316 * MiB;
constexpr size_t WS_G = 188 * MiB;
constexpr size_t WS_MG = 380 * MiB;
constexpr size_t WS_MX = 124 * MiB;
constexpr size_t WS_H = 124 * MiB;
constexpr size_t WS_F = 316 * MiB;

constexpr int LDS_BYTES = 147456;
#ifndef PHM
#define PHM 0xFFFF
#define NLAYER_RUN DEPTH
#define STOP_AT 11
#define DBG_MASK ((1u << 9) | (1u << 11))
#define DBG_LAYER 1
#define DBG_F 0
#define DBG_G 1
#define DBG_GL 0
#ifndef ABL
#define ABL 0
#endif
#endif
#define PH(b) if constexpr ((PHM >> (b)) & 1)
#define GSYNC_CG() do { asm volatile("s_waitcnt vmcnt(0)" ::: "memory"); __threadfence(); grid.sync(); } while (0)
#define GSYNC() xsync(ws, lds)

struct Args { const float* in[30]; float* out; unsigned char* ws; };

typedef _Float16 h16x2 __attribute__((ext_vector_type(2)));
typedef _Float16 h16x8 __attribute__((ext_vector_type(8)));
__device__ __forceinline__ unsigned cvt_pk_bf16(float lo, float hi) { h16x2 v; v.x = (_Float16)lo; v.y = (_Float16)hi; return __builtin_bit_cast(unsigned, v); }
__device__ __forceinline__ float bflo(unsigned u) { return (float)__builtin_bit_cast(h16x2, u).x; }
__device__ __forceinline__ float bfhi(unsigned u) { return (float)__builtin_bit_cast(h16x2, u).y; }
__device__ __forceinline__ float h8(const u32x4& v, int j) { const unsigned w = (j >> 1) == 0 ? v.x : (j >> 1) == 1 ? v.y : (j >> 1) == 2 ? v.z : v.w; return (j & 1) ? bfhi(w) : bflo(w); }
__device__ __forceinline__ float rcpf_(float x) { return __builtin_amdgcn_rcpf(x); }
__device__ __forceinline__ float sigm(float x) { return rcpf_(1.f + __expf(-x)); }
__device__ __forceinline__ float silu_(float x) { return x * sigm(x); }
__device__ __forceinline__ float gelu_(float x) { const float u = 1.5957691216057308f * (x + 0.044715f * x * x * x); return x * sigm(u); }
#define GAS __attribute__((address_space(1)))
__device__ __forceinline__ const float* in_ptr(const float* const* tab, int i) {
    unsigned long long v = *(const unsigned long long*)(tab + i);
    const unsigned lo = __builtin_amdgcn_readfirstlane((unsigned)v), hi = __builtin_amdgcn_readfirstlane((unsigned)(v >> 32));
    v = ((unsigned long long)hi << 32) | lo;
    return (const float*)(GAS const float*)v;
}
__device__ __forceinline__ float wave_sum(float v, int lane) {
#pragma unroll
    for (int o = 1; o < 64; o <<= 1) v += __int_as_float(__builtin_amdgcn_ds_bpermute((lane ^ o) << 2, __float_as_int(v)));
    return v;
}

constexpr size_t WS_BAR = 131072;
constexpr int LDS_BAR_ST = LDS_BYTES - 64;
#define XB_TMO      128
#define XB_XCNT(j)  (256  + 64 * (j))
#define XB_XSUB(j)  (1280 + 64 * (j))
#define XB_XGEN(j)  (2304 + 64 * (j))
#define XB_TOP      3328
#define XB_TOPGEN   3392
#define XCD_BAR_WORDS 3456
#define XB_SPIN_CAP (1u << 20)
__device__ __forceinline__ unsigned xb_ld(unsigned* p)              { return __hip_atomic_load(p, __ATOMIC_RELAXED, __HIP_MEMORY_SCOPE_AGENT); }
__device__ __forceinline__ unsigned xb_add(unsigned* p, unsigned v) { return __hip_atomic_fetch_add(p, v, __ATOMIC_RELAXED, __HIP_MEMORY_SCOPE_AGENT); }
__device__ __forceinline__ unsigned xb_xcc_id() { return (unsigned)__builtin_amdgcn_s_getreg((3 << 11) | 20) & 0xFu; }
#define XB_SPIN(cond, bar) do { unsigned _sp = 0; while (cond) { __builtin_amdgcn_s_sleep(1); \
    if ((++_sp & 255u) == 0u) { if (xb_ld(&(bar)[XB_TMO])) break; if (_sp > XB_SPIN_CAP) { atomicAdd(&(bar)[XB_TMO], 1u); break; } } } } while (0)
__device__ __forceinline__ void xcd_barrier_complete(unsigned* bar, unsigned x, unsigned& nloc, unsigned& nx) {
    const unsigned G = gridDim.x * gridDim.y * gridDim.z;
    unsigned sum, cnt, mine, sp = 0u;
    for (;;) {
        sum = 0u; cnt = 0u; mine = 0u;
#pragma unroll
        for (unsigned j = 0; j < 16; ++j) { const unsigned c = xb_ld(&bar[XB_XCNT(j)]); sum += c; cnt += (c > 0u) ? 1u : 0u; mine = (j == x) ? c : mine; }
        if (sum == G) break;
        __builtin_amdgcn_s_sleep(1);
        if ((++sp & 255u) == 0u) { if (xb_ld(&bar[XB_TMO])) break; if (sp > XB_SPIN_CAP) { atomicAdd(&bar[XB_TMO], 1u); break; } }
    }
    nloc = mine > 0u ? mine : 1u; nx = cnt > 0u ? cnt : 1u;
}
__device__ __forceinline__ void xsync(unsigned char* ws, LAS unsigned char* lds) {
    asm volatile("s_waitcnt vmcnt(0)" ::: "memory");
    __syncthreads();
    if (threadIdx.x == 0) {
        unsigned* bar = (unsigned*)(ws + WS_BAR); const unsigned x = xb_xcc_id();
        volatile LAS unsigned* st = (volatile LAS unsigned*)(lds + LDS_BAR_ST);
        __builtin_amdgcn_s_waitcnt(0);
        unsigned nloc = st[0], nx = st[1];
        if (nloc == 0u) { xcd_barrier_complete(bar, x, nloc, nx); st[0] = nloc; st[1] = nx; }
        const unsigned old = xb_add(&bar[XB_XSUB(x)], 1u);
        const unsigned gen = old / nloc;
        if (old + 1u == (gen + 1u) * nloc) {
            __builtin_amdgcn_fence(__ATOMIC_RELEASE, "agent");
            asm volatile("s_waitcnt vmcnt(0)" ::: "memory");
            const unsigned og = xb_add(&bar[XB_TOP], 1u);
            const unsigned tg = og / nx;
            if (og + 1u == (tg + 1u) * nx) xb_add(&bar[XB_TOPGEN], 1u);
            else XB_SPIN(xb_ld(&bar[XB_TOPGEN]) == tg, bar);
            __builtin_amdgcn_fence(__ATOMIC_ACQUIRE, "agent");
            xb_add(&bar[XB_XGEN(x)], 1u);
            asm volatile("s_waitcnt vmcnt(0)" ::: "memory");
        } else {
            XB_SPIN(xb_ld(&bar[XB_XGEN(x)]) == gen, bar);
            __builtin_amdgcn_fence(__ATOMIC_ACQUIRE, "agent");
            asm volatile("s_waitcnt vmcnt(0)" ::: "memory");
        }
    }
    __syncthreads();
}

namespace pg8 {
constexpr int BM = 256, BK = 64, HALF = 128, HTB = HALF * BK * 2, STAGE_BYTES = 8 * HTB, NXCD = 8, WGM = 8;
__host__ __device__ __forceinline__ int lds_byte(int r, int c) { const int st = (r >> 4) * 2 + (c >> 5), rr = r & 15, cc = c & 31, ob = rr * 64 + cc * 2; return st * 1024 + (ob ^ (((ob >> 9) & 1) << 5)); }
__host__ __device__ __forceinline__ void stage_rc(int b, int& R, int& C) { const int st = b / 1024, sb = b % 1024, swz = sb ^ (((sb >> 9) & 1) << 5); R = (st >> 1) * 16 + swz / 64; C = (st & 1) * 32 + (swz % 64) / 2; }
__host__ __device__ __forceinline__ int perm32(int rho) { const int n = rho >> 4, i = rho & 15; return 8 * (i >> 2) + 4 * n + (i & 3); }

struct Unit { int pm, pn; };
struct Gemm { const bf16_t* A; const bf16_t* A2; const bf16_t* Bt; int M, N, K, lda, ksplit, apn_shift, apn_bytes; };

struct StaticOrder {
    int nM, nN, nwg, G, c;
    __device__ void init(int M, int N, int G_, int c_) { nM = M / BM; nN = N / BM; nwg = nM * nN; G = G_; c = c_; }
    __device__ bool next(int i, Unit& u) const {
        const long L = (long)i * G + c; if (L >= nwg) return false;
        int wgid = (int)L; { const int q = nwg / NXCD, r = nwg % NXCD, xcd = wgid % NXCD, off = wgid / NXCD; wgid = (xcd < r ? xcd * (q + 1) : r * (q + 1) + (xcd - r) * q) + off; }
        const int nig = WGM * nN, gid = wgid / nig, fm = gid * WGM, gsz = (nM - fm) < WGM ? (nM - fm) : WGM;
        u.pm = fm + ((wgid % nig) % gsz); u.pn = (wgid % nig) / gsz; return true;
    }
};

template <class Epi, bool ALIGN_EPI>
__device__ __forceinline__ void gemm_phase(LAS unsigned char* lds, const Gemm g, const StaticOrder& S, const Epi& E) {
    int tid_ = threadIdx.x; asm volatile("" : "+v"(tid_));
    const int tid = tid_, wid = __builtin_amdgcn_readfirstlane(tid >> 6), lane = tid & 63, wr = wid >> 2, wc = wid & 3, fr = lane & 15, fq = lane >> 4;
    const int K = g.K, nt = K / BK, lda = g.lda;
    unsigned voffA[2], voffB[2];
#pragma unroll
    for (int i = 0; i < 2; ++i) { int R, C; stage_rc(tid * 16 + i * 8192, R, C); const int Rb = Epi::PERM ? ((R & ~31) + perm32(R & 31)) : R;
        voffA[i] = (unsigned)(R * lda + C) * 2u; voffB[i] = (unsigned)(Rb * K + C) * 2u; }
    const size_t kstep = (size_t)(BK * 2);
    const size_t hstepA = (size_t)HALF * lda * 2, tstepA = 2 * hstepA;
    const size_t hstepB = (size_t)HALF * K * 2, tstepB = 2 * hstepB;
    const unsigned ldsw = (unsigned)wid * 1024u;
    const int aoff = lds_byte(wr * 64 + fr, fq * 8), boff = lds_byte(wc * 32 + fr, fq * 8);
#define PG8_SA(b, h) (((b) * 2 + (h)) * HTB)
#define PG8_SB(b, h) ((4 + (b) * 2 + (h)) * HTB)
#define PG8_STAGE(bufoff, gbase, voff) do { _Pragma("unroll") for (int _i = 0; _i < 2; ++_i) \
        __builtin_amdgcn_global_load_lds((const unsigned*)((const char*)(gbase) + (voff)[_i]), (LAS unsigned*)(lds + (bufoff) + ldsw + _i * 8192), 16, 0, 0); } while (0)
#define PG8_LDA(dst, b, h) do { _Pragma("unroll") for (int m = 0; m < 4; ++m) _Pragma("unroll") for (int k = 0; k < 2; ++k) dst[m][k] = *(const LAS bf16x8*)(lds + PG8_SA(b, h) + aoff + m * 2048 + k * 1024); } while (0)
#define PG8_LDB(dst, b, h) do { _Pragma("unroll") for (int n = 0; n < 2; ++n) _Pragma("unroll") for (int k = 0; k < 2; ++k) dst[n][k] = *(const LAS bf16x8*)(lds + PG8_SB(b, h) + boff + n * 2048 + k * 1024); } while (0)
#define PG8_MMA(ai, bj, At, Bt) do { __builtin_amdgcn_s_setprio(1); _Pragma("unroll") for (int m = 0; m < 4; ++m) _Pragma("unroll") for (int n = 0; n < 2; ++n) _Pragma("unroll") for (int k = 0; k < 2; ++k) \
        acc[ai][bj][m][n] = __builtin_amdgcn_mfma_f32_16x16x32_f16(__builtin_bit_cast(h16x8, Bt[n][k]), __builtin_bit_cast(h16x8, At[m][k]), acc[ai][bj][m][n], 0, 0, 0); __builtin_amdgcn_s_setprio(0); } while (0)
#define PG8_WAIT_V(n) asm volatile("s_waitcnt vmcnt(" #n ")" ::: "memory")
#define PG8_WAIT_L(n) asm volatile("s_waitcnt lgkmcnt(" #n ")" ::: "memory")
#define PG8_BAR __builtin_amdgcn_s_barrier()
#define PG8_SCHED __builtin_amdgcn_sched_barrier(0)
    Unit cur, nxt; int ui = 0;
    if (!S.next(0, cur)) return;
    f32x4 acc[2][2][4][2];
#pragma unroll
    for (int a = 0; a < 2; ++a)
#pragma unroll
        for (int b = 0; b < 2; ++b)
#pragma unroll
            for (int m = 0; m < 4; ++m)
#pragma unroll
                for (int n = 0; n < 2; ++n) acc[a][b][m][n] = (f32x4){0.f, 0.f, 0.f, 0.f};
    bf16x8 At[4][2], B0[2][2], B1[2][2];
    const char* cA = (const char*)g.A + (size_t)cur.pm * tstepA + (size_t)(cur.pn >> g.apn_shift) * g.apn_bytes;
    const char* cA2 = (const char*)g.A2 + (size_t)cur.pm * tstepA;
    const char* cB = (const char*)g.Bt + (size_t)cur.pn * tstepB;
    PG8_STAGE(PG8_SB(0, 0), cB, voffB); PG8_STAGE(PG8_SB(0, 1), cB + hstepB, voffB); PG8_STAGE(PG8_SA(0, 0), cA, voffA); PG8_STAGE(PG8_SA(0, 1), cA + hstepA, voffA);
    if (wr == 1) PG8_BAR;
    PG8_WAIT_V(2); PG8_BAR;
    PG8_STAGE(PG8_SB(1, 0), cB + kstep, voffB); PG8_STAGE(PG8_SA(1, 0), cA + kstep, voffA); PG8_STAGE(PG8_SB(1, 1), cB + hstepB + kstep, voffB);
    PG8_WAIT_V(6); PG8_BAR;
    for (;;) {
        const bool has_next = S.next(ui + 1, nxt);
        const char* nA = has_next ? (const char*)g.A + (size_t)nxt.pm * tstepA + (size_t)(nxt.pn >> g.apn_shift) * g.apn_bytes : cA;
        const char* nA2 = has_next ? (const char*)g.A2 + (size_t)nxt.pm * tstepA : cA2;
        const char* nB = has_next ? (const char*)g.Bt + (size_t)nxt.pn * tstepB : cB;
        for (int t = 0; t < nt; t += 2) {
            const bool last = (t == nt - 2);
            const char* a1 = ((t < g.ksplit) ? cA : cA2) + (size_t)(t + 1) * kstep;
            const char* a2 = last ? nA : ((t + 2 < g.ksplit) ? cA : cA2) + (size_t)(t + 2) * kstep;
            const char* b2 = last ? nB : cB + (size_t)(t + 2) * kstep;
            const char* a3 = a2 + kstep; const char* b3 = b2 + kstep;
            if constexpr (Epi::HOOK) { if (t == g.ksplit || t == g.ksplit + 8) E.hook(acc, cur, (t - g.ksplit) >> 3, wr, wc, fr, fq); }
            PG8_LDB(B0, 0, 0); PG8_LDB(B1, 0, 1); PG8_SCHED; PG8_LDA(At, 0, 0); PG8_STAGE(PG8_SA(1, 1), a1 + hstepA, voffA);
            PG8_WAIT_V(8); PG8_WAIT_L(0); PG8_BAR; PG8_MMA(0, 0, At, B0); PG8_MMA(0, 1, At, B1); PG8_BAR; PG8_SCHED;
            PG8_LDA(At, 0, 1); PG8_STAGE(PG8_SB(0, 0), b2, voffB); PG8_STAGE(PG8_SB(0, 1), b2 + hstepB, voffB); PG8_STAGE(PG8_SA(0, 0), a2, voffA);
            PG8_WAIT_V(8); PG8_WAIT_L(0); PG8_BAR; PG8_MMA(1, 0, At, B0); PG8_MMA(1, 1, At, B1); PG8_BAR; PG8_SCHED;
            PG8_LDB(B0, 1, 0); PG8_LDB(B1, 1, 1); PG8_SCHED; PG8_LDA(At, 1, 0); PG8_STAGE(PG8_SA(0, 1), a2 + hstepA, voffA);
            PG8_WAIT_V(8); PG8_WAIT_L(0); PG8_BAR; PG8_MMA(0, 0, At, B0); PG8_MMA(0, 1, At, B1); PG8_BAR; PG8_SCHED;
            PG8_LDA(At, 1, 1); PG8_STAGE(PG8_SB(1, 0), b3, voffB); PG8_STAGE(PG8_SB(1, 1), b3 + hstepB, voffB); PG8_STAGE(PG8_SA(1, 0), a3, voffA);
            PG8_WAIT_V(8); PG8_WAIT_L(0); PG8_BAR; PG8_MMA(1, 0, At, B0); PG8_MMA(1, 1, At, B1); PG8_BAR; PG8_SCHED;
        }
        if constexpr (ALIGN_EPI) { if (wr == 0) PG8_BAR; }
        E(acc, cur, wr, wc, fr, fq);
        if (!has_next) break;
#pragma unroll
        for (int a = 0; a < 2; ++a)
#pragma unroll
            for (int b = 0; b < 2; ++b)
#pragma unroll
                for (int m = 0; m < 4; ++m)
#pragma unroll
                    for (int n = 0; n < 2; ++n) acc[a][b][m][n] = (f32x4){0.f, 0.f, 0.f, 0.f};
        cur = nxt; cA = nA; cA2 = nA2; cB = nB; ++ui;
        if constexpr (ALIGN_EPI) { if (wr == 1) PG8_BAR; }
    }
    PG8_WAIT_V(0);
    if constexpr (!ALIGN_EPI) { if (wr == 0) PG8_BAR; }
    PG8_BAR;
#undef PG8_SA
#undef PG8_SB
#undef PG8_STAGE
#undef PG8_LDA
#undef PG8_LDB
#undef PG8_MMA
#undef PG8_WAIT_V
#undef PG8_WAIT_L
#undef PG8_BAR
#undef PG8_SCHED
}

template <int MODE> struct EpiBf {
    static constexpr bool PERM = true, HOOK = false;
    bf16_t* O; int ldc; bf16_t* O1; bf16_t* O2; bf16_t* O3;
    __device__ __forceinline__ void operator()(const f32x4 (&acc)[2][2][4][2], const Unit& u, int wr, int wc, int fr, int fq) const {
        bf16_t* base = O; int ld = ldc; int colt = u.pn * BM;
        if (MODE == 2) { const int pn = u.pn;
            if (pn < 4) { base = O; ld = 1024; colt = pn * 256; } else if (pn < 8) { base = O1; ld = 1024; colt = (pn - 4) * 256; }
            else if (pn < 14) { base = O2; ld = 1536; colt = (pn - 8) * 256; } else { base = O3; ld = 1024; colt = (pn - 14) * 256; } }
        const int row0 = u.pm * BM + wr * 64 + fr, col0 = colt + wc * 32 + 8 * fq;
#pragma unroll
        for (int ai = 0; ai < 2; ++ai)
#pragma unroll
            for (int m = 0; m < 4; ++m) { bf16_t* rowp = base + (size_t)(row0 + ai * HALF + m * 16) * ld + col0;
#pragma unroll
                for (int bj = 0; bj < 2; ++bj) { f32x4 v0 = acc[ai][bj][m][0], v1 = acc[ai][bj][m][1];
                    if (MODE == 1) {
#pragma unroll
                        for (int j = 0; j < 4; ++j) { v0[j] = sigm(v0[j]); v1[j] = sigm(v1[j]); } }
                    u32x4 w; w.x = cvt_pk_bf16(v0[0], v0[1]); w.y = cvt_pk_bf16(v0[2], v0[3]); w.z = cvt_pk_bf16(v1[0], v1[1]); w.w = cvt_pk_bf16(v1[2], v1[3]);
                    *(u32x4*)(rowp + bj * HALF) = w; } }
    }
};
struct EpiSwiGLU {
    static constexpr bool PERM = true, HOOK = false;
    bf16_t* O; int ldc;
    __device__ __forceinline__ void operator()(const f32x4 (&acc)[2][2][4][2], const Unit& u, int wr, int wc, int fr, int fq) const {
        const int row0 = u.pm * BM + wr * 64 + fr, col0 = u.pn * HALF + wc * 32 + 8 * fq;
#pragma unroll
        for (int ai = 0; ai < 2; ++ai)
#pragma unroll
            for (int m = 0; m < 4; ++m) { bf16_t* rowp = O + (size_t)(row0 + ai * HALF + m * 16) * ldc + col0;
                f32x4 h0, h1;
#pragma unroll
                for (int j = 0; j < 4; ++j) { h0[j] = silu_(acc[ai][0][m][0][j]) * acc[ai][1][m][0][j]; h1[j] = silu_(acc[ai][0][m][1][j]) * acc[ai][1][m][1][j]; }
                u32x4 w; w.x = cvt_pk_bf16(h0[0], h0[1]); w.y = cvt_pk_bf16(h0[2], h0[3]); w.z = cvt_pk_bf16(h1[0], h1[1]); w.w = cvt_pk_bf16(h1[2], h1[3]);
                *(u32x4*)rowp = w; }
    }
};
struct EpiMerge {
    static constexpr bool PERM = true, HOOK = true;
    const bf16_t* G; bf16_t* O;
    __device__ __forceinline__ void hook(f32x4 (&acc)[2][2][4][2], const Unit& u, int which, int wr, int wc, int fr, int fq) const {
        int row0 = u.pm * BM + wr * 64 + fr, col0 = u.pn * BM + wc * 32 + 8 * fq + which * 1024;
        asm volatile("" : "+v"(row0), "+v"(col0));
#pragma unroll
        for (int ai = 0; ai < 2; ++ai)
#pragma unroll
            for (int m = 0; m < 4; ++m) { const bf16_t* gp = G + (size_t)(row0 + ai * HALF + m * 16) * 3072 + col0;
#pragma unroll
                for (int bj = 0; bj < 2; ++bj)
#pragma unroll
                    for (int n = 0; n < 2; ++n) { const u32x2 ga = *(const u32x2*)(gp + bj * HALF + 4 * n), gb = *(const u32x2*)(gp + 1024 + bj * HALF + 4 * n);
                        f32x4 r; r[0] = bflo(ga.x) * rcpf_(bflo(gb.x)); r[1] = bfhi(ga.x) * rcpf_(bfhi(gb.x)); r[2] = bflo(ga.y) * rcpf_(bflo(gb.y)); r[3] = bfhi(ga.y) * rcpf_(bfhi(gb.y));
                        acc[ai][bj][m][n] *= r; asm volatile("" ::: "memory"); } }
    }
    __device__ __forceinline__ void operator()(const f32x4 (&acc)[2][2][4][2], const Unit& u, int wr, int wc, int fr, int fq) const {
        const int row0 = u.pm * BM + wr * 64 + fr, col0 = u.pn * BM + wc * 32 + 8 * fq;
#pragma unroll
        for (int ai = 0; ai < 2; ++ai)
#pragma unroll
            for (int m = 0; m < 4; ++m) { const size_t r = (size_t)(row0 + ai * HALF + m * 16);
#pragma unroll
                for (int bj = 0; bj < 2; ++bj) { const u32x4 gc = *(const u32x4*)(G + r * 3072 + 2048 + col0 + bj * HALF);
                    const f32x4 v0 = acc[ai][bj][m][0], v1 = acc[ai][bj][m][1];
                    u32x4 w; w.x = cvt_pk_bf16(v0[0] * bflo(gc.x), v0[1] * bfhi(gc.x)); w.y = cvt_pk_bf16(v0[2] * bflo(gc.y), v0[3] * bfhi(gc.y));
                    w.z = cvt_pk_bf16(v1[0] * bflo(gc.z), v1[1] * bfhi(gc.z)); w.w = cvt_pk_bf16(v1[2] * bflo(gc.w), v1[3] * bfhi(gc.w));
                    *(u32x4*)(O + r * 1024 + col0 + bj * HALF) = w; }
                asm volatile("" ::: "memory"); }
    }
};
struct EpiGates {
    static constexpr bool PERM = false, HOOK = false;
    const bf16_t* XC; bf16_t* U; unsigned char* R; const float* ba; const float* bx; const float* lc;
    __device__ __forceinline__ void operator()(const f32x4 (&acc)[2][2][4][2], const Unit& u, int wr, int wc, int fr, int fq) const {
        int ch0 = 64 * u.pn + 16 * wc + 4 * fq, row0 = u.pm * BM + wr * 64 + fr;
        asm volatile("" : "+v"(row0), "+v"(ch0));
#pragma unroll
        for (int ai = 0; ai < 2; ++ai)
#pragma unroll
            for (int m = 0; m < 4; ++m) { const unsigned off = (unsigned)(row0 + ai * HALF + m * 16) * 1024u + (unsigned)ch0;
                const u32x2 xw = *(const u32x2*)((const char*)XC + (size_t)(off * 2u));
#pragma unroll
                for (int d = 0; d < 2; ++d) {
                    const f32x4 ba4 = *(const f32x4*)(ba + d * 1024 + ch0), bx4 = *(const f32x4*)(bx + d * 1024 + ch0);
                    f32x4 xc; xc[0] = bflo(xw.x); xc[1] = bfhi(xw.x); xc[2] = bflo(xw.y); xc[3] = bfhi(xw.y);
                    f32x4 uv; unsigned rq = 0;
#pragma unroll
                    for (int j = 0; j < 4; ++j) { const float rr = sigm(acc[ai][d][m][0][j] + ba4[j]), ig = sigm(acc[ai][d][m][1][j] + bx4[j]);
                        uv[j] = ig * xc[j];
                        rq |= ((unsigned)__builtin_rintf(rr * 255.f)) << (8 * j); }
                    u32x2 w; w.x = cvt_pk_bf16(uv[0], uv[1]); w.y = cvt_pk_bf16(uv[2], uv[3]);
                    *(u32x2*)((char*)(U + (size_t)d * T * 1024) + (size_t)(off * 2u)) = w;
                    *(unsigned*)((char*)(R + (size_t)d * T * 1024) + (size_t)off) = rq;
                    asm volatile("" ::: "memory"); } }
    }
};
}

__device__ __forceinline__ int w_rowmap(int mode, int n, int p0) {
    if (mode == 0) return n;
    if (mode == 1) return 256 * (n >> 7) + p0 + (n & 127);
    const int dir = p0 >> 3, head = (p0 >> 1) & 3, ri = p0 & 1, ch = 256 * head + n;
    return 256 * (ch >> 6) + 128 * dir + 32 * ((ch >> 4) & 3) + 16 * ri + (ch & 15);
}
__device__ __forceinline__ void tr_item(const float* W, int N, int item, bf16_t* WT, int ldk, int koff, int mode, int p0, LAS float* scr, int lane) {
    const int nblk = N / 32, kb = item / nblk, nb = item % nblk, k0 = 64 * kb, n0 = 32 * nb;
#pragma unroll 8
    for (int i = 0; i < 32; ++i) { const int kk = 2 * i + (lane >> 5); scr[kk * 33 + (lane & 31)] = W[(size_t)(k0 + kk) * N + n0 + (lane & 31)]; }
    asm volatile("s_waitcnt lgkmcnt(0)" ::: "memory");
    const int c = lane & 7;
#pragma unroll
    for (int j = 0; j < 4; ++j) { const int nn = (lane >> 3) + 8 * j; const LAS float* s = scr + (8 * c) * 33 + nn;
        u32x4 o; o.x = cvt_pk_bf16(s[0 * 33], s[1 * 33]); o.y = cvt_pk_bf16(s[2 * 33], s[3 * 33]); o.z = cvt_pk_bf16(s[4 * 33], s[5 * 33]); o.w = cvt_pk_bf16(s[6 * 33], s[7 * 33]);
        *(u32x4*)(WT + (size_t)w_rowmap(mode, n0 + nn, p0) * ldk + koff + k0 + 8 * c) = o; }
    asm volatile("s_waitcnt lgkmcnt(0)" ::: "memory");
}
__device__ __forceinline__ void convert_layer(const float* const* tab, unsigned char* ws, int l, LAS unsigned char* lds) {
    int tid_ = threadIdx.x; asm volatile("" : "+v"(tid_));
    const int tid = tid_, lane = tid & 63, wave = tid >> 6;
    LAS float* scr = (LAS float*)(lds + wave * 8448);
    const int gw = blockIdx.x * NWAVES + wave, NGW = gridDim.x * NWAVES;
    constexpr int I_UP = 16 * 88, I_DN = 44 * 32, I_IN = 16 * 240, I_LRU = 256, I_SQ = 512, I_HALF = 256;
    constexpr int NITEMS = 6 * I_UP + I_IN + 2 * I_LRU + 2 * I_SQ + 2 * I_HALF;
    const size_t oUP = (size_t)l * D * FF, oSQ = (size_t)l * D * D, oHF = (size_t)l * 512 * D, oLRU = (size_t)l * 2 * 4 * 256 * 256;
    for (int it = gw; it < NITEMS; it += NGW) {
        int r = it;
        if (r < I_UP) { tr_item(in_ptr(tab, 2) + oUP, FF, r, (bf16_t*)(ws + W_UP1), 1024, 0, 1, 0, scr, lane); continue; } r -= I_UP;
        if (r < I_UP) { tr_item(in_ptr(tab, 3) + oUP, FF, r, (bf16_t*)(ws + W_UP1), 1024, 0, 1, 128, scr, lane); continue; } r -= I_UP;
        if (r < I_DN) { tr_item(in_ptr(tab, 4) + oUP, D, r, (bf16_t*)(ws + W_DN1), FF, 0, 0, 0, scr, lane); continue; } r -= I_DN;
        if (r < I_IN) { tr_item(in_ptr(tab, 7) + (size_t)l * D * DIN, DIN, r, (bf16_t*)(ws + W_IN), 1024, 0, 0, 0, scr, lane); continue; } r -= I_IN;
        if (r < I_LRU) { const int mat = r >> 5; tr_item(in_ptr(tab, 10) + oLRU + (size_t)mat * 65536, 256, r & 31, (bf16_t*)(ws + W_LRU), 256, 0, 2, ((mat >> 2) << 3) | ((mat & 3) << 1) | 0, scr, lane); continue; } r -= I_LRU;
        if (r < I_LRU) { const int mat = r >> 5; tr_item(in_ptr(tab, 12) + oLRU + (size_t)mat * 65536, 256, r & 31, (bf16_t*)(ws + W_LRU), 256, 0, 2, ((mat >> 2) << 3) | ((mat & 3) << 1) | 1, scr, lane); continue; } r -= I_LRU;
        if (r < I_SQ) { tr_item(in_ptr(tab, 15) + oSQ, D, r, (bf16_t*)(ws + W_CAT), 2048, 0, 0, 0, scr, lane); continue; } r -= I_SQ;
        if (r < I_HALF) { tr_item(in_ptr(tab, 17) + oHF, D, r, (bf16_t*)(ws + W_CAT), 2048, 1024, 0, 0, scr, lane); continue; } r -= I_HALF;
        if (r < I_HALF) { tr_item(in_ptr(tab, 22) + oHF, D, r, (bf16_t*)(ws + W_CAT), 2048, 1536, 0, 0, scr, lane); continue; } r -= I_HALF;
        if (r < I_SQ) { tr_item(in_ptr(tab, 23) + oSQ, D, r, (bf16_t*)(ws + W_O), 1024, 0, 0, 0, scr, lane); continue; } r -= I_SQ;
        if (r < I_UP) { tr_item(in_ptr(tab, 26) + oUP, FF, r, (bf16_t*)(ws + W_UP2), 1024, 0, 1, 0, scr, lane); continue; } r -= I_UP;
        if (r < I_UP) { tr_item(in_ptr(tab, 27) + oUP, FF, r, (bf16_t*)(ws + W_UP2), 1024, 0, 1, 128, scr, lane); continue; } r -= I_UP;
        tr_item(in_ptr(tab, 28) + oUP, D, r, (bf16_t*)(ws + W_DN2), FF, 0, 0, 0, scr, lane);
    }
}
__device__ __forceinline__ void lc_all(const float* const* tab, unsigned char* ws) {
    float* LC = (float*)(ws + WS_LC); const float* lam = in_ptr(tab, 14);
    for (int i = blockIdx.x * NTHR + threadIdx.x; i < DEPTH * 2048; i += gridDim.x * NTHR) LC[i] = -8.f * log1pf(expf(-lam[i]));
}

__device__ __forceinline__ void wave_sum2(float& a, float& b, int lane) {
#pragma unroll
    for (int o = 1; o < 64; o <<= 1) { const int ad = (lane ^ o) << 2;
        const float ta = __int_as_float(__builtin_amdgcn_ds_bpermute(ad, __float_as_int(a))), tb = __int_as_float(__builtin_amdgcn_ds_bpermute(ad, __float_as_int(b)));
        a += ta; b += tb; }
}
template <bool HASF>
__device__ __forceinline__ void ew_phase(const float* xin, float* xout, const bf16_t* Fb, float scale, const float* post_g, const float* pre_g, bf16_t* XN) {
    int tid_ = threadIdx.x; asm volatile("" : "+v"(tid_));
    const int tid = tid_, lane = tid & 63, wave = tid >> 6;
    const int gw = blockIdx.x * NWAVES + wave, NGW = gridDim.x * NWAVES;
    for (int m = gw; m < T; m += 2 * NGW) {
        f32x4 v[2][4]; f32x4 f[2][4];
#pragma unroll
        for (int r = 0; r < 2; ++r) { const f32x4* xr = (const f32x4*)(xin + (size_t)(m + r * NGW) * D) + lane;
#pragma unroll
            for (int j = 0; j < 4; ++j) v[r][j] = xr[64 * j]; }
        if (HASF) {
            u32x2 fw[2][4];
#pragma unroll
            for (int r = 0; r < 2; ++r) { const u32x2* fr_ = (const u32x2*)(Fb + (size_t)(m + r * NGW) * D) + lane;
#pragma unroll
                for (int j = 0; j < 4; ++j) fw[r][j] = fr_[64 * j]; }
            float ss[2] = {0.f, 0.f};
#pragma unroll
            for (int r = 0; r < 2; ++r)
#pragma unroll
                for (int j = 0; j < 4; ++j) { const u32x2 w = fw[r][j]; f[r][j][0] = bflo(w.x); f[r][j][1] = bfhi(w.x); f[r][j][2] = bflo(w.y); f[r][j][3] = bfhi(w.y);
                    ss[r] += (f[r][j][0] * f[r][j][0] + f[r][j][1] * f[r][j][1]) + (f[r][j][2] * f[r][j][2] + f[r][j][3] * f[r][j][3]); }
            wave_sum2(ss[0], ss[1], lane);
            const float rs0 = scale * __builtin_amdgcn_rsqf(ss[0] * (1.f / D) + EPS), rs1 = scale * __builtin_amdgcn_rsqf(ss[1] * (1.f / D) + EPS);
#pragma unroll
            for (int j = 0; j < 4; ++j) { const f32x4 pg = *((const f32x4*)post_g + 64 * j + lane); v[0][j] += f[0][j] * rs0 * pg; v[1][j] += f[1][j] * rs1 * pg; }
        }
        if (HASF || xin != xout) {
#pragma unroll
            for (int r = 0; r < 2; ++r) { f32x4* xo = (f32x4*)(xout + (size_t)(m + r * NGW) * D) + lane;
#pragma unroll
                for (int j = 0; j < 4; ++j) xo[64 * j] = v[r][j]; }
        }
        if (pre_g) {
            float s2[2] = {0.f, 0.f};
#pragma unroll
            for (int r = 0; r < 2; ++r)
#pragma unroll
                for (int j = 0; j < 4; ++j) s2[r] += (v[r][j][0] * v[r][j][0] + v[r][j][1] * v[r][j][1]) + (v[r][j][2] * v[r][j][2] + v[r][j][3] * v[r][j][3]);
            wave_sum2(s2[0], s2[1], lane);
            const float q0 = __builtin_amdgcn_rsqf(s2[0] * (1.f / D) + EPS), q1 = __builtin_amdgcn_rsqf(s2[1] * (1.f / D) + EPS);
            u32x2* o0 = (u32x2*)(XN + (size_t)m * D) + lane; u32x2* o1 = (u32x2*)(XN + (size_t)(m + NGW) * D) + lane;
#pragma unroll
            for (int j = 0; j < 4; ++j) { const f32x4 g = *((const f32x4*)pre_g + 64 * j + lane); const f32x4 y0 = v[0][j] * q0 * g, y1 = v[1][j] * q1 * g;
                u32x2 w0, w1; w0.x = cvt_pk_bf16(y0[0], y0[1]); w0.y = cvt_pk_bf16(y0[2], y0[3]); w1.x = cvt_pk_bf16(y1[0], y1[1]); w1.y = cvt_pk_bf16(y1[2], y1[3]);
                o0[64 * j] = w0; o1[64 * j] = w1; }
        }
    }
}

constexpr int VT_PITCH = 272;
__device__ __forceinline__ void prep_phase(const float* const* tab, unsigned char* ws, int l, LAS unsigned char* lds) {
    int tid_ = threadIdx.x; asm volatile("" : "+v"(tid_));
    const int tid = tid_, lane = tid & 63, wave = tid >> 6;
    const bf16_t* ZX = (const bf16_t*)(ws + WS_ZX); const bf16_t* ZSC = (const bf16_t*)(ws + WS_ZSC); const bf16_t* ZSGU = (const bf16_t*)(ws + WS_ZSGU);
    bf16_t* XC = (bf16_t*)(ws + WS_XC); bf16_t* YBC = (bf16_t*)(ws + WS_YBC);
    for (int item = blockIdx.x; item < T / 128; item += gridDim.x) {
        const int b = item >> 7, n = item & 127, t0 = n * 128; const size_t rb = (size_t)b * S;
        {
            const int c = 8 * (tid & 127), sg = tid >> 7; const float* cw = in_ptr(tab, 8) + (size_t)l * 4096 + c; const float* cb = in_ptr(tab, 9) + (size_t)l * 1024 + c;
            float wk[4][8], bb[8];
#pragma unroll
            for (int k = 0; k < 4; ++k) { const f32x4 a0 = *(const f32x4*)(cw + k * 1024), a1 = *(const f32x4*)(cw + k * 1024 + 4);
#pragma unroll
                for (int j = 0; j < 4; ++j) { wk[k][j] = a0[j]; wk[k][4 + j] = a1[j]; } }
            { const f32x4 a0 = *(const f32x4*)cb, a1 = *(const f32x4*)(cb + 4);
#pragma unroll
              for (int j = 0; j < 4; ++j) { bb[j] = a0[j]; bb[4 + j] = a1[j]; } }
            const bf16_t* src = ZX + rb * 1024 + c;
#pragma unroll 1
            for (int blk = 0; blk < 4; ++blk) { const int tb = t0 + sg * 32 + blk * 8;
                u32x4 xr[11];
#pragma unroll
                for (int i = 0; i < 11; ++i) { const int t = tb - 2 + i; xr[i] = (t >= 0 && t < S) ? *(const u32x4*)(src + (size_t)t * 1024) : (u32x4){0u, 0u, 0u, 0u}; }
#pragma unroll
                for (int o = 0; o < 8; ++o) { float y[8];
#pragma unroll
                    for (int j = 0; j < 8; ++j) y[j] = bb[j] + wk[0][j] * h8(xr[o], j) + wk[1][j] * h8(xr[o + 1], j) + wk[2][j] * h8(xr[o + 2], j) + wk[3][j] * h8(xr[o + 3], j);
                    u32x4 w; w.x = cvt_pk_bf16(y[0], y[1]); w.y = cvt_pk_bf16(y[2], y[3]); w.z = cvt_pk_bf16(y[4], y[5]); w.w = cvt_pk_bf16(y[6], y[7]);
                    *(u32x4*)(XC + (rb + tb + o) * 1024 + c) = w; } }
        }
        {
            const int c = 8 * (tid & 63), sg = tid >> 6; const float* cw = in_ptr(tab, 16) + (size_t)l * 1536 + c;
            float wk[3][8];
#pragma unroll
            for (int k = 0; k < 3; ++k) { const f32x4 a0 = *(const f32x4*)(cw + k * 512), a1 = *(const f32x4*)(cw + k * 512 + 4);
#pragma unroll
                for (int j = 0; j < 4; ++j) { wk[k][j] = a0[j]; wk[k][4 + j] = a1[j]; } }
            const bf16_t* src = ZSC + rb * 1536 + c;
#pragma unroll 1
            for (int blk = 0; blk < 4; ++blk) { const int tb = t0 + sg * 16 + blk * 4;
                u32x4 cr[6], xr[6], br[4];
#pragma unroll
                for (int i = 0; i < 6; ++i) { const int t = tb - 1 + i; const bool in = (t >= 0 && t < S);
                    cr[i] = in ? *(const u32x4*)(src + (size_t)t * 1536 + 512) : (u32x4){0u, 0u, 0u, 0u}; xr[i] = in ? *(const u32x4*)(src + (size_t)t * 1536 + 1024) : (u32x4){0u, 0u, 0u, 0u}; }
#pragma unroll
                for (int o = 0; o < 4; ++o) br[o] = *(const u32x4*)(src + (size_t)(tb + o) * 1536);
                float p[6][8];
#pragma unroll
                for (int i = 0; i < 6; ++i)
#pragma unroll
                    for (int j = 0; j < 8; ++j) p[i][j] = h8(cr[i], j) * h8(xr[i], j);
#pragma unroll
                for (int o = 0; o < 4; ++o) { float y[8];
#pragma unroll
                    for (int j = 0; j < 8; ++j) y[j] = h8(br[o], j) * (wk[0][j] * p[o][j] + wk[1][j] * p[o + 1][j] + wk[2][j] * p[o + 2][j]);
                    u32x4 w; w.x = cvt_pk_bf16(y[0], y[1]); w.y = cvt_pk_bf16(y[2], y[3]); w.z = cvt_pk_bf16(y[4], y[5]); w.w = cvt_pk_bf16(y[6], y[7]);
                    *(u32x4*)(YBC + (rb + tb + o) * 1024 + c) = w; } }
        }
        {
            const float* lg = in_ptr(tab, 18) + (size_t)l * 512; const float* lb = in_ptr(tab, 19) + (size_t)l * 512;
            f32x4 g0 = *(const f32x4*)(lg + 8 * lane), g1 = *(const f32x4*)(lg + 8 * lane + 4), b0 = *(const f32x4*)(lb + 8 * lane), b1 = *(const f32x4*)(lb + 8 * lane + 4);
            u32x4 wrow[16];
#pragma unroll
            for (int qi = 0; qi < 16; ++qi) wrow[qi] = *(const u32x4*)(ZSGU + (rb + t0 + wave + 8 * qi) * 1024 + 512 + 8 * lane);
#pragma unroll
            for (int qi = 0; qi < 16; ++qi) { const int q = wave + 8 * qi; const u32x4 w = wrow[qi];
                float v[8]; v[0] = bflo(w.x); v[1] = bfhi(w.x); v[2] = bflo(w.y); v[3] = bfhi(w.y); v[4] = bflo(w.z); v[5] = bfhi(w.z); v[6] = bflo(w.w); v[7] = bfhi(w.w);
                float s = 0.f;
#pragma unroll
                for (int j = 0; j < 8; ++j) { v[j] = gelu_(v[j]); s += v[j]; }
                const float mu = wave_sum(s, lane) * (1.f / 512.f); float s2 = 0.f;
#pragma unroll
                for (int j = 0; j < 8; ++j) { v[j] -= mu; s2 += v[j] * v[j]; }
                const float rstd = __builtin_amdgcn_rsqf(wave_sum(s2, lane) * (1.f / 512.f) + EPS);
#pragma unroll
                for (int j = 0; j < 8; ++j) { const float y = v[j] * rstd * (j < 4 ? g0[j & 3] : g1[j & 3]) + (j < 4 ? b0[j & 3] : b1[j & 3]);
                    *(LAS bf16_t*)(lds + (8 * lane + j) * VT_PITCH + 2 * q) = (bf16_t)(cvt_pk_bf16(y, 0.f) & 0xffffu); }
            }
            __syncthreads();
            const int g = wave >> 1, p0 = 64 * (wave & 1), fr = lane & 15, fq = lane >> 4;
            const float* Wg = in_ptr(tab, 20) + (size_t)l * 65536 + (size_t)g * 16384; const float* bs = in_ptr(tab, 21) + (size_t)l * 512 + g * 128;
            bf16x8 Wf[4][4];
#pragma unroll
            for (int m = 0; m < 4; ++m)
#pragma unroll
                for (int kk = 0; kk < 4; ++kk) { const float* p = Wg + (size_t)(p0 + 16 * m + fr) * 128 + 32 * kk + 8 * fq; const f32x4 x0 = *(const f32x4*)p, x1 = *(const f32x4*)(p + 4);
                    u32x4 w; w.x = cvt_pk_bf16(x0[0], x0[1]); w.y = cvt_pk_bf16(x0[2], x0[3]); w.z = cvt_pk_bf16(x1[0], x1[1]); w.w = cvt_pk_bf16(x1[2], x1[3]);
                    Wf[m][kk] = __builtin_bit_cast(bf16x8, w); }
            float bsv[4];
#pragma unroll
            for (int m = 0; m < 4; ++m) bsv[m] = bs[p0 + 16 * m + fr];
            for (int nn = 0; nn < 8; ++nn) {
                f32x4 acc[4];
#pragma unroll
                for (int m = 0; m < 4; ++m) acc[m] = (f32x4){0.f, 0.f, 0.f, 0.f};
#pragma unroll
                for (int kk = 0; kk < 4; ++kk) { const bf16x8 vf = *(const LAS bf16x8*)(lds + (g * 128 + 16 * nn + fr) * VT_PITCH + (32 * kk + 8 * fq) * 2);
#pragma unroll
                    for (int m = 0; m < 4; ++m) acc[m] = __builtin_amdgcn_mfma_f32_16x16x32_f16(__builtin_bit_cast(h16x8, vf), __builtin_bit_cast(h16x8, Wf[m][kk]), acc[m], 0, 0, 0); }
                const int cc = g * 128 + 16 * nn + 4 * fq;
#pragma unroll
                for (int m = 0; m < 4; ++m) { const size_t row = rb + t0 + p0 + 16 * m + fr;
                    const u32x2 uw = *(const u32x2*)(ZSGU + row * 1024 + cc);
                    const float o0 = gelu_(bflo(uw.x)) * (acc[m][0] + bsv[m]), o1 = gelu_(bfhi(uw.x)) * (acc[m][1] + bsv[m]), o2 = gelu_(bflo(uw.y)) * (acc[m][2] + bsv[m]), o3 = gelu_(bfhi(uw.y)) * (acc[m][3] + bsv[m]);
                    u32x2 w; w.x = cvt_pk_bf16(o0, o1); w.y = cvt_pk_bf16(o2, o3); if (ABL == 3) { w.x = 0u; w.y = 0u; }
                    *(u32x2*)(YBC + row * 1024 + 512 + cc) = w; }
            }
            __syncthreads();
        }
    }
}

__device__ __forceinline__ void scan_pass1(unsigned char* ws, int l, LAS unsigned char* lds) {
    int tid_ = threadIdx.x; asm volatile("" : "+v"(tid_));
    const int tid = tid_, lane = tid & 63, seg = tid >> 6;
    const float* LC = (const float*)(ws + WS_LC) + l * 2048; f32x2* SUM = (f32x2*)(ws + WS_SUM);
    LAS f32x4* SEG = (LAS f32x4*)lds;
    for (int item = blockIdx.x; item < 2048; item += gridDim.x) {
        const int dir = item & 1, grp = (item >> 1) & 7, chunk = (item >> 4) & 63, b = item >> 10;
        const int ch = grp * 128 + 2 * lane;
        const float l0 = LC[dir * 1024 + ch] * (1.f / 255.f), l1 = LC[dir * 1024 + ch + 1] * (1.f / 255.f);
        const bf16_t* U = (const bf16_t*)(ws + WS_U) + (size_t)dir * T * 1024 + ((size_t)b * S + chunk * 256) * 1024 + ch;
        const unsigned char* R = ws + WS_R + (size_t)dir * T * 1024 + ((size_t)b * S + chunk * 256) * 1024 + ch;
        float A0 = 1.f, A1 = 1.f, H0 = 0.f, H1 = 0.f;
#pragma unroll 8
        for (int k = 0; k < 32; ++k) { const int p = seg * 32 + k, to = dir ? 255 - p : p;
            const unsigned uw = *(const unsigned*)(U + (size_t)to * 1024); const unsigned rw = *(const unsigned short*)(R + (size_t)to * 1024);
            const float a0 = __expf(l0 * (float)(rw & 255u)), a1 = __expf(l1 * (float)(rw >> 8));
            H0 = a0 * H0 + bflo(uw) * __builtin_sqrtf(1.f - a0 * a0); H1 = a1 * H1 + bfhi(uw) * __builtin_sqrtf(1.f - a1 * a1); A0 *= a0; A1 *= a1; }
        SEG[seg * 64 + lane] = (f32x4){A0, H0, A1, H1};
        __syncthreads();
        if (tid < 64) { float cA0 = 1.f, cA1 = 1.f, cH0 = 0.f, cH1 = 0.f;
#pragma unroll
            for (int s = 0; s < 8; ++s) { const f32x4 v = SEG[s * 64 + tid]; cH0 = v[0] * cH0 + v[1]; cA0 *= v[0]; cH1 = v[2] * cH1 + v[3]; cA1 *= v[2]; }
            f32x4* o = (f32x4*)(SUM + ((size_t)((dir * 2 + b) * 64 + chunk)) * 1024 + grp * 128 + 2 * tid); *o = (f32x4){cA0, cH0, cA1, cH1}; }
        __syncthreads();
    }
}
__device__ __forceinline__ void scan_pass2(unsigned char* ws, int l, LAS unsigned char* lds) {
    int tid_ = threadIdx.x; asm volatile("" : "+v"(tid_));
    const int tid = tid_, lane = tid & 63, seg = tid >> 6;
    const float* LC = (const float*)(ws + WS_LC) + l * 2048; const f32x2* SUM = (const f32x2*)(ws + WS_SUM);
    LAS f32x2* HF = (LAS f32x2*)lds;
    LAS f32x4* SEG = (LAS f32x4*)(lds + 131072);
    LAS f32x2* CAR = (LAS f32x2*)(lds + 131072 + 8192);
    for (int item = blockIdx.x; item < 1024; item += gridDim.x) {
        const int grp = item & 7, chunk = (item >> 3) & 63, b = item >> 9;
        const int ch = grp * 128 + 2 * lane;
        bf16_t* ZG = (bf16_t*)(ws + WS_ZG) + ((size_t)b * S + chunk * 256) * 1024 + ch;
#pragma unroll 1
        for (int dir = 0; dir < 2; ++dir) {
            const float l0 = LC[dir * 1024 + ch] * (1.f / 255.f), l1 = LC[dir * 1024 + ch + 1] * (1.f / 255.f);
            const bf16_t* U = (const bf16_t*)(ws + WS_U) + (size_t)dir * T * 1024 + ((size_t)b * S + chunk * 256) * 1024 + ch;
            const unsigned char* R = ws + WS_R + (size_t)dir * T * 1024 + ((size_t)b * S + chunk * 256) * 1024 + ch;
            { float A0 = 1.f, A1 = 1.f, H0 = 0.f, H1 = 0.f;
#pragma unroll 8
              for (int k = 0; k < 32; ++k) { const int p = seg * 32 + k, to = dir ? 255 - p : p;
                  const unsigned uw = *(const unsigned*)(U + (size_t)to * 1024); const unsigned rw = *(const unsigned short*)(R + (size_t)to * 1024);
                  const float a0 = __expf(l0 * (float)(rw & 255u)), a1 = __expf(l1 * (float)(rw >> 8));
                  H0 = a0 * H0 + bflo(uw) * __builtin_sqrtf(1.f - a0 * a0); H1 = a1 * H1 + bfhi(uw) * __builtin_sqrtf(1.f - a1 * a1); A0 *= a0; A1 *= a1; }
              SEG[seg * 64 + lane] = (f32x4){A0, H0, A1, H1}; }
            if (tid < 64) { const f32x4* sp = (const f32x4*)(SUM + ((size_t)((dir * 2 + b) * 64)) * 1024 + grp * 128 + 2 * tid);
                float h0 = 0.f, h1 = 0.f;
                const int nprev = dir ? 63 - chunk : chunk;
                for (int j0 = 0; j0 < nprev; j0 += 8) { f32x4 v[8];
#pragma unroll
                    for (int u = 0; u < 8; ++u) { const int jj = j0 + u; const int cj = dir ? 63 - jj : jj; const int cl = jj < nprev ? cj : chunk;
                        v[u] = sp[(size_t)cl * 512]; if (jj >= nprev) v[u] = (f32x4){1.f, 0.f, 1.f, 0.f}; }
#pragma unroll
                    for (int u = 0; u < 8; ++u) { h0 = v[u][0] * h0 + v[u][1]; h1 = v[u][2] * h1 + v[u][3]; } }
                CAR[tid] = (f32x2){h0, h1}; }
            __syncthreads();
            float h0, h1; { const f32x2 c = CAR[lane]; h0 = c[0]; h1 = c[1]; }
            for (int s = 0; s < seg; ++s) { const f32x4 v = SEG[s * 64 + lane]; h0 = v[0] * h0 + v[1]; h1 = v[2] * h1 + v[3]; }
#pragma unroll 1
            for (int kb = 0; kb < 4; ++kb) { unsigned uw8[8], rw8[8], gw8[8];
#pragma unroll
                for (int u = 0; u < 8; ++u) { const int p = seg * 32 + kb * 8 + u, to = dir ? 255 - p : p;
                    uw8[u] = *(const unsigned*)(U + (size_t)to * 1024); rw8[u] = *(const unsigned short*)(R + (size_t)to * 1024);
                    gw8[u] = dir ? *(const unsigned*)(ZG + (size_t)to * 1024) : 0u; }
#pragma unroll
                for (int u = 0; u < 8; ++u) { const int p = seg * 32 + kb * 8 + u, to = dir ? 255 - p : p; const unsigned uw = uw8[u], rw = rw8[u];
                    const float a0 = __expf(l0 * (float)(rw & 255u)), a1 = __expf(l1 * (float)(rw >> 8));
                    h0 = a0 * h0 + bflo(uw) * __builtin_sqrtf(1.f - a0 * a0); h1 = a1 * h1 + bfhi(uw) * __builtin_sqrtf(1.f - a1 * a1);
                    if (dir == 0) HF[to * 64 + lane] = (f32x2){h0, h1};
                    else { const f32x2 hf = HF[to * 64 + lane]; const unsigned gw = gw8[u];
                        *(unsigned*)(ZG + (size_t)to * 1024) = cvt_pk_bf16((hf[0] + h0) * gelu_(bflo(gw)), (hf[1] + h1) * gelu_(bfhi(gw))); } } }
            __syncthreads();
        }
    }
}

#ifdef DBG
constexpr size_t WS_DBG = 70000;
__device__ __forceinline__ float bfv(const bf16_t* p) { return bflo((unsigned)*p); }
__device__ __forceinline__ float dotA(const bf16_t* arow, const float* W, int K, int N, int col) { float s = 0.f; for (int k = 0; k < K; ++k) s += bfv(arow + k) * W[(size_t)k * N + col]; return s; }
__device__ __forceinline__ void dbg_cmp(unsigned* dbg, unsigned code, float got, float ref, float tol_rel, float tol_abs) {
    const float e = fabsf(got - ref); if (!(e <= tol_rel * fabsf(ref) + tol_abs)) atomicMin(dbg, code); }
__device__ __forceinline__ void dbg_check(int stage, const float* const* tab, unsigned char* ws, float* X) {
    unsigned* dbg = (unsigned*)(ws + WS_DBG); const int t = blockIdx.x * 64 + threadIdx.x;
    int r = (int)(((long)t * 5273 + 17) % T); const bf16_t* XN = (const bf16_t*)(ws + WS_XN);
    { const int q = t >> 1; const int base = (q & 1) ? S : 0;
      if (t < 40) { const int k = q >> 1; const int off = (k == 0) ? 0 : (k == 1) ? 1 : (k == 2) ? 2 : (k == 3) ? 127 : (k == 4) ? 128 : (k == 5) ? 255 : (k == 6) ? 256 : (k == 7) ? S - 1 : (k == 8) ? S - 2 : S - 3; r = base + off; } }
    if (stage == 2) { const int c = (int)((long)t * 911 + 3) % FF; const float g = dotA(XN + (size_t)r * D, (in_ptr(tab, DBG_F ? 26 : 2) + (size_t)DBG_LAYER * (D*FF)), D, FF, c), u = dotA(XN + (size_t)r * D, (in_ptr(tab, DBG_F ? 27 : 3) + (size_t)DBG_LAYER * (D*FF)), D, FF, c);
        dbg_cmp(dbg, 2, bfv((const bf16_t*)(ws + WS_H) + (size_t)r * FF + c), g / (1.f + expf(-g)) * u, 0.03f, 0.03f); }
    if (stage == 3) { const int c = (int)((long)t * 911 + 3) % D; dbg_cmp(dbg, 3, bfv((const bf16_t*)(ws + WS_F) + (size_t)r * D + c), dotA((const bf16_t*)(ws + WS_H) + (size_t)r * FF, (in_ptr(tab, DBG_F ? 28 : 4) + (size_t)DBG_LAYER * (D*FF)), FF, D, c), 0.03f, 0.03f); }
    if (stage == 4) { const int c = (int)((long)t * 911 + 3) % D; const bf16_t* F = (const bf16_t*)(ws + WS_F) + (size_t)r * D; float ss = 0.f; for (int k = 0; k < D; ++k) ss += bfv(F + k) * bfv(F + k);
        const float* x0 = in_ptr(tab, 0) + (size_t)r * D; float s2 = 0.f;
        for (int k = 0; k < D; ++k) { const float xv = x0[k] + 0.5f * bfv(F + k) * rsqrtf(ss / D + EPS) * (in_ptr(tab, 5) + (size_t)DBG_LAYER * (D))[k]; s2 += xv * xv; if (k == c) dbg_cmp(dbg, 4, X[(size_t)r * D + c], xv, 0.001f, 0.001f); }
        dbg_cmp(dbg, 4, bfv(XN + (size_t)r * D + c), X[(size_t)r * D + c] * rsqrtf(s2 / D + EPS) * (in_ptr(tab, 6) + (size_t)DBG_LAYER * (D))[c], 0.01f, 0.01f); }
    if (stage == 5) { const int c = (int)((long)t * 911 + 3) % ZN; const float z = dotA(XN + (size_t)r * D, (in_ptr(tab, 7) + (size_t)DBG_LAYER * (D*DIN)), D, DIN, c); float got;
        if (c < 1024) got = bfv((const bf16_t*)(ws + WS_ZG) + (size_t)r * 1024 + c); else if (c < 2048) got = bfv((const bf16_t*)(ws + WS_ZX) + (size_t)r * 1024 + c - 1024);
        else if (c < 3584) got = bfv((const bf16_t*)(ws + WS_ZSC) + (size_t)r * 1536 + c - 2048); else got = bfv((const bf16_t*)(ws + WS_ZSGU) + (size_t)r * 1024 + c - 3584);
        dbg_cmp(dbg, 5, got, z, 0.03f, 0.03f); }
    if (stage == 6) { const int b = r / S, tt = r % S; const size_t rb = (size_t)b * S;
        { const int c = (int)((long)t * 911 + 3) % 1024; float o = (in_ptr(tab, 9) + (size_t)DBG_LAYER * (1024))[c]; for (int k = 0; k < 4; ++k) { const int q = tt + k - 2; if (q >= 0 && q < S) o += (in_ptr(tab, 8) + (size_t)DBG_LAYER * (4096))[k * 1024 + c] * bfv((const bf16_t*)(ws + WS_ZX) + (rb + q) * 1024 + c); }
          dbg_cmp(dbg, 6, bfv((const bf16_t*)(ws + WS_XC) + (size_t)r * 1024 + c), o, 0.02f, 0.02f); }
        { const int c = (int)((long)t * 911 + 3) % 512; const bf16_t* Z = (const bf16_t*)(ws + WS_ZSC); float o = 0.f; for (int k = 0; k < 3; ++k) { const int q = tt + k - 1; if (q >= 0 && q < S) o += (in_ptr(tab, 16) + (size_t)DBG_LAYER * (1536))[k * 512 + c] * bfv(Z + (rb + q) * 1536 + 512 + c) * bfv(Z + (rb + q) * 1536 + 1024 + c); }
          dbg_cmp(dbg, 7, bfv((const bf16_t*)(ws + WS_YBC) + (size_t)r * 1024 + c), o * bfv(Z + (size_t)r * 1536 + c), 0.02f, 0.02f); }
        { const int c = (int)((long)t * 911 + 3) % 512, g = c >> 7, p = tt & 127, t0 = tt - p; const bf16_t* Z = (const bf16_t*)(ws + WS_ZSGU); float mix = (in_ptr(tab, 21) + (size_t)DBG_LAYER * (512))[g * 128 + p];
          for (int q = 0; q < 128; ++q) { const bf16_t* vr = Z + (rb + t0 + q) * 1024 + 512; float mu = 0.f, var = 0.f; for (int k = 0; k < 512; ++k) mu += gelu_(bfv(vr + k)); mu /= 512.f;
              for (int k = 0; k < 512; ++k) { const float d = gelu_(bfv(vr + k)) - mu; var += d * d; } var /= 512.f;
              const float vn = (gelu_(bfv(vr + c)) - mu) * rsqrtf(var + EPS) * (in_ptr(tab, 18) + (size_t)DBG_LAYER * (512))[c] + (in_ptr(tab, 19) + (size_t)DBG_LAYER * (512))[c]; mix += (in_ptr(tab, 20) + (size_t)DBG_LAYER * (65536))[(size_t)g * 16384 + p * 128 + q] * vn; }
          dbg_cmp(dbg, 8, bfv((const bf16_t*)(ws + WS_YBC) + (size_t)r * 1024 + 512 + c), gelu_(bfv(Z + (size_t)r * 1024 + c)) * mix, 0.03f, 0.03f); } }
    if (stage == 9) { const int c = (int)((long)t * 911 + 3) % 1024, dir = t & 1, head = c >> 8, e = c & 255; const bf16_t* xr = (const bf16_t*)(ws + WS_XC) + (size_t)r * 1024 + head * 256;
        const float pa = dotA(xr, (in_ptr(tab, 10) + (size_t)DBG_LAYER * (524288)) + (size_t)(dir * 4 + head) * 65536, 256, 256, e) + (in_ptr(tab, 11) + (size_t)DBG_LAYER * (2048))[dir * 1024 + c], px = dotA(xr, (in_ptr(tab, 12) + (size_t)DBG_LAYER * (524288)) + (size_t)(dir * 4 + head) * 65536, 256, 256, e) + (in_ptr(tab, 13) + (size_t)DBG_LAYER * (2048))[dir * 1024 + c];
        const float rr = 1.f / (1.f + expf(-pa)), ii = 1.f / (1.f + expf(-px));
        dbg_cmp(dbg, 9, (float)*(ws + WS_R + (size_t)dir * T * 1024 + (size_t)r * 1024 + c), rr * 255.f, 0.02f, 1.5f);
        dbg_cmp(dbg, 10, bfv((const bf16_t*)(ws + WS_U) + (size_t)dir * T * 1024 + (size_t)r * 1024 + c), ii * bfv(xr + e), 0.03f, 0.03f); }
    if (stage == 11) { const int c = (int)((long)t * 911 + 3) % 1024, b = r / S, tt = r % S; const size_t rb = (size_t)b * S; const float* LC = (const float*)(ws + WS_LC) + DBG_LAYER * 2048; float hs = 0.f;
        for (int dir = 0; dir < 2; ++dir) { const bf16_t* U = (const bf16_t*)(ws + WS_U) + (size_t)dir * T * 1024; const unsigned char* R = ws + WS_R + (size_t)dir * T * 1024; float h = 0.f;
            if (dir == 0) { for (int q = 0; q <= tt; ++q) { const float a = expf(LC[c] * (float)R[(rb + q) * 1024 + c] / 255.f); h = a * h + bfv(U + (rb + q) * 1024 + c) * sqrtf(1.f - a * a); } }
            else { for (int q = S - 1; q >= tt; --q) { const float a = expf(LC[1024 + c] * (float)R[(rb + q) * 1024 + c] / 255.f); h = a * h + bfv(U + (rb + q) * 1024 + c) * sqrtf(1.f - a * a); } }
            hs += h; }
        const float gate = dotA(XN + (size_t)r * D, (in_ptr(tab, 7) + (size_t)DBG_LAYER * (D*DIN)), D, DIN, c);
        dbg_cmp(dbg, 11, bfv((const bf16_t*)(ws + WS_ZG) + (size_t)r * 1024 + c), hs * gelu_(gate), 0.03f, 0.03f); }
    if (stage == 10) { const int c = (int)((long)t * 911 + 3) % 1024; ((float*)(ws + WS_DBG + 1024))[t] = bfv((const bf16_t*)(ws + WS_ZG) + (size_t)r * 1024 + c); }
    if (stage == 12) { const int c = (int)((long)t * 911 + 3) % 3072; const float z = dotA(XN + (size_t)r * D, (in_ptr(tab, 7) + (size_t)DBG_LAYER * (D*DIN)), D, DIN, ZN + c);
        dbg_cmp(dbg, 12, bfv((const bf16_t*)(ws + WS_G) + (size_t)r * 3072 + c), 1.f / (1.f + expf(-z)), 0.02f, 0.01f); }
    if (stage == 13) { const int c = (int)((long)t * 911 + 3) % 1024; const bf16_t* G = (const bf16_t*)(ws + WS_G) + (size_t)r * 3072;
        const float ya = dotA((const bf16_t*)(ws + WS_ZG) + (size_t)r * 1024, (in_ptr(tab, 15) + (size_t)DBG_LAYER * (D*D)), 1024, 1024, c), yb = dotA((const bf16_t*)(ws + WS_YBC) + (size_t)r * 1024, (in_ptr(tab, 17) + (size_t)DBG_LAYER * (512*D)), 512, 1024, c), yc = dotA((const bf16_t*)(ws + WS_YBC) + (size_t)r * 1024 + 512, (in_ptr(tab, 22) + (size_t)DBG_LAYER * (512*D)), 512, 1024, c);
        dbg_cmp(dbg, 13, bfv((const bf16_t*)(ws + WS_MG) + (size_t)r * 1024 + c), bfv(G + c) * ya + bfv(G + 1024 + c) * yb + bfv(G + 2048 + c) * yc, 0.03f, 0.05f); }
    if (stage == 15) { const int c = (int)((long)t * 911 + 3) % D; float s2 = 0.f; for (int k = 0; k < D; ++k) s2 += X[(size_t)r * D + k] * X[(size_t)r * D + k];
        dbg_cmp(dbg, 15, bfv(XN + (size_t)r * D + c), X[(size_t)r * D + c] * rsqrtf(s2 / D + EPS) * (in_ptr(tab, DBG_G) + (size_t)DBG_GL * D)[c], 0.01f, 0.01f); }
    if (stage == 16) { const int c = (int)((long)t * 911 + 3) % D; const bf16_t* F = (const bf16_t*)(ws + WS_MX) + (size_t)r * D; float ss = 0.f; for (int k = 0; k < D; ++k) ss += bfv(F + k) * bfv(F + k);
        const float xb = X[(size_t)r * D + c];
        dbg_cmp(dbg, 16, ((const float*)(ws + WS_G))[(size_t)r * D + c], xb + bfv(F + c) * rsqrtf(ss / D + EPS) * (in_ptr(tab, 24) + (size_t)DBG_LAYER * D)[c], 0.001f, 0.001f); }
    if (stage == 17) { const int c = (int)((long)t * 911 + 3) % D; const bf16_t* F = (const bf16_t*)(ws + WS_F) + (size_t)r * D; float ss = 0.f; for (int k = 0; k < D; ++k) ss += bfv(F + k) * bfv(F + k);
        const float xb = X[(size_t)r * D + c];
        dbg_cmp(dbg, 17, ((const float*)(ws + WS_G))[(size_t)r * D + c], xb + 0.5f * bfv(F + c) * rsqrtf(ss / D + EPS) * (in_ptr(tab, 29) + (size_t)DBG_LAYER * D)[c], 0.001f, 0.001f); }
    if (stage == 14) { const int c = (int)((long)t * 911 + 3) % 1024; dbg_cmp(dbg, 14, bfv((const bf16_t*)(ws + WS_MX) + (size_t)r * 1024 + c), dotA((const bf16_t*)(ws + WS_MG) + (size_t)r * 1024, (in_ptr(tab, 23) + (size_t)DBG_LAYER * (D*D)), 1024, 1024, c), 0.03f, 0.03f); }
}
__global__ void __launch_bounds__(64) dbg_kernel(Args a, unsigned mask) {
    unsigned char* ws = a.ws; const float* const* tab = (const float* const*)(ws + WS_TAB);
    for (int st = 2; st <= 17; ++st) if ((mask >> st) & 1u) dbg_check(st, tab, ws, a.out);
}
__global__ void dbg_final(Args a) { const unsigned cde = *(volatile unsigned*)(a.ws + WS_DBG); a.out[0] = (cde != 99u) ? 1000.f + 100.f * (float)cde : 0.f; }
#define DBGCHK(st) do { if (l == DBG_LAYER && (st) == STOP_AT) return; } while (0)
#else
#define DBGCHK(st) do { } while (0)
#endif

__global__ void __launch_bounds__(NTHR, 2) fwd_kernel(Args a) {
    extern __shared__ __attribute__((aligned(16))) unsigned char lds_raw[];
    LAS unsigned char* lds = (LAS unsigned char*)lds_raw;
    cg::grid_group grid = cg::this_grid();
    unsigned char* ws = a.ws;
    { const float** tw = (const float**)(ws + WS_TAB);
      if (threadIdx.x == 0) {
#pragma unroll
          for (int i = 0; i < 30; ++i) tw[i] = a.in[i];
          volatile LAS unsigned* st = (volatile LAS unsigned*)(lds + LDS_BAR_ST); st[0] = 0u; st[1] = 0u;
          (void)xb_add((unsigned*)(ws + WS_BAR) + XB_XCNT(xb_xcc_id()), 1u);
          __threadfence(); }
      __syncthreads(); }
    const float* const* tab = (const float* const*)(ws + WS_TAB);
    const int G = gridDim.x, c = blockIdx.x;
    bf16_t* XN = (bf16_t*)(ws + WS_XN);
    float* X = a.out;
    unsigned char* const ws0 = ws; const int G0 = G, c0 = c; float* const X0 = X;
    constexpr int BIG = 1 << 28;

#ifdef SKEL
    { const float* xin = a.in[0]; for (size_t i = (size_t)blockIdx.x * NTHR + threadIdx.x; i < (size_t)T * D; i += (size_t)gridDim.x * NTHR) a.out[i] = xin[i];
      GSYNC();
#if SKEL >= 2
      convert_layer(tab, ws, 0, lds); GSYNC();
#endif
#if SKEL >= 3
      lc_all(tab, ws); GSYNC();
#endif
#if SKEL >= 4
      ew_phase<false>(in_ptr(tab, 0), X, nullptr, 0.f, nullptr, in_ptr(tab, 1), XN); GSYNC();
#endif
#if SKEL >= 5
      ew_phase<true>(X, X, (const bf16_t*)(ws + WS_F), 0.5f, in_ptr(tab, 5), in_ptr(tab, 6), XN); GSYNC();
#endif
#if SKEL >= 6
      convert_layer(tab, ws, 1, lds); GSYNC();
#endif
      return; }
#endif
#ifdef DBG
    if (blockIdx.x == 0 && threadIdx.x == 0) *(unsigned*)(ws + WS_DBG) = 99u;
#endif
    PH(0) { convert_layer(tab, ws, 0, lds); lc_all(tab, ws); }
    PH(1) ew_phase<false>(in_ptr(tab, 0), X, nullptr, 0.f, nullptr, in_ptr(tab, 1), XN);
    GSYNC_CG();
#ifdef DBG
    if (STOP_AT == 20) return;
#endif

#pragma unroll 1
    for (int l = 0; l < NLAYER_RUN; ++l) {
#pragma unroll 1
        for (int f = 0; f < 2; ++f) {
            unsigned long long wsv = (unsigned long long)ws0, xv = (unsigned long long)X0; int G = G0, c = c0;
#ifndef NOASM
            asm volatile("" : "+s"(wsv), "+s"(G), "+s"(c), "+s"(xv));
#endif
            unsigned char* ws = (unsigned char*)(GAS unsigned char*)wsv; float* X = (float*)(GAS float*)xv;
            const float* const* tab = (const float* const*)(ws + WS_TAB); bf16_t* XN = (bf16_t*)(ws + WS_XN);
            if (f == 1) {
                PH(2) { pg8::Gemm g{XN, XN, (const bf16_t*)(ws + W_IN), T, ZN, D, D, BIG, 0, 0}; pg8::StaticOrder So; So.init(T, ZN, G, c);
                  pg8::EpiBf<2> E{(bf16_t*)(ws + WS_ZG), 1024, (bf16_t*)(ws + WS_ZX), (bf16_t*)(ws + WS_ZSC), (bf16_t*)(ws + WS_ZSGU)};
                  pg8::gemm_phase<pg8::EpiBf<2>, true>(lds, g, So, E); }
                GSYNC();
                DBGCHK(5);
                PH(3) prep_phase(tab, ws, l, lds);
                GSYNC();
                DBGCHK(6);
                PH(4) { const bf16_t* XC = (const bf16_t*)(ws + WS_XC);
                  pg8::Gemm g{XC, XC, (const bf16_t*)(ws + W_LRU), T, 4096, 256, 1024, BIG, 2, 512}; pg8::StaticOrder So; So.init(T, 4096, G, c);
                  pg8::EpiGates E{XC, (bf16_t*)(ws + WS_U), ws + WS_R, in_ptr(tab, 11) + (size_t)l * 2048, in_ptr(tab, 13) + (size_t)l * 2048, (const float*)(ws + WS_LC)};
                  pg8::gemm_phase<pg8::EpiGates, true>(lds, g, So, E); }
                GSYNC();
                DBGCHK(9);
                PH(5) scan_pass1(ws, l, lds);
                GSYNC();
                PH(6) scan_pass2(ws, l, lds);
                GSYNC();
                DBGCHK(11);
                PH(7) { pg8::Gemm g{XN, XN, (const bf16_t*)(ws + W_IN) + (size_t)ZN * D, T, 3072, D, D, BIG, 0, 0}; pg8::StaticOrder So; So.init(T, 3072, G, c);
                  pg8::EpiBf<1> E{(bf16_t*)(ws + WS_G), 3072, nullptr, nullptr, nullptr};
                  pg8::gemm_phase<pg8::EpiBf<1>, true>(lds, g, So, E); }
                GSYNC();
                DBGCHK(12);
                PH(8) { pg8::Gemm g{(const bf16_t*)(ws + WS_ZG), (const bf16_t*)(ws + WS_YBC) - 16 * 64, (const bf16_t*)(ws + W_CAT), T, D, 2048, 1024, 16, 0, 0}; pg8::StaticOrder So; So.init(T, D, G, c);
                  pg8::EpiMerge E{(const bf16_t*)(ws + WS_G), (bf16_t*)(ws + WS_MG)};
                  pg8::gemm_phase<pg8::EpiMerge, true>(lds, g, So, E); }
                GSYNC();
                DBGCHK(13);
                PH(9) { const bf16_t* MG = (const bf16_t*)(ws + WS_MG);
                  pg8::Gemm g{MG, MG, (const bf16_t*)(ws + W_O), T, D, D, D, BIG, 0, 0}; pg8::StaticOrder So; So.init(T, D, G, c);
                  pg8::EpiBf<0> E{(bf16_t*)(ws + WS_MX), 1024, nullptr, nullptr, nullptr};
                  pg8::gemm_phase<pg8::EpiBf<0>, true>(lds, g, So, E); }
                GSYNC();
                DBGCHK(14);
#if defined(DBG) && STOP_AT == 21
                PH(10) ew_phase<true>(X, (float*)(ws + WS_G), (const bf16_t*)(ws + WS_MX), 1.f, in_ptr(tab, 24) + (size_t)l * D, in_ptr(tab, 25) + (size_t)l * D, XN);
#else
                PH(10) ew_phase<true>(X, X, (const bf16_t*)(ws + WS_MX), 1.f, in_ptr(tab, 24) + (size_t)l * D, in_ptr(tab, 25) + (size_t)l * D, XN);
#endif
                GSYNC();
                DBGCHK(21);
            }
            PH(11) { pg8::Gemm g{XN, XN, (const bf16_t*)(ws + (f ? W_UP2 : W_UP1)), T, 2 * FF, D, D, BIG, 0, 0}; pg8::StaticOrder So; So.init(T, 2 * FF, G, c);
              pg8::EpiSwiGLU E{(bf16_t*)(ws + WS_H), FF};
              pg8::gemm_phase<pg8::EpiSwiGLU, true>(lds, g, So, E); }
            GSYNC();
            if (f == DBG_F) DBGCHK(2);
            PH(12) { const bf16_t* H = (const bf16_t*)(ws + WS_H);
              pg8::Gemm g{H, H, (const bf16_t*)(ws + (f ? W_DN2 : W_DN1)), T, D, FF, FF, BIG, 0, 0}; pg8::StaticOrder So; So.init(T, D, G, c);
              pg8::EpiBf<0> E{(bf16_t*)(ws + WS_F), 1024, nullptr, nullptr, nullptr};
              pg8::gemm_phase<pg8::EpiBf<0>, true>(lds, g, So, E); }
            GSYNC();
            if (f == DBG_F) DBGCHK(3);
            if (f == 0) {
                ew_phase<true>(X, X, (const bf16_t*)(ws + WS_F), 0.5f, in_ptr(tab, 5) + (size_t)l * D, in_ptr(tab, 6) + (size_t)l * D, XN);
            } else {
                if (l + 1 < DEPTH) convert_layer(tab, ws, l + 1, lds);
#if defined(DBG) && STOP_AT == 22
                ew_phase<true>(X, (l == DBG_LAYER) ? (float*)(ws + WS_G) : X, (const bf16_t*)(ws + WS_F), 0.5f, in_ptr(tab, 29) + (size_t)l * D, (l + 1 < DEPTH) ? in_ptr(tab, 1) + (size_t)(l + 1) * D : nullptr, XN);
#else
                ew_phase<true>(X, X, (const bf16_t*)(ws + WS_F), 0.5f, in_ptr(tab, 29) + (size_t)l * D, (l + 1 < DEPTH) ? in_ptr(tab, 1) + (size_t)(l + 1) * D : nullptr, XN);
#endif
            }
            GSYNC();
            if (f == 0) DBGCHK(4);
            if (f == 1) DBGCHK(22);
        }
    }
}

extern "C" void kernel_launch(void* const* d_in, const int* in_sizes, int n_in, void* d_out, int out_size, void* d_ws, size_t ws_size, hipStream_t stream) {
    static int grid = 0;
    if (grid == 0) {
        if (n_in != 30 || in_sizes[0] != T * D || out_size != T * D || ws_size < WS_END) { fprintf(stderr, "kernel_launch: unexpected problem geometry (n_in %d, ws %zu)\n", n_in, ws_size); grid = -1; return; }
        int dev = 0, cus = 0, per_cu = 0;
        if (hipGetDevice(&dev) != hipSuccess || hipDeviceGetAttribute(&cus, hipDeviceAttributeMultiprocessorCount, dev) != hipSuccess) { grid = -1; return; }
        if (hipFuncSetAttribute((const void*)fwd_kernel, hipFuncAttributeMaxDynamicSharedMemorySize, LDS_BYTES) != hipSuccess) { fprintf(stderr, "kernel_launch: hipFuncSetAttribute failed\n"); grid = -1; return; }
        if (hipOccupancyMaxActiveBlocksPerMultiprocessor(&per_cu, (const void*)fwd_kernel, NTHR, LDS_BYTES) != hipSuccess || per_cu < 1) { fprintf(stderr, "kernel_launch: occupancy query failed (%d)\n", per_cu); (void)hipGetLastError(); grid = -1; return; }
        grid = cus * per_cu;
        if (T % (2 * grid * NWAVES) != 0) { fprintf(stderr, "kernel_launch: grid %d does not divide the row pairs of the norm phases\n", grid); grid = -1; return; }
    }
    if (grid < 0) return;
    Args a{};
    for (int i = 0; i < 30; ++i) a.in[i] = (const float*)d_in[i];
    a.out = (float*)d_out; a.ws = (unsigned char*)d_ws;
    if (hipMemsetAsync((char*)d_ws + WS_BAR, 0, 16384, stream) != hipSuccess) { fprintf(stderr, "kernel_launch: hipMemsetAsync failed\n"); return; }
    void* args[] = {&a};
    hipError_t e = hipLaunchCooperativeKernel((const void*)fwd_kernel, dim3(grid), dim3(NTHR), args, LDS_BYTES, stream);
    if (e != hipSuccess) fprintf(stderr, "kernel_launch: cooperative launch failed: %s (grid %d)\n", hipGetErrorString(e), grid);
#ifdef DBG
    dbg_kernel<<<128, 64, 0, stream>>>(a, (unsigned)DBG_MASK);
    dbg_final<<<1, 1, 0, stream>>>(a);
#endif
}
```

```cpp
#include <hip/hip_runtime.h>
#include <hip/hip_cooperative_groups.h>
#include <cstdio>
#include <cstdint>
namespace cg = cooperative_groups;

#define LAS __attribute__((address_space(3)))
typedef unsigned short bf16_t;
typedef short bf16x8 __attribute__((ext_vector_type(8)));
typedef float f32x4 __attribute__((ext_vector_type(4)));
typedef float f32x2 __attribute__((ext_vector_type(2)));
typedef unsigned u32x4 __attribute__((ext_vector_type(4)));
typedef unsigned u32x2 __attribute__((ext_vector_type(2)));

constexpr int NB = 2, S = 16384, T = NB * S, D = 1024, FF = 2816, DIN = 7680, ZN = 4608, DEPTH = 4;
constexpr float EPS = 1e-6f;
constexpr int NTHR = 512, NWAVES = 8;

constexpr size_t MiB = 1u << 20;
constexpr size_t WS_LC = 0;
constexpr size_t WS_TAB = 65536;
constexpr size_t WS_SUM = 1 * MiB;
constexpr size_t WS_W = 4 * MiB;
constexpr size_t W_UP1 = WS_W, W_DN1 = W_UP1 + 11 * MiB, W_IN = W_DN1 + 11 * MiB / 2, W_LRU = W_IN + 15 * MiB, W_CAT = W_LRU + 2 * MiB,
                 W_O = W_CAT + 4 * MiB, W_UP2 = W_O + 2 * MiB, W_DN2 = W_UP2 + 11 * MiB, W_END = W_DN2 + 11 * MiB / 2;
static_assert(W_END == 60 * MiB, "weight map");
constexpr size_t WS_XN = 60 * MiB;
constexpr size_t WS_ZG = 124 * MiB, WS_ZX = 188 * MiB, WS_ZSC = 252 * MiB, WS_ZSGU = 348 * MiB, WS_XC = 412 * MiB, WS_YBC = 476 * MiB, WS_END = 540 * MiB;
constexpr size_t WS_U = 188 * MiB, WS_R = 316 * MiB;
constexpr size_t WS_G = 188 * MiB;
constexpr size_t WS_MG = 380 * MiB;
constexpr size_t WS_MX = 124 * MiB;
constexpr size_t WS_H = 124 * MiB;
constexpr size_t WS_F = 316 * MiB;

constexpr int LDS_BYTES = 147456;
#ifndef PHM
#define PHM 0xFFFF
#define NLAYER_RUN DEPTH
#define STOP_AT 11
#define DBG_MASK ((1u << 9) | (1u << 11))
#define DBG_LAYER 1
#define DBG_F 0
#define DBG_G 1
#define DBG_GL 0
#ifndef ABL
#define ABL 0
#endif
#endif
#define PH(b) if constexpr ((PHM >> (b)) & 1)
#define GSYNC_CG() do { asm volatile("s_waitcnt vmcnt(0)" ::: "memory"); __threadfence(); grid.sync(); } while (0)
#define GSYNC() xsync(ws, lds)

struct Args { const float* in[30]; float* out; unsigned char* ws; };

typedef _Float16 h16x2 __attribute__((ext_vector_type(2)));
typedef _Float16 h16x8 __attribute__((ext_vector_type(8)));
__device__ __forceinline__ unsigned cvt_pk_bf16(float lo, float hi) { h16x2 v; v.x = (_Float16)lo; v.y = (_Float16)hi; return __builtin_bit_cast(unsigned, v); }
__device__ __forceinline__ float bflo(unsigned u) { return (float)__builtin_bit_cast(h16x2, u).x; }
__device__ __forceinline__ float bfhi(unsigned u) { return (float)__builtin_bit_cast(h16x2, u).y; }
__device__ __forceinline__ float h8(const u32x4& v, int j) { const unsigned w = (j >> 1) == 0 ? v.x : (j >> 1) == 1 ? v.y : (j >> 1) == 2 ? v.z : v.w; return (j & 1) ? bfhi(w) : bflo(w); }
__device__ __forceinline__ float rcpf_(float x) { return __builtin_amdgcn_rcpf(x); }
__device__ __forceinline__ float sigm(float x) { return rcpf_(1.f + __expf(-x)); }
__device__ __forceinline__ float silu_(float x) { return x * sigm(x); }
__device__ __forceinline__ float gelu_(float x) { const float u = 1.5957691216057308f * (x + 0.044715f * x * x * x); return x * sigm(u); }
#define GAS __attribute__((address_space(1)))
__device__ __forceinline__ const float* in_ptr(const float* const* tab, int i) {
    unsigned long long v = *(const unsigned long long*)(tab + i);
    const unsigned lo = __builtin_amdgcn_readfirstlane((unsigned)v), hi = __builtin_amdgcn_readfirstlane((unsigned)(v >> 32));
    v = ((unsigned long long)hi << 32) | lo;
    return (const float*)(GAS const float*)v;
}
__device__ __forceinline__ float wave_sum(float v, int lane) {
#pragma unroll
    for (int o = 1; o < 64; o <<= 1) v += __int_as_float(__builtin_amdgcn_ds_bpermute((lane ^ o) << 2, __float_as_int(v)));
    return v;
}

constexpr size_t WS_BAR = 131072;
constexpr int LDS_BAR_ST = LDS_BYTES - 64;
#define XB_TMO      128
#define XB_XCNT(j)  (256  + 64 * (j))
#define XB_XSUB(j)  (1280 + 64 * (j))
#define XB_XGEN(j)  (2304 + 64 * (j))
#define XB_TOP      3328
#define XB_TOPGEN   3392
#define XCD_BAR_WORDS 3456
#define XB_SPIN_CAP (1u << 20)
__device__ __forceinline__ unsigned xb_ld(unsigned* p)              { return __hip_atomic_load(p, __ATOMIC_RELAXED, __HIP_MEMORY_SCOPE_AGENT); }
__device__ __forceinline__ unsigned xb_add(unsigned* p, unsigned v) { return __hip_atomic_fetch_add(p, v, __ATOMIC_RELAXED, __HIP_MEMORY_SCOPE_AGENT); }
__device__ __forceinline__ unsigned xb_xcc_id() { return (unsigned)__builtin_amdgcn_s_getreg((3 << 11) | 20) & 0xFu; }
#define XB_SPIN(cond, bar) do { unsigned _sp = 0; while (cond) { __builtin_amdgcn_s_sleep(1); \
    if ((++_sp & 255u) == 0u) { if (xb_ld(&(bar)[XB_TMO])) break; if (_sp > XB_SPIN_CAP) { atomicAdd(&(bar)[XB_TMO], 1u); break; } } } } while (0)
__device__ __forceinline__ void xcd_barrier_complete(unsigned* bar, unsigned x, unsigned& nloc, unsigned& nx) {
    const unsigned G = gridDim.x * gridDim.y * gridDim.z;
    unsigned sum, cnt, mine, sp = 0u;
    for (;;) {
        sum = 0u; cnt = 0u; mine = 0u;
#pragma unroll
        for (unsigned j = 0; j < 16; ++j) { const unsigned c = xb_ld(&bar[XB_XCNT(j)]); sum += c; cnt += (c > 0u) ? 1u : 0u; mine = (j == x) ? c : mine; }
        if (sum == G) break;
        __builtin_amdgcn_s_sleep(1);
        if ((++sp & 255u) == 0u) { if (xb_ld(&bar[XB_TMO])) break; if (sp > XB_SPIN_CAP) { atomicAdd(&bar[XB_TMO], 1u); break; } }
    }
    nloc = mine > 0u ? mine : 1u; nx = cnt > 0u ? cnt : 1u;
}
__device__ __forceinline__ void xsync(unsigned char* ws, LAS unsigned char* lds) {
    asm volatile("s_waitcnt vmcnt(0)" ::: "memory");
    __syncthreads();
    if (threadIdx.x == 0) {
        unsigned* bar = (unsigned*)(ws + WS_BAR); const unsigned x = xb_xcc_id();
        volatile LAS unsigned* st = (volatile LAS unsigned*)(lds + LDS_BAR_ST);
        __builtin_amdgcn_s_waitcnt(0);
        unsigned nloc = st[0], nx = st[1];
        if (nloc == 0u) { xcd_barrier_complete(bar, x, nloc, nx); st[0] = nloc; st[1] = nx; }
        const unsigned old = xb_add(&bar[XB_XSUB(x)], 1u);
        const unsigned gen = old / nloc;
        if (old + 1u == (gen + 1u) * nloc) {
            __builtin_amdgcn_fence(__ATOMIC_RELEASE, "agent");
            asm volatile("s_waitcnt vmcnt(0)" ::: "memory");
            const unsigned og = xb_add(&bar[XB_TOP], 1u);
            const unsigned tg = og / nx;
            if (og + 1u == (tg + 1u) * nx) xb_add(&bar[XB_TOPGEN], 1u);
            else XB_SPIN(xb_ld(&bar[XB_TOPGEN]) == tg, bar);
            __builtin_amdgcn_fence(__ATOMIC_ACQUIRE, "agent");
            xb_add(&bar[XB_XGEN(x)], 1u);
            asm volatile("s_waitcnt vmcnt(0)" ::: "memory");
        } else {
            XB_SPIN(xb_ld(&bar[XB_XGEN(x)]) == gen, bar);
            __builtin_amdgcn_fence(__ATOMIC_ACQUIRE, "agent");
            asm volatile("s_waitcnt vmcnt(0)" ::: "memory");
        }
    }
    __syncthreads();
}

namespace pg8 {
constexpr int BM = 256, BK = 64, HALF = 128, HTB = HALF * BK * 2, STAGE_BYTES = 8 * HTB, NXCD = 8, WGM = 8;
__host__ __device__ __forceinline__ int lds_byte(int r, int c) { const int st = (r >> 4) * 2 + (c >> 5), rr = r & 15, cc = c & 31, ob = rr * 64 + cc * 2; return st * 1024 + (ob ^ (((ob >> 9) & 1) << 5)); }
__host__ __device__ __forceinline__ void stage_rc(int b, int& R, int& C) { const int st = b / 1024, sb = b % 1024, swz = sb ^ (((sb >> 9) & 1) << 5); R = (st >> 1) * 16 + swz / 64; C = (st & 1) * 32 + (swz % 64) / 2; }
__host__ __device__ __forceinline__ int perm32(int rho) { const int n = rho >> 4, i = rho & 15; return 8 * (i >> 2) + 4 * n + (i & 3); }

struct Unit { int pm, pn; };
struct Gemm { const bf16_t* A; const bf16_t* A2; const bf16_t* Bt; int M, N, K, lda, ksplit, apn_shift, apn_bytes; };

struct StaticOrder {
    int nM, nN, nwg, G, c;
    __device__ void init(int M, int N, int G_, int c_) { nM = M / BM; nN = N / BM; nwg = nM * nN; G = G_; c = c_; }
    __device__ bool next(int i, Unit& u) const {
        const long L = (long)i * G + c; if (L >= nwg) return false;
        int wgid = (int)L; { const int q = nwg / NXCD, r = nwg % NXCD, xcd = wgid % NXCD, off = wgid / NXCD; wgid = (xcd < r ? xcd * (q + 1) : r * (q + 1) + (xcd - r) * q) + off; }
        const int nig = WGM * nN, gid = wgid / nig, fm = gid * WGM, gsz = (nM - fm) < WGM ? (nM - fm) : WGM;
        u.pm = fm + ((wgid % nig) % gsz); u.pn = (wgid % nig) / gsz; return true;
    }
};

template <class Epi, bool ALIGN_EPI>
__device__ __forceinline__ void gemm_phase(LAS unsigned char* lds, const Gemm g, const StaticOrder& S, const Epi& E) {
    int tid_ = threadIdx.x; asm volatile("" : "+v"(tid_));
    const int tid = tid_, wid = __builtin_amdgcn_readfirstlane(tid >> 6), lane = tid & 63, wr = wid >> 2, wc = wid & 3, fr = lane & 15, fq = lane >> 4;
    const int K = g.K, nt = K / BK, lda = g.lda;
    unsigned voffA[2], voffB[2];
#pragma unroll
    for (int i = 0; i < 2; ++i) { int R, C; stage_rc(tid * 16 + i * 8192, R, C); const int Rb = Epi::PERM ? ((R & ~31) + perm32(R & 31)) : R;
        voffA[i] = (unsigned)(R * lda + C) * 2u; voffB[i] = (unsigned)(Rb * K + C) * 2u; }
    const size_t kstep = (size_t)(BK * 2);
    const size_t hstepA = (size_t)HALF * lda * 2, tstepA = 2 * hstepA;
    const size_t hstepB = (size_t)HALF * K * 2, tstepB = 2 * hstepB;
    const unsigned ldsw = (unsigned)wid * 1024u;
    const int aoff = lds_byte(wr * 64 + fr, fq * 8), boff = lds_byte(wc * 32 + fr, fq * 8);
#define PG8_SA(b, h) (((b) * 2 + (h)) * HTB)
#define PG8_SB(b, h) ((4 + (b) * 2 + (h)) * HTB)
#define PG8_STAGE(bufoff, gbase, voff) do { _Pragma("unroll") for (int _i = 0; _i < 2; ++_i) \
        __builtin_amdgcn_global_load_lds((const unsigned*)((const char*)(gbase) + (voff)[_i]), (LAS unsigned*)(lds + (bufoff) + ldsw + _i * 8192), 16, 0, 0); } while (0)
#define PG8_LDA(dst, b, h) do { _Pragma("unroll") for (int m = 0; m < 4; ++m) _Pragma("unroll") for (int k = 0; k < 2; ++k) dst[m][k] = *(const LAS bf16x8*)(lds + PG8_SA(b, h) + aoff + m * 2048 + k * 1024); } while (0)
#define PG8_LDB(dst, b, h) do { _Pragma("unroll") for (int n = 0; n < 2; ++n) _Pragma("unroll") for (int k = 0; k < 2; ++k) dst[n][k] = *(const LAS bf16x8*)(lds + PG8_SB(b, h) + boff + n * 2048 + k * 1024); } while (0)
#define PG8_MMA(ai, bj, At, Bt) do { __builtin_amdgcn_s_setprio(1); _Pragma("unroll") for (int m = 0; m < 4; ++m) _Pragma("unroll") for (int n = 0; n < 2; ++n) _Pragma("unroll") for (int k = 0; k < 2; ++k) \
        acc[ai][bj][m][n] = __builtin_amdgcn_mfma_f32_16x16x32_f16(__builtin_bit_cast(h16x8, Bt[n][k]), __builtin_bit_cast(h16x8, At[m][k]), acc[ai][bj][m][n], 0, 0, 0); __builtin_amdgcn_s_setprio(0); } while (0)
#define PG8_WAIT_V(n) asm volatile("s_waitcnt vmcnt(" #n ")" ::: "memory")
#define PG8_WAIT_L(n) asm volatile("s_waitcnt lgkmcnt(" #n ")" ::: "memory")
#define PG8_BAR __builtin_amdgcn_s_barrier()
#define PG8_SCHED __builtin_amdgcn_sched_barrier(0)
    Unit cur, nxt; int ui = 0;
    if (!S.next(0, cur)) return;
    f32x4 acc[2][2][4][2];
#pragma unroll
    for (int a = 0; a < 2; ++a)
#pragma unroll
        for (int b = 0; b < 2; ++b)
#pragma unroll
            for (int m = 0; m < 4; ++m)
#pragma unroll
                for (int n = 0; n < 2; ++n) acc[a][b][m][n] = (f32x4){0.f, 0.f, 0.f, 0.f};
    bf16x8 At[4][2], B0[2][2], B1[2][2];
    const char* cA = (const char*)g.A + (size_t)cur.pm * tstepA + (size_t)(cur.pn >> g.apn_shift) * g.apn_bytes;
    const char* cA2 = (const char*)g.A2 + (size_t)cur.pm * tstepA;
    const char* cB = (const char*)g.Bt + (size_t)cur.pn * tstepB;
    PG8_STAGE(PG8_SB(0, 0), cB, voffB); PG8_STAGE(PG8_SB(0, 1), cB + hstepB, voffB); PG8_STAGE(PG8_SA(0, 0), cA, voffA); PG8_STAGE(PG8_SA(0, 1), cA + hstepA, voffA);
    if (wr == 1) PG8_BAR;
    PG8_WAIT_V(2); PG8_BAR;
    PG8_STAGE(PG8_SB(1, 0), cB + kstep, voffB); PG8_STAGE(PG8_SA(1, 0), cA + kstep, voffA); PG8_STAGE(PG8_SB(1, 1), cB + hstepB + kstep, voffB);
    PG8_WAIT_V(6); PG8_BAR;
    for (;;) {
        const bool has_next = S.next(ui + 1, nxt);
        const char* nA = has_next ? (const char*)g.A + (size_t)nxt.pm * tstepA + (size_t)(nxt.pn >> g.apn_shift) * g.apn_bytes : cA;
        const char* nA2 = has_next ? (const char*)g.A2 + (size_t)nxt.pm * tstepA : cA2;
        const char* nB = has_next ? (const char*)g.Bt + (size_t)nxt.pn * tstepB : cB;
        for (int t = 0; t < nt; t += 2) {
            const bool last = (t == nt - 2);
            const char* a1 = ((t < g.ksplit) ? cA : cA2) + (size_t)(t + 1) * kstep;
            const char* a2 = last ? nA : ((t + 2 < g.ksplit) ? cA : cA2) + (size_t)(t + 2) * kstep;
            const char* b2 = last ? nB : cB + (size_t)(t + 2) * kstep;
            const char* a3 = a2 + kstep; const char* b3 = b2 + kstep;
            if constexpr (Epi::HOOK) { if (t == g.ksplit || t == g.ksplit + 8) E.hook(acc, cur, (t - g.ksplit) >> 3, wr, wc, fr, fq); }
            PG8_LDB(B0, 0, 0); PG8_LDB(B1, 0, 1); PG8_SCHED; PG8_LDA(At, 0, 0); PG8_STAGE(PG8_SA(1, 1), a1 + hstepA, voffA);
            PG8_WAIT_V(8); PG8_WAIT_L(0); PG8_BAR; PG8_MMA(0, 0, At, B0); PG8_MMA(0, 1, At, B1); PG8_BAR; PG8_SCHED;
            PG8_LDA(At, 0, 1); PG8_STAGE(PG8_SB(0, 0), b2, voffB); PG8_STAGE(PG8_SB(0, 1), b2 + hstepB, voffB); PG8_STAGE(PG8_SA(0, 0), a2, voffA);
            PG8_WAIT_V(8); PG8_WAIT_L(0); PG8_BAR; PG8_MMA(1, 0, At, B0); PG8_MMA(1, 1, At, B1); PG8_BAR; PG8_SCHED;
            PG8_LDB(B0, 1, 0); PG8_LDB(B1, 1, 1); PG8_SCHED; PG8_LDA(At, 1, 0); PG8_STAGE(PG8_SA(0, 1), a2 + hstepA, voffA);
            PG8_WAIT_V(8); PG8_WAIT_L(0); PG8_BAR; PG8_MMA(0, 0, At, B0); PG8_MMA(0, 1, At, B1); PG8_BAR; PG8_SCHED;
            PG8_LDA(At, 1, 1); PG8_STAGE(PG8_SB(1, 0), b3, voffB); PG8_STAGE(PG8_SB(1, 1), b3 + hstepB, voffB); PG8_STAGE(PG8_SA(1, 0), a3, voffA);
            PG8_WAIT_V(8); PG8_WAIT_L(0); PG8_BAR; PG8_MMA(1, 0, At, B0); PG8_MMA(1, 1, At, B1); PG8_BAR; PG8_SCHED;
        }
        if constexpr (ALIGN_EPI) { if (wr == 0) PG8_BAR; }
        E(acc, cur, wr, wc, fr, fq);
        if (!has_next) break;
#pragma unroll
        for (int a = 0; a < 2; ++a)
#pragma unroll
            for (int b = 0; b < 2; ++b)
#pragma unroll
                for (int m = 0; m < 4; ++m)
#pragma unroll
                    for (int n = 0; n < 2; ++n) acc[a][b][m][n] = (f32x4){0.f, 0.f, 0.f, 0.f};
        cur = nxt; cA = nA; cA2 = nA2; cB = nB; ++ui;
        if constexpr (ALIGN_EPI) { if (wr == 1) PG8_BAR; }
    }
    PG8_WAIT_V(0);
    if constexpr (!ALIGN_EPI) { if (wr == 0) PG8_BAR; }
    PG8_BAR;
#undef PG8_SA
#undef PG8_SB
#undef PG8_STAGE
#undef PG8_LDA
#undef PG8_LDB
#undef PG8_MMA
#undef PG8_WAIT_V
#undef PG8_WAIT_L
#undef PG8_BAR
#undef PG8_SCHED
}

template <int MODE> struct EpiBf {
    static constexpr bool PERM = true, HOOK = false;
    bf16_t* O; int ldc; bf16_t* O1; bf16_t* O2; bf16_t* O3;
    __device__ __forceinline__ void operator()(const f32x4 (&acc)[2][2][4][2], const Unit& u, int wr, int wc, int fr, int fq) const {
        bf16_t* base = O; int ld = ldc; int colt = u.pn * BM;
        if (MODE == 2) { const int pn = u.pn;
            if (pn < 4) { base = O; ld = 1024; colt = pn * 256; } else if (pn < 8) { base = O1; ld = 1024; colt = (pn - 4) * 256; }
            else if (pn < 14) { base = O2; ld = 1536; colt = (pn - 8) * 256; } else { base = O3; ld = 1024; colt = (pn - 14) * 256; } }
        const int row0 = u.pm * BM + wr * 64 + fr, col0 = colt + wc * 32 + 8 * fq;
#pragma unroll
        for (int ai = 0; ai < 2; ++ai)
#pragma unroll
            for (int m = 0; m < 4; ++m) { bf16_t* rowp = base + (size_t)(row0 + ai * HALF + m * 16) * ld + col0;
#pragma unroll
                for (int bj = 0; bj < 2; ++bj) { f32x4 v0 = acc[ai][bj][m][0], v1 = acc[ai][bj][m][1];
                    if (MODE == 1) {
#pragma unroll
                        for (int j = 0; j < 4; ++j) { v0[j] = sigm(v0[j]); v1[j] = sigm(v1[j]); } }
                    u32x4 w; w.x = cvt_pk_bf16(v0[0], v0[1]); w.y = cvt_pk_bf16(v0[2], v0[3]); w.z = cvt_pk_bf16(v1[0], v1[1]); w.w = cvt_pk_bf16(v1[2], v1[3]);
                    *(u32x4*)(rowp + bj * HALF) = w; } }
    }
};
struct EpiSwiGLU {
    static constexpr bool PERM = true, HOOK = false;
    bf16_t* O; int ldc;
    __device__ __forceinline__ void operator()(const f32x4 (&acc)[2][2][4][2], const Unit& u, int wr, int wc, int fr, int fq) const {
        const int row0 = u.pm * BM + wr * 64 + fr, col0 = u.pn * HALF + wc * 32 + 8 * fq;
#pragma unroll
        for (int ai = 0; ai < 2; ++ai)
#pragma unroll
            for (int m = 0; m < 4; ++m) { bf16_t* rowp = O + (size_t)(row0 + ai * HALF + m * 16) * ldc + col0;
                f32x4 h0, h1;
#pragma unroll
                for (int j = 0; j < 4; ++j) { h0[j] = silu_(acc[ai][0][m][0][j]) * acc[ai][1][m][0][j]; h1[j] = silu_(acc[ai][0][m][1][j]) * acc[ai][1][m][1][j]; }
                u32x4 w; w.x = cvt_pk_bf16(h0[0], h0[1]); w.y = cvt_pk_bf16(h0[2], h0[3]); w.z = cvt_pk_bf16(h1[0], h1[1]); w.w = cvt_pk_bf16(h1[2], h1[3]);
                *(u32x4*)rowp = w; }
    }
};
struct EpiMerge {
    static constexpr bool PERM = true, HOOK = true;
    const bf16_t* G; bf16_t* O;
    __device__ __forceinline__ void hook(f32x4 (&acc)[2][2][4][2], const Unit& u, int which, int wr, int wc, int fr, int fq) const {
        int row0 = u.pm * BM + wr * 64 + fr, col0 = u.pn * BM + wc * 32 + 8 * fq + which * 1024;
        asm volatile("" : "+v"(row0), "+v"(col0));
#pragma unroll
        for (int ai = 0; ai < 2; ++ai)
#pragma unroll
            for (int m = 0; m < 4; ++m) { const bf16_t* gp = G + (size_t)(row0 + ai * HALF + m * 16) * 3072 + col0;
#pragma unroll
                for (int bj = 0; bj < 2; ++bj)
#pragma unroll
                    for (int n = 0; n < 2; ++n) { const u32x2 ga = *(const u32x2*)(gp + bj * HALF + 4 * n), gb = *(const u32x2*)(gp + 1024 + bj * HALF + 4 * n);
                        f32x4 r; r[0] = bflo(ga.x) * rcpf_(bflo(gb.x)); r[1] = bfhi(ga.x) * rcpf_(bfhi(gb.x)); r[2] = bflo(ga.y) * rcpf_(bflo(gb.y)); r[3] = bfhi(ga.y) * rcpf_(bfhi(gb.y));
                        acc[ai][bj][m][n] *= r; asm volatile("" ::: "memory"); } }
    }
    __device__ __forceinline__ void operator()(const f32x4 (&acc)[2][2][4][2], const Unit& u, int wr, int wc, int fr, int fq) const {
        const int row0 = u.pm * BM + wr * 64 + fr, col0 = u.pn * BM + wc * 32 + 8 * fq;
#pragma unroll
        for (int ai = 0; ai < 2; ++ai)
#pragma unroll
            for (int m = 0; m < 4; ++m) { const size_t r = (size_t)(row0 + ai * HALF + m * 16);
#pragma unroll
                for (int bj = 0; bj < 2; ++bj) { const u32x4 gc = *(const u32x4*)(G + r * 3072 + 2048 + col0 + bj * HALF);
                    const f32x4 v0 = acc[ai][bj][m][0], v1 = acc[ai][bj][m][1];
                    u32x4 w; w.x = cvt_pk_bf16(v0[0] * bflo(gc.x), v0[1] * bfhi(gc.x)); w.y = cvt_pk_bf16(v0[2] * bflo(gc.y), v0[3] * bfhi(gc.y));
                    w.z = cvt_pk_bf16(v1[0] * bflo(gc.z), v1[1] * bfhi(gc.z)); w.w = cvt_pk_bf16(v1[2] * bflo(gc.w), v1[3] * bfhi(gc.w));
                    *(u32x4*)(O + r * 1024 + col0 + bj * HALF) = w; }
                asm volatile("" ::: "memory"); }
    }
};
struct EpiGates {
    static constexpr bool PERM = true, HOOK = false;
    const bf16_t* XC; bf16_t* U; unsigned char* R; const float* ba; const float* bx; const float* lc;
    __device__ __forceinline__ void operator()(const f32x4 (&acc)[2][2][4][2], const Unit& u, int wr, int wc, int fr, int fq) const {
        const int d = u.pn & 1;
        int ch0 = 128 * (u.pn >> 1) + 32 * wc + 8 * fq, row0 = u.pm * BM + wr * 64 + fr;
        asm volatile("" : "+v"(row0), "+v"(ch0));
        char* Ud = (char*)(U + (size_t)d * T * 1024); unsigned char* Rd = R + (size_t)d * T * 1024;
        const float* bad = ba + d * 1024 + ch0; const float* bxd = bx + d * 1024 + ch0;
#pragma unroll
        for (int ai = 0; ai < 2; ++ai)
#pragma unroll
            for (int m = 0; m < 4; ++m) { const unsigned off = (unsigned)(row0 + ai * HALF + m * 16) * 1024u + (unsigned)ch0;
                const u32x4 xw = *(const u32x4*)((const char*)XC + (size_t)(off * 2u));
                float uv[8]; unsigned rq[2] = {0u, 0u};
#pragma unroll
                for (int n = 0; n < 2; ++n) { const f32x4 ba4 = *(const f32x4*)(bad + 4 * n), bx4 = *(const f32x4*)(bxd + 4 * n);
#pragma unroll
                    for (int j = 0; j < 4; ++j) { const float rr = sigm(acc[ai][0][m][n][j] + ba4[j]), ig = sigm(acc[ai][1][m][n][j] + bx4[j]);
                        uv[4 * n + j] = ig * h8(xw, 4 * n + j);
                        rq[n] |= ((unsigned)__builtin_rintf(rr * 255.f)) << (8 * j); } }
                u32x4 w; w.x = cvt_pk_bf16(uv[0], uv[1]); w.y = cvt_pk_bf16(uv[2], uv[3]); w.z = cvt_pk_bf16(uv[4], uv[5]); w.w = cvt_pk_bf16(uv[6], uv[7]);
                *(u32x4*)(Ud + (size_t)(off * 2u)) = w;
                u32x2 rw; rw.x = rq[0]; rw.y = rq[1];
                *(u32x2*)(Rd + (size_t)off) = rw;
                asm volatile("" ::: "memory"); }
    }
};
}

__device__ __forceinline__ int w_rowmap(int mode, int n, int p0) {
    if (mode == 0) return n;
    if (mode == 1) return 256 * (n >> 7) + p0 + (n & 127);
    const int dir = p0 >> 3, head = (p0 >> 1) & 3, ri = p0 & 1, ch = 256 * head + n;
    return 256 * (2 * (ch >> 7) + dir) + 128 * ri + (ch & 127);
}
__device__ __forceinline__ void tr_item(const float* W, int N, int item, bf16_t* WT, int ldk, int koff, int mode, int p0, LAS float* scr, int lane) {
    const int nblk = N / 32, kb = item / nblk, nb = item % nblk, k0 = 64 * kb, n0 = 32 * nb;
#pragma unroll 8
    for (int i = 0; i < 32; ++i) { const int kk = 2 * i + (lane >> 5); scr[kk * 33 + (lane & 31)] = W[(size_t)(k0 + kk) * N + n0 + (lane & 31)]; }
    asm volatile("s_waitcnt lgkmcnt(0)" ::: "memory");
    const int c = lane & 7;
#pragma unroll
    for (int j = 0; j < 4; ++j) { const int nn = (lane >> 3) + 8 * j; const LAS float* s = scr + (8 * c) * 33 + nn;
        u32x4 o; o.x = cvt_pk_bf16(s[0 * 33], s[1 * 33]); o.y = cvt_pk_bf16(s[2 * 33], s[3 * 33]); o.z = cvt_pk_bf16(s[4 * 33], s[5 * 33]); o.w = cvt_pk_bf16(s[6 * 33], s[7 * 33]);
        *(u32x4*)(WT + (size_t)w_rowmap(mode, n0 + nn, p0) * ldk + koff + k0 + 8 * c) = o; }
    asm volatile("s_waitcnt lgkmcnt(0)" ::: "memory");
}
__device__ __forceinline__ void convert_layer(const float* const* tab, unsigned char* ws, int l, LAS unsigned char* lds) {
    int tid_ = threadIdx.x; asm volatile("" : "+v"(tid_));
    const int tid = tid_, lane = tid & 63, wave = tid >> 6;
    LAS float* scr = (LAS float*)(lds + wave * 8448);
    const int gw = blockIdx.x * NWAVES + wave, NGW = gridDim.x * NWAVES;
    constexpr int I_UP = 16 * 88, I_DN = 44 * 32, I_IN = 16 * 240, I_LRU = 256, I_SQ = 512, I_HALF = 256;
    constexpr int NITEMS = 6 * I_UP + I_IN + 2 * I_LRU + 2 * I_SQ + 2 * I_HALF;
    const size_t oUP = (size_t)l * D * FF, oSQ = (size_t)l * D * D, oHF = (size_t)l * 512 * D, oLRU = (size_t)l * 2 * 4 * 256 * 256;
    for (int it = gw; it < NITEMS; it += NGW) {
        int r = it;
        if (r < I_UP) { tr_item(in_ptr(tab, 2) + oUP, FF, r, (bf16_t*)(ws + W_UP1), 1024, 0, 1, 0, scr, lane); continue; } r -= I_UP;
        if (r < I_UP) { tr_item(in_ptr(tab, 3) + oUP, FF, r, (bf16_t*)(ws + W_UP1), 1024, 0, 1, 128, scr, lane); continue; } r -= I_UP;
        if (r < I_DN) { tr_item(in_ptr(tab, 4) + oUP, D, r, (bf16_t*)(ws + W_DN1), FF, 0, 0, 0, scr, lane); continue; } r -= I_DN;
        if (r < I_IN) { tr_item(in_ptr(tab, 7) + (size_t)l * D * DIN, DIN, r, (bf16_t*)(ws + W_IN), 1024, 0, 0, 0, scr, lane); continue; } r -= I_IN;
        if (r < I_LRU) { const int mat = r >> 5; tr_item(in_ptr(tab, 10) + oLRU + (size_t)mat * 65536, 256, r & 31, (bf16_t*)(ws + W_LRU), 256, 0, 2, ((mat >> 2) << 3) | ((mat & 3) << 1) | 0, scr, lane); continue; } r -= I_LRU;
        if (r < I_LRU) { const int mat = r >> 5; tr_item(in_ptr(tab, 12) + oLRU + (size_t)mat * 65536, 256, r & 31, (bf16_t*)(ws + W_LRU), 256, 0, 2, ((mat >> 2) << 3) | ((mat & 3) << 1) | 1, scr, lane); continue; } r -= I_LRU;
        if (r < I_SQ) { tr_item(in_ptr(tab, 15) + oSQ, D, r, (bf16_t*)(ws + W_CAT), 2048, 0, 0, 0, scr, lane); continue; } r -= I_SQ;
        if (r < I_HALF) { tr_item(in_ptr(tab, 17) + oHF, D, r, (bf16_t*)(ws + W_CAT), 2048, 1024, 0, 0, scr, lane); continue; } r -= I_HALF;
        if (r < I_HALF) { tr_item(in_ptr(tab, 22) + oHF, D, r, (bf16_t*)(ws + W_CAT), 2048, 1536, 0, 0, scr, lane); continue; } r -= I_HALF;
        if (r < I_SQ) { tr_item(in_ptr(tab, 23) + oSQ, D, r, (bf16_t*)(ws + W_O), 1024, 0, 0, 0, scr, lane); continue; } r -= I_SQ;
        if (r < I_UP) { tr_item(in_ptr(tab, 26) + oUP, FF, r, (bf16_t*)(ws + W_UP2), 1024, 0, 1, 0, scr, lane); continue; } r -= I_UP;
        if (r < I_UP) { tr_item(in_ptr(tab, 27) + oUP, FF, r, (bf16_t*)(ws + W_UP2), 1024, 0, 1, 128, scr, lane); continue; } r -= I_UP;
        tr_item(in_ptr(tab, 28) + oUP, D, r, (bf16_t*)(ws + W_DN2), FF, 0, 0, 0, scr, lane);
    }
}
__device__ __forceinline__ void lc_all(const float* const* tab, unsigned char* ws) {
    float* LC = (float*)(ws + WS_LC); const float* lam = in_ptr(tab, 14);
    for (int i = blockIdx.x * NTHR + threadIdx.x; i < DEPTH * 2048; i += gridDim.x * NTHR) LC[i] = -8.f * log1pf(expf(-lam[i]));
}

__device__ __forceinline__ void wave_sum2(float& a, float& b, int lane) {
#pragma unroll
    for (int o = 1; o < 64; o <<= 1) { const int ad = (lane ^ o) << 2;
        const float ta = __int_as_float(__builtin_amdgcn_ds_bpermute(ad, __float_as_int(a))), tb = __int_as_float(__builtin_amdgcn_ds_bpermute(ad, __float_as_int(b)));
        a += ta; b += tb; }
}
template <bool HASF>
__device__ __forceinline__ void ew_phase(const float* xin, float* xout, const bf16_t* Fb, float scale, const float* post_g, const float* pre_g, bf16_t* XN) {
    int tid_ = threadIdx.x; asm volatile("" : "+v"(tid_));
    const int tid = tid_, lane = tid & 63, wave = tid >> 6;
    const int gw = blockIdx.x * NWAVES + wave, NGW = gridDim.x * NWAVES;
    for (int m = gw; m < T; m += 2 * NGW) {
        f32x4 v[2][4]; f32x4 f[2][4];
#pragma unroll
        for (int r = 0; r < 2; ++r) { const f32x4* xr = (const f32x4*)(xin + (size_t)(m + r * NGW) * D) + lane;
#pragma unroll
            for (int j = 0; j < 4; ++j) v[r][j] = xr[64 * j]; }
        if (HASF) {
            u32x2 fw[2][4];
#pragma unroll
            for (int r = 0; r < 2; ++r) { const u32x2* fr_ = (const u32x2*)(Fb + (size_t)(m + r * NGW) * D) + lane;
#pragma unroll
                for (int j = 0; j < 4; ++j) fw[r][j] = fr_[64 * j]; }
            float ss[2] = {0.f, 0.f};
#pragma unroll
            for (int r = 0; r < 2; ++r)
#pragma unroll
                for (int j = 0; j < 4; ++j) { const u32x2 w = fw[r][j]; f[r][j][0] = bflo(w.x); f[r][j][1] = bfhi(w.x); f[r][j][2] = bflo(w.y); f[r][j][3] = bfhi(w.y);
                    ss[r] += (f[r][j][0] * f[r][j][0] + f[r][j][1] * f[r][j][1]) + (f[r][j][2] * f[r][j][2] + f[r][j][3] * f[r][j][3]); }
            wave_sum2(ss[0], ss[1], lane);
            const float rs0 = scale * __builtin_amdgcn_rsqf(ss[0] * (1.f / D) + EPS), rs1 = scale * __builtin_amdgcn_rsqf(ss[1] * (1.f / D) + EPS);
#pragma unroll
            for (int j = 0; j < 4; ++j) { const f32x4 pg = *((const f32x4*)post_g + 64 * j + lane); v[0][j] += f[0][j] * rs0 * pg; v[1][j] += f[1][j] * rs1 * pg; }
        }
        if (HASF || xin != xout) {
#pragma unroll
            for (int r = 0; r < 2; ++r) { f32x4* xo = (f32x4*)(xout + (size_t)(m + r * NGW) * D) + lane;
#pragma unroll
                for (int j = 0; j < 4; ++j) xo[64 * j] = v[r][j]; }
        }
        if (pre_g) {
            float s2[2] = {0.f, 0.f};
#pragma unroll
            for (int r = 0; r < 2; ++r)
#pragma unroll
                for (int j = 0; j < 4; ++j) s2[r] += (v[r][j][0] * v[r][j][0] + v[r][j][1] * v[r][j][1]) + (v[r][j][2] * v[r][j][2] + v[r][j][3] * v[r][j][3]);
            wave_sum2(s2[0], s2[1], lane);
            const float q0 = __builtin_amdgcn_rsqf(s2[0] * (1.f / D) + EPS), q1 = __builtin_amdgcn_rsqf(s2[1] * (1.f / D) + EPS);
            u32x2* o0 = (u32x2*)(XN + (size_t)m * D) + lane; u32x2* o1 = (u32x2*)(XN + (size_t)(m + NGW) * D) + lane;
#pragma unroll
            for (int j = 0; j < 4; ++j) { const f32x4 g = *((const f32x4*)pre_g + 64 * j + lane); const f32x4 y0 = v[0][j] * q0 * g, y1 = v[1][j] * q1 * g;
                u32x2 w0, w1; w0.x = cvt_pk_bf16(y0[0], y0[1]); w0.y = cvt_pk_bf16(y0[2], y0[3]); w1.x = cvt_pk_bf16(y1[0], y1[1]); w1.y = cvt_pk_bf16(y1[2], y1[3]);
                o0[64 * j] = w0; o1[64 * j] = w1; }
        }
    }
}

constexpr int VT_PITCH = 272;
__device__ __forceinline__ void prep_phase(const float* const* tab, unsigned char* ws, int l, LAS unsigned char* lds) {
    int tid_ = threadIdx.x; asm volatile("" : "+v"(tid_));
    const int tid = tid_, lane = tid & 63, wave = tid >> 6;
    const bf16_t* ZX = (const bf16_t*)(ws + WS_ZX); const bf16_t* ZSC = (const bf16_t*)(ws + WS_ZSC); const bf16_t* ZSGU = (const bf16_t*)(ws + WS_ZSGU);
    bf16_t* XC = (bf16_t*)(ws + WS_XC); bf16_t* YBC = (bf16_t*)(ws + WS_YBC);
    for (int item = blockIdx.x; item < T / 128; item += gridDim.x) {
        const int b = item >> 7, n = item & 127, t0 = n * 128; const size_t rb = (size_t)b * S;
        {
            const int c = 8 * (tid & 127), sg = tid >> 7; const float* cw = in_ptr(tab, 8) + (size_t)l * 4096 + c; const float* cb = in_ptr(tab, 9) + (size_t)l * 1024 + c;
            float wk[4][8], bb[8];
#pragma unroll
            for (int k = 0; k < 4; ++k) { const f32x4 a0 = *(const f32x4*)(cw + k * 1024), a1 = *(const f32x4*)(cw + k * 1024 + 4);
#pragma unroll
                for (int j = 0; j < 4; ++j) { wk[k][j] = a0[j]; wk[k][4 + j] = a1[j]; } }
            { const f32x4 a0 = *(const f32x4*)cb, a1 = *(const f32x4*)(cb + 4);
#pragma unroll
              for (int j = 0; j < 4; ++j) { bb[j] = a0[j]; bb[4 + j] = a1[j]; } }
            const bf16_t* src = ZX + rb * 1024 + c;
#pragma unroll 1
            for (int blk = 0; blk < 4; ++blk) { const int tb = t0 + sg * 32 + blk * 8;
                u32x4 xr[11];
#pragma unroll
                for (int i = 0; i < 11; ++i) { const int t = tb - 2 + i; xr[i] = (t >= 0 && t < S) ? *(const u32x4*)(src + (size_t)t * 1024) : (u32x4){0u, 0u, 0u, 0u}; }
#pragma unroll
                for (int o = 0; o < 8; ++o) { float y[8];
#pragma unroll
                    for (int j = 0; j < 8; ++j) y[j] = bb[j] + wk[0][j] * h8(xr[o], j) + wk[1][j] * h8(xr[o + 1], j) + wk[2][j] * h8(xr[o + 2], j) + wk[3][j] * h8(xr[o + 3], j);
                    u32x4 w; w.x = cvt_pk_bf16(y[0], y[1]); w.y = cvt_pk_bf16(y[2], y[3]); w.z = cvt_pk_bf16(y[4], y[5]); w.w = cvt_pk_bf16(y[6], y[7]);
                    *(u32x4*)(XC + (rb + tb + o) * 1024 + c) = w; } }
        }
        {
            const int c = 8 * (tid & 63), sg = tid >> 6; const float* cw = in_ptr(tab, 16) + (size_t)l * 1536 + c;
            float wk[3][8];
#pragma unroll
            for (int k = 0; k < 3; ++k) { const f32x4 a0 = *(const f32x4*)(cw + k * 512), a1 = *(const f32x4*)(cw + k * 512 + 4);
#pragma unroll
                for (int j = 0; j < 4; ++j) { wk[k][j] = a0[j]; wk[k][4 + j] = a1[j]; } }
            const bf16_t* src = ZSC + rb * 1536 + c;
#pragma unroll 1
            for (int blk = 0; blk < 4; ++blk) { const int tb = t0 + sg * 16 + blk * 4;
                u32x4 cr[6], xr[6], br[4];
#pragma unroll
                for (int i = 0; i < 6; ++i) { const int t = tb - 1 + i; const bool in = (t >= 0 && t < S);
                    cr[i] = in ? *(const u32x4*)(src + (size_t)t * 1536 + 512) : (u32x4){0u, 0u, 0u, 0u}; xr[i] = in ? *(const u32x4*)(src + (size_t)t * 1536 + 1024) : (u32x4){0u, 0u, 0u, 0u}; }
#pragma unroll
                for (int o = 0; o < 4; ++o) br[o] = *(const u32x4*)(src + (size_t)(tb + o) * 1536);
                float p[6][8];
#pragma unroll
                for (int i = 0; i < 6; ++i)
#pragma unroll
                    for (int j = 0; j < 8; ++j) p[i][j] = h8(cr[i], j) * h8(xr[i], j);
#pragma unroll
                for (int o = 0; o < 4; ++o) { float y[8];
#pragma unroll
                    for (int j = 0; j < 8; ++j) y[j] = h8(br[o], j) * (wk[0][j] * p[o][j] + wk[1][j] * p[o + 1][j] + wk[2][j] * p[o + 2][j]);
                    u32x4 w; w.x = cvt_pk_bf16(y[0], y[1]); w.y = cvt_pk_bf16(y[2], y[3]); w.z = cvt_pk_bf16(y[4], y[5]); w.w = cvt_pk_bf16(y[6], y[7]);
                    *(u32x4*)(YBC + (rb + tb + o) * 1024 + c) = w; } }
        }
        {
            const float* lg = in_ptr(tab, 18) + (size_t)l * 512; const float* lb = in_ptr(tab, 19) + (size_t)l * 512;
            f32x4 g0 = *(const f32x4*)(lg + 8 * lane), g1 = *(const f32x4*)(lg + 8 * lane + 4), b0 = *(const f32x4*)(lb + 8 * lane), b1 = *(const f32x4*)(lb + 8 * lane + 4);
            u32x4 wrow[16];
#pragma unroll
            for (int qi = 0; qi < 16; ++qi) wrow[qi] = *(const u32x4*)(ZSGU + (rb + t0 + wave + 8 * qi) * 1024 + 512 + 8 * lane);
#pragma unroll
            for (int qi = 0; qi < 16; ++qi) { const int q = wave + 8 * qi; const u32x4 w = wrow[qi];
                float v[8]; v[0] = bflo(w.x); v[1] = bfhi(w.x); v[2] = bflo(w.y); v[3] = bfhi(w.y); v[4] = bflo(w.z); v[5] = bfhi(w.z); v[6] = bflo(w.w); v[7] = bfhi(w.w);
                float s = 0.f;
#pragma unroll
                for (int j = 0; j < 8; ++j) { v[j] = gelu_(v[j]); s += v[j]; }
                const float mu = wave_sum(s, lane) * (1.f / 512.f); float s2 = 0.f;
#pragma unroll
                for (int j = 0; j < 8; ++j) { v[j] -= mu; s2 += v[j] * v[j]; }
                const float rstd = __builtin_amdgcn_rsqf(wave_sum(s2, lane) * (1.f / 512.f) + EPS);
#pragma unroll
                for (int j = 0; j < 8; ++j) { const float y = v[j] * rstd * (j < 4 ? g0[j & 3] : g1[j & 3]) + (j < 4 ? b0[j & 3] : b1[j & 3]);
                    *(LAS bf16_t*)(lds + (8 * lane + j) * VT_PITCH + 2 * q) = (bf16_t)(cvt_pk_bf16(y, 0.f) & 0xffffu); }
            }
            __syncthreads();
            const int g = wave >> 1, p0 = 64 * (wave & 1), fr = lane & 15, fq = lane >> 4;
            const float* Wg = in_ptr(tab, 20) + (size_t)l * 65536 + (size_t)g * 16384; const float* bs = in_ptr(tab, 21) + (size_t)l * 512 + g * 128;
            bf16x8 Wf[4][4];
#pragma unroll
            for (int m = 0; m < 4; ++m)
#pragma unroll
                for (int kk = 0; kk < 4; ++kk) { const float* p = Wg + (size_t)(p0 + 16 * m + fr) * 128 + 32 * kk + 8 * fq; const f32x4 x0 = *(const f32x4*)p, x1 = *(const f32x4*)(p + 4);
                    u32x4 w; w.x = cvt_pk_bf16(x0[0], x0[1]); w.y = cvt_pk_bf16(x0[2], x0[3]); w.z = cvt_pk_bf16(x1[0], x1[1]); w.w = cvt_pk_bf16(x1[2], x1[3]);
                    Wf[m][kk] = __builtin_bit_cast(bf16x8, w); }
            float bsv[4];
#pragma unroll
            for (int m = 0; m < 4; ++m) bsv[m] = bs[p0 + 16 * m + fr];
            for (int nn = 0; nn < 8; ++nn) {
                f32x4 acc[4];
#pragma unroll
                for (int m = 0; m < 4; ++m) acc[m] = (f32x4){0.f, 0.f, 0.f, 0.f};
#pragma unroll
                for (int kk = 0; kk < 4; ++kk) { const bf16x8 vf = *(const LAS bf16x8*)(lds + (g * 128 + 16 * nn + fr) * VT_PITCH + (32 * kk + 8 * fq) * 2);
#pragma unroll
                    for (int m = 0; m < 4; ++m) acc[m] = __builtin_amdgcn_mfma_f32_16x16x32_f16(__builtin_bit_cast(h16x8, vf), __builtin_bit_cast(h16x8, Wf[m][kk]), acc[m], 0, 0, 0); }
                const int cc = g * 128 + 16 * nn + 4 * fq;
#pragma unroll
                for (int m = 0; m < 4; ++m) { const size_t row = rb + t0 + p0 + 16 * m + fr;
                    const u32x2 uw = *(const u32x2*)(ZSGU + row * 1024 + cc);
                    const float o0 = gelu_(bflo(uw.x)) * (acc[m][0] + bsv[m]), o1 = gelu_(bfhi(uw.x)) * (acc[m][1] + bsv[m]), o2 = gelu_(bflo(uw.y)) * (acc[m][2] + bsv[m]), o3 = gelu_(bfhi(uw.y)) * (acc[m][3] + bsv[m]);
                    u32x2 w; w.x = cvt_pk_bf16(o0, o1); w.y = cvt_pk_bf16(o2, o3); if (ABL == 3) { w.x = 0u; w.y = 0u; }
                    *(u32x2*)(YBC + row * 1024 + 512 + cc) = w; }
            }
            __syncthreads();
        }
    }
}

__device__ __forceinline__ void scan_pass1(unsigned char* ws, int l, LAS unsigned char* lds) {
    int tid_ = threadIdx.x; asm volatile("" : "+v"(tid_));
    const int tid = tid_, lane = tid & 63, seg = tid >> 6;
    const float* LC = (const float*)(ws + WS_LC) + l * 2048; f32x2* SUM = (f32x2*)(ws + WS_SUM);
    LAS f32x4* SEG = (LAS f32x4*)lds;
    for (int item = blockIdx.x; item < 2048; item += gridDim.x) {
        const int dir = item & 1, grp = (item >> 1) & 7, chunk = (item >> 4) & 63, b = item >> 10;
        const int ch = grp * 128 + 2 * lane;
        const float l0 = LC[dir * 1024 + ch] * (1.f / 255.f), l1 = LC[dir * 1024 + ch + 1] * (1.f / 255.f);
        const bf16_t* U = (const bf16_t*)(ws + WS_U) + (size_t)dir * T * 1024 + ((size_t)b * S + chunk * 256) * 1024 + ch;
        const unsigned char* R = ws + WS_R + (size_t)dir * T * 1024 + ((size_t)b * S + chunk * 256) * 1024 + ch;
        float A0 = 1.f, A1 = 1.f, H0 = 0.f, H1 = 0.f;
#pragma unroll 8
        for (int k = 0; k < 32; ++k) { const int p = seg * 32 + k, to = dir ? 255 - p : p;
            const unsigned uw = *(const unsigned*)(U + (size_t)to * 1024); const unsigned rw = *(const unsigned short*)(R + (size_t)to * 1024);
            const float a0 = __expf(l0 * (float)(rw & 255u)), a1 = __expf(l1 * (float)(rw >> 8));
            H0 = a0 * H0 + bflo(uw) * __builtin_sqrtf(1.f - a0 * a0); H1 = a1 * H1 + bfhi(uw) * __builtin_sqrtf(1.f - a1 * a1); A0 *= a0; A1 *= a1; }
        SEG[seg * 64 + lane] = (f32x4){A0, H0, A1, H1};
        __syncthreads();
        if (tid < 64) { float cA0 = 1.f, cA1 = 1.f, cH0 = 0.f, cH1 = 0.f;
#pragma unroll
            for (int s = 0; s < 8; ++s) { const f32x4 v = SEG[s * 64 + tid]; cH0 = v[0] * cH0 + v[1]; cA0 *= v[0]; cH1 = v[2] * cH1 + v[3]; cA1 *= v[2]; }
            f32x4* o = (f32x4*)(SUM + ((size_t)((dir * 2 + b) * 64 + chunk)) * 1024 + grp * 128 + 2 * tid); *o = (f32x4){cA0, cH0, cA1, cH1}; }
        __syncthreads();
    }
}
__device__ __forceinline__ void scan_pass2(unsigned char* ws, int l, LAS unsigned char* lds) {
    int tid_ = threadIdx.x; asm volatile("" : "+v"(tid_));
    const int tid = tid_, lane = tid & 63, seg = tid >> 6;
    const float* LC = (const float*)(ws + WS_LC) + l * 2048; const f32x2* SUM = (const f32x2*)(ws + WS_SUM);
    LAS f32x2* HF = (LAS f32x2*)lds;
    LAS f32x4* SEG = (LAS f32x4*)(lds + 131072);
    LAS f32x2* CAR = (LAS f32x2*)(lds + 131072 + 8192);
    for (int item = blockIdx.x; item < 1024; item += gridDim.x) {
        const int grp = item & 7, chunk = (item >> 3) & 63, b = item >> 9;
        const int ch = grp * 128 + 2 * lane;
        bf16_t* ZG = (bf16_t*)(ws + WS_ZG) + ((size_t)b * S + chunk * 256) * 1024 + ch;
#pragma unroll 1
        for (int dir = 0; dir < 2; ++dir) {
            const float l0 = LC[dir * 1024 + ch] * (1.f / 255.f), l1 = LC[dir * 1024 + ch + 1] * (1.f / 255.f);
            const bf16_t* U = (const bf16_t*)(ws + WS_U) + (size_t)dir * T * 1024 + ((size_t)b * S + chunk * 256) * 1024 + ch;
            const unsigned char* R = ws + WS_R + (size_t)dir * T * 1024 + ((size_t)b * S + chunk * 256) * 1024 + ch;
            { float A0 = 1.f, A1 = 1.f, H0 = 0.f, H1 = 0.f;
#pragma unroll 8
              for (int k = 0; k < 32; ++k) { const int p = seg * 32 + k, to = dir ? 255 - p : p;
                  const unsigned uw = *(const unsigned*)(U + (size_t)to * 1024); const unsigned rw = *(const unsigned short*)(R + (size_t)to * 1024);
                  const float a0 = __expf(l0 * (float)(rw & 255u)), a1 = __expf(l1 * (float)(rw >> 8));
                  H0 = a0 * H0 + bflo(uw) * __builtin_sqrtf(1.f - a0 * a0); H1 = a1 * H1 + bfhi(uw) * __builtin_sqrtf(1.f - a1 * a1); A0 *= a0; A1 *= a1; }
              SEG[seg * 64 + lane] = (f32x4){A0, H0, A1, H1}; }
            if (tid < 64) { const f32x4* sp = (const f32x4*)(SUM + ((size_t)((dir * 2 + b) * 64)) * 1024 + grp * 128 + 2 * tid);
                float h0 = 0.f, h1 = 0.f;
                const int nprev = dir ? 63 - chunk : chunk;
                for (int j0 = 0; j0 < nprev; j0 += 8) { f32x4 v[8];
#pragma unroll
                    for (int u = 0; u < 8; ++u) { const int jj = j0 + u; const int cj = dir ? 63 - jj : jj; const int cl = jj < nprev ? cj : chunk;
                        v[u] = sp[(size_t)cl * 512]; if (jj >= nprev) v[u] = (f32x4){1.f, 0.f, 1.f, 0.f}; }
#pragma unroll
                    for (int u = 0; u < 8; ++u) { h0 = v[u][0] * h0 + v[u][1]; h1 = v[u][2] * h1 + v[u][3]; } }
                CAR[tid] = (f32x2){h0, h1}; }
            __syncthreads();
            float h0, h1; { const f32x2 c = CAR[lane]; h0 = c[0]; h1 = c[1]; }
            for (int s = 0; s < seg; ++s) { const f32x4 v = SEG[s * 64 + lane]; h0 = v[0] * h0 + v[1]; h1 = v[2] * h1 + v[3]; }
#pragma unroll 1
            for (int kb = 0; kb < 4; ++kb) { unsigned uw8[8], rw8[8], gw8[8];
#pragma unroll
                for (int u = 0; u < 8; ++u) { const int p = seg * 32 + kb * 8 + u, to = dir ? 255 - p : p;
                    uw8[u] = *(const unsigned*)(U + (size_t)to * 1024); rw8[u] = *(const unsigned short*)(R + (size_t)to * 1024);
                    gw8[u] = dir ? *(const unsigned*)(ZG + (size_t)to * 1024) : 0u; }
#pragma unroll
                for (int u = 0; u < 8; ++u) { const int p = seg * 32 + kb * 8 + u, to = dir ? 255 - p : p; const unsigned uw = uw8[u], rw = rw8[u];
                    const float a0 = __expf(l0 * (float)(rw & 255u)), a1 = __expf(l1 * (float)(rw >> 8));
                    h0 = a0 * h0 + bflo(uw) * __builtin_sqrtf(1.f - a0 * a0); h1 = a1 * h1 + bfhi(uw) * __builtin_sqrtf(1.f - a1 * a1);
                    if (dir == 0) HF[to * 64 + lane] = (f32x2){h0, h1};
                    else { const f32x2 hf = HF[to * 64 + lane]; const unsigned gw = gw8[u];
                        *(unsigned*)(ZG + (size_t)to * 1024) = cvt_pk_bf16((hf[0] + h0) * gelu_(bflo(gw)), (hf[1] + h1) * gelu_(bfhi(gw))); } } }
            __syncthreads();
        }
    }
}

#ifdef DBG
constexpr size_t WS_DBG = 70000;
__device__ __forceinline__ float bfv(const bf16_t* p) { return bflo((unsigned)*p); }
__device__ __forceinline__ float dotA(const bf16_t* arow, const float* W, int K, int N, int col) { float s = 0.f; for (int k = 0; k < K; ++k) s += bfv(arow + k) * W[(size_t)k * N + col]; return s; }
__device__ __forceinline__ void dbg_cmp(unsigned* dbg, unsigned code, float got, float ref, float tol_rel, float tol_abs) {
    const float e = fabsf(got - ref); if (!(e <= tol_rel * fabsf(ref) + tol_abs)) atomicMin(dbg, code); }
__device__ __forceinline__ void dbg_check(int stage, const float* const* tab, unsigned char* ws, float* X) {
    unsigned* dbg = (unsigned*)(ws + WS_DBG); const int t = blockIdx.x * 64 + threadIdx.x;
    int r = (int)(((long)t * 5273 + 17) % T); const bf16_t* XN = (const bf16_t*)(ws + WS_XN);
    { const int q = t >> 1; const int base = (q & 1) ? S : 0;
      if (t < 40) { const int k = q >> 1; const int off = (k == 0) ? 0 : (k == 1) ? 1 : (k == 2) ? 2 : (k == 3) ? 127 : (k == 4) ? 128 : (k == 5) ? 255 : (k == 6) ? 256 : (k == 7) ? S - 1 : (k == 8) ? S - 2 : S - 3; r = base + off; } }
    if (stage == 2) { const int c = (int)((long)t * 911 + 3) % FF; const float g = dotA(XN + (size_t)r * D, (in_ptr(tab, DBG_F ? 26 : 2) + (size_t)DBG_LAYER * (D*FF)), D, FF, c), u = dotA(XN + (size_t)r * D, (in_ptr(tab, DBG_F ? 27 : 3) + (size_t)DBG_LAYER * (D*FF)), D, FF, c);
        dbg_cmp(dbg, 2, bfv((const bf16_t*)(ws + WS_H) + (size_t)r * FF + c), g / (1.f + expf(-g)) * u, 0.03f, 0.03f); }
    if (stage == 3) { const int c = (int)((long)t * 911 + 3) % D; dbg_cmp(dbg, 3, bfv((const bf16_t*)(ws + WS_F) + (size_t)r * D + c), dotA((const bf16_t*)(ws + WS_H) + (size_t)r * FF, (in_ptr(tab, DBG_F ? 28 : 4) + (size_t)DBG_LAYER * (D*FF)), FF, D, c), 0.03f, 0.03f); }
    if (stage == 4) { const int c = (int)((long)t * 911 + 3) % D; const bf16_t* F = (const bf16_t*)(ws + WS_F) + (size_t)r * D; float ss = 0.f; for (int k = 0; k < D; ++k) ss += bfv(F + k) * bfv(F + k);
        const float* x0 = in_ptr(tab, 0) + (size_t)r * D; float s2 = 0.f;
        for (int k = 0; k < D; ++k) { const float xv = x0[k] + 0.5f * bfv(F + k) * rsqrtf(ss / D + EPS) * (in_ptr(tab, 5) + (size_t)DBG_LAYER * (D))[k]; s2 += xv * xv; if (k == c) dbg_cmp(dbg, 4, X[(size_t)r * D + c], xv, 0.001f, 0.001f); }
        dbg_cmp(dbg, 4, bfv(XN + (size_t)r * D + c), X[(size_t)r * D + c] * rsqrtf(s2 / D + EPS) * (in_ptr(tab, 6) + (size_t)DBG_LAYER * (D))[c], 0.01f, 0.01f); }
    if (stage == 5) { const int c = (int)((long)t * 911 + 3) % ZN; const float z = dotA(XN + (size_t)r * D, (in_ptr(tab, 7) + (size_t)DBG_LAYER * (D*DIN)), D, DIN, c); float got;
        if (c < 1024) got = bfv((const bf16_t*)(ws + WS_ZG) + (size_t)r * 1024 + c); else if (c < 2048) got = bfv((const bf16_t*)(ws + WS_ZX) + (size_t)r * 1024 + c - 1024);
        else if (c < 3584) got = bfv((const bf16_t*)(ws + WS_ZSC) + (size_t)r * 1536 + c - 2048); else got = bfv((const bf16_t*)(ws + WS_ZSGU) + (size_t)r * 1024 + c - 3584);
        dbg_cmp(dbg, 5, got, z, 0.03f, 0.03f); }
    if (stage == 6) { const int b = r / S, tt = r % S; const size_t rb = (size_t)b * S;
        { const int c = (int)((long)t * 911 + 3) % 1024; float o = (in_ptr(tab, 9) + (size_t)DBG_LAYER * (1024))[c]; for (int k = 0; k < 4; ++k) { const int q = tt + k - 2; if (q >= 0 && q < S) o += (in_ptr(tab, 8) + (size_t)DBG_LAYER * (4096))[k * 1024 + c] * bfv((const bf16_t*)(ws + WS_ZX) + (rb + q) * 1024 + c); }
          dbg_cmp(dbg, 6, bfv((const bf16_t*)(ws + WS_XC) + (size_t)r * 1024 + c), o, 0.02f, 0.02f); }
        { const int c = (int)((long)t * 911 + 3) % 512; const bf16_t* Z = (const bf16_t*)(ws + WS_ZSC); float o = 0.f; for (int k = 0; k < 3; ++k) { const int q = tt + k - 1; if (q >= 0 && q < S) o += (in_ptr(tab, 16) + (size_t)DBG_LAYER * (1536))[k * 512 + c] * bfv(Z + (rb + q) * 1536 + 512 + c) * bfv(Z + (rb + q) * 1536 + 1024 + c); }
          dbg_cmp(dbg, 7, bfv((const bf16_t*)(ws + WS_YBC) + (size_t)r * 1024 + c), o * bfv(Z + (size_t)r * 1536 + c), 0.02f, 0.02f); }
        { const int c = (int)((long)t * 911 + 3) % 512, g = c >> 7, p = tt & 127, t0 = tt - p; const bf16_t* Z = (const bf16_t*)(ws + WS_ZSGU); float mix = (in_ptr(tab, 21) + (size_t)DBG_LAYER * (512))[g * 128 + p];
          for (int q = 0; q < 128; ++q) { const bf16_t* vr = Z + (rb + t0 + q) * 1024 + 512; float mu = 0.f, var = 0.f; for (int k = 0; k < 512; ++k) mu += gelu_(bfv(vr + k)); mu /= 512.f;
              for (int k = 0; k < 512; ++k) { const float d = gelu_(bfv(vr + k)) - mu; var += d * d; } var /= 512.f;
              const float vn = (gelu_(bfv(vr + c)) - mu) * rsqrtf(var + EPS) * (in_ptr(tab, 18) + (size_t)DBG_LAYER * (512))[c] + (in_ptr(tab, 19) + (size_t)DBG_LAYER * (512))[c]; mix += (in_ptr(tab, 20) + (size_t)DBG_LAYER * (65536))[(size_t)g * 16384 + p * 128 + q] * vn; }
          dbg_cmp(dbg, 8, bfv((const bf16_t*)(ws + WS_YBC) + (size_t)r * 1024 + 512 + c), gelu_(bfv(Z + (size_t)r * 1024 + c)) * mix, 0.03f, 0.03f); } }
    if (stage == 9) { const int c = (int)((long)t * 911 + 3) % 1024, dir = t & 1, head = c >> 8, e = c & 255; const bf16_t* xr = (const bf16_t*)(ws + WS_XC) + (size_t)r * 1024 + head * 256;
        const float pa = dotA(xr, (in_ptr(tab, 10) + (size_t)DBG_LAYER * (524288)) + (size_t)(dir * 4 + head) * 65536, 256, 256, e) + (in_ptr(tab, 11) + (size_t)DBG_LAYER * (2048))[dir * 1024 + c], px = dotA(xr, (in_ptr(tab, 12) + (size_t)DBG_LAYER * (524288)) + (size_t)(dir * 4 + head) * 65536, 256, 256, e) + (in_ptr(tab, 13) + (size_t)DBG_LAYER * (2048))[dir * 1024 + c];
        const float rr = 1.f / (1.f + expf(-pa)), ii = 1.f / (1.f + expf(-px));
        dbg_cmp(dbg, 9, (float)*(ws + WS_R + (size_t)dir * T * 1024 + (size_t)r * 1024 + c), rr * 255.f, 0.02f, 1.5f);
        dbg_cmp(dbg, 10, bfv((const bf16_t*)(ws + WS_U) + (size_t)dir * T * 1024 + (size_t)r * 1024 + c), ii * bfv(xr + e), 0.03f, 0.03f); }
    if (stage == 11) { const int c = (int)((long)t * 911 + 3) % 1024, b = r / S, tt = r % S; const size_t rb = (size_t)b * S; const float* LC = (const float*)(ws + WS_LC) + DBG_LAYER * 2048; float hs = 0.f;
        for (int dir = 0; dir < 2; ++dir) { const bf16_t* U = (const bf16_t*)(ws + WS_U) + (size_t)dir * T * 1024; const unsigned char* R = ws + WS_R + (size_t)dir * T * 1024; float h = 0.f;
            if (dir == 0) { for (int q = 0; q <= tt; ++q) { const float a = expf(LC[c] * (float)R[(rb + q) * 1024 + c] / 255.f); h = a * h + bfv(U + (rb + q) * 1024 + c) * sqrtf(1.f - a * a); } }
            else { for (int q = S - 1; q >= tt; --q) { const float a = expf(LC[1024 + c] * (float)R[(rb + q) * 1024 + c] / 255.f); h = a * h + bfv(U + (rb + q) * 1024 + c) * sqrtf(1.f - a * a); } }
            hs += h; }
        const float gate = dotA(XN + (size_t)r * D, (in_ptr(tab, 7) + (size_t)DBG_LAYER * (D*DIN)), D, DIN, c);
        dbg_cmp(dbg, 11, bfv((const bf16_t*)(ws + WS_ZG) + (size_t)r * 1024 + c), hs * gelu_(gate), 0.03f, 0.03f); }
    if (stage == 10) { const int c = (int)((long)t * 911 + 3) % 1024; ((float*)(ws + WS_DBG + 1024))[t] = bfv((const bf16_t*)(ws + WS_ZG) + (size_t)r * 1024 + c); }
    if (stage == 12) { const int c = (int)((long)t * 911 + 3) % 3072; const float z = dotA(XN + (size_t)r * D, (in_ptr(tab, 7) + (size_t)DBG_LAYER * (D*DIN)), D, DIN, ZN + c);
        dbg_cmp(dbg, 12, bfv((const bf16_t*)(ws + WS_G) + (size_t)r * 3072 + c), 1.f / (1.f + expf(-z)), 0.02f, 0.01f); }
    if (stage == 13) { const int c = (int)((long)t * 911 + 3) % 1024; const bf16_t* G = (const bf16_t*)(ws + WS_G) + (size_t)r * 3072;
        const float ya = dotA((const bf16_t*)(ws + WS_ZG) + (size_t)r * 1024, (in_ptr(tab, 15) + (size_t)DBG_LAYER * (D*D)), 1024, 1024, c), yb = dotA((const bf16_t*)(ws + WS_YBC) + (size_t)r * 1024, (in_ptr(tab, 17) + (size_t)DBG_LAYER * (512*D)), 512, 1024, c), yc = dotA((const bf16_t*)(ws + WS_YBC) + (size_t)r * 1024 + 512, (in_ptr(tab, 22) + (size_t)DBG_LAYER * (512*D)), 512, 1024, c);
        dbg_cmp(dbg, 13, bfv((const bf16_t*)(ws + WS_MG) + (size_t)r * 1024 + c), bfv(G + c) * ya + bfv(G + 1024 + c) * yb + bfv(G + 2048 + c) * yc, 0.03f, 0.05f); }
    if (stage == 15) { const int c = (int)((long)t * 911 + 3) % D; float s2 = 0.f; for (int k = 0; k < D; ++k) s2 += X[(size_t)r * D + k] * X[(size_t)r * D + k];
        dbg_cmp(dbg, 15, bfv(XN + (size_t)r * D + c), X[(size_t)r * D + c] * rsqrtf(s2 / D + EPS) * (in_ptr(tab, DBG_G) + (size_t)DBG_GL * D)[c], 0.01f, 0.01f); }
    if (stage == 16) { const int c = (int)((long)t * 911 + 3) % D; const bf16_t* F = (const bf16_t*)(ws + WS_MX) + (size_t)r * D; float ss = 0.f; for (int k = 0; k < D; ++k) ss += bfv(F + k) * bfv(F + k);
        const float xb = X[(size_t)r * D + c];
        dbg_cmp(dbg, 16, ((const float*)(ws + WS_G))[(size_t)r * D + c], xb + bfv(F + c) * rsqrtf(ss / D + EPS) * (in_ptr(tab, 24) + (size_t)DBG_LAYER * D)[c], 0.001f, 0.001f); }
    if (stage == 17) { const int c = (int)((long)t * 911 + 3) % D; const bf16_t* F = (const bf16_t*)(ws + WS_F) + (size_t)r * D; float ss = 0.f; for (int k = 0; k < D; ++k) ss += bfv(F + k) * bfv(F + k);
        const float xb = X[(size_t)r * D + c];
        dbg_cmp(dbg, 17, ((const float*)(ws + WS_G))[(size_t)r * D + c], xb + 0.5f * bfv(F + c) * rsqrtf(ss / D + EPS) * (in_ptr(tab, 29) + (size_t)DBG_LAYER * D)[c], 0.001f, 0.001f); }
    if (stage == 14) { const int c = (int)((long)t * 911 + 3) % 1024; dbg_cmp(dbg, 14, bfv((const bf16_t*)(ws + WS_MX) + (size_t)r * 1024 + c), dotA((const bf16_t*)(ws + WS_MG) + (size_t)r * 1024, (in_ptr(tab, 23) + (size_t)DBG_LAYER * (D*D)), 1024, 1024, c), 0.03f, 0.03f); }
}
__global__ void __launch_bounds__(64) dbg_kernel(Args a, unsigned mask) {
    unsigned char* ws = a.ws; const float* const* tab = (const float* const*)(ws + WS_TAB);
    for (int st = 2; st <= 17; ++st) if ((mask >> st) & 1u) dbg_check(st, tab, ws, a.out);
}
__global__ void dbg_final(Args a) { const unsigned cde = *(volatile unsigned*)(a.ws + WS_DBG); a.out[0] = (cde != 99u) ? 1000.f + 100.f * (float)cde : 0.f; }
#define DBGCHK(st) do { if (l == DBG_LAYER && (st) == STOP_AT) return; } while (0)
#else
#define DBGCHK(st) do { } while (0)
#endif

__global__ void __launch_bounds__(NTHR, 2) fwd_kernel(Args a) {
    extern __shared__ __attribute__((aligned(16))) unsigned char lds_raw[];
    LAS unsigned char* lds = (LAS unsigned char*)lds_raw;
    cg::grid_group grid = cg::this_grid();
    unsigned char* ws = a.ws;
    { const float** tw = (const float**)(ws + WS_TAB);
      if (threadIdx.x == 0) {
#pragma unroll
          for (int i = 0; i < 30; ++i) tw[i] = a.in[i];
          volatile LAS unsigned* st = (volatile LAS unsigned*)(lds + LDS_BAR_ST); st[0] = 0u; st[1] = 0u;
          (void)xb_add((unsigned*)(ws + WS_BAR) + XB_XCNT(xb_xcc_id()), 1u);
          __threadfence(); }
      __syncthreads(); }
    const float* const* tab = (const float* const*)(ws + WS_TAB);
    const int G = gridDim.x, c = blockIdx.x;
    bf16_t* XN = (bf16_t*)(ws + WS_XN);
    float* X = a.out;
    unsigned char* const ws0 = ws; const int G0 = G, c0 = c; float* const X0 = X;
    constexpr int BIG = 1 << 28;

#ifdef SKEL
    { const float* xin = a.in[0]; for (size_t i = (size_t)blockIdx.x * NTHR + threadIdx.x; i < (size_t)T * D; i += (size_t)gridDim.x * NTHR) a.out[i] = xin[i];
      GSYNC();
#if SKEL >= 2
      convert_layer(tab, ws, 0, lds); GSYNC();
#endif
#if SKEL >= 3
      lc_all(tab, ws); GSYNC();
#endif
#if SKEL >= 4
      ew_phase<false>(in_ptr(tab, 0), X, nullptr, 0.f, nullptr, in_ptr(tab, 1), XN); GSYNC();
#endif
#if SKEL >= 5
      ew_phase<true>(X, X, (const bf16_t*)(ws + WS_F), 0.5f, in_ptr(tab, 5), in_ptr(tab, 6), XN); GSYNC();
#endif
#if SKEL >= 6
      convert_layer(tab, ws, 1, lds); GSYNC();
#endif
      return; }
#endif
#ifdef DBG
    if (blockIdx.x == 0 && threadIdx.x == 0) *(unsigned*)(ws + WS_DBG) = 99u;
#endif
    PH(0) { convert_layer(tab, ws, 0, lds); lc_all(tab, ws); }
    PH(1) ew_phase<false>(in_ptr(tab, 0), X, nullptr, 0.f, nullptr, in_ptr(tab, 1), XN);
    GSYNC_CG();
#ifdef DBG
    if (STOP_AT == 20) return;
#endif

#pragma unroll 1
    for (int l = 0; l < NLAYER_RUN; ++l) {
#pragma unroll 1
        for (int f = 0; f < 2; ++f) {
            unsigned long long wsv = (unsigned long long)ws0, xv = (unsigned long long)X0; int G = G0, c = c0;
#ifndef NOASM
            asm volatile("" : "+s"(wsv), "+s"(G), "+s"(c), "+s"(xv));
#endif
            unsigned char* ws = (unsigned char*)(GAS unsigned char*)wsv; float* X = (float*)(GAS float*)xv;
            const float* const* tab = (const float* const*)(ws + WS_TAB); bf16_t* XN = (bf16_t*)(ws + WS_XN);
            if (f == 1) {
                PH(2) { pg8::Gemm g{XN, XN, (const bf16_t*)(ws + W_IN), T, ZN, D, D, BIG, 0, 0}; pg8::StaticOrder So; So.init(T, ZN, G, c);
                  pg8::EpiBf<2> E{(bf16_t*)(ws + WS_ZG), 1024, (bf16_t*)(ws + WS_ZX), (bf16_t*)(ws + WS_ZSC), (bf16_t*)(ws + WS_ZSGU)};
                  pg8::gemm_phase<pg8::EpiBf<2>, true>(lds, g, So, E); }
                GSYNC();
                DBGCHK(5);
                PH(3) prep_phase(tab, ws, l, lds);
                GSYNC();
                DBGCHK(6);
                PH(4) { const bf16_t* XC = (const bf16_t*)(ws + WS_XC);
                  pg8::Gemm g{XC, XC, (const bf16_t*)(ws + W_LRU), T, 4096, 256, 1024, BIG, 2, 512}; pg8::StaticOrder So; So.init(T, 4096, G, c);
                  pg8::EpiGates E{XC, (bf16_t*)(ws + WS_U), ws + WS_R, in_ptr(tab, 11) + (size_t)l * 2048, in_ptr(tab, 13) + (size_t)l * 2048, (const float*)(ws + WS_LC)};
                  pg8::gemm_phase<pg8::EpiGates, true>(lds, g, So, E); }
                GSYNC();
                DBGCHK(9);
                PH(5) scan_pass1(ws, l, lds);
                GSYNC();
                PH(6) scan_pass2(ws, l, lds);
                GSYNC();
                DBGCHK(11);
                PH(7) { pg8::Gemm g{XN, XN, (const bf16_t*)(ws + W_IN) + (size_t)ZN * D, T, 3072, D, D, BIG, 0, 0}; pg8::StaticOrder So; So.init(T, 3072, G, c);
                  pg8::EpiBf<1> E{(bf16_t*)(ws + WS_G), 3072, nullptr, nullptr, nullptr};
                  pg8::gemm_phase<pg8::EpiBf<1>, true>(lds, g, So, E); }
                GSYNC();
                DBGCHK(12);
                PH(8) { pg8::Gemm g{(const bf16_t*)(ws + WS_ZG), (const bf16_t*)(ws + WS_YBC) - 16 * 64, (const bf16_t*)(ws + W_CAT), T, D, 2048, 1024, 16, 0, 0}; pg8::StaticOrder So; So.init(T, D, G, c);
                  pg8::EpiMerge E{(const bf16_t*)(ws + WS_G), (bf16_t*)(ws + WS_MG)};
                  pg8::gemm_phase<pg8::EpiMerge, true>(lds, g, So, E); }
                GSYNC();
                DBGCHK(13);
                PH(9) { const bf16_t* MG = (const bf16_t*)(ws + WS_MG);
                  pg8::Gemm g{MG, MG, (const bf16_t*)(ws + W_O), T, D, D, D, BIG, 0, 0}; pg8::StaticOrder So; So.init(T, D, G, c);
                  pg8::EpiBf<0> E{(bf16_t*)(ws + WS_MX), 1024, nullptr, nullptr, nullptr};
                  pg8::gemm_phase<pg8::EpiBf<0>, true>(lds, g, So, E); }
                GSYNC();
                DBGCHK(14);
#if defined(DBG) && STOP_AT == 21
                PH(10) ew_phase<true>(X, (float*)(ws + WS_G), (const bf16_t*)(ws + WS_MX), 1.f, in_ptr(tab, 24) + (size_t)l * D, in_ptr(tab, 25) + (size_t)l * D, XN);
#else
                PH(10) ew_phase<true>(X, X, (const bf16_t*)(ws + WS_MX), 1.f, in_ptr(tab, 24) + (size_t)l * D, in_ptr(tab, 25) + (size_t)l * D, XN);
#endif
                GSYNC();
                DBGCHK(21);
            }
            PH(11) { pg8::Gemm g{XN, XN, (const bf16_t*)(ws + (f ? W_UP2 : W_UP1)), T, 2 * FF, D, D, BIG, 0, 0}; pg8::StaticOrder So; So.init(T, 2 * FF, G, c);
              pg8::EpiSwiGLU E{(bf16_t*)(ws + WS_H), FF};
              pg8::gemm_phase<pg8::EpiSwiGLU, true>(lds, g, So, E); }
            GSYNC();
            if (f == DBG_F) DBGCHK(2);
            PH(12) { const bf16_t* H = (const bf16_t*)(ws + WS_H);
              pg8::Gemm g{H, H, (const bf16_t*)(ws + (f ? W_DN2 : W_DN1)), T, D, FF, FF, BIG, 0, 0}; pg8::StaticOrder So; So.init(T, D, G, c);
              pg8::EpiBf<0> E{(bf16_t*)(ws + WS_F), 1024, nullptr, nullptr, nullptr};
              pg8::gemm_phase<pg8::EpiBf<0>, true>(lds, g, So, E); }
            GSYNC();
            if (f == DBG_F) DBGCHK(3);
            if (f == 0) {
                ew_phase<true>(X, X, (const bf16_t*)(ws + WS_F), 0.5f, in_ptr(tab, 5) + (size_t)l * D, in_ptr(tab, 6) + (size_t)l * D, XN);
            } else {
                if (l + 1 < DEPTH) convert_layer(tab, ws, l + 1, lds);
#if defined(DBG) && STOP_AT == 22
                ew_phase<true>(X, (l == DBG_LAYER) ? (float*)(ws + WS_G) : X, (const bf16_t*)(ws + WS_F), 0.5f, in_ptr(tab, 29) + (size_t)l * D, (l + 1 < DEPTH) ? in_ptr(tab, 1) + (size_t)(l + 1) * D : nullptr, XN);
#else
                ew_phase<true>(X, X, (const bf16_t*)(ws + WS_F), 0.5f, in_ptr(tab, 29) + (size_t)l * D, (l + 1 < DEPTH) ? in_ptr(tab, 1) + (size_t)(l + 1) * D : nullptr, XN);
#endif
            }
            GSYNC();
            if (f == 0) DBGCHK(4);
            if (f == 1) DBGCHK(22);
        }
    }
}

extern "C" void kernel_launch(void* const* d_in, const int* in_sizes, int n_in, void* d_out, int out_size, void* d_ws, size_t ws_size, hipStream_t stream) {
    static int grid = 0;
    if (grid == 0) {
        if (n_in != 30 || in_sizes[0] != T * D || out_size != T * D || ws_size < WS_END) { fprintf(stderr, "kernel_launch: unexpected problem geometry (n_in %d, ws %zu)\n", n_in, ws_size); grid = -1; return; }
        int dev = 0, cus = 0, per_cu = 0;
        if (hipGetDevice(&dev) != hipSuccess || hipDeviceGetAttribute(&cus, hipDeviceAttributeMultiprocessorCount, dev) != hipSuccess) { grid = -1; return; }
        if (hipFuncSetAttribute((const void*)fwd_kernel, hipFuncAttributeMaxDynamicSharedMemorySize, LDS_BYTES) != hipSuccess) { fprintf(stderr, "kernel_launch: hipFuncSetAttribute failed\n"); grid = -1; return; }
        if (hipOccupancyMaxActiveBlocksPerMultiprocessor(&per_cu, (const void*)fwd_kernel, NTHR, LDS_BYTES) != hipSuccess || per_cu < 1) { fprintf(stderr, "kernel_launch: occupancy query failed (%d)\n", per_cu); (void)hipGetLastError(); grid = -1; return; }
        grid = cus * per_cu;
        if (T % (2 * grid * NWAVES) != 0) { fprintf(stderr, "kernel_launch: grid %d does not divide the row pairs of the norm phases\n", grid); grid = -1; return; }
    }
    if (grid < 0) return;
    Args a{};
    for (int i = 0; i < 30; ++i) a.in[i] = (const float*)d_in[i];
    a.out = (float*)d_out; a.ws = (unsigned char*)d_ws;
    if (hipMemsetAsync((char*)d_ws + WS_BAR, 0, 16384, stream) != hipSuccess) { fprintf(stderr, "kernel_launch: hipMemsetAsync failed\n"); return; }
    void* args[] = {&a};
    hipError_t e = hipLaunchCooperativeKernel((const void*)fwd_kernel, dim3(grid), dim3(NTHR), args, LDS_BYTES, stream);
    if (e != hipSuccess) fprintf(stderr, "kernel_launch: cooperative launch failed: %s (grid %d)\n", hipGetErrorString(e), grid);
#ifdef DBG
    dbg_kernel<<<128, 64, 0, stream>>>(a, (unsigned)DBG_MASK);
    dbg_final<<<1, 1, 0, stream>>>(a);
#endif
}
```

```cpp
#include <hip/hip_runtime.h>
#include <hip/hip_cooperative_groups.h>
#include <cstdio>
#include <cstdint>
namespace cg = cooperative_groups;

#define LAS __attribute__((address_space(3)))
typedef unsigned short bf16_t;
typedef short bf16x8 __attribute__((ext_vector_type(8)));
typedef float f32x4 __attribute__((ext_vector_type(4)));
typedef float f32x2 __attribute__((ext_vector_type(2)));
typedef unsigned u32x4 __attribute__((ext_vector_type(4)));
typedef unsigned u32x2 __attribute__((ext_vector_type(2)));

constexpr int NB = 2, S = 16384, T = NB * S, D = 1024, FF = 2816, DIN = 7680, ZN = 4608, DEPTH = 4;
constexpr float EPS = 1e-6f;
constexpr int NTHR = 512, NWAVES = 8;

constexpr size_t MiB = 1u << 20;
constexpr size_t WS_LC = 0;
constexpr size_t WS_TAB = 65536;
constexpr size_t WS_SUM = 1 * MiB;
constexpr size_t WS_W = 4 * MiB;
constexpr size_t W_UP1 = WS_W, W_DN1 = W_UP1 + 11 * MiB, W_IN = W_DN1 + 11 * MiB / 2, W_LRU = W_IN + 15 * MiB, W_CAT = W_LRU + 2 * MiB,
                 W_O = W_CAT + 4 * MiB, W_UP2 = W_O + 2 * MiB, W_DN2 = W_UP2 + 11 * MiB, W_END = W_DN2 + 11 * MiB / 2;
static_assert(W_END == 60 * MiB, "weight map");
constexpr size_t WS_XN = 60 * MiB;
constexpr size_t WS_ZG = 124 * MiB, WS_ZX = 188 * MiB, WS_ZSC = 252 * MiB, WS_ZSGU = 348 * MiB, WS_XC = 412 * MiB, WS_YBC = 476 * MiB, WS_END = 540 * MiB;
constexpr size_t WS_U = 188 * MiB, WS_R = 316 * MiB;
constexpr size_t WS_G = 188 * MiB;
constexpr size_t WS_SEG = 380 * MiB;
constexpr size_t WS_MG = 380 * MiB;
constexpr size_t WS_MX = 124 * MiB;
constexpr size_t WS_H = 124 * MiB;
constexpr size_t WS_F = 316 * MiB;

constexpr int LDS_BYTES = 147456;
#ifndef PHM
#define PHM 0xFFFF
#define NLAYER_RUN DEPTH
#define STOP_AT 11
#define DBG_MASK ((1u << 9) | (1u << 11))
#define DBG_LAYER 1
#define DBG_F 0
#define DBG_G 1
#define DBG_GL 0
#ifndef ABL
#define ABL 0
#endif
#endif
#define PH(b) if constexpr ((PHM >> (b)) & 1)
#define GSYNC_CG() do { asm volatile("s_waitcnt vmcnt(0)" ::: "memory"); __threadfence(); grid.sync(); } while (0)
#define GSYNC() xsync(ws, lds)

struct Args { const float* in[30]; float* out; unsigned char* ws; };

typedef _Float16 h16x2 __attribute__((ext_vector_type(2)));
typedef _Float16 h16x8 __attribute__((ext_vector_type(8)));
__device__ __forceinline__ unsigned cvt_pk_bf16(float lo, float hi) { h16x2 v; v.x = (_Float16)lo; v.y = (_Float16)hi; return __builtin_bit_cast(unsigned, v); }
__device__ __forceinline__ float bflo(unsigned u) { return (float)__builtin_bit_cast(h16x2, u).x; }
__device__ __forceinline__ float bfhi(unsigned u) { return (float)__builtin_bit_cast(h16x2, u).y; }
__device__ __forceinline__ float h8(const u32x4& v, int j) { const unsigned w = (j >> 1) == 0 ? v.x : (j >> 1) == 1 ? v.y : (j >> 1) == 2 ? v.z : v.w; return (j & 1) ? bfhi(w) : bflo(w); }
__device__ __forceinline__ float rcpf_(float x) { return __builtin_amdgcn_rcpf(x); }
__device__ __forceinline__ float sigm(float x) { return rcpf_(1.f + __expf(-x)); }
__device__ __forceinline__ float silu_(float x) { return x * sigm(x); }
__device__ __forceinline__ float gelu_(float x) { const float u = 1.5957691216057308f * (x + 0.044715f * x * x * x); return x * sigm(u); }
#define GAS __attribute__((address_space(1)))
__device__ __forceinline__ const float* in_ptr(const float* const* tab, int i) {
    unsigned long long v = *(const unsigned long long*)(tab + i);
    const unsigned lo = __builtin_amdgcn_readfirstlane((unsigned)v), hi = __builtin_amdgcn_readfirstlane((unsigned)(v >> 32));
    v = ((unsigned long long)hi << 32) | lo;
    return (const float*)(GAS const float*)v;
}
__device__ __forceinline__ float wave_sum(float v, int lane) {
#pragma unroll
    for (int o = 1; o < 64; o <<= 1) v += __int_as_float(__builtin_amdgcn_ds_bpermute((lane ^ o) << 2, __float_as_int(v)));
    return v;
}

constexpr size_t WS_BAR = 131072;
constexpr int LDS_BAR_ST = LDS_BYTES - 64;
#define XB_TMO      128
#define XB_XCNT(j)  (256  + 64 * (j))
#define XB_XSUB(j)  (1280 + 64 * (j))
#define XB_XGEN(j)  (2304 + 64 * (j))
#define XB_TOP      3328
#define XB_TOPGEN   3392
#define XCD_BAR_WORDS 3456
#define XB_SPIN_CAP (1u << 20)
__device__ __forceinline__ unsigned xb_ld(unsigned* p)              { return __hip_atomic_load(p, __ATOMIC_RELAXED, __HIP_MEMORY_SCOPE_AGENT); }
__device__ __forceinline__ unsigned xb_add(unsigned* p, unsigned v) { return __hip_atomic_fetch_add(p, v, __ATOMIC_RELAXED, __HIP_MEMORY_SCOPE_AGENT); }
__device__ __forceinline__ unsigned xb_xcc_id() { return (unsigned)__builtin_amdgcn_s_getreg((3 << 11) | 20) & 0xFu; }
#define XB_SPIN(cond, bar) do { unsigned _sp = 0; while (cond) { __builtin_amdgcn_s_sleep(1); \
    if ((++_sp & 255u) == 0u) { if (xb_ld(&(bar)[XB_TMO])) break; if (_sp > XB_SPIN_CAP) { atomicAdd(&(bar)[XB_TMO], 1u); break; } } } } while (0)
__device__ __forceinline__ void xcd_barrier_complete(unsigned* bar, unsigned x, unsigned& nloc, unsigned& nx) {
    const unsigned G = gridDim.x * gridDim.y * gridDim.z;
    unsigned sum, cnt, mine, sp = 0u;
    for (;;) {
        sum = 0u; cnt = 0u; mine = 0u;
#pragma unroll
        for (unsigned j = 0; j < 16; ++j) { const unsigned c = xb_ld(&bar[XB_XCNT(j)]); sum += c; cnt += (c > 0u) ? 1u : 0u; mine = (j == x) ? c : mine; }
        if (sum == G) break;
        __builtin_amdgcn_s_sleep(1);
        if ((++sp & 255u) == 0u) { if (xb_ld(&bar[XB_TMO])) break; if (sp > XB_SPIN_CAP) { atomicAdd(&bar[XB_TMO], 1u); break; } }
    }
    nloc = mine > 0u ? mine : 1u; nx = cnt > 0u ? cnt : 1u;
}
__device__ __forceinline__ void xsync(unsigned char* ws, LAS unsigned char* lds) {
    asm volatile("s_waitcnt vmcnt(0)" ::: "memory");
    __syncthreads();
    if (threadIdx.x == 0) {
        unsigned* bar = (unsigned*)(ws + WS_BAR); const unsigned x = xb_xcc_id();
        volatile LAS unsigned* st = (volatile LAS unsigned*)(lds + LDS_BAR_ST);
        __builtin_amdgcn_s_waitcnt(0);
        unsigned nloc = st[0], nx = st[1];
        if (nloc == 0u) { xcd_barrier_complete(bar, x, nloc, nx); st[0] = nloc; st[1] = nx; }
        const unsigned old = xb_add(&bar[XB_XSUB(x)], 1u);
        const unsigned gen = old / nloc;
        if (old + 1u == (gen + 1u) * nloc) {
            __builtin_amdgcn_fence(__ATOMIC_RELEASE, "agent");
            asm volatile("s_waitcnt vmcnt(0)" ::: "memory");
            const unsigned og = xb_add(&bar[XB_TOP], 1u);
            const unsigned tg = og / nx;
            if (og + 1u == (tg + 1u) * nx) xb_add(&bar[XB_TOPGEN], 1u);
            else XB_SPIN(xb_ld(&bar[XB_TOPGEN]) == tg, bar);
            __builtin_amdgcn_fence(__ATOMIC_ACQUIRE, "agent");
            xb_add(&bar[XB_XGEN(x)], 1u);
            asm volatile("s_waitcnt vmcnt(0)" ::: "memory");
        } else {
            XB_SPIN(xb_ld(&bar[XB_XGEN(x)]) == gen, bar);
            __builtin_amdgcn_fence(__ATOMIC_ACQUIRE, "agent");
            asm volatile("s_waitcnt vmcnt(0)" ::: "memory");
        }
    }
    __syncthreads();
}

namespace pg8 {
constexpr int BM = 256, BK = 64, HALF = 128, HTB = HALF * BK * 2, STAGE_BYTES = 8 * HTB, NXCD = 8, WGM = 8;
__host__ __device__ __forceinline__ int lds_byte(int r, int c) { const int st = (r >> 4) * 2 + (c >> 5), rr = r & 15, cc = c & 31, ob = rr * 64 + cc * 2; return st * 1024 + (ob ^ (((ob >> 9) & 1) << 5)); }
__host__ __device__ __forceinline__ void stage_rc(int b, int& R, int& C) { const int st = b / 1024, sb = b % 1024, swz = sb ^ (((sb >> 9) & 1) << 5); R = (st >> 1) * 16 + swz / 64; C = (st & 1) * 32 + (swz % 64) / 2; }
__host__ __device__ __forceinline__ int perm32(int rho) { const int n = rho >> 4, i = rho & 15; return 8 * (i >> 2) + 4 * n + (i & 3); }

struct Unit { int pm, pn; };
struct Gemm { const bf16_t* A; const bf16_t* A2; const bf16_t* Bt; int M, N, K, lda, ksplit, apn_shift, apn_bytes; };

struct StaticOrder {
    int nM, nN, nwg, G, c;
    __device__ void init(int M, int N, int G_, int c_) { nM = M / BM; nN = N / BM; nwg = nM * nN; G = G_; c = c_; }
    __device__ bool next(int i, Unit& u) const {
        const long L = (long)i * G + c; if (L >= nwg) return false;
        int wgid = (int)L; { const int q = nwg / NXCD, r = nwg % NXCD, xcd = wgid % NXCD, off = wgid / NXCD; wgid = (xcd < r ? xcd * (q + 1) : r * (q + 1) + (xcd - r) * q) + off; }
        const int nig = WGM * nN, gid = wgid / nig, fm = gid * WGM, gsz = (nM - fm) < WGM ? (nM - fm) : WGM;
        u.pm = fm + ((wgid % nig) % gsz); u.pn = (wgid % nig) / gsz; return true;
    }
};

template <class Epi, bool ALIGN_EPI>
__device__ __forceinline__ void gemm_phase(LAS unsigned char* lds, const Gemm g, const StaticOrder& S, const Epi& E) {
    int tid_ = threadIdx.x; asm volatile("" : "+v"(tid_));
    const int tid = tid_, wid = __builtin_amdgcn_readfirstlane(tid >> 6), lane = tid & 63, wr = wid >> 2, wc = wid & 3, fr = lane & 15, fq = lane >> 4;
    const int K = g.K, nt = K / BK, lda = g.lda;
    unsigned voffA[2], voffB[2];
#pragma unroll
    for (int i = 0; i < 2; ++i) { int R, C; stage_rc(tid * 16 + i * 8192, R, C); const int Rb = Epi::PERM ? ((R & ~31) + perm32(R & 31)) : R;
        voffA[i] = (unsigned)(R * lda + C) * 2u; voffB[i] = (unsigned)(Rb * K + C) * 2u; }
    const size_t kstep = (size_t)(BK * 2);
    const size_t hstepA = (size_t)HALF * lda * 2, tstepA = 2 * hstepA;
    const size_t hstepB = (size_t)HALF * K * 2, tstepB = 2 * hstepB;
    const unsigned ldsw = (unsigned)wid * 1024u;
    const int aoff = lds_byte(wr * 64 + fr, fq * 8), boff = lds_byte(wc * 32 + fr, fq * 8);
#define PG8_SA(b, h) (((b) * 2 + (h)) * HTB)
#define PG8_SB(b, h) ((4 + (b) * 2 + (h)) * HTB)
#define PG8_STAGE(bufoff, gbase, voff) do { _Pragma("unroll") for (int _i = 0; _i < 2; ++_i) \
        __builtin_amdgcn_global_load_lds((const unsigned*)((const char*)(gbase) + (voff)[_i]), (LAS unsigned*)(lds + (bufoff) + ldsw + _i * 8192), 16, 0, 0); } while (0)
#define PG8_LDA(dst, b, h) do { _Pragma("unroll") for (int m = 0; m < 4; ++m) _Pragma("unroll") for (int k = 0; k < 2; ++k) dst[m][k] = *(const LAS bf16x8*)(lds + PG8_SA(b, h) + aoff + m * 2048 + k * 1024); } while (0)
#define PG8_LDB(dst, b, h) do { _Pragma("unroll") for (int n = 0; n < 2; ++n) _Pragma("unroll") for (int k = 0; k < 2; ++k) dst[n][k] = *(const LAS bf16x8*)(lds + PG8_SB(b, h) + boff + n * 2048 + k * 1024); } while (0)
#define PG8_MMA(ai, bj, At, Bt) do { __builtin_amdgcn_s_setprio(1); _Pragma("unroll") for (int m = 0; m < 4; ++m) _Pragma("unroll") for (int n = 0; n < 2; ++n) _Pragma("unroll") for (int k = 0; k < 2; ++k) \
        acc[ai][bj][m][n] = __builtin_amdgcn_mfma_f32_16x16x32_f16(__builtin_bit_cast(h16x8, Bt[n][k]), __builtin_bit_cast(h16x8, At[m][k]), acc[ai][bj][m][n], 0, 0, 0); __builtin_amdgcn_s_setprio(0); } while (0)
#define PG8_WAIT_V(n) asm volatile("s_waitcnt vmcnt(" #n ")" ::: "memory")
#define PG8_WAIT_L(n) asm volatile("s_waitcnt lgkmcnt(" #n ")" ::: "memory")
#define PG8_BAR __builtin_amdgcn_s_barrier()
#define PG8_SCHED __builtin_amdgcn_sched_barrier(0)
    Unit cur, nxt; int ui = 0;
    if (!S.next(0, cur)) return;
    f32x4 acc[2][2][4][2];
#pragma unroll
    for (int a = 0; a < 2; ++a)
#pragma unroll
        for (int b = 0; b < 2; ++b)
#pragma unroll
            for (int m = 0; m < 4; ++m)
#pragma unroll
                for (int n = 0; n < 2; ++n) acc[a][b][m][n] = (f32x4){0.f, 0.f, 0.f, 0.f};
    bf16x8 At[4][2], B0[2][2], B1[2][2];
    const char* cA = (const char*)g.A + (size_t)cur.pm * tstepA + (size_t)(cur.pn >> g.apn_shift) * g.apn_bytes;
    const char* cA2 = (const char*)g.A2 + (size_t)cur.pm * tstepA;
    const char* cB = (const char*)g.Bt + (size_t)cur.pn * tstepB;
    PG8_STAGE(PG8_SB(0, 0), cB, voffB); PG8_STAGE(PG8_SB(0, 1), cB + hstepB, voffB); PG8_STAGE(PG8_SA(0, 0), cA, voffA); PG8_STAGE(PG8_SA(0, 1), cA + hstepA, voffA);
    if (wr == 1) PG8_BAR;
    PG8_WAIT_V(2); PG8_BAR;
    PG8_STAGE(PG8_SB(1, 0), cB + kstep, voffB); PG8_STAGE(PG8_SA(1, 0), cA + kstep, voffA); PG8_STAGE(PG8_SB(1, 1), cB + hstepB + kstep, voffB);
    PG8_WAIT_V(6); PG8_BAR;
    for (;;) {
        const bool has_next = S.next(ui + 1, nxt);
        const char* nA = has_next ? (const char*)g.A + (size_t)nxt.pm * tstepA + (size_t)(nxt.pn >> g.apn_shift) * g.apn_bytes : cA;
        const char* nA2 = has_next ? (const char*)g.A2 + (size_t)nxt.pm * tstepA : cA2;
        const char* nB = has_next ? (const char*)g.Bt + (size_t)nxt.pn * tstepB : cB;
        for (int t = 0; t < nt; t += 2) {
            const bool last = (t == nt - 2);
            const char* a1 = ((t < g.ksplit) ? cA : cA2) + (size_t)(t + 1) * kstep;
            const char* a2 = last ? nA : ((t + 2 < g.ksplit) ? cA : cA2) + (size_t)(t + 2) * kstep;
            const char* b2 = last ? nB : cB + (size_t)(t + 2) * kstep;
            const char* a3 = a2 + kstep; const char* b3 = b2 + kstep;
            if constexpr (Epi::HOOK) { if (t == g.ksplit || t == g.ksplit + 8) E.hook(acc, cur, (t - g.ksplit) >> 3, wr, wc, fr, fq); }
            PG8_LDB(B0, 0, 0); PG8_LDB(B1, 0, 1); PG8_SCHED; PG8_LDA(At, 0, 0); PG8_STAGE(PG8_SA(1, 1), a1 + hstepA, voffA);
            PG8_WAIT_V(8); PG8_WAIT_L(0); PG8_BAR; PG8_MMA(0, 0, At, B0); PG8_MMA(0, 1, At, B1); PG8_BAR; PG8_SCHED;
            PG8_LDA(At, 0, 1); PG8_STAGE(PG8_SB(0, 0), b2, voffB); PG8_STAGE(PG8_SB(0, 1), b2 + hstepB, voffB); PG8_STAGE(PG8_SA(0, 0), a2, voffA);
            PG8_WAIT_V(8); PG8_WAIT_L(0); PG8_BAR; PG8_MMA(1, 0, At, B0); PG8_MMA(1, 1, At, B1); PG8_BAR; PG8_SCHED;
            PG8_LDB(B0, 1, 0); PG8_LDB(B1, 1, 1); PG8_SCHED; PG8_LDA(At, 1, 0); PG8_STAGE(PG8_SA(0, 1), a2 + hstepA, voffA);
            PG8_WAIT_V(8); PG8_WAIT_L(0); PG8_BAR; PG8_MMA(0, 0, At, B0); PG8_MMA(0, 1, At, B1); PG8_BAR; PG8_SCHED;
            PG8_LDA(At, 1, 1); PG8_STAGE(PG8_SB(1, 0), b3, voffB); PG8_STAGE(PG8_SB(1, 1), b3 + hstepB, voffB); PG8_STAGE(PG8_SA(1, 0), a3, voffA);
            PG8_WAIT_V(8); PG8_WAIT_L(0); PG8_BAR; PG8_MMA(1, 0, At, B0); PG8_MMA(1, 1, At, B1); PG8_BAR; PG8_SCHED;
        }
        if constexpr (ALIGN_EPI) { if (wr == 0) PG8_BAR; }
        E(acc, cur, wr, wc, fr, fq);
        if (!has_next) break;
#pragma unroll
        for (int a = 0; a < 2; ++a)
#pragma unroll
            for (int b = 0; b < 2; ++b)
#pragma unroll
                for (int m = 0; m < 4; ++m)
#pragma unroll
                    for (int n = 0; n < 2; ++n) acc[a][b][m][n] = (f32x4){0.f, 0.f, 0.f, 0.f};
        cur = nxt; cA = nA; cA2 = nA2; cB = nB; ++ui;
        if constexpr (ALIGN_EPI) { if (wr == 1) PG8_BAR; }
    }
    PG8_WAIT_V(0);
    if constexpr (!ALIGN_EPI) { if (wr == 0) PG8_BAR; }
    PG8_BAR;
#undef PG8_SA
#undef PG8_SB
#undef PG8_STAGE
#undef PG8_LDA
#undef PG8_LDB
#undef PG8_MMA
#undef PG8_WAIT_V
#undef PG8_WAIT_L
#undef PG8_BAR
#undef PG8_SCHED
}

template <int MODE> struct EpiBf {
    static constexpr bool PERM = true, HOOK = false;
    bf16_t* O; int ldc; bf16_t* O1; bf16_t* O2; bf16_t* O3;
    __device__ __forceinline__ void operator()(const f32x4 (&acc)[2][2][4][2], const Unit& u, int wr, int wc, int fr, int fq) const {
        bf16_t* base = O; int ld = ldc; int colt = u.pn * BM;
        if (MODE == 2) { const int pn = u.pn;
            if (pn < 4) { base = O; ld = 1024; colt = pn * 256; } else if (pn < 8) { base = O1; ld = 1024; colt = (pn - 4) * 256; }
            else if (pn < 14) { base = O2; ld = 1536; colt = (pn - 8) * 256; } else { base = O3; ld = 1024; colt = (pn - 14) * 256; } }
        const int row0 = u.pm * BM + wr * 64 + fr, col0 = colt + wc * 32 + 8 * fq;
#pragma unroll
        for (int ai = 0; ai < 2; ++ai)
#pragma unroll
            for (int m = 0; m < 4; ++m) { bf16_t* rowp = base + (size_t)(row0 + ai * HALF + m * 16) * ld + col0;
#pragma unroll
                for (int bj = 0; bj < 2; ++bj) { f32x4 v0 = acc[ai][bj][m][0], v1 = acc[ai][bj][m][1];
                    if (MODE == 1) {
#pragma unroll
                        for (int j = 0; j < 4; ++j) { v0[j] = sigm(v0[j]); v1[j] = sigm(v1[j]); } }
                    u32x4 w; w.x = cvt_pk_bf16(v0[0], v0[1]); w.y = cvt_pk_bf16(v0[2], v0[3]); w.z = cvt_pk_bf16(v1[0], v1[1]); w.w = cvt_pk_bf16(v1[2], v1[3]);
                    *(u32x4*)(rowp + bj * HALF) = w; } }
    }
};
struct EpiSwiGLU {
    static constexpr bool PERM = true, HOOK = false;
    bf16_t* O; int ldc;
    __device__ __forceinline__ void operator()(const f32x4 (&acc)[2][2][4][2], const Unit& u, int wr, int wc, int fr, int fq) const {
        const int row0 = u.pm * BM + wr * 64 + fr, col0 = u.pn * HALF + wc * 32 + 8 * fq;
#pragma unroll
        for (int ai = 0; ai < 2; ++ai)
#pragma unroll
            for (int m = 0; m < 4; ++m) { bf16_t* rowp = O + (size_t)(row0 + ai * HALF + m * 16) * ldc + col0;
                f32x4 h0, h1;
#pragma unroll
                for (int j = 0; j < 4; ++j) { h0[j] = silu_(acc[ai][0][m][0][j]) * acc[ai][1][m][0][j]; h1[j] = silu_(acc[ai][0][m][1][j]) * acc[ai][1][m][1][j]; }
                u32x4 w; w.x = cvt_pk_bf16(h0[0], h0[1]); w.y = cvt_pk_bf16(h0[2], h0[3]); w.z = cvt_pk_bf16(h1[0], h1[1]); w.w = cvt_pk_bf16(h1[2], h1[3]);
                *(u32x4*)rowp = w; }
    }
};
struct EpiMerge {
    static constexpr bool PERM = true, HOOK = true;
    const bf16_t* G; bf16_t* O;
    __device__ __forceinline__ void hook(f32x4 (&acc)[2][2][4][2], const Unit& u, int which, int wr, int wc, int fr, int fq) const {
        int row0 = u.pm * BM + wr * 64 + fr, col0 = u.pn * BM + wc * 32 + 8 * fq + which * 1024;
        asm volatile("" : "+v"(row0), "+v"(col0));
#pragma unroll
        for (int ai = 0; ai < 2; ++ai)
#pragma unroll
            for (int m = 0; m < 4; ++m) { const bf16_t* gp = G + (size_t)(row0 + ai * HALF + m * 16) * 3072 + col0;
#pragma unroll
                for (int bj = 0; bj < 2; ++bj)
#pragma unroll
                    for (int n = 0; n < 2; ++n) { const u32x2 ga = *(const u32x2*)(gp + bj * HALF + 4 * n), gb = *(const u32x2*)(gp + 1024 + bj * HALF + 4 * n);
                        f32x4 r; r[0] = bflo(ga.x) * rcpf_(bflo(gb.x)); r[1] = bfhi(ga.x) * rcpf_(bfhi(gb.x)); r[2] = bflo(ga.y) * rcpf_(bflo(gb.y)); r[3] = bfhi(ga.y) * rcpf_(bfhi(gb.y));
                        acc[ai][bj][m][n] *= r; asm volatile("" ::: "memory"); } }
    }
    __device__ __forceinline__ void operator()(const f32x4 (&acc)[2][2][4][2], const Unit& u, int wr, int wc, int fr, int fq) const {
        const int row0 = u.pm * BM + wr * 64 + fr, col0 = u.pn * BM + wc * 32 + 8 * fq;
#pragma unroll
        for (int ai = 0; ai < 2; ++ai)
#pragma unroll
            for (int m = 0; m < 4; ++m) { const size_t r = (size_t)(row0 + ai * HALF + m * 16);
#pragma unroll
                for (int bj = 0; bj < 2; ++bj) { const u32x4 gc = *(const u32x4*)(G + r * 3072 + 2048 + col0 + bj * HALF);
                    const f32x4 v0 = acc[ai][bj][m][0], v1 = acc[ai][bj][m][1];
                    u32x4 w; w.x = cvt_pk_bf16(v0[0] * bflo(gc.x), v0[1] * bfhi(gc.x)); w.y = cvt_pk_bf16(v0[2] * bflo(gc.y), v0[3] * bfhi(gc.y));
                    w.z = cvt_pk_bf16(v1[0] * bflo(gc.z), v1[1] * bfhi(gc.z)); w.w = cvt_pk_bf16(v1[2] * bflo(gc.w), v1[3] * bfhi(gc.w));
                    *(u32x4*)(O + r * 1024 + col0 + bj * HALF) = w; }
                asm volatile("" ::: "memory"); }
    }
};
struct EpiGates {
    static constexpr bool PERM = true, HOOK = false;
    const bf16_t* XC; bf16_t* U; unsigned char* R; const float* ba; const float* bx; const float* lc;
    __device__ __forceinline__ void operator()(const f32x4 (&acc)[2][2][4][2], const Unit& u, int wr, int wc, int fr, int fq) const {
        const int d = u.pn & 1;
        int ch0 = 128 * (u.pn >> 1) + 32 * wc + 8 * fq, row0 = u.pm * BM + wr * 64 + fr;
        asm volatile("" : "+v"(row0), "+v"(ch0));
        char* Ud = (char*)(U + (size_t)d * T * 1024); unsigned char* Rd = R + (size_t)d * T * 1024;
        const float* bad = ba + d * 1024 + ch0; const float* bxd = bx + d * 1024 + ch0;
#pragma unroll
        for (int ai = 0; ai < 2; ++ai)
#pragma unroll
            for (int m = 0; m < 4; ++m) { const unsigned off = (unsigned)(row0 + ai * HALF + m * 16) * 1024u + (unsigned)ch0;
                const u32x4 xw = *(const u32x4*)((const char*)XC + (size_t)(off * 2u));
                float uv[8]; unsigned rq[2] = {0u, 0u};
#pragma unroll
                for (int n = 0; n < 2; ++n) { const f32x4 ba4 = *(const f32x4*)(bad + 4 * n), bx4 = *(const f32x4*)(bxd + 4 * n);
#pragma unroll
                    for (int j = 0; j < 4; ++j) { const float rr = sigm(acc[ai][0][m][n][j] + ba4[j]), ig = sigm(acc[ai][1][m][n][j] + bx4[j]);
                        uv[4 * n + j] = ig * h8(xw, 4 * n + j);
                        rq[n] |= ((unsigned)__builtin_rintf(rr * 255.f)) << (8 * j); } }
                u32x4 w; w.x = cvt_pk_bf16(uv[0], uv[1]); w.y = cvt_pk_bf16(uv[2], uv[3]); w.z = cvt_pk_bf16(uv[4], uv[5]); w.w = cvt_pk_bf16(uv[6], uv[7]);
                *(u32x4*)(Ud + (size_t)(off * 2u)) = w;
                u32x2 rw; rw.x = rq[0]; rw.y = rq[1];
                *(u32x2*)(Rd + (size_t)off) = rw;
                asm volatile("" ::: "memory"); }
    }
};
}

__device__ __forceinline__ int w_rowmap(int mode, int n, int p0) {
    if (mode == 0) return n;
    if (mode == 1) return 256 * (n >> 7) + p0 + (n & 127);
    const int dir = p0 >> 3, head = (p0 >> 1) & 3, ri = p0 & 1, ch = 256 * head + n;
    return 256 * (2 * (ch >> 7) + dir) + 128 * ri + (ch & 127);
}
__device__ __forceinline__ void tr_item(const float* W, int N, int item, bf16_t* WT, int ldk, int koff, int mode, int p0, LAS float* scr, int lane) {
    const int nblk = N / 32, kb = item / nblk, nb = item % nblk, k0 = 64 * kb, n0 = 32 * nb;
#pragma unroll 8
    for (int i = 0; i < 32; ++i) { const int kk = 2 * i + (lane >> 5); scr[kk * 33 + (lane & 31)] = W[(size_t)(k0 + kk) * N + n0 + (lane & 31)]; }
    asm volatile("s_waitcnt lgkmcnt(0)" ::: "memory");
    const int c = lane & 7;
#pragma unroll
    for (int j = 0; j < 4; ++j) { const int nn = (lane >> 3) + 8 * j; const LAS float* s = scr + (8 * c) * 33 + nn;
        u32x4 o; o.x = cvt_pk_bf16(s[0 * 33], s[1 * 33]); o.y = cvt_pk_bf16(s[2 * 33], s[3 * 33]); o.z = cvt_pk_bf16(s[4 * 33], s[5 * 33]); o.w = cvt_pk_bf16(s[6 * 33], s[7 * 33]);
        *(u32x4*)(WT + (size_t)w_rowmap(mode, n0 + nn, p0) * ldk + koff + k0 + 8 * c) = o; }
    asm volatile("s_waitcnt lgkmcnt(0)" ::: "memory");
}
__device__ __forceinline__ void convert_layer(const float* const* tab, unsigned char* ws, int l, LAS unsigned char* lds) {
    int tid_ = threadIdx.x; asm volatile("" : "+v"(tid_));
    const int tid = tid_, lane = tid & 63, wave = tid >> 6;
    LAS float* scr = (LAS float*)(lds + wave * 8448);
    const int gw = blockIdx.x * NWAVES + wave, NGW = gridDim.x * NWAVES;
    constexpr int I_UP = 16 * 88, I_DN = 44 * 32, I_IN = 16 * 240, I_LRU = 256, I_SQ = 512, I_HALF = 256;
    constexpr int NITEMS = 6 * I_UP + I_IN + 2 * I_LRU + 2 * I_SQ + 2 * I_HALF;
    const size_t oUP = (size_t)l * D * FF, oSQ = (size_t)l * D * D, oHF = (size_t)l * 512 * D, oLRU = (size_t)l * 2 * 4 * 256 * 256;
    for (int it = gw; it < NITEMS; it += NGW) {
        int r = it;
        if (r < I_UP) { tr_item(in_ptr(tab, 2) + oUP, FF, r, (bf16_t*)(ws + W_UP1), 1024, 0, 1, 0, scr, lane); continue; } r -= I_UP;
        if (r < I_UP) { tr_item(in_ptr(tab, 3) + oUP, FF, r, (bf16_t*)(ws + W_UP1), 1024, 0, 1, 128, scr, lane); continue; } r -= I_UP;
        if (r < I_DN) { tr_item(in_ptr(tab, 4) + oUP, D, r, (bf16_t*)(ws + W_DN1), FF, 0, 0, 0, scr, lane); continue; } r -= I_DN;
        if (r < I_IN) { tr_item(in_ptr(tab, 7) + (size_t)l * D * DIN, DIN, r, (bf16_t*)(ws + W_IN), 1024, 0, 0, 0, scr, lane); continue; } r -= I_IN;
        if (r < I_LRU) { const int mat = r >> 5; tr_item(in_ptr(tab, 10) + oLRU + (size_t)mat * 65536, 256, r & 31, (bf16_t*)(ws + W_LRU), 256, 0, 2, ((mat >> 2) << 3) | ((mat & 3) << 1) | 0, scr, lane); continue; } r -= I_LRU;
        if (r < I_LRU) { const int mat = r >> 5; tr_item(in_ptr(tab, 12) + oLRU + (size_t)mat * 65536, 256, r & 31, (bf16_t*)(ws + W_LRU), 256, 0, 2, ((mat >> 2) << 3) | ((mat & 3) << 1) | 1, scr, lane); continue; } r -= I_LRU;
        if (r < I_SQ) { tr_item(in_ptr(tab, 15) + oSQ, D, r, (bf16_t*)(ws + W_CAT), 2048, 0, 0, 0, scr, lane); continue; } r -= I_SQ;
        if (r < I_HALF) { tr_item(in_ptr(tab, 17) + oHF, D, r, (bf16_t*)(ws + W_CAT), 2048, 1024, 0, 0, scr, lane); continue; } r -= I_HALF;
        if (r < I_HALF) { tr_item(in_ptr(tab, 22) + oHF, D, r, (bf16_t*)(ws + W_CAT), 2048, 1536, 0, 0, scr, lane); continue; } r -= I_HALF;
        if (r < I_SQ) { tr_item(in_ptr(tab, 23) + oSQ, D, r, (bf16_t*)(ws + W_O), 1024, 0, 0, 0, scr, lane); continue; } r -= I_SQ;
        if (r < I_UP) { tr_item(in_ptr(tab, 26) + oUP, FF, r, (bf16_t*)(ws + W_UP2), 1024, 0, 1, 0, scr, lane); continue; } r -= I_UP;
        if (r < I_UP) { tr_item(in_ptr(tab, 27) + oUP, FF, r, (bf16_t*)(ws + W_UP2), 1024, 0, 1, 128, scr, lane); continue; } r -= I_UP;
        tr_item(in_ptr(tab, 28) + oUP, D, r, (bf16_t*)(ws + W_DN2), FF, 0, 0, 0, scr, lane);
    }
}
__device__ __forceinline__ void lc_all(const float* const* tab, unsigned char* ws) {
    float* LC = (float*)(ws + WS_LC); const float* lam = in_ptr(tab, 14);
    for (int i = blockIdx.x * NTHR + threadIdx.x; i < DEPTH * 2048; i += gridDim.x * NTHR) LC[i] = -8.f * log1pf(expf(-lam[i]));
}

__device__ __forceinline__ void wave_sum2(float& a, float& b, int lane) {
#pragma unroll
    for (int o = 1; o < 64; o <<= 1) { const int ad = (lane ^ o) << 2;
        const float ta = __int_as_float(__builtin_amdgcn_ds_bpermute(ad, __float_as_int(a))), tb = __int_as_float(__builtin_amdgcn_ds_bpermute(ad, __float_as_int(b)));
        a += ta; b += tb; }
}
template <bool HASF>
__device__ __forceinline__ void ew_phase(const float* xin, float* xout, const bf16_t* Fb, float scale, const float* post_g, const float* pre_g, bf16_t* XN) {
    int tid_ = threadIdx.x; asm volatile("" : "+v"(tid_));
    const int tid = tid_, lane = tid & 63, wave = tid >> 6;
    const int gw = blockIdx.x * NWAVES + wave, NGW = gridDim.x * NWAVES;
    for (int m = gw; m < T; m += 2 * NGW) {
        f32x4 v[2][4]; f32x4 f[2][4];
#pragma unroll
        for (int r = 0; r < 2; ++r) { const f32x4* xr = (const f32x4*)(xin + (size_t)(m + r * NGW) * D) + lane;
#pragma unroll
            for (int j = 0; j < 4; ++j) v[r][j] = xr[64 * j]; }
        if (HASF) {
            u32x2 fw[2][4];
#pragma unroll
            for (int r = 0; r < 2; ++r) { const u32x2* fr_ = (const u32x2*)(Fb + (size_t)(m + r * NGW) * D) + lane;
#pragma unroll
                for (int j = 0; j < 4; ++j) fw[r][j] = fr_[64 * j]; }
            float ss[2] = {0.f, 0.f};
#pragma unroll
            for (int r = 0; r < 2; ++r)
#pragma unroll
                for (int j = 0; j < 4; ++j) { const u32x2 w = fw[r][j]; f[r][j][0] = bflo(w.x); f[r][j][1] = bfhi(w.x); f[r][j][2] = bflo(w.y); f[r][j][3] = bfhi(w.y);
                    ss[r] += (f[r][j][0] * f[r][j][0] + f[r][j][1] * f[r][j][1]) + (f[r][j][2] * f[r][j][2] + f[r][j][3] * f[r][j][3]); }
            wave_sum2(ss[0], ss[1], lane);
            const float rs0 = scale * __builtin_amdgcn_rsqf(ss[0] * (1.f / D) + EPS), rs1 = scale * __builtin_amdgcn_rsqf(ss[1] * (1.f / D) + EPS);
#pragma unroll
            for (int j = 0; j < 4; ++j) { const f32x4 pg = *((const f32x4*)post_g + 64 * j + lane); v[0][j] += f[0][j] * rs0 * pg; v[1][j] += f[1][j] * rs1 * pg; }
        }
        if (HASF || xin != xout) {
#pragma unroll
            for (int r = 0; r < 2; ++r) { f32x4* xo = (f32x4*)(xout + (size_t)(m + r * NGW) * D) + lane;
#pragma unroll
                for (int j = 0; j < 4; ++j) xo[64 * j] = v[r][j]; }
        }
        if (pre_g) {
            float s2[2] = {0.f, 0.f};
#pragma unroll
            for (int r = 0; r < 2; ++r)
#pragma unroll
                for (int j = 0; j < 4; ++j) s2[r] += (v[r][j][0] * v[r][j][0] + v[r][j][1] * v[r][j][1]) + (v[r][j][2] * v[r][j][2] + v[r][j][3] * v[r][j][3]);
            wave_sum2(s2[0], s2[1], lane);
            const float q0 = __builtin_amdgcn_rsqf(s2[0] * (1.f / D) + EPS), q1 = __builtin_amdgcn_rsqf(s2[1] * (1.f / D) + EPS);
            u32x2* o0 = (u32x2*)(XN + (size_t)m * D) + lane; u32x2* o1 = (u32x2*)(XN + (size_t)(m + NGW) * D) + lane;
#pragma unroll
            for (int j = 0; j < 4; ++j) { const f32x4 g = *((const f32x4*)pre_g + 64 * j + lane); const f32x4 y0 = v[0][j] * q0 * g, y1 = v[1][j] * q1 * g;
                u32x2 w0, w1; w0.x = cvt_pk_bf16(y0[0], y0[1]); w0.y = cvt_pk_bf16(y0[2], y0[3]); w1.x = cvt_pk_bf16(y1[0], y1[1]); w1.y = cvt_pk_bf16(y1[2], y1[3]);
                o0[64 * j] = w0; o1[64 * j] = w1; }
        }
    }
}

constexpr int VT_PITCH = 272;
__device__ __forceinline__ void prep_phase(const float* const* tab, unsigned char* ws, int l, LAS unsigned char* lds) {
    int tid_ = threadIdx.x; asm volatile("" : "+v"(tid_));
    const int tid = tid_, lane = tid & 63, wave = tid >> 6;
    const bf16_t* ZX = (const bf16_t*)(ws + WS_ZX); const bf16_t* ZSC = (const bf16_t*)(ws + WS_ZSC); const bf16_t* ZSGU = (const bf16_t*)(ws + WS_ZSGU);
    bf16_t* XC = (bf16_t*)(ws + WS_XC); bf16_t* YBC = (bf16_t*)(ws + WS_YBC);
    for (int item = blockIdx.x; item < T / 128; item += gridDim.x) {
        const int b = item >> 7, n = item & 127, t0 = n * 128; const size_t rb = (size_t)b * S;
        {
            const int c = 8 * (tid & 127), sg = tid >> 7; const float* cw = in_ptr(tab, 8) + (size_t)l * 4096 + c; const float* cb = in_ptr(tab, 9) + (size_t)l * 1024 + c;
            float wk[4][8], bb[8];
#pragma unroll
            for (int k = 0; k < 4; ++k) { const f32x4 a0 = *(const f32x4*)(cw + k * 1024), a1 = *(const f32x4*)(cw + k * 1024 + 4);
#pragma unroll
                for (int j = 0; j < 4; ++j) { wk[k][j] = a0[j]; wk[k][4 + j] = a1[j]; } }
            { const f32x4 a0 = *(const f32x4*)cb, a1 = *(const f32x4*)(cb + 4);
#pragma unroll
              for (int j = 0; j < 4; ++j) { bb[j] = a0[j]; bb[4 + j] = a1[j]; } }
            const bf16_t* src = ZX + rb * 1024 + c;
#pragma unroll 1
            for (int blk = 0; blk < 4; ++blk) { const int tb = t0 + sg * 32 + blk * 8;
                u32x4 xr[11];
#pragma unroll
                for (int i = 0; i < 11; ++i) { const int t = tb - 2 + i; xr[i] = (t >= 0 && t < S) ? *(const u32x4*)(src + (size_t)t * 1024) : (u32x4){0u, 0u, 0u, 0u}; }
#pragma unroll
                for (int o = 0; o < 8; ++o) { float y[8];
#pragma unroll
                    for (int j = 0; j < 8; ++j) y[j] = bb[j] + wk[0][j] * h8(xr[o], j) + wk[1][j] * h8(xr[o + 1], j) + wk[2][j] * h8(xr[o + 2], j) + wk[3][j] * h8(xr[o + 3], j);
                    u32x4 w; w.x = cvt_pk_bf16(y[0], y[1]); w.y = cvt_pk_bf16(y[2], y[3]); w.z = cvt_pk_bf16(y[4], y[5]); w.w = cvt_pk_bf16(y[6], y[7]);
                    *(u32x4*)(XC + (rb + tb + o) * 1024 + c) = w; } }
        }
        {
            const int c = 8 * (tid & 63), sg = tid >> 6; const float* cw = in_ptr(tab, 16) + (size_t)l * 1536 + c;
            float wk[3][8];
#pragma unroll
            for (int k = 0; k < 3; ++k) { const f32x4 a0 = *(const f32x4*)(cw + k * 512), a1 = *(const f32x4*)(cw + k * 512 + 4);
#pragma unroll
                for (int j = 0; j < 4; ++j) { wk[k][j] = a0[j]; wk[k][4 + j] = a1[j]; } }
            const bf16_t* src = ZSC + rb * 1536 + c;
#pragma unroll 1
            for (int blk = 0; blk < 4; ++blk) { const int tb = t0 + sg * 16 + blk * 4;
                u32x4 cr[6], xr[6], br[4];
#pragma unroll
                for (int i = 0; i < 6; ++i) { const int t = tb - 1 + i; const bool in = (t >= 0 && t < S);
                    cr[i] = in ? *(const u32x4*)(src + (size_t)t * 1536 + 512) : (u32x4){0u, 0u, 0u, 0u}; xr[i] = in ? *(const u32x4*)(src + (size_t)t * 1536 + 1024) : (u32x4){0u, 0u, 0u, 0u}; }
#pragma unroll
                for (int o = 0; o < 4; ++o) br[o] = *(const u32x4*)(src + (size_t)(tb + o) * 1536);
                float p[6][8];
#pragma unroll
                for (int i = 0; i < 6; ++i)
#pragma unroll
                    for (int j = 0; j < 8; ++j) p[i][j] = h8(cr[i], j) * h8(xr[i], j);
#pragma unroll
                for (int o = 0; o < 4; ++o) { float y[8];
#pragma unroll
                    for (int j = 0; j < 8; ++j) y[j] = h8(br[o], j) * (wk[0][j] * p[o][j] + wk[1][j] * p[o + 1][j] + wk[2][j] * p[o + 2][j]);
                    u32x4 w; w.x = cvt_pk_bf16(y[0], y[1]); w.y = cvt_pk_bf16(y[2], y[3]); w.z = cvt_pk_bf16(y[4], y[5]); w.w = cvt_pk_bf16(y[6], y[7]);
                    *(u32x4*)(YBC + (rb + tb + o) * 1024 + c) = w; } }
        }
        {
            const float* lg = in_ptr(tab, 18) + (size_t)l * 512; const float* lb = in_ptr(tab, 19) + (size_t)l * 512;
            f32x4 g0 = *(const f32x4*)(lg + 8 * lane), g1 = *(const f32x4*)(lg + 8 * lane + 4), b0 = *(const f32x4*)(lb + 8 * lane), b1 = *(const f32x4*)(lb + 8 * lane + 4);
            u32x4 wrow[16];
#pragma unroll
            for (int qi = 0; qi < 16; ++qi) wrow[qi] = *(const u32x4*)(ZSGU + (rb + t0 + wave + 8 * qi) * 1024 + 512 + 8 * lane);
#pragma unroll
            for (int qi = 0; qi < 16; ++qi) { const int q = wave + 8 * qi; const u32x4 w = wrow[qi];
                float v[8]; v[0] = bflo(w.x); v[1] = bfhi(w.x); v[2] = bflo(w.y); v[3] = bfhi(w.y); v[4] = bflo(w.z); v[5] = bfhi(w.z); v[6] = bflo(w.w); v[7] = bfhi(w.w);
                float s = 0.f;
#pragma unroll
                for (int j = 0; j < 8; ++j) { v[j] = gelu_(v[j]); s += v[j]; }
                const float mu = wave_sum(s, lane) * (1.f / 512.f); float s2 = 0.f;
#pragma unroll
                for (int j = 0; j < 8; ++j) { v[j] -= mu; s2 += v[j] * v[j]; }
                const float rstd = __builtin_amdgcn_rsqf(wave_sum(s2, lane) * (1.f / 512.f) + EPS);
#pragma unroll
                for (int j = 0; j < 8; ++j) { const float y = v[j] * rstd * (j < 4 ? g0[j & 3] : g1[j & 3]) + (j < 4 ? b0[j & 3] : b1[j & 3]);
                    *(LAS bf16_t*)(lds + (8 * lane + j) * VT_PITCH + 2 * q) = (bf16_t)(cvt_pk_bf16(y, 0.f) & 0xffffu); }
            }
            __syncthreads();
            const int g = wave >> 1, p0 = 64 * (wave & 1), fr = lane & 15, fq = lane >> 4;
            const float* Wg = in_ptr(tab, 20) + (size_t)l * 65536 + (size_t)g * 16384; const float* bs = in_ptr(tab, 21) + (size_t)l * 512 + g * 128;
            bf16x8 Wf[4][4];
#pragma unroll
            for (int m = 0; m < 4; ++m)
#pragma unroll
                for (int kk = 0; kk < 4; ++kk) { const float* p = Wg + (size_t)(p0 + 16 * m + fr) * 128 + 32 * kk + 8 * fq; const f32x4 x0 = *(const f32x4*)p, x1 = *(const f32x4*)(p + 4);
                    u32x4 w; w.x = cvt_pk_bf16(x0[0], x0[1]); w.y = cvt_pk_bf16(x0[2], x0[3]); w.z = cvt_pk_bf16(x1[0], x1[1]); w.w = cvt_pk_bf16(x1[2], x1[3]);
                    Wf[m][kk] = __builtin_bit_cast(bf16x8, w); }
            float bsv[4];
#pragma unroll
            for (int m = 0; m < 4; ++m) bsv[m] = bs[p0 + 16 * m + fr];
            for (int nn = 0; nn < 8; ++nn) {
                f32x4 acc[4];
#pragma unroll
                for (int m = 0; m < 4; ++m) acc[m] = (f32x4){0.f, 0.f, 0.f, 0.f};
#pragma unroll
                for (int kk = 0; kk < 4; ++kk) { const bf16x8 vf = *(const LAS bf16x8*)(lds + (g * 128 + 16 * nn + fr) * VT_PITCH + (32 * kk + 8 * fq) * 2);
#pragma unroll
                    for (int m = 0; m < 4; ++m) acc[m] = __builtin_amdgcn_mfma_f32_16x16x32_f16(__builtin_bit_cast(h16x8, vf), __builtin_bit_cast(h16x8, Wf[m][kk]), acc[m], 0, 0, 0); }
                const int cc = g * 128 + 16 * nn + 4 * fq;
#pragma unroll
                for (int m = 0; m < 4; ++m) { const size_t row = rb + t0 + p0 + 16 * m + fr;
                    const u32x2 uw = *(const u32x2*)(ZSGU + row * 1024 + cc);
                    const float o0 = gelu_(bflo(uw.x)) * (acc[m][0] + bsv[m]), o1 = gelu_(bfhi(uw.x)) * (acc[m][1] + bsv[m]), o2 = gelu_(bflo(uw.y)) * (acc[m][2] + bsv[m]), o3 = gelu_(bfhi(uw.y)) * (acc[m][3] + bsv[m]);
                    u32x2 w; w.x = cvt_pk_bf16(o0, o1); w.y = cvt_pk_bf16(o2, o3); if (ABL == 3) { w.x = 0u; w.y = 0u; }
                    *(u32x2*)(YBC + row * 1024 + 512 + cc) = w; }
            }
            __syncthreads();
        }
    }
}

__device__ __forceinline__ void scan_pass1(unsigned char* ws, int l, LAS unsigned char* lds) {
    int tid_ = threadIdx.x; asm volatile("" : "+v"(tid_));
    const int tid = tid_, lane = tid & 63, seg = tid >> 6;
    const float* LC = (const float*)(ws + WS_LC) + l * 2048; f32x2* SUM = (f32x2*)(ws + WS_SUM); f32x4* SEGS = (f32x4*)(ws + WS_SEG);
    LAS f32x4* SEG = (LAS f32x4*)lds;
    for (int item = blockIdx.x; item < 2048; item += gridDim.x) {
        const int dir = item & 1, grp = (item >> 1) & 7, chunk = (item >> 4) & 63, b = item >> 10;
        const int ch = grp * 128 + 2 * lane;
        const float l0 = LC[dir * 1024 + ch] * (1.f / 255.f), l1 = LC[dir * 1024 + ch + 1] * (1.f / 255.f);
        const bf16_t* U = (const bf16_t*)(ws + WS_U) + (size_t)dir * T * 1024 + ((size_t)b * S + chunk * 256) * 1024 + ch;
        const unsigned char* R = ws + WS_R + (size_t)dir * T * 1024 + ((size_t)b * S + chunk * 256) * 1024 + ch;
        unsigned uw[32], rw[32];
#pragma unroll
        for (int k = 0; k < 32; ++k) { const int p = seg * 32 + k, to = dir ? 255 - p : p; uw[k] = *(const unsigned*)(U + (size_t)to * 1024); rw[k] = *(const unsigned short*)(R + (size_t)to * 1024); }
        float A0 = 1.f, A1 = 1.f, H0 = 0.f, H1 = 0.f;
#pragma unroll
        for (int k = 0; k < 32; ++k) { const float a0 = __expf(l0 * (float)(rw[k] & 255u)), a1 = __expf(l1 * (float)(rw[k] >> 8));
            H0 = a0 * H0 + bflo(uw[k]) * __builtin_sqrtf(1.f - a0 * a0); H1 = a1 * H1 + bfhi(uw[k]) * __builtin_sqrtf(1.f - a1 * a1); A0 *= a0; A1 *= a1; }
        const f32x4 sv = (f32x4){A0, H0, A1, H1};
        SEG[seg * 64 + lane] = sv;
        SEGS[((size_t)(((dir * 2 + b) * 64 + chunk) * 8 + seg)) * 512 + grp * 64 + lane] = sv;
        __syncthreads();
        if (tid < 64) { float cA0 = 1.f, cA1 = 1.f, cH0 = 0.f, cH1 = 0.f;
#pragma unroll
            for (int s = 0; s < 8; ++s) { const f32x4 v = SEG[s * 64 + tid]; cH0 = v[0] * cH0 + v[1]; cA0 *= v[0]; cH1 = v[2] * cH1 + v[3]; cA1 *= v[2]; }
            f32x4* o = (f32x4*)(SUM + ((size_t)((dir * 2 + b) * 64 + chunk)) * 1024 + grp * 128 + 2 * tid); *o = (f32x4){cA0, cH0, cA1, cH1}; }
        __syncthreads();
    }
}
__device__ __forceinline__ void scan_pass2(unsigned char* ws, int l, LAS unsigned char* lds) {
    int tid_ = threadIdx.x; asm volatile("" : "+v"(tid_));
    const int tid = tid_, lane = tid & 63, seg = tid >> 6;
    const float* LC = (const float*)(ws + WS_LC) + l * 2048; const f32x2* SUM = (const f32x2*)(ws + WS_SUM); const f32x4* SEGS = (const f32x4*)(ws + WS_SEG);
    LAS f32x2* HF = (LAS f32x2*)lds;
    LAS f32x2* CAR = (LAS f32x2*)(lds + 131072);
    for (int item0 = blockIdx.x; item0 < 1024; item0 += 4 * gridDim.x) {
        { const int slot = seg >> 1, dir = seg & 1, item = item0 + slot * gridDim.x;
          if (item < 1024) { const int grp = item & 7, chunk = (item >> 3) & 63, b = item >> 9;
              const f32x4* sp = (const f32x4*)(SUM + ((size_t)((dir * 2 + b) * 64)) * 1024 + grp * 128 + 2 * lane);
              float h0 = 0.f, h1 = 0.f; const int nprev = dir ? 63 - chunk : chunk;
              for (int j0 = 0; j0 < nprev; j0 += 8) { f32x4 v[8];
#pragma unroll
                  for (int u = 0; u < 8; ++u) { const int jj = j0 + u; const int cj = dir ? 63 - jj : jj; const int cl = jj < nprev ? cj : chunk;
                      v[u] = sp[(size_t)cl * 512]; if (jj >= nprev) v[u] = (f32x4){1.f, 0.f, 1.f, 0.f}; }
#pragma unroll
                  for (int u = 0; u < 8; ++u) { h0 = v[u][0] * h0 + v[u][1]; h1 = v[u][2] * h1 + v[u][3]; } }
              CAR[seg * 64 + lane] = (f32x2){h0, h1}; } }
        __syncthreads();
#pragma unroll 1
        for (int slot = 0; slot < 4; ++slot) { const int item = item0 + slot * gridDim.x; if (item >= 1024) break;
            const int grp = item & 7, chunk = (item >> 3) & 63, b = item >> 9;
            const int ch = grp * 128 + 2 * lane;
            bf16_t* ZG = (bf16_t*)(ws + WS_ZG) + ((size_t)b * S + chunk * 256) * 1024 + ch;
#pragma unroll 1
            for (int dir = 0; dir < 2; ++dir) {
                const float l0 = LC[dir * 1024 + ch] * (1.f / 255.f), l1 = LC[dir * 1024 + ch + 1] * (1.f / 255.f);
                const bf16_t* U = (const bf16_t*)(ws + WS_U) + (size_t)dir * T * 1024 + ((size_t)b * S + chunk * 256) * 1024 + ch;
                const unsigned char* R = ws + WS_R + (size_t)dir * T * 1024 + ((size_t)b * S + chunk * 256) * 1024 + ch;
                float h0, h1; { const f32x2 c = CAR[(slot * 2 + dir) * 64 + lane]; h0 = c[0]; h1 = c[1]; }
                { const f32x4* sg = SEGS + ((size_t)(((dir * 2 + b) * 64 + chunk) * 8)) * 512 + grp * 64 + lane; f32x4 v[7];
#pragma unroll
                  for (int s = 0; s < 7; ++s) v[s] = sg[(size_t)s * 512];
#pragma unroll
                  for (int s = 0; s < 7; ++s) if (s < seg) { h0 = v[s][0] * h0 + v[s][1]; h1 = v[s][2] * h1 + v[s][3]; } }
#pragma unroll 1
                for (int kb = 0; kb < 4; ++kb) { unsigned uw8[8], rw8[8], gw8[8];
#pragma unroll
                    for (int u = 0; u < 8; ++u) { const int p = seg * 32 + kb * 8 + u, to = dir ? 255 - p : p;
                        uw8[u] = *(const unsigned*)(U + (size_t)to * 1024); rw8[u] = *(const unsigned short*)(R + (size_t)to * 1024);
                        gw8[u] = dir ? *(const unsigned*)(ZG + (size_t)to * 1024) : 0u; }
#pragma unroll
                    for (int u = 0; u < 8; ++u) { const int p = seg * 32 + kb * 8 + u, to = dir ? 255 - p : p; const unsigned uw = uw8[u], rw = rw8[u];
                        const float a0 = __expf(l0 * (float)(rw & 255u)), a1 = __expf(l1 * (float)(rw >> 8));
                        h0 = a0 * h0 + bflo(uw) * __builtin_sqrtf(1.f - a0 * a0); h1 = a1 * h1 + bfhi(uw) * __builtin_sqrtf(1.f - a1 * a1);
                        if (dir == 0) HF[to * 64 + lane] = (f32x2){h0, h1};
                        else { const f32x2 hf = HF[to * 64 + lane]; const unsigned gw = gw8[u];
                            *(unsigned*)(ZG + (size_t)to * 1024) = cvt_pk_bf16((hf[0] + h0) * gelu_(bflo(gw)), (hf[1] + h1) * gelu_(bfhi(gw))); } } }
                __syncthreads();
            }
        }
    }
}

#ifdef DBG
constexpr size_t WS_DBG = 70000;
__device__ __forceinline__ float bfv(const bf16_t* p) { return bflo((unsigned)*p); }
__device__ __forceinline__ float dotA(const bf16_t* arow, const float* W, int K, int N, int col) { float s = 0.f; for (int k = 0; k < K; ++k) s += bfv(arow + k) * W[(size_t)k * N + col]; return s; }
__device__ __forceinline__ void dbg_cmp(unsigned* dbg, unsigned code, float got, float ref, float tol_rel, float tol_abs) {
    const float e = fabsf(got - ref); if (!(e <= tol_rel * fabsf(ref) + tol_abs)) atomicMin(dbg, code); }
__device__ __forceinline__ void dbg_check(int stage, const float* const* tab, unsigned char* ws, float* X) {
    unsigned* dbg = (unsigned*)(ws + WS_DBG); const int t = blockIdx.x * 64 + threadIdx.x;
    int r = (int)(((long)t * 5273 + 17) % T); const bf16_t* XN = (const bf16_t*)(ws + WS_XN);
    { const int q = t >> 1; const int base = (q & 1) ? S : 0;
      if (t < 40) { const int k = q >> 1; const int off = (k == 0) ? 0 : (k == 1) ? 1 : (k == 2) ? 2 : (k == 3) ? 127 : (k == 4) ? 128 : (k == 5) ? 255 : (k == 6) ? 256 : (k == 7) ? S - 1 : (k == 8) ? S - 2 : S - 3; r = base + off; } }
    if (stage == 2) { const int c = (int)((long)t * 911 + 3) % FF; const float g = dotA(XN + (size_t)r * D, (in_ptr(tab, DBG_F ? 26 : 2) + (size_t)DBG_LAYER * (D*FF)), D, FF, c), u = dotA(XN + (size_t)r * D, (in_ptr(tab, DBG_F ? 27 : 3) + (size_t)DBG_LAYER * (D*FF)), D, FF, c);
        dbg_cmp(dbg, 2, bfv((const bf16_t*)(ws + WS_H) + (size_t)r * FF + c), g / (1.f + expf(-g)) * u, 0.03f, 0.03f); }
    if (stage == 3) { const int c = (int)((long)t * 911 + 3) % D; dbg_cmp(dbg, 3, bfv((const bf16_t*)(ws + WS_F) + (size_t)r * D + c), dotA((const bf16_t*)(ws + WS_H) + (size_t)r * FF, (in_ptr(tab, DBG_F ? 28 : 4) + (size_t)DBG_LAYER * (D*FF)), FF, D, c), 0.03f, 0.03f); }
    if (stage == 4) { const int c = (int)((long)t * 911 + 3) % D; const bf16_t* F = (const bf16_t*)(ws + WS_F) + (size_t)r * D; float ss = 0.f; for (int k = 0; k < D; ++k) ss += bfv(F + k) * bfv(F + k);
        const float* x0 = in_ptr(tab, 0) + (size_t)r * D; float s2 = 0.f;
        for (int k = 0; k < D; ++k) { const float xv = x0[k] + 0.5f * bfv(F + k) * rsqrtf(ss / D + EPS) * (in_ptr(tab, 5) + (size_t)DBG_LAYER * (D))[k]; s2 += xv * xv; if (k == c) dbg_cmp(dbg, 4, X[(size_t)r * D + c], xv, 0.001f, 0.001f); }
        dbg_cmp(dbg, 4, bfv(XN + (size_t)r * D + c), X[(size_t)r * D + c] * rsqrtf(s2 / D + EPS) * (in_ptr(tab, 6) + (size_t)DBG_LAYER * (D))[c], 0.01f, 0.01f); }
    if (stage == 5) { const int c = (int)((long)t * 911 + 3) % ZN; const float z = dotA(XN + (size_t)r * D, (in_ptr(tab, 7) + (size_t)DBG_LAYER * (D*DIN)), D, DIN, c); float got;
        if (c < 1024) got = bfv((const bf16_t*)(ws + WS_ZG) + (size_t)r * 1024 + c); else if (c < 2048) got = bfv((const bf16_t*)(ws + WS_ZX) + (size_t)r * 1024 + c - 1024);
        else if (c < 3584) got = bfv((const bf16_t*)(ws + WS_ZSC) + (size_t)r * 1536 + c - 2048); else got = bfv((const bf16_t*)(ws + WS_ZSGU) + (size_t)r * 1024 + c - 3584);
        dbg_cmp(dbg, 5, got, z, 0.03f, 0.03f); }
    if (stage == 6) { const int b = r / S, tt = r % S; const size_t rb = (size_t)b * S;
        { const int c = (int)((long)t * 911 + 3) % 1024; float o = (in_ptr(tab, 9) + (size_t)DBG_LAYER * (1024))[c]; for (int k = 0; k < 4; ++k) { const int q = tt + k - 2; if (q >= 0 && q < S) o += (in_ptr(tab, 8) + (size_t)DBG_LAYER * (4096))[k * 1024 + c] * bfv((const bf16_t*)(ws + WS_ZX) + (rb + q) * 1024 + c); }
          dbg_cmp(dbg, 6, bfv((const bf16_t*)(ws + WS_XC) + (size_t)r * 1024 + c), o, 0.02f, 0.02f); }
        { const int c = (int)((long)t * 911 + 3) % 512; const bf16_t* Z = (const bf16_t*)(ws + WS_ZSC); float o = 0.f; for (int k = 0; k < 3; ++k) { const int q = tt + k - 1; if (q >= 0 && q < S) o += (in_ptr(tab, 16) + (size_t)DBG_LAYER * (1536))[k * 512 + c] * bfv(Z + (rb + q) * 1536 + 512 + c) * bfv(Z + (rb + q) * 1536 + 1024 + c); }
          dbg_cmp(dbg, 7, bfv((const bf16_t*)(ws + WS_YBC) + (size_t)r * 1024 + c), o * bfv(Z + (size_t)r * 1536 + c), 0.02f, 0.02f); }
        { const int c = (int)((long)t * 911 + 3) % 512, g = c >> 7, p = tt & 127, t0 = tt - p; const bf16_t* Z = (const bf16_t*)(ws + WS_ZSGU); float mix = (in_ptr(tab, 21) + (size_t)DBG_LAYER * (512))[g * 128 + p];
          for (int q = 0; q < 128; ++q) { const bf16_t* vr = Z + (rb + t0 + q) * 1024 + 512; float mu = 0.f, var = 0.f; for (int k = 0; k < 512; ++k) mu += gelu_(bfv(vr + k)); mu /= 512.f;
              for (int k = 0; k < 512; ++k) { const float d = gelu_(bfv(vr + k)) - mu; var += d * d; } var /= 512.f;
              const float vn = (gelu_(bfv(vr + c)) - mu) * rsqrtf(var + EPS) * (in_ptr(tab, 18) + (size_t)DBG_LAYER * (512))[c] + (in_ptr(tab, 19) + (size_t)DBG_LAYER * (512))[c]; mix += (in_ptr(tab, 20) + (size_t)DBG_LAYER * (65536))[(size_t)g * 16384 + p * 128 + q] * vn; }
          dbg_cmp(dbg, 8, bfv((const bf16_t*)(ws + WS_YBC) + (size_t)r * 1024 + 512 + c), gelu_(bfv(Z + (size_t)r * 1024 + c)) * mix, 0.03f, 0.03f); } }
    if (stage == 9) { const int c = (int)((long)t * 911 + 3) % 1024, dir = t & 1, head = c >> 8, e = c & 255; const bf16_t* xr = (const bf16_t*)(ws + WS_XC) + (size_t)r * 1024 + head * 256;
        const float pa = dotA(xr, (in_ptr(tab, 10) + (size_t)DBG_LAYER * (524288)) + (size_t)(dir * 4 + head) * 65536, 256, 256, e) + (in_ptr(tab, 11) + (size_t)DBG_LAYER * (2048))[dir * 1024 + c], px = dotA(xr, (in_ptr(tab, 12) + (size_t)DBG_LAYER * (524288)) + (size_t)(dir * 4 + head) * 65536, 256, 256, e) + (in_ptr(tab, 13) + (size_t)DBG_LAYER * (2048))[dir * 1024 + c];
        const float rr = 1.f / (1.f + expf(-pa)), ii = 1.f / (1.f + expf(-px));
        dbg_cmp(dbg, 9, (float)*(ws + WS_R + (size_t)dir * T * 1024 + (size_t)r * 1024 + c), rr * 255.f, 0.02f, 1.5f);
        dbg_cmp(dbg, 10, bfv((const bf16_t*)(ws + WS_U) + (size_t)dir * T * 1024 + (size_t)r * 1024 + c), ii * bfv(xr + e), 0.03f, 0.03f); }
    if (stage == 11) { const int c = (int)((long)t * 911 + 3) % 1024, b = r / S, tt = r % S; const size_t rb = (size_t)b * S; const float* LC = (const float*)(ws + WS_LC) + DBG_LAYER * 2048; float hs = 0.f;
        for (int dir = 0; dir < 2; ++dir) { const bf16_t* U = (const bf16_t*)(ws + WS_U) + (size_t)dir * T * 1024; const unsigned char* R = ws + WS_R + (size_t)dir * T * 1024; float h = 0.f;
            if (dir == 0) { for (int q = 0; q <= tt; ++q) { const float a = expf(LC[c] * (float)R[(rb + q) * 1024 + c] / 255.f); h = a * h + bfv(U + (rb + q) * 1024 + c) * sqrtf(1.f - a * a); } }
            else { for (int q = S - 1; q >= tt; --q) { const float a = expf(LC[1024 + c] * (float)R[(rb + q) * 1024 + c] / 255.f); h = a * h + bfv(U + (rb + q) * 1024 + c) * sqrtf(1.f - a * a); } }
            hs += h; }
        const float gate = dotA(XN + (size_t)r * D, (in_ptr(tab, 7) + (size_t)DBG_LAYER * (D*DIN)), D, DIN, c);
        dbg_cmp(dbg, 11, bfv((const bf16_t*)(ws + WS_ZG) + (size_t)r * 1024 + c), hs * gelu_(gate), 0.03f, 0.03f); }
    if (stage == 10) { const int c = (int)((long)t * 911 + 3) % 1024; ((float*)(ws + WS_DBG + 1024))[t] = bfv((const bf16_t*)(ws + WS_ZG) + (size_t)r * 1024 + c); }
    if (stage == 12) { const int c = (int)((long)t * 911 + 3) % 3072; const float z = dotA(XN + (size_t)r * D, (in_ptr(tab, 7) + (size_t)DBG_LAYER * (D*DIN)), D, DIN, ZN + c);
        dbg_cmp(dbg, 12, bfv((const bf16_t*)(ws + WS_G) + (size_t)r * 3072 + c), 1.f / (1.f + expf(-z)), 0.02f, 0.01f); }
    if (stage == 13) { const int c = (int)((long)t * 911 + 3) % 1024; const bf16_t* G = (const bf16_t*)(ws + WS_G) + (size_t)r * 3072;
        const float ya = dotA((const bf16_t*)(ws + WS_ZG) + (size_t)r * 1024, (in_ptr(tab, 15) + (size_t)DBG_LAYER * (D*D)), 1024, 1024, c), yb = dotA((const bf16_t*)(ws + WS_YBC) + (size_t)r * 1024, (in_ptr(tab, 17) + (size_t)DBG_LAYER * (512*D)), 512, 1024, c), yc = dotA((const bf16_t*)(ws + WS_YBC) + (size_t)r * 1024 + 512, (in_ptr(tab, 22) + (size_t)DBG_LAYER * (512*D)), 512, 1024, c);
        dbg_cmp(dbg, 13, bfv((const bf16_t*)(ws + WS_MG) + (size_t)r * 1024 + c), bfv(G + c) * ya + bfv(G + 1024 + c) * yb + bfv(G + 2048 + c) * yc, 0.03f, 0.05f); }
    if (stage == 15) { const int c = (int)((long)t * 911 + 3) % D; float s2 = 0.f; for (int k = 0; k < D; ++k) s2 += X[(size_t)r * D + k] * X[(size_t)r * D + k];
        dbg_cmp(dbg, 15, bfv(XN + (size_t)r * D + c), X[(size_t)r * D + c] * rsqrtf(s2 / D + EPS) * (in_ptr(tab, DBG_G) + (size_t)DBG_GL * D)[c], 0.01f, 0.01f); }
    if (stage == 16) { const int c = (int)((long)t * 911 + 3) % D; const bf16_t* F = (const bf16_t*)(ws + WS_MX) + (size_t)r * D; float ss = 0.f; for (int k = 0; k < D; ++k) ss += bfv(F + k) * bfv(F + k);
        const float xb = X[(size_t)r * D + c];
        dbg_cmp(dbg, 16, ((const float*)(ws + WS_G))[(size_t)r * D + c], xb + bfv(F + c) * rsqrtf(ss / D + EPS) * (in_ptr(tab, 24) + (size_t)DBG_LAYER * D)[c], 0.001f, 0.001f); }
    if (stage == 17) { const int c = (int)((long)t * 911 + 3) % D; const bf16_t* F = (const bf16_t*)(ws + WS_F) + (size_t)r * D; float ss = 0.f; for (int k = 0; k < D; ++k) ss += bfv(F + k) * bfv(F + k);
        const float xb = X[(size_t)r * D + c];
        dbg_cmp(dbg, 17, ((const float*)(ws + WS_G))[(size_t)r * D + c], xb + 0.5f * bfv(F + c) * rsqrtf(ss / D + EPS) * (in_ptr(tab, 29) + (size_t)DBG_LAYER * D)[c], 0.001f, 0.001f); }
    if (stage == 14) { const int c = (int)((long)t * 911 + 3) % 1024; dbg_cmp(dbg, 14, bfv((const bf16_t*)(ws + WS_MX) + (size_t)r * 1024 + c), dotA((const bf16_t*)(ws + WS_MG) + (size_t)r * 1024, (in_ptr(tab, 23) + (size_t)DBG_LAYER * (D*D)), 1024, 1024, c), 0.03f, 0.03f); }
}
__global__ void __launch_bounds__(64) dbg_kernel(Args a, unsigned mask) {
    unsigned char* ws = a.ws; const float* const* tab = (const float* const*)(ws + WS_TAB);
    for (int st = 2; st <= 17; ++st) if ((mask >> st) & 1u) dbg_check(st, tab, ws, a.out);
}
__global__ void dbg_final(Args a) { const unsigned cde = *(volatile unsigned*)(a.ws + WS_DBG); a.out[0] = (cde != 99u) ? 1000.f + 100.f * (float)cde : 0.f; }
#define DBGCHK(st) do { if (l == DBG_LAYER && (st) == STOP_AT) return; } while (0)
#else
#define DBGCHK(st) do { } while (0)
#endif

__global__ void __launch_bounds__(NTHR, 2) fwd_kernel(Args a) {
    extern __shared__ __attribute__((aligned(16))) unsigned char lds_raw[];
    LAS unsigned char* lds = (LAS unsigned char*)lds_raw;
    cg::grid_group grid = cg::this_grid();
    unsigned char* ws = a.ws;
    { const float** tw = (const float**)(ws + WS_TAB);
      if (threadIdx.x == 0) {
#pragma unroll
          for (int i = 0; i < 30; ++i) tw[i] = a.in[i];
          volatile LAS unsigned* st = (volatile LAS unsigned*)(lds + LDS_BAR_ST); st[0] = 0u; st[1] = 0u;
          (void)xb_add((unsigned*)(ws + WS_BAR) + XB_XCNT(xb_xcc_id()), 1u);
          __threadfence(); }
      __syncthreads(); }
    const float* const* tab = (const float* const*)(ws + WS_TAB);
    const int G = gridDim.x, c = blockIdx.x;
    bf16_t* XN = (bf16_t*)(ws + WS_XN);
    float* X = a.out;
    unsigned char* const ws0 = ws; const int G0 = G, c0 = c; float* const X0 = X;
    constexpr int BIG = 1 << 28;

#ifdef SKEL
    { const float* xin = a.in[0]; for (size_t i = (size_t)blockIdx.x * NTHR + threadIdx.x; i < (size_t)T * D; i += (size_t)gridDim.x * NTHR) a.out[i] = xin[i];
      GSYNC();
#if SKEL >= 2
      convert_layer(tab, ws, 0, lds); GSYNC();
#endif
#if SKEL >= 3
      lc_all(tab, ws); GSYNC();
#endif
#if SKEL >= 4
      ew_phase<false>(in_ptr(tab, 0), X, nullptr, 0.f, nullptr, in_ptr(tab, 1), XN); GSYNC();
#endif
#if SKEL >= 5
      ew_phase<true>(X, X, (const bf16_t*)(ws + WS_F), 0.5f, in_ptr(tab, 5), in_ptr(tab, 6), XN); GSYNC();
#endif
#if SKEL >= 6
      convert_layer(tab, ws, 1, lds); GSYNC();
#endif
      return; }
#endif
#ifdef DBG
    if (blockIdx.x == 0 && threadIdx.x == 0) *(unsigned*)(ws + WS_DBG) = 99u;
#endif
    PH(0) { convert_layer(tab, ws, 0, lds); lc_all(tab, ws); }
    PH(1) ew_phase<false>(in_ptr(tab, 0), X, nullptr, 0.f, nullptr, in_ptr(tab, 1), XN);
    GSYNC_CG();
#ifdef DBG
    if (STOP_AT == 20) return;
#endif

#pragma unroll 1
    for (int l = 0; l < NLAYER_RUN; ++l) {
#pragma unroll 1
        for (int f = 0; f < 2; ++f) {
            unsigned long long wsv = (unsigned long long)ws0, xv = (unsigned long long)X0; int G = G0, c = c0;
#ifndef NOASM
            asm volatile("" : "+s"(wsv), "+s"(G), "+s"(c), "+s"(xv));
#endif
            unsigned char* ws = (unsigned char*)(GAS unsigned char*)wsv; float* X = (float*)(GAS float*)xv;
            const float* const* tab = (const float* const*)(ws + WS_TAB); bf16_t* XN = (bf16_t*)(ws + WS_XN);
            if (f == 1) {
                PH(2) { pg8::Gemm g{XN, XN, (const bf16_t*)(ws + W_IN), T, ZN, D, D, BIG, 0, 0}; pg8::StaticOrder So; So.init(T, ZN, G, c);
                  pg8::EpiBf<2> E{(bf16_t*)(ws + WS_ZG), 1024, (bf16_t*)(ws + WS_ZX), (bf16_t*)(ws + WS_ZSC), (bf16_t*)(ws + WS_ZSGU)};
                  pg8::gemm_phase<pg8::EpiBf<2>, true>(lds, g, So, E); }
                GSYNC();
                DBGCHK(5);
                PH(3) prep_phase(tab, ws, l, lds);
                GSYNC();
                DBGCHK(6);
                PH(4) { const bf16_t* XC = (const bf16_t*)(ws + WS_XC);
                  pg8::Gemm g{XC, XC, (const bf16_t*)(ws + W_LRU), T, 4096, 256, 1024, BIG, 2, 512}; pg8::StaticOrder So; So.init(T, 4096, G, c);
                  pg8::EpiGates E{XC, (bf16_t*)(ws + WS_U), ws + WS_R, in_ptr(tab, 11) + (size_t)l * 2048, in_ptr(tab, 13) + (size_t)l * 2048, (const float*)(ws + WS_LC)};
                  pg8::gemm_phase<pg8::EpiGates, true>(lds, g, So, E); }
                GSYNC();
                DBGCHK(9);
                PH(5) scan_pass1(ws, l, lds);
                GSYNC();
                PH(6) scan_pass2(ws, l, lds);
                GSYNC();
                DBGCHK(11);
                PH(7) { pg8::Gemm g{XN, XN, (const bf16_t*)(ws + W_IN) + (size_t)ZN * D, T, 3072, D, D, BIG, 0, 0}; pg8::StaticOrder So; So.init(T, 3072, G, c);
                  pg8::EpiBf<1> E{(bf16_t*)(ws + WS_G), 3072, nullptr, nullptr, nullptr};
                  pg8::gemm_phase<pg8::EpiBf<1>, true>(lds, g, So, E); }
                GSYNC();
                DBGCHK(12);
                PH(8) { pg8::Gemm g{(const bf16_t*)(ws + WS_ZG), (const bf16_t*)(ws + WS_YBC) - 16 * 64, (const bf16_t*)(ws + W_CAT), T, D, 2048, 1024, 16, 0, 0}; pg8::StaticOrder So; So.init(T, D, G, c);
                  pg8::EpiMerge E{(const bf16_t*)(ws + WS_G), (bf16_t*)(ws + WS_MG)};
                  pg8::gemm_phase<pg8::EpiMerge, true>(lds, g, So, E); }
                GSYNC();
                DBGCHK(13);
                PH(9) { const bf16_t* MG = (const bf16_t*)(ws + WS_MG);
                  pg8::Gemm g{MG, MG, (const bf16_t*)(ws + W_O), T, D, D, D, BIG, 0, 0}; pg8::StaticOrder So; So.init(T, D, G, c);
                  pg8::EpiBf<0> E{(bf16_t*)(ws + WS_MX), 1024, nullptr, nullptr, nullptr};
                  pg8::gemm_phase<pg8::EpiBf<0>, true>(lds, g, So, E); }
                GSYNC();
                DBGCHK(14);
#if defined(DBG) && STOP_AT == 21
                PH(10) ew_phase<true>(X, (float*)(ws + WS_G), (const bf16_t*)(ws + WS_MX), 1.f, in_ptr(tab, 24) + (size_t)l * D, in_ptr(tab, 25) + (size_t)l * D, XN);
#else
                PH(10) ew_phase<true>(X, X, (const bf16_t*)(ws + WS_MX), 1.f, in_ptr(tab, 24) + (size_t)l * D, in_ptr(tab, 25) + (size_t)l * D, XN);
#endif
                GSYNC();
                DBGCHK(21);
            }
            PH(11) { pg8::Gemm g{XN, XN, (const bf16_t*)(ws + (f ? W_UP2 : W_UP1)), T, 2 * FF, D, D, BIG, 0, 0}; pg8::StaticOrder So; So.init(T, 2 * FF, G, c);
              pg8::EpiSwiGLU E{(bf16_t*)(ws + WS_H), FF};
              pg8::gemm_phase<pg8::EpiSwiGLU, true>(lds, g, So, E); }
            GSYNC();
            if (f == DBG_F) DBGCHK(2);
            PH(12) { const bf16_t* H = (const bf16_t*)(ws + WS_H);
              pg8::Gemm g{H, H, (const bf16_t*)(ws + (f ? W_DN2 : W_DN1)), T, D, FF, FF, BIG, 0, 0}; pg8::StaticOrder So; So.init(T, D, G, c);
              pg8::EpiBf<0> E{(bf16_t*)(ws + WS_F), 1024, nullptr, nullptr, nullptr};
              pg8::gemm_phase<pg8::EpiBf<0>, true>(lds, g, So, E); }
            GSYNC();
            if (f == DBG_F) DBGCHK(3);
            if (f == 0) {
                ew_phase<true>(X, X, (const bf16_t*)(ws + WS_F), 0.5f, in_ptr(tab, 5) + (size_t)l * D, in_ptr(tab, 6) + (size_t)l * D, XN);
            } else {
                if (l + 1 < DEPTH) convert_layer(tab, ws, l + 1, lds);
#if defined(DBG) && STOP_AT == 22
                ew_phase<true>(X, (l == DBG_LAYER) ? (float*)(ws + WS_G) : X, (const bf16_t*)(ws + WS_F), 0.5f, in_ptr(tab, 29) + (size_t)l * D, (l + 1 < DEPTH) ? in_ptr(tab, 1) + (size_t)(l + 1) * D : nullptr, XN);
#else
                ew_phase<true>(X, X, (const bf16_t*)(ws + WS_F), 0.5f, in_ptr(tab, 29) + (size_t)l * D, (l + 1 < DEPTH) ? in_ptr(tab, 1) + (size_t)(l + 1) * D : nullptr, XN);
#endif
            }
            GSYNC();
            if (f == 0) DBGCHK(4);
            if (f == 1) DBGCHK(22);
        }
    }
}

extern "C" void kernel_launch(void* const* d_in, const int* in_sizes, int n_in, void* d_out, int out_size, void* d_ws, size_t ws_size, hipStream_t stream) {
    static int grid = 0;
    if (grid == 0) {
        if (n_in != 30 || in_sizes[0] != T * D || out_size != T * D || ws_size < WS_END) { fprintf(stderr, "kernel_launch: unexpected problem geometry (n_in %d, ws %zu)\n", n_in, ws_size); grid = -1; return; }
        int dev = 0, cus = 0, per_cu = 0;
        if (hipGetDevice(&dev) != hipSuccess || hipDeviceGetAttribute(&cus, hipDeviceAttributeMultiprocessorCount, dev) != hipSuccess) { grid = -1; return; }
        if (hipFuncSetAttribute((const void*)fwd_kernel, hipFuncAttributeMaxDynamicSharedMemorySize, LDS_BYTES) != hipSuccess) { fprintf(stderr, "kernel_launch: hipFuncSetAttribute failed\n"); grid = -1; return; }
        if (hipOccupancyMaxActiveBlocksPerMultiprocessor(&per_cu, (const void*)fwd_kernel, NTHR, LDS_BYTES) != hipSuccess || per_cu < 1) { fprintf(stderr, "kernel_launch: occupancy query failed (%d)\n", per_cu); (void)hipGetLastError(); grid = -1; return; }
        grid = cus * per_cu;
        if (T % (2 * grid * NWAVES) != 0) { fprintf(stderr, "kernel_launch: grid %d does not divide the row pairs of the norm phases\n", grid); grid = -1; return; }
    }
    if (grid < 0) return;
    Args a{};
    for (int i = 0; i < 30; ++i) a.in[i] = (const float*)d_in[i];
    a.out = (float*)d_out; a.ws = (unsigned char*)d_ws;
    if (hipMemsetAsync((char*)d_ws + WS_BAR, 0, 16384, stream) != hipSuccess) { fprintf(stderr, "kernel_launch: hipMemsetAsync failed\n"); return; }
    void* args[] = {&a};
    hipError_t e = hipLaunchCooperativeKernel((const void*)fwd_kernel, dim3(grid), dim3(NTHR), args, LDS_BYTES, stream);
    if (e != hipSuccess) fprintf(stderr, "kernel_launch: cooperative launch failed: %s (grid %d)\n", hipGetErrorString(e), grid);
#ifdef DBG
    dbg_kernel<<<128, 64, 0, stream>>>(a, (unsigned)DBG_MASK);
    dbg_final<<<1, 1, 0, stream>>>(a);
#endif
}
```

```cpp
#include <hip/hip_runtime.h>
#include <hip/hip_cooperative_groups.h>
#include <cstdio>
#include <cstdint>
namespace cg = cooperative_groups;

#define LAS __attribute__((address_space(3)))
typedef unsigned short bf16_t;
typedef short bf16x8 __attribute__((ext_vector_type(8)));
typedef float f32x4 __attribute__((ext_vector_type(4)));
typedef float f32x2 __attribute__((ext_vector_type(2)));
typedef unsigned u32x4 __attribute__((ext_vector_type(4)));
typedef unsigned u32x2 __attribute__((ext_vector_type(2)));

constexpr int NB = 2, S = 16384, T = NB * S, D = 1024, FF = 2816, DIN = 7680, ZN = 4608, DEPTH = 4;
constexpr float EPS = 1e-6f;
constexpr int NTHR = 512, NWAVES = 8;

constexpr size_t MiB = 1u << 20;
constexpr size_t WS_LC = 0;
constexpr size_t WS_TAB = 65536;
constexpr size_t WS_SUM = 1 * MiB;
constexpr size_t WS_W = 4 * MiB;
constexpr size_t W_UP1 = WS_W, W_DN1 = W_UP1 + 11 * MiB, W_IN = W_DN1 + 11 * MiB / 2, W_LRU = W_IN + 15 * MiB, W_CAT = W_LRU + 2 * MiB,
                 W_O = W_CAT + 4 * MiB, W_UP2 = W_O + 2 * MiB, W_DN2 = W_UP2 + 11 * MiB, W_END = W_DN2 + 11 * MiB / 2;
static_assert(W_END == 60 * MiB, "weight map");
constexpr size_t WS_XN = 60 * MiB;
constexpr size_t WS_ZG = 124 * MiB, WS_ZX = 188 * MiB, WS_ZSC = 252 * MiB, WS_ZSGU = 348 * MiB, WS_XC = 412 * MiB, WS_YBC = 476 * MiB, WS_END = 540 * MiB;
constexpr size_t WS_U = 188 * MiB, WS_R = 316 * MiB;
constexpr size_t WS_G = 188 * MiB;
constexpr size_t WS_SEG = 380 * MiB;
constexpr size_t WS_MG = 380 * MiB;
constexpr size_t WS_MX = 124 * MiB;
constexpr size_t WS_H = 124 * MiB;
constexpr size_t WS_F = 316 * MiB;

constexpr int LDS_BYTES = 147456;
#ifndef PHM
#define PHM 0xFFFF
#define NLAYER_RUN DEPTH
#define STOP_AT 11
#define DBG_MASK ((1u << 9) | (1u << 11))
#define DBG_LAYER 1
#define DBG_F 0
#define DBG_G 1
#define DBG_GL 0
#ifndef ABL
#define ABL 0
#endif
#endif
#define PH(b) if constexpr ((PHM >> (b)) & 1)
#define GSYNC_CG() do { asm volatile("s_waitcnt vmcnt(0)" ::: "memory"); __threadfence(); grid.sync(); } while (0)
#define GSYNC() xsync(ws, lds)

struct Args { const float* in[30]; float* out; unsigned char* ws; };

typedef _Float16 h16x2 __attribute__((ext_vector_type(2)));
typedef _Float16 h16x8 __attribute__((ext_vector_type(8)));
__device__ __forceinline__ unsigned cvt_pk_bf16(float lo, float hi) { h16x2 v; v.x = (_Float16)lo; v.y = (_Float16)hi; return __builtin_bit_cast(unsigned, v); }
__device__ __forceinline__ float bflo(unsigned u) { return (float)__builtin_bit_cast(h16x2, u).x; }
__device__ __forceinline__ float bfhi(unsigned u) { return (float)__builtin_bit_cast(h16x2, u).y; }
__device__ __forceinline__ float h8(const u32x4& v, int j) { const unsigned w = (j >> 1) == 0 ? v.x : (j >> 1) == 1 ? v.y : (j >> 1) == 2 ? v.z : v.w; return (j & 1) ? bfhi(w) : bflo(w); }
__device__ __forceinline__ float rcpf_(float x) { return __builtin_amdgcn_rcpf(x); }
__device__ __forceinline__ float sigm(float x) { return rcpf_(1.f + __expf(-x)); }
__device__ __forceinline__ float silu_(float x) { return x * sigm(x); }
__device__ __forceinline__ float gelu_(float x) { const float u = 1.5957691216057308f * (x + 0.044715f * x * x * x); return x * sigm(u); }
#define GAS __attribute__((address_space(1)))
__device__ __forceinline__ const float* in_ptr(const float* const* tab, int i) {
    unsigned long long v = *(const unsigned long long*)(tab + i);
    const unsigned lo = __builtin_amdgcn_readfirstlane((unsigned)v), hi = __builtin_amdgcn_readfirstlane((unsigned)(v >> 32));
    v = ((unsigned long long)hi << 32) | lo;
    return (const float*)(GAS const float*)v;
}
__device__ __forceinline__ float wave_sum(float v, int lane) {
#pragma unroll
    for (int o = 1; o < 64; o <<= 1) v += __int_as_float(__builtin_amdgcn_ds_bpermute((lane ^ o) << 2, __float_as_int(v)));
    return v;
}

constexpr size_t WS_BAR = 131072;
constexpr int LDS_BAR_ST = LDS_BYTES - 64;
#define XB_TMO      128
#define XB_XCNT(j)  (256  + 64 * (j))
#define XB_XSUB(j)  (1280 + 64 * (j))
#define XB_XGEN(j)  (2304 + 64 * (j))
#define XB_TOP      3328
#define XB_TOPGEN   3392
#define XCD_BAR_WORDS 3456
#define XB_SPIN_CAP (1u << 20)
__device__ __forceinline__ unsigned xb_ld(unsigned* p)              { return __hip_atomic_load(p, __ATOMIC_RELAXED, __HIP_MEMORY_SCOPE_AGENT); }
__device__ __forceinline__ unsigned xb_add(unsigned* p, unsigned v) { return __hip_atomic_fetch_add(p, v, __ATOMIC_RELAXED, __HIP_MEMORY_SCOPE_AGENT); }
__device__ __forceinline__ unsigned xb_xcc_id() { return (unsigned)__builtin_amdgcn_s_getreg((3 << 11) | 20) & 0xFu; }
#define XB_SPIN(cond, bar) do { unsigned _sp = 0; while (cond) { __builtin_amdgcn_s_sleep(1); \
    if ((++_sp & 255u) == 0u) { if (xb_ld(&(bar)[XB_TMO])) break; if (_sp > XB_SPIN_CAP) { atomicAdd(&(bar)[XB_TMO], 1u); break; } } } } while (0)
__device__ __forceinline__ void xcd_barrier_complete(unsigned* bar, unsigned x, unsigned& nloc, unsigned& nx) {
    const unsigned G = gridDim.x * gridDim.y * gridDim.z;
    unsigned sum, cnt, mine, sp = 0u;
    for (;;) {
        sum = 0u; cnt = 0u; mine = 0u;
#pragma unroll
        for (unsigned j = 0; j < 16; ++j) { const unsigned c = xb_ld(&bar[XB_XCNT(j)]); sum += c; cnt += (c > 0u) ? 1u : 0u; mine = (j == x) ? c : mine; }
        if (sum == G) break;
        __builtin_amdgcn_s_sleep(1);
        if ((++sp & 255u) == 0u) { if (xb_ld(&bar[XB_TMO])) break; if (sp > XB_SPIN_CAP) { atomicAdd(&bar[XB_TMO], 1u); break; } }
    }
    nloc = mine > 0u ? mine : 1u; nx = cnt > 0u ? cnt : 1u;
}
__device__ __forceinline__ void xsync(unsigned char* ws, LAS unsigned char* lds) {
    asm volatile("s_waitcnt vmcnt(0)" ::: "memory");
    __syncthreads();
    if (threadIdx.x == 0) {
        unsigned* bar = (unsigned*)(ws + WS_BAR); const unsigned x = xb_xcc_id();
        volatile LAS unsigned* st = (volatile LAS unsigned*)(lds + LDS_BAR_ST);
        __builtin_amdgcn_s_waitcnt(0);
        unsigned nloc = st[0], nx = st[1];
        if (nloc == 0u) { xcd_barrier_complete(bar, x, nloc, nx); st[0] = nloc; st[1] = nx; }
        const unsigned old = xb_add(&bar[XB_XSUB(x)], 1u);
        const unsigned gen = old / nloc;
        if (old + 1u == (gen + 1u) * nloc) {
            __builtin_amdgcn_fence(__ATOMIC_RELEASE, "agent");
            asm volatile("s_waitcnt vmcnt(0)" ::: "memory");
            const unsigned og = xb_add(&bar[XB_TOP], 1u);
            const unsigned tg = og / nx;
            if (og + 1u == (tg + 1u) * nx) xb_add(&bar[XB_TOPGEN], 1u);
            else XB_SPIN(xb_ld(&bar[XB_TOPGEN]) == tg, bar);
            __builtin_amdgcn_fence(__ATOMIC_ACQUIRE, "agent");
            xb_add(&bar[XB_XGEN(x)], 1u);
            asm volatile("s_waitcnt vmcnt(0)" ::: "memory");
        } else {
            XB_SPIN(xb_ld(&bar[XB_XGEN(x)]) == gen, bar);
            __builtin_amdgcn_fence(__ATOMIC_ACQUIRE, "agent");
            asm volatile("s_waitcnt vmcnt(0)" ::: "memory");
        }
    }
    __syncthreads();
}

namespace pg8 {
constexpr int BM = 256, BK = 64, HALF = 128, HTB = HALF * BK * 2, STAGE_BYTES = 8 * HTB, NXCD = 8, WGM = 8;
__host__ __device__ __forceinline__ int lds_byte(int r, int c) { const int st = (r >> 4) * 2 + (c >> 5), rr = r & 15, cc = c & 31, ob = rr * 64 + cc * 2; return st * 1024 + (ob ^ (((ob >> 9) & 1) << 5)); }
__host__ __device__ __forceinline__ void stage_rc(int b, int& R, int& C) { const int st = b / 1024, sb = b % 1024, swz = sb ^ (((sb >> 9) & 1) << 5); R = (st >> 1) * 16 + swz / 64; C = (st & 1) * 32 + (swz % 64) / 2; }
__host__ __device__ __forceinline__ int perm32(int rho) { const int n = rho >> 4, i = rho & 15; return 8 * (i >> 2) + 4 * n + (i & 3); }

struct Unit { int pm, pn; };
struct Gemm { const bf16_t* A; const bf16_t* A2; const bf16_t* Bt; int M, N, K, lda, ksplit, apn_shift, apn_bytes; };

struct StaticOrder {
    int nM, nN, nwg, G, c;
    __device__ void init(int M, int N, int G_, int c_) { nM = M / BM; nN = N / BM; nwg = nM * nN; G = G_; c = c_; }
    __device__ bool next(int i, Unit& u) const {
        const long L = (long)i * G + c; if (L >= nwg) return false;
        int wgid = (int)L; { const int q = nwg / NXCD, r = nwg % NXCD, xcd = wgid % NXCD, off = wgid / NXCD; wgid = (xcd < r ? xcd * (q + 1) : r * (q + 1) + (xcd - r) * q) + off; }
        const int nig = WGM * nN, gid = wgid / nig, fm = gid * WGM, gsz = (nM - fm) < WGM ? (nM - fm) : WGM;
        u.pm = fm + ((wgid % nig) % gsz); u.pn = (wgid % nig) / gsz; return true;
    }
};

template <class Epi, bool ALIGN_EPI>
__device__ __forceinline__ void gemm_phase(LAS unsigned char* lds, const Gemm g, const StaticOrder& S, const Epi& E) {
    int tid_ = threadIdx.x; asm volatile("" : "+v"(tid_));
    const int tid = tid_, wid = __builtin_amdgcn_readfirstlane(tid >> 6), lane = tid & 63, wr = wid >> 2, wc = wid & 3, fr = lane & 15, fq = lane >> 4;
    const int K = g.K, nt = K / BK, lda = g.lda;
    unsigned voffA[2], voffB[2];
#pragma unroll
    for (int i = 0; i < 2; ++i) { int R, C; stage_rc(tid * 16 + i * 8192, R, C); const int Rb = Epi::PERM ? ((R & ~31) + perm32(R & 31)) : R;
        voffA[i] = (unsigned)(R * lda + C) * 2u; voffB[i] = (unsigned)(Rb * K + C) * 2u; }
    const size_t kstep = (size_t)(BK * 2);
    const size_t hstepA = (size_t)HALF * lda * 2, tstepA = 2 * hstepA;
    const size_t hstepB = (size_t)HALF * K * 2, tstepB = 2 * hstepB;
    const unsigned ldsw = (unsigned)wid * 1024u;
    const int aoff = lds_byte(wr * 64 + fr, fq * 8), boff = lds_byte(wc * 32 + fr, fq * 8);
#define PG8_SA(b, h) (((b) * 2 + (h)) * HTB)
#define PG8_SB(b, h) ((4 + (b) * 2 + (h)) * HTB)
#define PG8_STAGE(bufoff, gbase, voff) do { _Pragma("unroll") for (int _i = 0; _i < 2; ++_i) \
        __builtin_amdgcn_global_load_lds((const unsigned*)((const char*)(gbase) + (voff)[_i]), (LAS unsigned*)(lds + (bufoff) + ldsw + _i * 8192), 16, 0, 0); } while (0)
#define PG8_LDA(dst, b, h) do { _Pragma("unroll") for (int m = 0; m < 4; ++m) _Pragma("unroll") for (int k = 0; k < 2; ++k) dst[m][k] = *(const LAS bf16x8*)(lds + PG8_SA(b, h) + aoff + m * 2048 + k * 1024); } while (0)
#define PG8_LDB(dst, b, h) do { _Pragma("unroll") for (int n = 0; n < 2; ++n) _Pragma("unroll") for (int k = 0; k < 2; ++k) dst[n][k] = *(const LAS bf16x8*)(lds + PG8_SB(b, h) + boff + n * 2048 + k * 1024); } while (0)
#define PG8_MMA(ai, bj, At, Bt) do { __builtin_amdgcn_s_setprio(1); _Pragma("unroll") for (int m = 0; m < 4; ++m) _Pragma("unroll") for (int n = 0; n < 2; ++n) _Pragma("unroll") for (int k = 0; k < 2; ++k) \
        acc[ai][bj][m][n] = __builtin_amdgcn_mfma_f32_16x16x32_f16(__builtin_bit_cast(h16x8, Bt[n][k]), __builtin_bit_cast(h16x8, At[m][k]), acc[ai][bj][m][n], 0, 0, 0); __builtin_amdgcn_s_setprio(0); } while (0)
#define PG8_WAIT_V(n) asm volatile("s_waitcnt vmcnt(" #n ")" ::: "memory")
#define PG8_WAIT_L(n) asm volatile("s_waitcnt lgkmcnt(" #n ")" ::: "memory")
#define PG8_BAR __builtin_amdgcn_s_barrier()
#define PG8_SCHED __builtin_amdgcn_sched_barrier(0)
    Unit cur, nxt; int ui = 0;
    if (!S.next(0, cur)) return;
    f32x4 acc[2][2][4][2];
#pragma unroll
    for (int a = 0; a < 2; ++a)
#pragma unroll
        for (int b = 0; b < 2; ++b)
#pragma unroll
            for (int m = 0; m < 4; ++m)
#pragma unroll
                for (int n = 0; n < 2; ++n) acc[a][b][m][n] = (f32x4){0.f, 0.f, 0.f, 0.f};
    bf16x8 At[4][2], B0[2][2], B1[2][2];
    const char* cA = (const char*)g.A + (size_t)cur.pm * tstepA + (size_t)(cur.pn >> g.apn_shift) * g.apn_bytes;
    const char* cA2 = (const char*)g.A2 + (size_t)cur.pm * tstepA;
    const char* cB = (const char*)g.Bt + (size_t)cur.pn * tstepB;
    PG8_STAGE(PG8_SB(0, 0), cB, voffB); PG8_STAGE(PG8_SB(0, 1), cB + hstepB, voffB); PG8_STAGE(PG8_SA(0, 0), cA, voffA); PG8_STAGE(PG8_SA(0, 1), cA + hstepA, voffA);
    if (wr == 1) PG8_BAR;
    PG8_WAIT_V(2); PG8_BAR;
    PG8_STAGE(PG8_SB(1, 0), cB + kstep, voffB); PG8_STAGE(PG8_SA(1, 0), cA + kstep, voffA); PG8_STAGE(PG8_SB(1, 1), cB + hstepB + kstep, voffB);
    PG8_WAIT_V(6); PG8_BAR;
    for (;;) {
        const bool has_next = S.next(ui + 1, nxt);
        const char* nA = has_next ? (const char*)g.A + (size_t)nxt.pm * tstepA + (size_t)(nxt.pn >> g.apn_shift) * g.apn_bytes : cA;
        const char* nA2 = has_next ? (const char*)g.A2 + (size_t)nxt.pm * tstepA : cA2;
        const char* nB = has_next ? (const char*)g.Bt + (size_t)nxt.pn * tstepB : cB;
        for (int t = 0; t < nt; t += 2) {
            const bool last = (t == nt - 2);
            const char* a1 = ((t < g.ksplit) ? cA : cA2) + (size_t)(t + 1) * kstep;
            const char* a2 = last ? nA : ((t + 2 < g.ksplit) ? cA : cA2) + (size_t)(t + 2) * kstep;
            const char* b2 = last ? nB : cB + (size_t)(t + 2) * kstep;
            const char* a3 = a2 + kstep; const char* b3 = b2 + kstep;
            if constexpr (Epi::HOOK) { if (t == g.ksplit || t == g.ksplit + 8) E.hook(acc, cur, (t - g.ksplit) >> 3, wr, wc, fr, fq); }
            PG8_LDB(B0, 0, 0); PG8_LDB(B1, 0, 1); PG8_SCHED; PG8_LDA(At, 0, 0); PG8_STAGE(PG8_SA(1, 1), a1 + hstepA, voffA);
            PG8_WAIT_V(8); PG8_WAIT_L(0); PG8_BAR; PG8_MMA(0, 0, At, B0); PG8_MMA(0, 1, At, B1); PG8_BAR; PG8_SCHED;
            PG8_LDA(At, 0, 1); PG8_STAGE(PG8_SB(0, 0), b2, voffB); PG8_STAGE(PG8_SB(0, 1), b2 + hstepB, voffB); PG8_STAGE(PG8_SA(0, 0), a2, voffA);
            PG8_WAIT_V(8); PG8_WAIT_L(0); PG8_BAR; PG8_MMA(1, 0, At, B0); PG8_MMA(1, 1, At, B1); PG8_BAR; PG8_SCHED;
            PG8_LDB(B0, 1, 0); PG8_LDB(B1, 1, 1); PG8_SCHED; PG8_LDA(At, 1, 0); PG8_STAGE(PG8_SA(0, 1), a2 + hstepA, voffA);
            PG8_WAIT_V(8); PG8_WAIT_L(0); PG8_BAR; PG8_MMA(0, 0, At, B0); PG8_MMA(0, 1, At, B1); PG8_BAR; PG8_SCHED;
            PG8_LDA(At, 1, 1); PG8_STAGE(PG8_SB(1, 0), b3, voffB); PG8_STAGE(PG8_SB(1, 1), b3 + hstepB, voffB); PG8_STAGE(PG8_SA(1, 0), a3, voffA);
            PG8_WAIT_V(8); PG8_WAIT_L(0); PG8_BAR; PG8_MMA(1, 0, At, B0); PG8_MMA(1, 1, At, B1); PG8_BAR; PG8_SCHED;
        }
        if constexpr (ALIGN_EPI) { if (wr == 0) PG8_BAR; }
        E(acc, cur, wr, wc, fr, fq);
        if (!has_next) break;
#pragma unroll
        for (int a = 0; a < 2; ++a)
#pragma unroll
            for (int b = 0; b < 2; ++b)
#pragma unroll
                for (int m = 0; m < 4; ++m)
#pragma unroll
                    for (int n = 0; n < 2; ++n) acc[a][b][m][n] = (f32x4){0.f, 0.f, 0.f, 0.f};
        cur = nxt; cA = nA; cA2 = nA2; cB = nB; ++ui;
        if constexpr (ALIGN_EPI) { if (wr == 1) PG8_BAR; }
    }
    PG8_WAIT_V(0);
    if constexpr (!ALIGN_EPI) { if (wr == 0) PG8_BAR; }
    PG8_BAR;
#undef PG8_SA
#undef PG8_SB
#undef PG8_STAGE
#undef PG8_LDA
#undef PG8_LDB
#undef PG8_MMA
#undef PG8_WAIT_V
#undef PG8_WAIT_L
#undef PG8_BAR
#undef PG8_SCHED
}

template <int MODE> struct EpiBf {
    static constexpr bool PERM = true, HOOK = false;
    bf16_t* O; int ldc; bf16_t* O1; bf16_t* O2; bf16_t* O3;
    __device__ __forceinline__ void operator()(const f32x4 (&acc)[2][2][4][2], const Unit& u, int wr, int wc, int fr, int fq) const {
        bf16_t* base = O; int ld = ldc; int colt = u.pn * BM;
        if (MODE == 2) { const int pn = u.pn;
            if (pn < 4) { base = O; ld = 1024; colt = pn * 256; } else if (pn < 8) { base = O1; ld = 1024; colt = (pn - 4) * 256; }
            else if (pn < 14) { base = O2; ld = 1536; colt = (pn - 8) * 256; } else { base = O3; ld = 1024; colt = (pn - 14) * 256; } }
        const int row0 = u.pm * BM + wr * 64 + fr, col0 = colt + wc * 32 + 8 * fq;
#pragma unroll
        for (int ai = 0; ai < 2; ++ai)
#pragma unroll
            for (int m = 0; m < 4; ++m) { bf16_t* rowp = base + (size_t)(row0 + ai * HALF + m * 16) * ld + col0;
#pragma unroll
                for (int bj = 0; bj < 2; ++bj) { f32x4 v0 = acc[ai][bj][m][0], v1 = acc[ai][bj][m][1];
                    if (MODE == 1) {
#pragma unroll
                        for (int j = 0; j < 4; ++j) { v0[j] = sigm(v0[j]); v1[j] = sigm(v1[j]); } }
                    u32x4 w; w.x = cvt_pk_bf16(v0[0], v0[1]); w.y = cvt_pk_bf16(v0[2], v0[3]); w.z = cvt_pk_bf16(v1[0], v1[1]); w.w = cvt_pk_bf16(v1[2], v1[3]);
                    *(u32x4*)(rowp + bj * HALF) = w; } }
    }
};
struct EpiSwiGLU {
    static constexpr bool PERM = true, HOOK = false;
    bf16_t* O; int ldc;
    __device__ __forceinline__ void operator()(const f32x4 (&acc)[2][2][4][2], const Unit& u, int wr, int wc, int fr, int fq) const {
        const int row0 = u.pm * BM + wr * 64 + fr, col0 = u.pn * HALF + wc * 32 + 8 * fq;
#pragma unroll
        for (int ai = 0; ai < 2; ++ai)
#pragma unroll
            for (int m = 0; m < 4; ++m) { bf16_t* rowp = O + (size_t)(row0 + ai * HALF + m * 16) * ldc + col0;
                f32x4 h0, h1;
#pragma unroll
                for (int j = 0; j < 4; ++j) { h0[j] = silu_(acc[ai][0][m][0][j]) * acc[ai][1][m][0][j]; h1[j] = silu_(acc[ai][0][m][1][j]) * acc[ai][1][m][1][j]; }
                u32x4 w; w.x = cvt_pk_bf16(h0[0], h0[1]); w.y = cvt_pk_bf16(h0[2], h0[3]); w.z = cvt_pk_bf16(h1[0], h1[1]); w.w = cvt_pk_bf16(h1[2], h1[3]);
                *(u32x4*)rowp = w; }
    }
};
struct EpiMerge {
    static constexpr bool PERM = true, HOOK = true;
    const bf16_t* G; bf16_t* O;
    __device__ __forceinline__ void hook(f32x4 (&acc)[2][2][4][2], const Unit& u, int which, int wr, int wc, int fr, int fq) const {
        int row0 = u.pm * BM + wr * 64 + fr, col0 = u.pn * BM + wc * 32 + 8 * fq + which * 1024;
        asm volatile("" : "+v"(row0), "+v"(col0));
#pragma unroll
        for (int ai = 0; ai < 2; ++ai)
#pragma unroll
            for (int m = 0; m < 4; ++m) { const bf16_t* gp = G + (size_t)(row0 + ai * HALF + m * 16) * 3072 + col0;
#pragma unroll
                for (int bj = 0; bj < 2; ++bj)
#pragma unroll
                    for (int n = 0; n < 2; ++n) { const u32x2 ga = *(const u32x2*)(gp + bj * HALF + 4 * n), gb = *(const u32x2*)(gp + 1024 + bj * HALF + 4 * n);
                        f32x4 r; r[0] = bflo(ga.x) * rcpf_(bflo(gb.x)); r[1] = bfhi(ga.x) * rcpf_(bfhi(gb.x)); r[2] = bflo(ga.y) * rcpf_(bflo(gb.y)); r[3] = bfhi(ga.y) * rcpf_(bfhi(gb.y));
                        acc[ai][bj][m][n] *= r; asm volatile("" ::: "memory"); } }
    }
    __device__ __forceinline__ void operator()(const f32x4 (&acc)[2][2][4][2], const Unit& u, int wr, int wc, int fr, int fq) const {
        const int row0 = u.pm * BM + wr * 64 + fr, col0 = u.pn * BM + wc * 32 + 8 * fq;
#pragma unroll
        for (int ai = 0; ai < 2; ++ai)
#pragma unroll
            for (int m = 0; m < 4; ++m) { const size_t r = (size_t)(row0 + ai * HALF + m * 16);
#pragma unroll
                for (int bj = 0; bj < 2; ++bj) { const u32x4 gc = *(const u32x4*)(G + r * 3072 + 2048 + col0 + bj * HALF);
                    const f32x4 v0 = acc[ai][bj][m][0], v1 = acc[ai][bj][m][1];
                    u32x4 w; w.x = cvt_pk_bf16(v0[0] * bflo(gc.x), v0[1] * bfhi(gc.x)); w.y = cvt_pk_bf16(v0[2] * bflo(gc.y), v0[3] * bfhi(gc.y));
                    w.z = cvt_pk_bf16(v1[0] * bflo(gc.z), v1[1] * bfhi(gc.z)); w.w = cvt_pk_bf16(v1[2] * bflo(gc.w), v1[3] * bfhi(gc.w));
                    *(u32x4*)(O + r * 1024 + col0 + bj * HALF) = w; }
                asm volatile("" ::: "memory"); }
    }
};
struct EpiGates {
    static constexpr bool PERM = true, HOOK = false;
    const bf16_t* XC; bf16_t* U; unsigned char* R; const float* ba; const float* bx; const float* lc;
    __device__ __forceinline__ void operator()(const f32x4 (&acc)[2][2][4][2], const Unit& u, int wr, int wc, int fr, int fq) const {
        const int d = u.pn & 1;
        int ch0 = 128 * (u.pn >> 1) + 32 * wc + 8 * fq, row0 = u.pm * BM + wr * 64 + fr;
        asm volatile("" : "+v"(row0), "+v"(ch0));
        char* Ud = (char*)(U + (size_t)d * T * 1024); unsigned char* Rd = R + (size_t)d * T * 1024;
        const float* bad = ba + d * 1024 + ch0; const float* bxd = bx + d * 1024 + ch0;
#pragma unroll
        for (int ai = 0; ai < 2; ++ai)
#pragma unroll
            for (int m = 0; m < 4; ++m) { const unsigned off = (unsigned)(row0 + ai * HALF + m * 16) * 1024u + (unsigned)ch0;
                const u32x4 xw = *(const u32x4*)((const char*)XC + (size_t)(off * 2u));
                float uv[8]; unsigned rq[2] = {0u, 0u};
#pragma unroll
                for (int n = 0; n < 2; ++n) { const f32x4 ba4 = *(const f32x4*)(bad + 4 * n), bx4 = *(const f32x4*)(bxd + 4 * n);
#pragma unroll
                    for (int j = 0; j < 4; ++j) { const float rr = sigm(acc[ai][0][m][n][j] + ba4[j]), ig = sigm(acc[ai][1][m][n][j] + bx4[j]);
                        uv[4 * n + j] = ig * h8(xw, 4 * n + j);
                        rq[n] |= ((unsigned)__builtin_rintf(rr * 255.f)) << (8 * j); } }
                u32x4 w; w.x = cvt_pk_bf16(uv[0], uv[1]); w.y = cvt_pk_bf16(uv[2], uv[3]); w.z = cvt_pk_bf16(uv[4], uv[5]); w.w = cvt_pk_bf16(uv[6], uv[7]);
                *(u32x4*)(Ud + (size_t)(off * 2u)) = w;
                u32x2 rw; rw.x = rq[0]; rw.y = rq[1];
                *(u32x2*)(Rd + (size_t)off) = rw;
                asm volatile("" ::: "memory"); }
    }
};
}

__device__ __forceinline__ int w_rowmap(int mode, int n, int p0) {
    if (mode == 0) return n;
    if (mode == 1) return 256 * (n >> 7) + p0 + (n & 127);
    const int dir = p0 >> 3, head = (p0 >> 1) & 3, ri = p0 & 1, ch = 256 * head + n;
    return 256 * (2 * (ch >> 7) + dir) + 128 * ri + (ch & 127);
}
__device__ __forceinline__ void tr_item(const float* W, int N, int item, bf16_t* WT, int ldk, int koff, int mode, int p0, LAS float* scr, int lane) {
    const int nblk = N / 32, kb = item / nblk, nb = item % nblk, k0 = 64 * kb, n0 = 32 * nb;
    float wv[32];
#pragma unroll
    for (int i = 0; i < 32; ++i) { const int kk = 2 * i + (lane >> 5); wv[i] = W[(size_t)(k0 + kk) * N + n0 + (lane & 31)]; }
#pragma unroll
    for (int i = 0; i < 32; ++i) { const int kk = 2 * i + (lane >> 5); scr[kk * 33 + (lane & 31)] = wv[i]; }
    asm volatile("s_waitcnt lgkmcnt(0)" ::: "memory");
    const int c = lane & 7;
#pragma unroll
    for (int j = 0; j < 4; ++j) { const int nn = (lane >> 3) + 8 * j; const LAS float* s = scr + (8 * c) * 33 + nn;
        u32x4 o; o.x = cvt_pk_bf16(s[0 * 33], s[1 * 33]); o.y = cvt_pk_bf16(s[2 * 33], s[3 * 33]); o.z = cvt_pk_bf16(s[4 * 33], s[5 * 33]); o.w = cvt_pk_bf16(s[6 * 33], s[7 * 33]);
        *(u32x4*)(WT + (size_t)w_rowmap(mode, n0 + nn, p0) * ldk + koff + k0 + 8 * c) = o; }
    asm volatile("s_waitcnt lgkmcnt(0)" ::: "memory");
}
__device__ __forceinline__ void convert_layer(const float* const* tab, unsigned char* ws, int l, LAS unsigned char* lds) {
    int tid_ = threadIdx.x; asm volatile("" : "+v"(tid_));
    const int tid = tid_, lane = tid & 63, wave = tid >> 6;
    LAS float* scr = (LAS float*)(lds + wave * 8448);
    const int gw = blockIdx.x * NWAVES + wave, NGW = gridDim.x * NWAVES;
    constexpr int I_UP = 16 * 88, I_DN = 44 * 32, I_IN = 16 * 240, I_LRU = 256, I_SQ = 512, I_HALF = 256;
    constexpr int NITEMS = 6 * I_UP + I_IN + 2 * I_LRU + 2 * I_SQ + 2 * I_HALF;
    const size_t oUP = (size_t)l * D * FF, oSQ = (size_t)l * D * D, oHF = (size_t)l * 512 * D, oLRU = (size_t)l * 2 * 4 * 256 * 256;
    for (int it = gw; it < NITEMS; it += NGW) {
        int r = it;
        if (r < I_UP) { tr_item(in_ptr(tab, 2) + oUP, FF, r, (bf16_t*)(ws + W_UP1), 1024, 0, 1, 0, scr, lane); continue; } r -= I_UP;
        if (r < I_UP) { tr_item(in_ptr(tab, 3) + oUP, FF, r, (bf16_t*)(ws + W_UP1), 1024, 0, 1, 128, scr, lane); continue; } r -= I_UP;
        if (r < I_DN) { tr_item(in_ptr(tab, 4) + oUP, D, r, (bf16_t*)(ws + W_DN1), FF, 0, 0, 0, scr, lane); continue; } r -= I_DN;
        if (r < I_IN) { tr_item(in_ptr(tab, 7) + (size_t)l * D * DIN, DIN, r, (bf16_t*)(ws + W_IN), 1024, 0, 0, 0, scr, lane); continue; } r -= I_IN;
        if (r < I_LRU) { const int mat = r >> 5; tr_item(in_ptr(tab, 10) + oLRU + (size_t)mat * 65536, 256, r & 31, (bf16_t*)(ws + W_LRU), 256, 0, 2, ((mat >> 2) << 3) | ((mat & 3) << 1) | 0, scr, lane); continue; } r -= I_LRU;
        if (r < I_LRU) { const int mat = r >> 5; tr_item(in_ptr(tab, 12) + oLRU + (size_t)mat * 65536, 256, r & 31, (bf16_t*)(ws + W_LRU), 256, 0, 2, ((mat >> 2) << 3) | ((mat & 3) << 1) | 1, scr, lane); continue; } r -= I_LRU;
        if (r < I_SQ) { tr_item(in_ptr(tab, 15) + oSQ, D, r, (bf16_t*)(ws + W_CAT), 2048, 0, 0, 0, scr, lane); continue; } r -= I_SQ;
        if (r < I_HALF) { tr_item(in_ptr(tab, 17) + oHF, D, r, (bf16_t*)(ws + W_CAT), 2048, 1024, 0, 0, scr, lane); continue; } r -= I_HALF;
        if (r < I_HALF) { tr_item(in_ptr(tab, 22) + oHF, D, r, (bf16_t*)(ws + W_CAT), 2048, 1536, 0, 0, scr, lane); continue; } r -= I_HALF;
        if (r < I_SQ) { tr_item(in_ptr(tab, 23) + oSQ, D, r, (bf16_t*)(ws + W_O), 1024, 0, 0, 0, scr, lane); continue; } r -= I_SQ;
        if (r < I_UP) { tr_item(in_ptr(tab, 26) + oUP, FF, r, (bf16_t*)(ws + W_UP2), 1024, 0, 1, 0, scr, lane); continue; } r -= I_UP;
        if (r < I_UP) { tr_item(in_ptr(tab, 27) + oUP, FF, r, (bf16_t*)(ws + W_UP2), 1024, 0, 1, 128, scr, lane); continue; } r -= I_UP;
        tr_item(in_ptr(tab, 28) + oUP, D, r, (bf16_t*)(ws + W_DN2), FF, 0, 0, 0, scr, lane);
    }
}
__device__ __forceinline__ void lc_all(const float* const* tab, unsigned char* ws) {
    float* LC = (float*)(ws + WS_LC); const float* lam = in_ptr(tab, 14);
    for (int i = blockIdx.x * NTHR + threadIdx.x; i < DEPTH * 2048; i += gridDim.x * NTHR) LC[i] = -8.f * log1pf(expf(-lam[i]));
}

__device__ __forceinline__ void wave_sum2(float& a, float& b, int lane) {
#pragma unroll
    for (int o = 1; o < 64; o <<= 1) { const int ad = (lane ^ o) << 2;
        const float ta = __int_as_float(__builtin_amdgcn_ds_bpermute(ad, __float_as_int(a))), tb = __int_as_float(__builtin_amdgcn_ds_bpermute(ad, __float_as_int(b)));
        a += ta; b += tb; }
}
template <bool HASF>
__device__ __forceinline__ void ew_phase(const float* xin, float* xout, const bf16_t* Fb, float scale, const float* post_g, const float* pre_g, bf16_t* XN) {
    int tid_ = threadIdx.x; asm volatile("" : "+v"(tid_));
    const int tid = tid_, lane = tid & 63, wave = tid >> 6;
    const int gw = blockIdx.x * NWAVES + wave, NGW = gridDim.x * NWAVES;
    for (int m = gw; m < T; m += 2 * NGW) {
        f32x4 v[2][4]; f32x4 f[2][4];
#pragma unroll
        for (int r = 0; r < 2; ++r) { const f32x4* xr = (const f32x4*)(xin + (size_t)(m + r * NGW) * D) + lane;
#pragma unroll
            for (int j = 0; j < 4; ++j) v[r][j] = xr[64 * j]; }
        if (HASF) {
            u32x2 fw[2][4];
#pragma unroll
            for (int r = 0; r < 2; ++r) { const u32x2* fr_ = (const u32x2*)(Fb + (size_t)(m + r * NGW) * D) + lane;
#pragma unroll
                for (int j = 0; j < 4; ++j) fw[r][j] = fr_[64 * j]; }
            float ss[2] = {0.f, 0.f};
#pragma unroll
            for (int r = 0; r < 2; ++r)
#pragma unroll
                for (int j = 0; j < 4; ++j) { const u32x2 w = fw[r][j]; f[r][j][0] = bflo(w.x); f[r][j][1] = bfhi(w.x); f[r][j][2] = bflo(w.y); f[r][j][3] = bfhi(w.y);
                    ss[r] += (f[r][j][0] * f[r][j][0] + f[r][j][1] * f[r][j][1]) + (f[r][j][2] * f[r][j][2] + f[r][j][3] * f[r][j][3]); }
            wave_sum2(ss[0], ss[1], lane);
            const float rs0 = scale * __builtin_amdgcn_rsqf(ss[0] * (1.f / D) + EPS), rs1 = scale * __builtin_amdgcn_rsqf(ss[1] * (1.f / D) + EPS);
#pragma unroll
            for (int j = 0; j < 4; ++j) { const f32x4 pg = *((const f32x4*)post_g + 64 * j + lane); v[0][j] += f[0][j] * rs0 * pg; v[1][j] += f[1][j] * rs1 * pg; }
        }
        if (HASF || xin != xout) {
#pragma unroll
            for (int r = 0; r < 2; ++r) { f32x4* xo = (f32x4*)(xout + (size_t)(m + r * NGW) * D) + lane;
#pragma unroll
                for (int j = 0; j < 4; ++j) xo[64 * j] = v[r][j]; }
        }
        if (pre_g) {
            float s2[2] = {0.f, 0.f};
#pragma unroll
            for (int r = 0; r < 2; ++r)
#pragma unroll
                for (int j = 0; j < 4; ++j) s2[r] += (v[r][j][0] * v[r][j][0] + v[r][j][1] * v[r][j][1]) + (v[r][j][2] * v[r][j][2] + v[r][j][3] * v[r][j][3]);
            wave_sum2(s2[0], s2[1], lane);
            const float q0 = __builtin_amdgcn_rsqf(s2[0] * (1.f / D) + EPS), q1 = __builtin_amdgcn_rsqf(s2[1] * (1.f / D) + EPS);
            u32x2* o0 = (u32x2*)(XN + (size_t)m * D) + lane; u32x2* o1 = (u32x2*)(XN + (size_t)(m + NGW) * D) + lane;
#pragma unroll
            for (int j = 0; j < 4; ++j) { const f32x4 g = *((const f32x4*)pre_g + 64 * j + lane); const f32x4 y0 = v[0][j] * q0 * g, y1 = v[1][j] * q1 * g;
                u32x2 w0, w1; w0.x = cvt_pk_bf16(y0[0], y0[1]); w0.y = cvt_pk_bf16(y0[2], y0[3]); w1.x = cvt_pk_bf16(y1[0], y1[1]); w1.y = cvt_pk_bf16(y1[2], y1[3]);
                o0[64 * j] = w0; o1[64 * j] = w1; }
        }
    }
}

constexpr int VT_PITCH = 272;
__device__ __forceinline__ void prep_phase(const float* const* tab, unsigned char* ws, int l, LAS unsigned char* lds) {
    int tid_ = threadIdx.x; asm volatile("" : "+v"(tid_));
    const int tid = tid_, lane = tid & 63, wave = tid >> 6;
    const bf16_t* ZX = (const bf16_t*)(ws + WS_ZX); const bf16_t* ZSC = (const bf16_t*)(ws + WS_ZSC); const bf16_t* ZSGU = (const bf16_t*)(ws + WS_ZSGU);
    bf16_t* XC = (bf16_t*)(ws + WS_XC); bf16_t* YBC = (bf16_t*)(ws + WS_YBC);
    for (int item = blockIdx.x; item < T / 128; item += gridDim.x) {
        const int b = item >> 7, n = item & 127, t0 = n * 128; const size_t rb = (size_t)b * S;
        {
            const int c = 8 * (tid & 127), sg = tid >> 7; const float* cw = in_ptr(tab, 8) + (size_t)l * 4096 + c; const float* cb = in_ptr(tab, 9) + (size_t)l * 1024 + c;
            float wk[4][8], bb[8];
#pragma unroll
            for (int k = 0; k < 4; ++k) { const f32x4 a0 = *(const f32x4*)(cw + k * 1024), a1 = *(const f32x4*)(cw + k * 1024 + 4);
#pragma unroll
                for (int j = 0; j < 4; ++j) { wk[k][j] = a0[j]; wk[k][4 + j] = a1[j]; } }
            { const f32x4 a0 = *(const f32x4*)cb, a1 = *(const f32x4*)(cb + 4);
#pragma unroll
              for (int j = 0; j < 4; ++j) { bb[j] = a0[j]; bb[4 + j] = a1[j]; } }
            const bf16_t* src = ZX + rb * 1024 + c;
#pragma unroll 1
            for (int blk = 0; blk < 4; ++blk) { const int tb = t0 + sg * 32 + blk * 8;
                u32x4 xr[11];
#pragma unroll
                for (int i = 0; i < 11; ++i) { const int t = tb - 2 + i; xr[i] = (t >= 0 && t < S) ? *(const u32x4*)(src + (size_t)t * 1024) : (u32x4){0u, 0u, 0u, 0u}; }
#pragma unroll
                for (int o = 0; o < 8; ++o) { float y[8];
#pragma unroll
                    for (int j = 0; j < 8; ++j) y[j] = bb[j] + wk[0][j] * h8(xr[o], j) + wk[1][j] * h8(xr[o + 1], j) + wk[2][j] * h8(xr[o + 2], j) + wk[3][j] * h8(xr[o + 3], j);
                    u32x4 w; w.x = cvt_pk_bf16(y[0], y[1]); w.y = cvt_pk_bf16(y[2], y[3]); w.z = cvt_pk_bf16(y[4], y[5]); w.w = cvt_pk_bf16(y[6], y[7]);
                    *(u32x4*)(XC + (rb + tb + o) * 1024 + c) = w; } }
        }
        {
            const int c = 8 * (tid & 63), sg = tid >> 6; const float* cw = in_ptr(tab, 16) + (size_t)l * 1536 + c;
            float wk[3][8];
#pragma unroll
            for (int k = 0; k < 3; ++k) { const f32x4 a0 = *(const f32x4*)(cw + k * 512), a1 = *(const f32x4*)(cw + k * 512 + 4);
#pragma unroll
                for (int j = 0; j < 4; ++j) { wk[k][j] = a0[j]; wk[k][4 + j] = a1[j]; } }
            const bf16_t* src = ZSC + rb * 1536 + c;
#pragma unroll 1
            for (int blk = 0; blk < 4; ++blk) { const int tb = t0 + sg * 16 + blk * 4;
                u32x4 cr[6], xr[6], br[4];
#pragma unroll
                for (int i = 0; i < 6; ++i) { const int t = tb - 1 + i; const bool in = (t >= 0 && t < S);
                    cr[i] = in ? *(const u32x4*)(src + (size_t)t * 1536 + 512) : (u32x4){0u, 0u, 0u, 0u}; xr[i] = in ? *(const u32x4*)(src + (size_t)t * 1536 + 1024) : (u32x4){0u, 0u, 0u, 0u}; }
#pragma unroll
                for (int o = 0; o < 4; ++o) br[o] = *(const u32x4*)(src + (size_t)(tb + o) * 1536);
                float p[6][8];
#pragma unroll
                for (int i = 0; i < 6; ++i)
#pragma unroll
                    for (int j = 0; j < 8; ++j) p[i][j] = h8(cr[i], j) * h8(xr[i], j);
#pragma unroll
                for (int o = 0; o < 4; ++o) { float y[8];
#pragma unroll
                    for (int j = 0; j < 8; ++j) y[j] = h8(br[o], j) * (wk[0][j] * p[o][j] + wk[1][j] * p[o + 1][j] + wk[2][j] * p[o + 2][j]);
                    u32x4 w; w.x = cvt_pk_bf16(y[0], y[1]); w.y = cvt_pk_bf16(y[2], y[3]); w.z = cvt_pk_bf16(y[4], y[5]); w.w = cvt_pk_bf16(y[6], y[7]);
                    *(u32x4*)(YBC + (rb + tb + o) * 1024 + c) = w; } }
        }
        {
            const float* lg = in_ptr(tab, 18) + (size_t)l * 512; const float* lb = in_ptr(tab, 19) + (size_t)l * 512;
            f32x4 g0 = *(const f32x4*)(lg + 8 * lane), g1 = *(const f32x4*)(lg + 8 * lane + 4), b0 = *(const f32x4*)(lb + 8 * lane), b1 = *(const f32x4*)(lb + 8 * lane + 4);
            u32x4 wrow[16];
#pragma unroll
            for (int qi = 0; qi < 16; ++qi) wrow[qi] = *(const u32x4*)(ZSGU + (rb + t0 + wave + 8 * qi) * 1024 + 512 + 8 * lane);
#pragma unroll
            for (int qi = 0; qi < 16; ++qi) { const int q = wave + 8 * qi; const u32x4 w = wrow[qi];
                float v[8]; v[0] = bflo(w.x); v[1] = bfhi(w.x); v[2] = bflo(w.y); v[3] = bfhi(w.y); v[4] = bflo(w.z); v[5] = bfhi(w.z); v[6] = bflo(w.w); v[7] = bfhi(w.w);
                float s = 0.f;
#pragma unroll
                for (int j = 0; j < 8; ++j) { v[j] = gelu_(v[j]); s += v[j]; }
                const float mu = wave_sum(s, lane) * (1.f / 512.f); float s2 = 0.f;
#pragma unroll
                for (int j = 0; j < 8; ++j) { v[j] -= mu; s2 += v[j] * v[j]; }
                const float rstd = __builtin_amdgcn_rsqf(wave_sum(s2, lane) * (1.f / 512.f) + EPS);
#pragma unroll
                for (int j = 0; j < 8; ++j) { const float y = v[j] * rstd * (j < 4 ? g0[j & 3] : g1[j & 3]) + (j < 4 ? b0[j & 3] : b1[j & 3]);
                    *(LAS bf16_t*)(lds + (8 * lane + j) * VT_PITCH + 2 * q) = (bf16_t)(cvt_pk_bf16(y, 0.f) & 0xffffu); }
            }
            __syncthreads();
            const int g = wave >> 1, p0 = 64 * (wave & 1), fr = lane & 15, fq = lane >> 4;
            const float* Wg = in_ptr(tab, 20) + (size_t)l * 65536 + (size_t)g * 16384; const float* bs = in_ptr(tab, 21) + (size_t)l * 512 + g * 128;
            bf16x8 Wf[4][4];
#pragma unroll
            for (int m = 0; m < 4; ++m)
#pragma unroll
                for (int kk = 0; kk < 4; ++kk) { const float* p = Wg + (size_t)(p0 + 16 * m + fr) * 128 + 32 * kk + 8 * fq; const f32x4 x0 = *(const f32x4*)p, x1 = *(const f32x4*)(p + 4);
                    u32x4 w; w.x = cvt_pk_bf16(x0[0], x0[1]); w.y = cvt_pk_bf16(x0[2], x0[3]); w.z = cvt_pk_bf16(x1[0], x1[1]); w.w = cvt_pk_bf16(x1[2], x1[3]);
                    Wf[m][kk] = __builtin_bit_cast(bf16x8, w); }
            float bsv[4];
#pragma unroll
            for (int m = 0; m < 4; ++m) bsv[m] = bs[p0 + 16 * m + fr];
            for (int nn = 0; nn < 8; ++nn) {
                f32x4 acc[4];
#pragma unroll
                for (int m = 0; m < 4; ++m) acc[m] = (f32x4){0.f, 0.f, 0.f, 0.f};
#pragma unroll
                for (int kk = 0; kk < 4; ++kk) { const bf16x8 vf = *(const LAS bf16x8*)(lds + (g * 128 + 16 * nn + fr) * VT_PITCH + (32 * kk + 8 * fq) * 2);
#pragma unroll
                    for (int m = 0; m < 4; ++m) acc[m] = __builtin_amdgcn_mfma_f32_16x16x32_f16(__builtin_bit_cast(h16x8, vf), __builtin_bit_cast(h16x8, Wf[m][kk]), acc[m], 0, 0, 0); }
                const int cc = g * 128 + 16 * nn + 4 * fq;
#pragma unroll
                for (int m = 0; m < 4; ++m) { const size_t row = rb + t0 + p0 + 16 * m + fr;
                    const u32x2 uw = *(const u32x2*)(ZSGU + row * 1024 + cc);
                    const float o0 = gelu_(bflo(uw.x)) * (acc[m][0] + bsv[m]), o1 = gelu_(bfhi(uw.x)) * (acc[m][1] + bsv[m]), o2 = gelu_(bflo(uw.y)) * (acc[m][2] + bsv[m]), o3 = gelu_(bfhi(uw.y)) * (acc[m][3] + bsv[m]);
                    u32x2 w; w.x = cvt_pk_bf16(o0, o1); w.y = cvt_pk_bf16(o2, o3); if (ABL == 3) { w.x = 0u; w.y = 0u; }
                    *(u32x2*)(YBC + row * 1024 + 512 + cc) = w; }
            }
            __syncthreads();
        }
    }
}

__device__ __forceinline__ void scan_pass1(unsigned char* ws, int l, LAS unsigned char* lds) {
    int tid_ = threadIdx.x; asm volatile("" : "+v"(tid_));
    const int tid = tid_, lane = tid & 63, seg = tid >> 6;
    const float* LC = (const float*)(ws + WS_LC) + l * 2048; f32x2* SUM = (f32x2*)(ws + WS_SUM); f32x4* SEGS = (f32x4*)(ws + WS_SEG);
    LAS f32x4* SEG = (LAS f32x4*)lds;
    for (int item = blockIdx.x; item < 2048; item += gridDim.x) {
        const int dir = item & 1, grp = (item >> 1) & 7, chunk = (item >> 4) & 63, b = item >> 10;
        const int ch = grp * 128 + 2 * lane;
        const float l0 = LC[dir * 1024 + ch] * (1.f / 255.f), l1 = LC[dir * 1024 + ch + 1] * (1.f / 255.f);
        const bf16_t* U = (const bf16_t*)(ws + WS_U) + (size_t)dir * T * 1024 + ((size_t)b * S + chunk * 256) * 1024 + ch;
        const unsigned char* R = ws + WS_R + (size_t)dir * T * 1024 + ((size_t)b * S + chunk * 256) * 1024 + ch;
        unsigned uw[32], rw[32];
#pragma unroll
        for (int k = 0; k < 32; ++k) { const int p = seg * 32 + k, to = dir ? 255 - p : p; uw[k] = *(const unsigned*)(U + (size_t)to * 1024); rw[k] = *(const unsigned short*)(R + (size_t)to * 1024); }
        float A0 = 1.f, A1 = 1.f, H0 = 0.f, H1 = 0.f;
#pragma unroll
        for (int k = 0; k < 32; ++k) { const float a0 = __expf(l0 * (float)(rw[k] & 255u)), a1 = __expf(l1 * (float)(rw[k] >> 8));
            H0 = a0 * H0 + bflo(uw[k]) * __builtin_sqrtf(1.f - a0 * a0); H1 = a1 * H1 + bfhi(uw[k]) * __builtin_sqrtf(1.f - a1 * a1); A0 *= a0; A1 *= a1; }
        const f32x4 sv = (f32x4){A0, H0, A1, H1};
        SEG[seg * 64 + lane] = sv;
        SEGS[((size_t)(((dir * 2 + b) * 64 + chunk) * 8 + seg)) * 512 + grp * 64 + lane] = sv;
        __syncthreads();
        if (tid < 64) { float cA0 = 1.f, cA1 = 1.f, cH0 = 0.f, cH1 = 0.f;
#pragma unroll
            for (int s = 0; s < 8; ++s) { const f32x4 v = SEG[s * 64 + tid]; cH0 = v[0] * cH0 + v[1]; cA0 *= v[0]; cH1 = v[2] * cH1 + v[3]; cA1 *= v[2]; }
            f32x4* o = (f32x4*)(SUM + ((size_t)((dir * 2 + b) * 64 + chunk)) * 1024 + grp * 128 + 2 * tid); *o = (f32x4){cA0, cH0, cA1, cH1}; }
        __syncthreads();
    }
}
__device__ __forceinline__ void scan_pass2(unsigned char* ws, int l, LAS unsigned char* lds) {
    int tid_ = threadIdx.x; asm volatile("" : "+v"(tid_));
    const int tid = tid_, lane = tid & 63, seg = tid >> 6;
    const float* LC = (const float*)(ws + WS_LC) + l * 2048; const f32x2* SUM = (const f32x2*)(ws + WS_SUM); const f32x4* SEGS = (const f32x4*)(ws + WS_SEG);
    LAS f32x2* HF = (LAS f32x2*)lds;
    LAS f32x2* CAR = (LAS f32x2*)(lds + 131072);
    for (int item0 = blockIdx.x; item0 < 1024; item0 += 4 * gridDim.x) {
        { const int slot = seg >> 1, dir = seg & 1, item = item0 + slot * gridDim.x;
          if (item < 1024) { const int grp = item & 7, chunk = (item >> 3) & 63, b = item >> 9;
              const f32x4* sp = (const f32x4*)(SUM + ((size_t)((dir * 2 + b) * 64)) * 1024 + grp * 128 + 2 * lane);
              float h0 = 0.f, h1 = 0.f; const int nprev = dir ? 63 - chunk : chunk;
              for (int j0 = 0; j0 < nprev; j0 += 8) { f32x4 v[8];
#pragma unroll
                  for (int u = 0; u < 8; ++u) { const int jj = j0 + u; const int cj = dir ? 63 - jj : jj; const int cl = jj < nprev ? cj : chunk;
                      v[u] = sp[(size_t)cl * 512]; if (jj >= nprev) v[u] = (f32x4){1.f, 0.f, 1.f, 0.f}; }
#pragma unroll
                  for (int u = 0; u < 8; ++u) { h0 = v[u][0] * h0 + v[u][1]; h1 = v[u][2] * h1 + v[u][3]; } }
              CAR[seg * 64 + lane] = (f32x2){h0, h1}; } }
        __syncthreads();
#pragma unroll 1
        for (int slot = 0; slot < 4; ++slot) { const int item = item0 + slot * gridDim.x; if (item >= 1024) break;
            const int grp = item & 7, chunk = (item >> 3) & 63, b = item >> 9;
            const int ch = grp * 128 + 2 * lane;
            bf16_t* ZG = (bf16_t*)(ws + WS_ZG) + ((size_t)b * S + chunk * 256) * 1024 + ch;
#pragma unroll 1
            for (int dir = 0; dir < 2; ++dir) {
                const float l0 = LC[dir * 1024 + ch] * (1.f / 255.f), l1 = LC[dir * 1024 + ch + 1] * (1.f / 255.f);
                const bf16_t* U = (const bf16_t*)(ws + WS_U) + (size_t)dir * T * 1024 + ((size_t)b * S + chunk * 256) * 1024 + ch;
                const unsigned char* R = ws + WS_R + (size_t)dir * T * 1024 + ((size_t)b * S + chunk * 256) * 1024 + ch;
                float h0, h1; { const f32x2 c = CAR[(slot * 2 + dir) * 64 + lane]; h0 = c[0]; h1 = c[1]; }
                { const f32x4* sg = SEGS + ((size_t)(((dir * 2 + b) * 64 + chunk) * 8)) * 512 + grp * 64 + lane; f32x4 v[7];
#pragma unroll
                  for (int s = 0; s < 7; ++s) v[s] = sg[(size_t)s * 512];
#pragma unroll
                  for (int s = 0; s < 7; ++s) if (s < seg) { h0 = v[s][0] * h0 + v[s][1]; h1 = v[s][2] * h1 + v[s][3]; } }
#pragma unroll 1
                for (int kb = 0; kb < 2; ++kb) { unsigned uw16[16], rw16[16], gw16[16];
#pragma unroll
                    for (int u = 0; u < 16; ++u) { const int p = seg * 32 + kb * 16 + u, to = dir ? 255 - p : p;
                        uw16[u] = *(const unsigned*)(U + (size_t)to * 1024); rw16[u] = *(const unsigned short*)(R + (size_t)to * 1024);
                        gw16[u] = dir ? *(const unsigned*)(ZG + (size_t)to * 1024) : 0u; }
#pragma unroll
                    for (int u = 0; u < 16; ++u) { const int p = seg * 32 + kb * 16 + u, to = dir ? 255 - p : p; const unsigned uw = uw16[u], rw = rw16[u];
                        const float a0 = __expf(l0 * (float)(rw & 255u)), a1 = __expf(l1 * (float)(rw >> 8));
                        h0 = a0 * h0 + bflo(uw) * __builtin_sqrtf(1.f - a0 * a0); h1 = a1 * h1 + bfhi(uw) * __builtin_sqrtf(1.f - a1 * a1);
                        if (dir == 0) HF[to * 64 + lane] = (f32x2){h0, h1};
                        else { const f32x2 hf = HF[to * 64 + lane]; const unsigned gw = gw16[u];
                            *(unsigned*)(ZG + (size_t)to * 1024) = cvt_pk_bf16((hf[0] + h0) * gelu_(bflo(gw)), (hf[1] + h1) * gelu_(bfhi(gw))); } } }
                __syncthreads();
            }
        }
    }
}

#ifdef DBG
constexpr size_t WS_DBG = 70000;
__device__ __forceinline__ float bfv(const bf16_t* p) { return bflo((unsigned)*p); }
__device__ __forceinline__ float dotA(const bf16_t* arow, const float* W, int K, int N, int col) { float s = 0.f; for (int k = 0; k < K; ++k) s += bfv(arow + k) * W[(size_t)k * N + col]; return s; }
__device__ __forceinline__ void dbg_cmp(unsigned* dbg, unsigned code, float got, float ref, float tol_rel, float tol_abs) {
    const float e = fabsf(got - ref); if (!(e <= tol_rel * fabsf(ref) + tol_abs)) atomicMin(dbg, code); }
__device__ __forceinline__ void dbg_check(int stage, const float* const* tab, unsigned char* ws, float* X) {
    unsigned* dbg = (unsigned*)(ws + WS_DBG); const int t = blockIdx.x * 64 + threadIdx.x;
    int r = (int)(((long)t * 5273 + 17) % T); const bf16_t* XN = (const bf16_t*)(ws + WS_XN);
    { const int q = t >> 1; const int base = (q & 1) ? S : 0;
      if (t < 40) { const int k = q >> 1; const int off = (k == 0) ? 0 : (k == 1) ? 1 : (k == 2) ? 2 : (k == 3) ? 127 : (k == 4) ? 128 : (k == 5) ? 255 : (k == 6) ? 256 : (k == 7) ? S - 1 : (k == 8) ? S - 2 : S - 3; r = base + off; } }
    if (stage == 2) { const int c = (int)((long)t * 911 + 3) % FF; const float g = dotA(XN + (size_t)r * D, (in_ptr(tab, DBG_F ? 26 : 2) + (size_t)DBG_LAYER * (D*FF)), D, FF, c), u = dotA(XN + (size_t)r * D, (in_ptr(tab, DBG_F ? 27 : 3) + (size_t)DBG_LAYER * (D*FF)), D, FF, c);
        dbg_cmp(dbg, 2, bfv((const bf16_t*)(ws + WS_H) + (size_t)r * FF + c), g / (1.f + expf(-g)) * u, 0.03f, 0.03f); }
    if (stage == 3) { const int c = (int)((long)t * 911 + 3) % D; dbg_cmp(dbg, 3, bfv((const bf16_t*)(ws + WS_F) + (size_t)r * D + c), dotA((const bf16_t*)(ws + WS_H) + (size_t)r * FF, (in_ptr(tab, DBG_F ? 28 : 4) + (size_t)DBG_LAYER * (D*FF)), FF, D, c), 0.03f, 0.03f); }
    if (stage == 4) { const int c = (int)((long)t * 911 + 3) % D; const bf16_t* F = (const bf16_t*)(ws + WS_F) + (size_t)r * D; float ss = 0.f; for (int k = 0; k < D; ++k) ss += bfv(F + k) * bfv(F + k);
        const float* x0 = in_ptr(tab, 0) + (size_t)r * D; float s2 = 0.f;
        for (int k = 0; k < D; ++k) { const float xv = x0[k] + 0.5f * bfv(F + k) * rsqrtf(ss / D + EPS) * (in_ptr(tab, 5) + (size_t)DBG_LAYER * (D))[k]; s2 += xv * xv; if (k == c) dbg_cmp(dbg, 4, X[(size_t)r * D + c], xv, 0.001f, 0.001f); }
        dbg_cmp(dbg, 4, bfv(XN + (size_t)r * D + c), X[(size_t)r * D + c] * rsqrtf(s2 / D + EPS) * (in_ptr(tab, 6) + (size_t)DBG_LAYER * (D))[c], 0.01f, 0.01f); }
    if (stage == 5) { const int c = (int)((long)t * 911 + 3) % ZN; const float z = dotA(XN + (size_t)r * D, (in_ptr(tab, 7) + (size_t)DBG_LAYER * (D*DIN)), D, DIN, c); float got;
        if (c < 1024) got = bfv((const bf16_t*)(ws + WS_ZG) + (size_t)r * 1024 + c); else if (c < 2048) got = bfv((const bf16_t*)(ws + WS_ZX) + (size_t)r * 1024 + c - 1024);
        else if (c < 3584) got = bfv((const bf16_t*)(ws + WS_ZSC) + (size_t)r * 1536 + c - 2048); else got = bfv((const bf16_t*)(ws + WS_ZSGU) + (size_t)r * 1024 + c - 3584);
        dbg_cmp(dbg, 5, got, z, 0.03f, 0.03f); }
    if (stage == 6) { const int b = r / S, tt = r % S; const size_t rb = (size_t)b * S;
        { const int c = (int)((long)t * 911 + 3) % 1024; float o = (in_ptr(tab, 9) + (size_t)DBG_LAYER * (1024))[c]; for (int k = 0; k < 4; ++k) { const int q = tt + k - 2; if (q >= 0 && q < S) o += (in_ptr(tab, 8) + (size_t)DBG_LAYER * (4096))[k * 1024 + c] * bfv((const bf16_t*)(ws + WS_ZX) + (rb + q) * 1024 + c); }
          dbg_cmp(dbg, 6, bfv((const bf16_t*)(ws + WS_XC) + (size_t)r * 1024 + c), o, 0.02f, 0.02f); }
        { const int c = (int)((long)t * 911 + 3) % 512; const bf16_t* Z = (const bf16_t*)(ws + WS_ZSC); float o = 0.f; for (int k = 0; k < 3; ++k) { const int q = tt + k - 1; if (q >= 0 && q < S) o += (in_ptr(tab, 16) + (size_t)DBG_LAYER * (1536))[k * 512 + c] * bfv(Z + (rb + q) * 1536 + 512 + c) * bfv(Z + (rb + q) * 1536 + 1024 + c); }
          dbg_cmp(dbg, 7, bfv((const bf16_t*)(ws + WS_YBC) + (size_t)r * 1024 + c), o * bfv(Z + (size_t)r * 1536 + c), 0.02f, 0.02f); }
        { const int c = (int)((long)t * 911 + 3) % 512, g = c >> 7, p = tt & 127, t0 = tt - p; const bf16_t* Z = (const bf16_t*)(ws + WS_ZSGU); float mix = (in_ptr(tab, 21) + (size_t)DBG_LAYER * (512))[g * 128 + p];
          for (int q = 0; q < 128; ++q) { const bf16_t* vr = Z + (rb + t0 + q) * 1024 + 512; float mu = 0.f, var = 0.f; for (int k = 0; k < 512; ++k) mu += gelu_(bfv(vr + k)); mu /= 512.f;
              for (int k = 0; k < 512; ++k) { const float d = gelu_(bfv(vr + k)) - mu; var += d * d; } var /= 512.f;
              const float vn = (gelu_(bfv(vr + c)) - mu) * rsqrtf(var + EPS) * (in_ptr(tab, 18) + (size_t)DBG_LAYER * (512))[c] + (in_ptr(tab, 19) + (size_t)DBG_LAYER * (512))[c]; mix += (in_ptr(tab, 20) + (size_t)DBG_LAYER * (65536))[(size_t)g * 16384 + p * 128 + q] * vn; }
          dbg_cmp(dbg, 8, bfv((const bf16_t*)(ws + WS_YBC) + (size_t)r * 1024 + 512 + c), gelu_(bfv(Z + (size_t)r * 1024 + c)) * mix, 0.03f, 0.03f); } }
    if (stage == 9) { const int c = (int)((long)t * 911 + 3) % 1024, dir = t & 1, head = c >> 8, e = c & 255; const bf16_t* xr = (const bf16_t*)(ws + WS_XC) + (size_t)r * 1024 + head * 256;
        const float pa = dotA(xr, (in_ptr(tab, 10) + (size_t)DBG_LAYER * (524288)) + (size_t)(dir * 4 + head) * 65536, 256, 256, e) + (in_ptr(tab, 11) + (size_t)DBG_LAYER * (2048))[dir * 1024 + c], px = dotA(xr, (in_ptr(tab, 12) + (size_t)DBG_LAYER * (524288)) + (size_t)(dir * 4 + head) * 65536, 256, 256, e) + (in_ptr(tab, 13) + (size_t)DBG_LAYER * (2048))[dir * 1024 + c];
        const float rr = 1.f / (1.f + expf(-pa)), ii = 1.f / (1.f + expf(-px));
        dbg_cmp(dbg, 9, (float)*(ws + WS_R + (size_t)dir * T * 1024 + (size_t)r * 1024 + c), rr * 255.f, 0.02f, 1.5f);
        dbg_cmp(dbg, 10, bfv((const bf16_t*)(ws + WS_U) + (size_t)dir * T * 1024 + (size_t)r * 1024 + c), ii * bfv(xr + e), 0.03f, 0.03f); }
    if (stage == 11) { const int c = (int)((long)t * 911 + 3) % 1024, b = r / S, tt = r % S; const size_t rb = (size_t)b * S; const float* LC = (const float*)(ws + WS_LC) + DBG_LAYER * 2048; float hs = 0.f;
        for (int dir = 0; dir < 2; ++dir) { const bf16_t* U = (const bf16_t*)(ws + WS_U) + (size_t)dir * T * 1024; const unsigned char* R = ws + WS_R + (size_t)dir * T * 1024; float h = 0.f;
            if (dir == 0) { for (int q = 0; q <= tt; ++q) { const float a = expf(LC[c] * (float)R[(rb + q) * 1024 + c] / 255.f); h = a * h + bfv(U + (rb + q) * 1024 + c) * sqrtf(1.f - a * a); } }
            else { for (int q = S - 1; q >= tt; --q) { const float a = expf(LC[1024 + c] * (float)R[(rb + q) * 1024 + c] / 255.f); h = a * h + bfv(U + (rb + q) * 1024 + c) * sqrtf(1.f - a * a); } }
            hs += h; }
        const float gate = dotA(XN + (size_t)r * D, (in_ptr(tab, 7) + (size_t)DBG_LAYER * (D*DIN)), D, DIN, c);
        dbg_cmp(dbg, 11, bfv((const bf16_t*)(ws + WS_ZG) + (size_t)r * 1024 + c), hs * gelu_(gate), 0.03f, 0.03f); }
    if (stage == 10) { const int c = (int)((long)t * 911 + 3) % 1024; ((float*)(ws + WS_DBG + 1024))[t] = bfv((const bf16_t*)(ws + WS_ZG) + (size_t)r * 1024 + c); }
    if (stage == 12) { const int c = (int)((long)t * 911 + 3) % 3072; const float z = dotA(XN + (size_t)r * D, (in_ptr(tab, 7) + (size_t)DBG_LAYER * (D*DIN)), D, DIN, ZN + c);
        dbg_cmp(dbg, 12, bfv((const bf16_t*)(ws + WS_G) + (size_t)r * 3072 + c), 1.f / (1.f + expf(-z)), 0.02f, 0.01f); }
    if (stage == 13) { const int c = (int)((long)t * 911 + 3) % 1024; const bf16_t* G = (const bf16_t*)(ws + WS_G) + (size_t)r * 3072;
        const float ya = dotA((const bf16_t*)(ws + WS_ZG) + (size_t)r * 1024, (in_ptr(tab, 15) + (size_t)DBG_LAYER * (D*D)), 1024, 1024, c), yb = dotA((const bf16_t*)(ws + WS_YBC) + (size_t)r * 1024, (in_ptr(tab, 17) + (size_t)DBG_LAYER * (512*D)), 512, 1024, c), yc = dotA((const bf16_t*)(ws + WS_YBC) + (size_t)r * 1024 + 512, (in_ptr(tab, 22) + (size_t)DBG_LAYER * (512*D)), 512, 1024, c);
        dbg_cmp(dbg, 13, bfv((const bf16_t*)(ws + WS_MG) + (size_t)r * 1024 + c), bfv(G + c) * ya + bfv(G + 1024 + c) * yb + bfv(G + 2048 + c) * yc, 0.03f, 0.05f); }
    if (stage == 15) { const int c = (int)((long)t * 911 + 3) % D; float s2 = 0.f; for (int k = 0; k < D; ++k) s2 += X[(size_t)r * D + k] * X[(size_t)r * D + k];
        dbg_cmp(dbg, 15, bfv(XN + (size_t)r * D + c), X[(size_t)r * D + c] * rsqrtf(s2 / D + EPS) * (in_ptr(tab, DBG_G) + (size_t)DBG_GL * D)[c], 0.01f, 0.01f); }
    if (stage == 16) { const int c = (int)((long)t * 911 + 3) % D; const bf16_t* F = (const bf16_t*)(ws + WS_MX) + (size_t)r * D; float ss = 0.f; for (int k = 0; k < D; ++k) ss += bfv(F + k) * bfv(F + k);
        const float xb = X[(size_t)r * D + c];
        dbg_cmp(dbg, 16, ((const float*)(ws + WS_G))[(size_t)r * D + c], xb + bfv(F + c) * rsqrtf(ss / D + EPS) * (in_ptr(tab, 24) + (size_t)DBG_LAYER * D)[c], 0.001f, 0.001f); }
    if (stage == 17) { const int c = (int)((long)t * 911 + 3) % D; const bf16_t* F = (const bf16_t*)(ws + WS_F) + (size_t)r * D; float ss = 0.f; for (int k = 0; k < D; ++k) ss += bfv(F + k) * bfv(F + k);
        const float xb = X[(size_t)r * D + c];
        dbg_cmp(dbg, 17, ((const float*)(ws + WS_G))[(size_t)r * D + c], xb + 0.5f * bfv(F + c) * rsqrtf(ss / D + EPS) * (in_ptr(tab, 29) + (size_t)DBG_LAYER * D)[c], 0.001f, 0.001f); }
    if (stage == 14) { const int c = (int)((long)t * 911 + 3) % 1024; dbg_cmp(dbg, 14, bfv((const bf16_t*)(ws + WS_MX) + (size_t)r * 1024 + c), dotA((const bf16_t*)(ws + WS_MG) + (size_t)r * 1024, (in_ptr(tab, 23) + (size_t)DBG_LAYER * (D*D)), 1024, 1024, c), 0.03f, 0.03f); }
}
__global__ void __launch_bounds__(64) dbg_kernel(Args a, unsigned mask) {
    unsigned char* ws = a.ws; const float* const* tab = (const float* const*)(ws + WS_TAB);
    for (int st = 2; st <= 17; ++st) if ((mask >> st) & 1u) dbg_check(st, tab, ws, a.out);
}
__global__ void dbg_final(Args a) { const unsigned cde = *(volatile unsigned*)(a.ws + WS_DBG); a.out[0] = (cde != 99u) ? 1000.f + 100.f * (float)cde : 0.f; }
#define DBGCHK(st) do { if (l == DBG_LAYER && (st) == STOP_AT) return; } while (0)
#else
#define DBGCHK(st) do { } while (0)
#endif

__global__ void __launch_bounds__(NTHR, 2) fwd_kernel(Args a) {
    extern __shared__ __attribute__((aligned(16))) unsigned char lds_raw[];
    LAS unsigned char* lds = (LAS unsigned char*)lds_raw;
    cg::grid_group grid = cg::this_grid();
    unsigned char* ws = a.ws;
    { const float** tw = (const float**)(ws + WS_TAB);
      if (threadIdx.x == 0) {
#pragma unroll
          for (int i = 0; i < 30; ++i) tw[i] = a.in[i];
          volatile LAS unsigned* st = (volatile LAS unsigned*)(lds + LDS_BAR_ST); st[0] = 0u; st[1] = 0u;
          (void)xb_add((unsigned*)(ws + WS_BAR) + XB_XCNT(xb_xcc_id()), 1u);
          __threadfence(); }
      __syncthreads(); }
    const float* const* tab = (const float* const*)(ws + WS_TAB);
    const int G = gridDim.x, c = blockIdx.x;
    bf16_t* XN = (bf16_t*)(ws + WS_XN);
    float* X = a.out;
    unsigned char* const ws0 = ws; const int G0 = G, c0 = c; float* const X0 = X;
    constexpr int BIG = 1 << 28;

#ifdef SKEL
    { const float* xin = a.in[0]; for (size_t i = (size_t)blockIdx.x * NTHR + threadIdx.x; i < (size_t)T * D; i += (size_t)gridDim.x * NTHR) a.out[i] = xin[i];
      GSYNC();
#if SKEL >= 2
      convert_layer(tab, ws, 0, lds); GSYNC();
#endif
#if SKEL >= 3
      lc_all(tab, ws); GSYNC();
#endif
#if SKEL >= 4
      ew_phase<false>(in_ptr(tab, 0), X, nullptr, 0.f, nullptr, in_ptr(tab, 1), XN); GSYNC();
#endif
#if SKEL >= 5
      ew_phase<true>(X, X, (const bf16_t*)(ws + WS_F), 0.5f, in_ptr(tab, 5), in_ptr(tab, 6), XN); GSYNC();
#endif
#if SKEL >= 6
      convert_layer(tab, ws, 1, lds); GSYNC();
#endif
      return; }
#endif
#ifdef DBG
    if (blockIdx.x == 0 && threadIdx.x == 0) *(unsigned*)(ws + WS_DBG) = 99u;
#endif
    PH(0) { convert_layer(tab, ws, 0, lds); lc_all(tab, ws); }
    PH(1) ew_phase<false>(in_ptr(tab, 0), X, nullptr, 0.f, nullptr, in_ptr(tab, 1), XN);
    GSYNC_CG();
#ifdef DBG
    if (STOP_AT == 20) return;
#endif

#pragma unroll 1
    for (int l = 0; l < NLAYER_RUN; ++l) {
#pragma unroll 1
        for (int f = 0; f < 2; ++f) {
            unsigned long long wsv = (unsigned long long)ws0, xv = (unsigned long long)X0; int G = G0, c = c0;
#ifndef NOASM
            asm volatile("" : "+s"(wsv), "+s"(G), "+s"(c), "+s"(xv));
#endif
            unsigned char* ws = (unsigned char*)(GAS unsigned char*)wsv; float* X = (float*)(GAS float*)xv;
            const float* const* tab = (const float* const*)(ws + WS_TAB); bf16_t* XN = (bf16_t*)(ws + WS_XN);
            if (f == 1) {
                PH(2) { pg8::Gemm g{XN, XN, (const bf16_t*)(ws + W_IN), T, ZN, D, D, BIG, 0, 0}; pg8::StaticOrder So; So.init(T, ZN, G, c);
                  pg8::EpiBf<2> E{(bf16_t*)(ws + WS_ZG), 1024, (bf16_t*)(ws + WS_ZX), (bf16_t*)(ws + WS_ZSC), (bf16_t*)(ws + WS_ZSGU)};
                  pg8::gemm_phase<pg8::EpiBf<2>, true>(lds, g, So, E); }
                GSYNC();
                DBGCHK(5);
                PH(3) prep_phase(tab, ws, l, lds);
                GSYNC();
                DBGCHK(6);
                PH(4) { const bf16_t* XC = (const bf16_t*)(ws + WS_XC);
                  pg8::Gemm g{XC, XC, (const bf16_t*)(ws + W_LRU), T, 4096, 256, 1024, BIG, 2, 512}; pg8::StaticOrder So; So.init(T, 4096, G, c);
                  pg8::EpiGates E{XC, (bf16_t*)(ws + WS_U), ws + WS_R, in_ptr(tab, 11) + (size_t)l * 2048, in_ptr(tab, 13) + (size_t)l * 2048, (const float*)(ws + WS_LC)};
                  pg8::gemm_phase<pg8::EpiGates, true>(lds, g, So, E); }
                GSYNC();
                DBGCHK(9);
                PH(5) scan_pass1(ws, l, lds);
                GSYNC();
                PH(6) scan_pass2(ws, l, lds);
                GSYNC();
                DBGCHK(11);
                PH(7) { pg8::Gemm g{XN, XN, (const bf16_t*)(ws + W_IN) + (size_t)ZN * D, T, 3072, D, D, BIG, 0, 0}; pg8::StaticOrder So; So.init(T, 3072, G, c);
                  pg8::EpiBf<1> E{(bf16_t*)(ws + WS_G), 3072, nullptr, nullptr, nullptr};
                  pg8::gemm_phase<pg8::EpiBf<1>, true>(lds, g, So, E); }
                GSYNC();
                DBGCHK(12);
                PH(8) { pg8::Gemm g{(const bf16_t*)(ws + WS_ZG), (const bf16_t*)(ws + WS_YBC) - 16 * 64, (const bf16_t*)(ws + W_CAT), T, D, 2048, 1024, 16, 0, 0}; pg8::StaticOrder So; So.init(T, D, G, c);
                  pg8::EpiMerge E{(const bf16_t*)(ws + WS_G), (bf16_t*)(ws + WS_MG)};
                  pg8::gemm_phase<pg8::EpiMerge, true>(lds, g, So, E); }
                GSYNC();
                DBGCHK(13);
                PH(9) { const bf16_t* MG = (const bf16_t*)(ws + WS_MG);
                  pg8::Gemm g{MG, MG, (const bf16_t*)(ws + W_O), T, D, D, D, BIG, 0, 0}; pg8::StaticOrder So; So.init(T, D, G, c);
                  pg8::EpiBf<0> E{(bf16_t*)(ws + WS_MX), 1024, nullptr, nullptr, nullptr};
                  pg8::gemm_phase<pg8::EpiBf<0>, true>(lds, g, So, E); }
                GSYNC();
                DBGCHK(14);
#if defined(DBG) && STOP_AT == 21
                PH(10) ew_phase<true>(X, (float*)(ws + WS_G), (const bf16_t*)(ws + WS_MX), 1.f, in_ptr(tab, 24) + (size_t)l * D, in_ptr(tab, 25) + (size_t)l * D, XN);
#else
                PH(10) ew_phase<true>(X, X, (const bf16_t*)(ws + WS_MX), 1.f, in_ptr(tab, 24) + (size_t)l * D, in_ptr(tab, 25) + (size_t)l * D, XN);
#endif
                GSYNC();
                DBGCHK(21);
            }
            PH(11) { pg8::Gemm g{XN, XN, (const bf16_t*)(ws + (f ? W_UP2 : W_UP1)), T, 2 * FF, D, D, BIG, 0, 0}; pg8::StaticOrder So; So.init(T, 2 * FF, G, c);
              pg8::EpiSwiGLU E{(bf16_t*)(ws + WS_H), FF};
              pg8::gemm_phase<pg8::EpiSwiGLU, true>(lds, g, So, E); }
            GSYNC();
            if (f == DBG_F) DBGCHK(2);
            PH(12) { const bf16_t* H = (const bf16_t*)(ws + WS_H);
              pg8::Gemm g{H, H, (const bf16_t*)(ws + (f ? W_DN2 : W_DN1)), T, D, FF, FF, BIG, 0, 0}; pg8::StaticOrder So; So.init(T, D, G, c);
              pg8::EpiBf<0> E{(bf16_t*)(ws + WS_F), 1024, nullptr, nullptr, nullptr};
              pg8::gemm_phase<pg8::EpiBf<0>, true>(lds, g, So, E); }
            GSYNC();
            if (f == DBG_F) DBGCHK(3);
            if (f == 0) {
                ew_phase<true>(X, X, (const bf16_t*)(ws + WS_F), 0.5f, in_ptr(tab, 5) + (size_t)l * D, in_ptr(tab, 6) + (size_t)l * D, XN);
            } else {
                if (l + 1 < DEPTH) convert_layer(tab, ws, l + 1, lds);
#if defined(DBG) && STOP_AT == 22
                ew_phase<true>(X, (l == DBG_LAYER) ? (float*)(ws + WS_G) : X, (const bf16_t*)(ws + WS_F), 0.5f, in_ptr(tab, 29) + (size_t)l * D, (l + 1 < DEPTH) ? in_ptr(tab, 1) + (size_t)(l + 1) * D : nullptr, XN);
#else
                ew_phase<true>(X, X, (const bf16_t*)(ws + WS_F), 0.5f, in_ptr(tab, 29) + (size_t)l * D, (l + 1 < DEPTH) ? in_ptr(tab, 1) + (size_t)(l + 1) * D : nullptr, XN);
#endif
            }
            GSYNC();
            if (f == 0) DBGCHK(4);
            if (f == 1) DBGCHK(22);
        }
    }
}

extern "C" void kernel_launch(void* const* d_in, const int* in_sizes, int n_in, void* d_out, int out_size, void* d_ws, size_t ws_size, hipStream_t stream) {
    static int grid = 0;
    if (grid == 0) {
        if (n_in != 30 || in_sizes[0] != T * D || out_size != T * D || ws_size < WS_END) { fprintf(stderr, "kernel_launch: unexpected problem geometry (n_in %d, ws %zu)\n", n_in, ws_size); grid = -1; return; }
        int dev = 0, cus = 0, per_cu = 0;
        if (hipGetDevice(&dev) != hipSuccess || hipDeviceGetAttribute(&cus, hipDeviceAttributeMultiprocessorCount, dev) != hipSuccess) { grid = -1; return; }
        if (hipFuncSetAttribute((const void*)fwd_kernel, hipFuncAttributeMaxDynamicSharedMemorySize, LDS_BYTES) != hipSuccess) { fprintf(stderr, "kernel_launch: hipFuncSetAttribute failed\n"); grid = -1; return; }
        if (hipOccupancyMaxActiveBlocksPerMultiprocessor(&per_cu, (const void*)fwd_kernel, NTHR, LDS_BYTES) != hipSuccess || per_cu < 1) { fprintf(stderr, "kernel_launch: occupancy query failed (%d)\n", per_cu); (void)hipGetLastError(); grid = -1; return; }
        grid = cus * per_cu;
        if (T % (2 * grid * NWAVES) != 0) { fprintf(stderr, "kernel_launch: grid %d does not divide the row pairs of the norm phases\n", grid); grid = -1; return; }
    }
    if (grid < 0) return;
    Args a{};
    for (int i = 0; i < 30; ++i) a.in[i] = (const float*)d_in[i];
    a.out = (float*)d_out; a.ws = (unsigned char*)d_ws;
    if (hipMemsetAsync((char*)d_ws + WS_BAR, 0, 16384, stream) != hipSuccess) { fprintf(stderr, "kernel_launch: hipMemsetAsync failed\n"); return; }
    void* args[] = {&a};
    hipError_t e = hipLaunchCooperativeKernel((const void*)fwd_kernel, dim3(grid), dim3(NTHR), args, LDS_BYTES, stream);
    if (e != hipSuccess) fprintf(stderr, "kernel_launch: cooperative launch failed: %s (grid %d)\n", hipGetErrorString(e), grid);
#ifdef DBG
    dbg_kernel<<<128, 64, 0, stream>>>(a, (unsigned)DBG_MASK);
    dbg_final<<<1, 1, 0, stream>>>(a);
#endif
}
```

```cpp
#include <hip/hip_runtime.h>
#include <hip/hip_cooperative_groups.h>
#include <cstdio>
#include <cstdint>
namespace cg = cooperative_groups;

#define LAS __attribute__((address_space(3)))
typedef unsigned short bf16_t;
typedef short bf16x8 __attribute__((ext_vector_type(8)));
typedef float f32x4 __attribute__((ext_vector_type(4)));
typedef float f32x2 __attribute__((ext_vector_type(2)));
typedef unsigned u32x4 __attribute__((ext_vector_type(4)));
typedef unsigned u32x2 __attribute__((ext_vector_type(2)));

constexpr int NB = 2, S = 16384, T = NB * S, D = 1024, FF = 2816, DIN = 7680, ZN = 4608, DEPTH = 4;
constexpr float EPS = 1e-6f;
constexpr int NTHR = 512, NWAVES = 8;

constexpr size_t MiB = 1u << 20;
constexpr size_t WS_LC = 0;
constexpr size_t WS_TAB = 65536;
constexpr size_t WS_SUM = 1 * MiB;
constexpr size_t WS_W = 4 * MiB;
constexpr size_t W_UP1 = WS_W, W_DN1 = W_UP1 + 11 * MiB, W_IN = W_DN1 + 11 * MiB / 2, W_LRU = W_IN + 15 * MiB, W_CAT = W_LRU + 2 * MiB,
                 W_O = W_CAT + 4 * MiB, W_UP2 = W_O + 2 * MiB, W_DN2 = W_UP2 + 11 * MiB, W_END = W_DN2 + 11 * MiB / 2;
static_assert(W_END == 60 * MiB, "weight map");
constexpr size_t WS_XN = 60 * MiB;
constexpr size_t WS_ZG = 124 * MiB, WS_ZX = 188 * MiB, WS_ZSC = 252 * MiB, WS_ZSGU = 348 * MiB, WS_XC = 412 * MiB, WS_YBC = 476 * MiB, WS_END = 540 * MiB;
constexpr size_t WS_U = 188 * MiB, WS_R = 316 * MiB;
constexpr size_t WS_G = 188 * MiB;
constexpr size_t WS_SEG = 380 * MiB;
constexpr size_t WS_MG = 380 * MiB;
constexpr size_t WS_MX = 124 * MiB;
constexpr size_t WS_H = 124 * MiB;
constexpr size_t WS_F = 316 * MiB;

constexpr int LDS_BYTES = 147456;
#ifndef PHM
#define PHM 0xFFFF
#define NLAYER_RUN DEPTH
#define STOP_AT 11
#define DBG_MASK ((1u << 9) | (1u << 11))
#define DBG_LAYER 1
#define DBG_F 0
#define DBG_G 1
#define DBG_GL 0
#ifndef ABL
#define ABL 0
#endif
#endif
#define PH(b) if constexpr ((PHM >> (b)) & 1)
#define GSYNC_CG() do { asm volatile("s_waitcnt vmcnt(0)" ::: "memory"); __threadfence(); grid.sync(); } while (0)
#define GSYNC() xsync(ws, lds)

struct Args { const float* in[30]; float* out; unsigned char* ws; };

typedef _Float16 h16x2 __attribute__((ext_vector_type(2)));
typedef _Float16 h16x8 __attribute__((ext_vector_type(8)));
__device__ __forceinline__ unsigned cvt_pk_bf16(float lo, float hi) { h16x2 v; v.x = (_Float16)lo; v.y = (_Float16)hi; return __builtin_bit_cast(unsigned, v); }
__device__ __forceinline__ float bflo(unsigned u) { return (float)__builtin_bit_cast(h16x2, u).x; }
__device__ __forceinline__ float bfhi(unsigned u) { return (float)__builtin_bit_cast(h16x2, u).y; }
__device__ __forceinline__ float h8(const u32x4& v, int j) { const unsigned w = (j >> 1) == 0 ? v.x : (j >> 1) == 1 ? v.y : (j >> 1) == 2 ? v.z : v.w; return (j & 1) ? bfhi(w) : bflo(w); }
__device__ __forceinline__ float rcpf_(float x) { return __builtin_amdgcn_rcpf(x); }
__device__ __forceinline__ float sigm(float x) { return rcpf_(1.f + __expf(-x)); }
__device__ __forceinline__ float silu_(float x) { return x * sigm(x); }
__device__ __forceinline__ float gelu_(float x) { const float u = 1.5957691216057308f * (x + 0.044715f * x * x * x); return x * sigm(u); }
#define GAS __attribute__((address_space(1)))
__device__ __forceinline__ const float* in_ptr(const float* const* tab, int i) {
    unsigned long long v = *(const unsigned long long*)(tab + i);
    const unsigned lo = __builtin_amdgcn_readfirstlane((unsigned)v), hi = __builtin_amdgcn_readfirstlane((unsigned)(v >> 32));
    v = ((unsigned long long)hi << 32) | lo;
    return (const float*)(GAS const float*)v;
}
__device__ __forceinline__ float wave_sum(float v, int lane) {
#pragma unroll
    for (int o = 1; o < 64; o <<= 1) v += __int_as_float(__builtin_amdgcn_ds_bpermute((lane ^ o) << 2, __float_as_int(v)));
    return v;
}

constexpr size_t WS_BAR = 131072;
constexpr int LDS_BAR_ST = LDS_BYTES - 64;
#define XB_TMO      128
#define XB_XCNT(j)  (256  + 64 * (j))
#define XB_XSUB(j)  (1280 + 64 * (j))
#define XB_XGEN(j)  (2304 + 64 * (j))
#define XB_TOP      3328
#define XB_TOPGEN   3392
#define XCD_BAR_WORDS 3456
#define XB_SPIN_CAP (1u << 20)
__device__ __forceinline__ unsigned xb_ld(unsigned* p)              { return __hip_atomic_load(p, __ATOMIC_RELAXED, __HIP_MEMORY_SCOPE_AGENT); }
__device__ __forceinline__ unsigned xb_add(unsigned* p, unsigned v) { return __hip_atomic_fetch_add(p, v, __ATOMIC_RELAXED, __HIP_MEMORY_SCOPE_AGENT); }
__device__ __forceinline__ unsigned xb_xcc_id() { return (unsigned)__builtin_amdgcn_s_getreg((3 << 11) | 20) & 0xFu; }
#define XB_SPIN(cond, bar) do { unsigned _sp = 0; while (cond) { __builtin_amdgcn_s_sleep(1); \
    if ((++_sp & 255u) == 0u) { if (xb_ld(&(bar)[XB_TMO])) break; if (_sp > XB_SPIN_CAP) { atomicAdd(&(bar)[XB_TMO], 1u); break; } } } } while (0)
__device__ __forceinline__ void xcd_barrier_complete(unsigned* bar, unsigned x, unsigned& nloc, unsigned& nx) {
    const unsigned G = gridDim.x * gridDim.y * gridDim.z;
    unsigned sum, cnt, mine, sp = 0u;
    for (;;) {
        sum = 0u; cnt = 0u; mine = 0u;
#pragma unroll
        for (unsigned j = 0; j < 16; ++j) { const unsigned c = xb_ld(&bar[XB_XCNT(j)]); sum += c; cnt += (c > 0u) ? 1u : 0u; mine = (j == x) ? c : mine; }
        if (sum == G) break;
        __builtin_amdgcn_s_sleep(1);
        if ((++sp & 255u) == 0u) { if (xb_ld(&bar[XB_TMO])) break; if (sp > XB_SPIN_CAP) { atomicAdd(&bar[XB_TMO], 1u); break; } }
    }
    nloc = mine > 0u ? mine : 1u; nx = cnt > 0u ? cnt : 1u;
}
__device__ __forceinline__ void xsync(unsigned char* ws, LAS unsigned char* lds) {
    asm volatile("s_waitcnt vmcnt(0)" ::: "memory");
    __syncthreads();
    if (threadIdx.x == 0) {
        unsigned* bar = (unsigned*)(ws + WS_BAR); const unsigned x = xb_xcc_id();
        volatile LAS unsigned* st = (volatile LAS unsigned*)(lds + LDS_BAR_ST);
        __builtin_amdgcn_s_waitcnt(0);
        unsigned nloc = st[0], nx = st[1];
        if (nloc == 0u) { xcd_barrier_complete(bar, x, nloc, nx); st[0] = nloc; st[1] = nx; }
        const unsigned old = xb_add(&bar[XB_XSUB(x)], 1u);
        const unsigned gen = old / nloc;
        if (old + 1u == (gen + 1u) * nloc) {
            __builtin_amdgcn_fence(__ATOMIC_RELEASE, "agent");
            asm volatile("s_waitcnt vmcnt(0)" ::: "memory");
            const unsigned og = xb_add(&bar[XB_TOP], 1u);
            const unsigned tg = og / nx;
            if (og + 1u == (tg + 1u) * nx) xb_add(&bar[XB_TOPGEN], 1u);
            else XB_SPIN(xb_ld(&bar[XB_TOPGEN]) == tg, bar);
            __builtin_amdgcn_fence(__ATOMIC_ACQUIRE, "agent");
            xb_add(&bar[XB_XGEN(x)], 1u);
            asm volatile("s_waitcnt vmcnt(0)" ::: "memory");
        } else {
            XB_SPIN(xb_ld(&bar[XB_XGEN(x)]) == gen, bar);
            __builtin_amdgcn_fence(__ATOMIC_ACQUIRE, "agent");
            asm volatile("s_waitcnt vmcnt(0)" ::: "memory");
        }
    }
    __syncthreads();
}

namespace pg8 {
constexpr int BM = 256, BK = 64, HALF = 128, HTB = HALF * BK * 2, STAGE_BYTES = 8 * HTB, NXCD = 8, WGM = 8;
__host__ __device__ __forceinline__ int lds_byte(int r, int c) { const int st = (r >> 4) * 2 + (c >> 5), rr = r & 15, cc = c & 31, ob = rr * 64 + cc * 2; return st * 1024 + (ob ^ (((ob >> 9) & 1) << 5)); }
__host__ __device__ __forceinline__ void stage_rc(int b, int& R, int& C) { const int st = b / 1024, sb = b % 1024, swz = sb ^ (((sb >> 9) & 1) << 5); R = (st >> 1) * 16 + swz / 64; C = (st & 1) * 32 + (swz % 64) / 2; }
__host__ __device__ __forceinline__ int perm32(int rho) { const int n = rho >> 4, i = rho & 15; return 8 * (i >> 2) + 4 * n + (i & 3); }

struct Unit { int pm, pn; };
struct Gemm { const bf16_t* A; const bf16_t* A2; const bf16_t* Bt; int M, N, K, lda, ksplit, apn_shift, apn_bytes; };

struct StaticOrder {
    int nM, nN, nwg, G, c;
    __device__ void init(int M, int N, int G_, int c_) { nM = M / BM; nN = N / BM; nwg = nM * nN; G = G_; c = c_; }
    __device__ bool next(int i, Unit& u) const {
        const long L = (long)i * G + c; if (L >= nwg) return false;
        int wgid = (int)L; { const int q = nwg / NXCD, r = nwg % NXCD, xcd = wgid % NXCD, off = wgid / NXCD; wgid = (xcd < r ? xcd * (q + 1) : r * (q + 1) + (xcd - r) * q) + off; }
        const int nig = WGM * nN, gid = wgid / nig, fm = gid * WGM, gsz = (nM - fm) < WGM ? (nM - fm) : WGM;
        u.pm = fm + ((wgid % nig) % gsz); u.pn = (wgid % nig) / gsz; return true;
    }
};

template <class Epi, bool ALIGN_EPI>
__device__ __forceinline__ void gemm_phase(LAS unsigned char* lds, const Gemm g, const StaticOrder& S, const Epi& E) {
    int tid_ = threadIdx.x; asm volatile("" : "+v"(tid_));
    const int tid = tid_, wid = __builtin_amdgcn_readfirstlane(tid >> 6), lane = tid & 63, wr = wid >> 2, wc = wid & 3, fr = lane & 15, fq = lane >> 4;
    const int K = g.K, nt = K / BK, lda = g.lda;
    unsigned voffA[2], voffB[2];
#pragma unroll
    for (int i = 0; i < 2; ++i) { int R, C; stage_rc(tid * 16 + i * 8192, R, C); const int Rb = Epi::PERM ? ((R & ~31) + perm32(R & 31)) : R;
        voffA[i] = (unsigned)(R * lda + C) * 2u; voffB[i] = (unsigned)(Rb * K + C) * 2u; }
    const size_t kstep = (size_t)(BK * 2);
    const size_t hstepA = (size_t)HALF * lda * 2, tstepA = 2 * hstepA;
    const size_t hstepB = (size_t)HALF * K * 2, tstepB = 2 * hstepB;
    const unsigned ldsw = (unsigned)wid * 1024u;
    const int aoff = lds_byte(wr * 64 + fr, fq * 8), boff = lds_byte(wc * 32 + fr, fq * 8);
#define PG8_SA(b, h) (((b) * 2 + (h)) * HTB)
#define PG8_SB(b, h) ((4 + (b) * 2 + (h)) * HTB)
#define PG8_STAGE(bufoff, gbase, voff) do { _Pragma("unroll") for (int _i = 0; _i < 2; ++_i) \
        __builtin_amdgcn_global_load_lds((const unsigned*)((const char*)(gbase) + (voff)[_i]), (LAS unsigned*)(lds + (bufoff) + ldsw + _i * 8192), 16, 0, 0); } while (0)
#define PG8_LDA(dst, b, h) do { _Pragma("unroll") for (int m = 0; m < 4; ++m) _Pragma("unroll") for (int k = 0; k < 2; ++k) dst[m][k] = *(const LAS bf16x8*)(lds + PG8_SA(b, h) + aoff + m * 2048 + k * 1024); } while (0)
#define PG8_LDB(dst, b, h) do { _Pragma("unroll") for (int n = 0; n < 2; ++n) _Pragma("unroll") for (int k = 0; k < 2; ++k) dst[n][k] = *(const LAS bf16x8*)(lds + PG8_SB(b, h) + boff + n * 2048 + k * 1024); } while (0)
#define PG8_MMA(ai, bj, At, Bt) do { __builtin_amdgcn_s_setprio(1); _Pragma("unroll") for (int m = 0; m < 4; ++m) _Pragma("unroll") for (int n = 0; n < 2; ++n) _Pragma("unroll") for (int k = 0; k < 2; ++k) \
        acc[ai][bj][m][n] = __builtin_amdgcn_mfma_f32_16x16x32_f16(__builtin_bit_cast(h16x8, Bt[n][k]), __builtin_bit_cast(h16x8, At[m][k]), acc[ai][bj][m][n], 0, 0, 0); __builtin_amdgcn_s_setprio(0); } while (0)
#define PG8_WAIT_V(n) asm volatile("s_waitcnt vmcnt(" #n ")" ::: "memory")
#define PG8_WAIT_L(n) asm volatile("s_waitcnt lgkmcnt(" #n ")" ::: "memory")
#define PG8_BAR __builtin_amdgcn_s_barrier()
#define PG8_SCHED __builtin_amdgcn_sched_barrier(0)
    Unit cur, nxt; int ui = 0;
    if (!S.next(0, cur)) return;
    f32x4 acc[2][2][4][2];
#pragma unroll
    for (int a = 0; a < 2; ++a)
#pragma unroll
        for (int b = 0; b < 2; ++b)
#pragma unroll
            for (int m = 0; m < 4; ++m)
#pragma unroll
                for (int n = 0; n < 2; ++n) acc[a][b][m][n] = (f32x4){0.f, 0.f, 0.f, 0.f};
    bf16x8 At[4][2], B0[2][2], B1[2][2];
    const char* cA = (const char*)g.A + (size_t)cur.pm * tstepA + (size_t)(cur.pn >> g.apn_shift) * g.apn_bytes;
    const char* cA2 = (const char*)g.A2 + (size_t)cur.pm * tstepA;
    const char* cB = (const char*)g.Bt + (size_t)cur.pn * tstepB;
    PG8_STAGE(PG8_SB(0, 0), cB, voffB); PG8_STAGE(PG8_SB(0, 1), cB + hstepB, voffB); PG8_STAGE(PG8_SA(0, 0), cA, voffA); PG8_STAGE(PG8_SA(0, 1), cA + hstepA, voffA);
    if (wr == 1) PG8_BAR;
    PG8_WAIT_V(2); PG8_BAR;
    PG8_STAGE(PG8_SB(1, 0), cB + kstep, voffB); PG8_STAGE(PG8_SA(1, 0), cA + kstep, voffA); PG8_STAGE(PG8_SB(1, 1), cB + hstepB + kstep, voffB);
    PG8_WAIT_V(6); PG8_BAR;
    for (;;) {
        const bool has_next = S.next(ui + 1, nxt);
        const char* nA = has_next ? (const char*)g.A + (size_t)nxt.pm * tstepA + (size_t)(nxt.pn >> g.apn_shift) * g.apn_bytes : cA;
        const char* nA2 = has_next ? (const char*)g.A2 + (size_t)nxt.pm * tstepA : cA2;
        const char* nB = has_next ? (const char*)g.Bt + (size_t)nxt.pn * tstepB : cB;
        for (int t = 0; t < nt; t += 2) {
            const bool last = (t == nt - 2);
            const char* a1 = ((t < g.ksplit) ? cA : cA2) + (size_t)(t + 1) * kstep;
            const char* a2 = last ? nA : ((t + 2 < g.ksplit) ? cA : cA2) + (size_t)(t + 2) * kstep;
            const char* b2 = last ? nB : cB + (size_t)(t + 2) * kstep;
            const char* a3 = a2 + kstep; const char* b3 = b2 + kstep;
            if constexpr (Epi::HOOK) { if (t == g.ksplit || t == g.ksplit + 8) E.hook(acc, cur, (t - g.ksplit) >> 3, wr, wc, fr, fq); }
            PG8_LDB(B0, 0, 0); PG8_LDB(B1, 0, 1); PG8_SCHED; PG8_LDA(At, 0, 0); PG8_STAGE(PG8_SA(1, 1), a1 + hstepA, voffA);
            PG8_WAIT_V(8); PG8_WAIT_L(0); PG8_BAR; PG8_MMA(0, 0, At, B0); PG8_MMA(0, 1, At, B1); PG8_BAR; PG8_SCHED;
            PG8_LDA(At, 0, 1); PG8_STAGE(PG8_SB(0, 0), b2, voffB); PG8_STAGE(PG8_SB(0, 1), b2 + hstepB, voffB); PG8_STAGE(PG8_SA(0, 0), a2, voffA);
            PG8_WAIT_V(8); PG8_WAIT_L(0); PG8_BAR; PG8_MMA(1, 0, At, B0); PG8_MMA(1, 1, At, B1); PG8_BAR; PG8_SCHED;
            PG8_LDB(B0, 1, 0); PG8_LDB(B1, 1, 1); PG8_SCHED; PG8_LDA(At, 1, 0); PG8_STAGE(PG8_SA(0, 1), a2 + hstepA, voffA);
            PG8_WAIT_V(8); PG8_WAIT_L(0); PG8_BAR; PG8_MMA(0, 0, At, B0); PG8_MMA(0, 1, At, B1); PG8_BAR; PG8_SCHED;
            PG8_LDA(At, 1, 1); PG8_STAGE(PG8_SB(1, 0), b3, voffB); PG8_STAGE(PG8_SB(1, 1), b3 + hstepB, voffB); PG8_STAGE(PG8_SA(1, 0), a3, voffA);
            PG8_WAIT_V(8); PG8_WAIT_L(0); PG8_BAR; PG8_MMA(1, 0, At, B0); PG8_MMA(1, 1, At, B1); PG8_BAR; PG8_SCHED;
        }
        if constexpr (ALIGN_EPI) { if (wr == 0) PG8_BAR; }
        E(acc, cur, wr, wc, fr, fq);
        if (!has_next) break;
#pragma unroll
        for (int a = 0; a < 2; ++a)
#pragma unroll
            for (int b = 0; b < 2; ++b)
#pragma unroll
                for (int m = 0; m < 4; ++m)
#pragma unroll
                    for (int n = 0; n < 2; ++n) acc[a][b][m][n] = (f32x4){0.f, 0.f, 0.f, 0.f};
        cur = nxt; cA = nA; cA2 = nA2; cB = nB; ++ui;
        if constexpr (ALIGN_EPI) { if (wr == 1) PG8_BAR; }
    }
    PG8_WAIT_V(0);
    if constexpr (!ALIGN_EPI) { if (wr == 0) PG8_BAR; }
    PG8_BAR;
#undef PG8_SA
#undef PG8_SB
#undef PG8_STAGE
#undef PG8_LDA
#undef PG8_LDB
#undef PG8_MMA
#undef PG8_WAIT_V
#undef PG8_WAIT_L
#undef PG8_BAR
#undef PG8_SCHED
}

template <int MODE> struct EpiBf {
    static constexpr bool PERM = true, HOOK = false;
    bf16_t* O; int ldc; bf16_t* O1; bf16_t* O2; bf16_t* O3;
    __device__ __forceinline__ void operator()(const f32x4 (&acc)[2][2][4][2], const Unit& u, int wr, int wc, int fr, int fq) const {
        bf16_t* base = O; int ld = ldc; int colt = u.pn * BM;
        if (MODE == 2) { const int pn = u.pn;
            if (pn < 4) { base = O; ld = 1024; colt = pn * 256; } else if (pn < 8) { base = O1; ld = 1024; colt = (pn - 4) * 256; }
            else if (pn < 14) { base = O2; ld = 1536; colt = (pn - 8) * 256; } else { base = O3; ld = 1024; colt = (pn - 14) * 256; } }
        const int row0 = u.pm * BM + wr * 64 + fr, col0 = colt + wc * 32 + 8 * fq;
#pragma unroll
        for (int ai = 0; ai < 2; ++ai)
#pragma unroll
            for (int m = 0; m < 4; ++m) { bf16_t* rowp = base + (size_t)(row0 + ai * HALF + m * 16) * ld + col0;
#pragma unroll
                for (int bj = 0; bj < 2; ++bj) { f32x4 v0 = acc[ai][bj][m][0], v1 = acc[ai][bj][m][1];
                    if (MODE == 1) {
#pragma unroll
                        for (int j = 0; j < 4; ++j) { v0[j] = sigm(v0[j]); v1[j] = sigm(v1[j]); } }
                    u32x4 w; w.x = cvt_pk_bf16(v0[0], v0[1]); w.y = cvt_pk_bf16(v0[2], v0[3]); w.z = cvt_pk_bf16(v1[0], v1[1]); w.w = cvt_pk_bf16(v1[2], v1[3]);
                    *(u32x4*)(rowp + bj * HALF) = w; } }
    }
};
struct EpiSwiGLU {
    static constexpr bool PERM = true, HOOK = false;
    bf16_t* O; int ldc;
    __device__ __forceinline__ void operator()(const f32x4 (&acc)[2][2][4][2], const Unit& u, int wr, int wc, int fr, int fq) const {
        const int row0 = u.pm * BM + wr * 64 + fr, col0 = u.pn * HALF + wc * 32 + 8 * fq;
#pragma unroll
        for (int ai = 0; ai < 2; ++ai)
#pragma unroll
            for (int m = 0; m < 4; ++m) { bf16_t* rowp = O + (size_t)(row0 + ai * HALF + m * 16) * ldc + col0;
                f32x4 h0, h1;
#pragma unroll
                for (int j = 0; j < 4; ++j) { h0[j] = silu_(acc[ai][0][m][0][j]) * acc[ai][1][m][0][j]; h1[j] = silu_(acc[ai][0][m][1][j]) * acc[ai][1][m][1][j]; }
                u32x4 w; w.x = cvt_pk_bf16(h0[0], h0[1]); w.y = cvt_pk_bf16(h0[2], h0[3]); w.z = cvt_pk_bf16(h1[0], h1[1]); w.w = cvt_pk_bf16(h1[2], h1[3]);
                *(u32x4*)rowp = w; }
    }
};
struct EpiMerge {
    static constexpr bool PERM = true, HOOK = true;
    const bf16_t* G; bf16_t* O;
    __device__ __forceinline__ void hook(f32x4 (&acc)[2][2][4][2], const Unit& u, int which, int wr, int wc, int fr, int fq) const {
        int row0 = u.pm * BM + wr * 64 + fr, col0 = u.pn * BM + wc * 32 + 8 * fq + which * 1024;
        asm volatile("" : "+v"(row0), "+v"(col0));
#pragma unroll
        for (int ai = 0; ai < 2; ++ai)
#pragma unroll
            for (int m = 0; m < 4; ++m) { const bf16_t* gp = G + (size_t)(row0 + ai * HALF + m * 16) * 3072 + col0;
                const u32x4 ga0 = *(const u32x4*)gp, gb0 = *(const u32x4*)(gp + 1024), ga1 = *(const u32x4*)(gp + HALF), gb1 = *(const u32x4*)(gp + 1024 + HALF);
#pragma unroll
                for (int n = 0; n < 2; ++n) { f32x4 r0, r1;
#pragma unroll
                    for (int j = 0; j < 4; ++j) { r0[j] = h8(ga0, 4 * n + j) * rcpf_(h8(gb0, 4 * n + j)); r1[j] = h8(ga1, 4 * n + j) * rcpf_(h8(gb1, 4 * n + j)); }
                    acc[ai][0][m][n] *= r0; acc[ai][1][m][n] *= r1; }
                asm volatile("" ::: "memory"); }
    }
    __device__ __forceinline__ void operator()(const f32x4 (&acc)[2][2][4][2], const Unit& u, int wr, int wc, int fr, int fq) const {
        const int row0 = u.pm * BM + wr * 64 + fr, col0 = u.pn * BM + wc * 32 + 8 * fq;
#pragma unroll
        for (int ai = 0; ai < 2; ++ai)
#pragma unroll
            for (int m = 0; m < 4; ++m) { const size_t r = (size_t)(row0 + ai * HALF + m * 16);
#pragma unroll
                for (int bj = 0; bj < 2; ++bj) { const u32x4 gc = *(const u32x4*)(G + r * 3072 + 2048 + col0 + bj * HALF);
                    const f32x4 v0 = acc[ai][bj][m][0], v1 = acc[ai][bj][m][1];
                    u32x4 w; w.x = cvt_pk_bf16(v0[0] * bflo(gc.x), v0[1] * bfhi(gc.x)); w.y = cvt_pk_bf16(v0[2] * bflo(gc.y), v0[3] * bfhi(gc.y));
                    w.z = cvt_pk_bf16(v1[0] * bflo(gc.z), v1[1] * bfhi(gc.z)); w.w = cvt_pk_bf16(v1[2] * bflo(gc.w), v1[3] * bfhi(gc.w));
                    *(u32x4*)(O + r * 1024 + col0 + bj * HALF) = w; }
                asm volatile("" ::: "memory"); }
    }
};
struct EpiGates {
    static constexpr bool PERM = true, HOOK = false;
    const bf16_t* XC; bf16_t* U; unsigned char* R; const float* ba; const float* bx; const float* lc;
    __device__ __forceinline__ void operator()(const f32x4 (&acc)[2][2][4][2], const Unit& u, int wr, int wc, int fr, int fq) const {
        const int d = u.pn & 1;
        int ch0 = 128 * (u.pn >> 1) + 32 * wc + 8 * fq, row0 = u.pm * BM + wr * 64 + fr;
        asm volatile("" : "+v"(row0), "+v"(ch0));
        char* Ud = (char*)(U + (size_t)d * T * 1024); unsigned char* Rd = R + (size_t)d * T * 1024;
        const float* bad = ba + d * 1024 + ch0; const float* bxd = bx + d * 1024 + ch0;
#pragma unroll
        for (int ai = 0; ai < 2; ++ai) {
            u32x4 xw4[4];
#pragma unroll
            for (int q = 0; q < 4; ++q) xw4[q] = *(const u32x4*)((const char*)XC + (size_t)(((unsigned)(row0 + ai * HALF + q * 16) * 1024u + (unsigned)ch0) * 2u));
#pragma unroll
            for (int m = 0; m < 4; ++m) { const unsigned off = (unsigned)(row0 + ai * HALF + m * 16) * 1024u + (unsigned)ch0;
                const u32x4 xw = xw4[m];
                float uv[8]; unsigned rq[2] = {0u, 0u};
#pragma unroll
                for (int n = 0; n < 2; ++n) { const f32x4 ba4 = *(const f32x4*)(bad + 4 * n), bx4 = *(const f32x4*)(bxd + 4 * n);
#pragma unroll
                    for (int j = 0; j < 4; ++j) { const float rr = sigm(acc[ai][0][m][n][j] + ba4[j]), ig = sigm(acc[ai][1][m][n][j] + bx4[j]);
                        uv[4 * n + j] = ig * h8(xw, 4 * n + j);
                        rq[n] |= ((unsigned)__builtin_rintf(rr * 255.f)) << (8 * j); } }
                u32x4 w; w.x = cvt_pk_bf16(uv[0], uv[1]); w.y = cvt_pk_bf16(uv[2], uv[3]); w.z = cvt_pk_bf16(uv[4], uv[5]); w.w = cvt_pk_bf16(uv[6], uv[7]);
                *(u32x4*)(Ud + (size_t)(off * 2u)) = w;
                u32x2 rw; rw.x = rq[0]; rw.y = rq[1];
                *(u32x2*)(Rd + (size_t)off) = rw;
                asm volatile("" ::: "memory"); } }
    }
};
}

__device__ __forceinline__ int w_rowmap(int mode, int n, int p0) {
    if (mode == 0) return n;
    if (mode == 1) return 256 * (n >> 7) + p0 + (n & 127);
    const int dir = p0 >> 3, head = (p0 >> 1) & 3, ri = p0 & 1, ch = 256 * head + n;
    return 256 * (2 * (ch >> 7) + dir) + 128 * ri + (ch & 127);
}
__device__ __forceinline__ void tr_item(const float* W, int N, int item, bf16_t* WT, int ldk, int koff, int mode, int p0, LAS float* scr, int lane) {
    const int nblk = N / 32, kb = item / nblk, nb = item % nblk, k0 = 64 * kb, n0 = 32 * nb;
    float wv[32];
#pragma unroll
    for (int i = 0; i < 32; ++i) { const int kk = 2 * i + (lane >> 5); wv[i] = W[(size_t)(k0 + kk) * N + n0 + (lane & 31)]; }
#pragma unroll
    for (int i = 0; i < 32; ++i) { const int kk = 2 * i + (lane >> 5); scr[kk * 33 + (lane & 31)] = wv[i]; }
    asm volatile("s_waitcnt lgkmcnt(0)" ::: "memory");
    const int c = lane & 7;
#pragma unroll
    for (int j = 0; j < 4; ++j) { const int nn = (lane >> 3) + 8 * j; const LAS float* s = scr + (8 * c) * 33 + nn;
        u32x4 o; o.x = cvt_pk_bf16(s[0 * 33], s[1 * 33]); o.y = cvt_pk_bf16(s[2 * 33], s[3 * 33]); o.z = cvt_pk_bf16(s[4 * 33], s[5 * 33]); o.w = cvt_pk_bf16(s[6 * 33], s[7 * 33]);
        *(u32x4*)(WT + (size_t)w_rowmap(mode, n0 + nn, p0) * ldk + koff + k0 + 8 * c) = o; }
    asm volatile("s_waitcnt lgkmcnt(0)" ::: "memory");
}
__device__ __forceinline__ void convert_layer(const float* const* tab, unsigned char* ws, int l, LAS unsigned char* lds) {
    int tid_ = threadIdx.x; asm volatile("" : "+v"(tid_));
    const int tid = tid_, lane = tid & 63, wave = tid >> 6;
    LAS float* scr = (LAS float*)(lds + wave * 8448);
    const int gw = blockIdx.x * NWAVES + wave, NGW = gridDim.x * NWAVES;
    constexpr int I_UP = 16 * 88, I_DN = 44 * 32, I_IN = 16 * 240, I_LRU = 256, I_SQ = 512, I_HALF = 256;
    constexpr int NITEMS = 6 * I_UP + I_IN + 2 * I_LRU + 2 * I_SQ + 2 * I_HALF;
    const size_t oUP = (size_t)l * D * FF, oSQ = (size_t)l * D * D, oHF = (size_t)l * 512 * D, oLRU = (size_t)l * 2 * 4 * 256 * 256;
    for (int it = gw; it < NITEMS; it += NGW) {
        int r = it;
        if (r < I_UP) { tr_item(in_ptr(tab, 2) + oUP, FF, r, (bf16_t*)(ws + W_UP1), 1024, 0, 1, 0, scr, lane); continue; } r -= I_UP;
        if (r < I_UP) { tr_item(in_ptr(tab, 3) + oUP, FF, r, (bf16_t*)(ws + W_UP1), 1024, 0, 1, 128, scr, lane); continue; } r -= I_UP;
        if (r < I_DN) { tr_item(in_ptr(tab, 4) + oUP, D, r, (bf16_t*)(ws + W_DN1), FF, 0, 0, 0, scr, lane); continue; } r -= I_DN;
        if (r < I_IN) { tr_item(in_ptr(tab, 7) + (size_t)l * D * DIN, DIN, r, (bf16_t*)(ws + W_IN), 1024, 0, 0, 0, scr, lane); continue; } r -= I_IN;
        if (r < I_LRU) { const int mat = r >> 5; tr_item(in_ptr(tab, 10) + oLRU + (size_t)mat * 65536, 256, r & 31, (bf16_t*)(ws + W_LRU), 256, 0, 2, ((mat >> 2) << 3) | ((mat & 3) << 1) | 0, scr, lane); continue; } r -= I_LRU;
        if (r < I_LRU) { const int mat = r >> 5; tr_item(in_ptr(tab, 12) + oLRU + (size_t)mat * 65536, 256, r & 31, (bf16_t*)(ws + W_LRU), 256, 0, 2, ((mat >> 2) << 3) | ((mat & 3) << 1) | 1, scr, lane); continue; } r -= I_LRU;
        if (r < I_SQ) { tr_item(in_ptr(tab, 15) + oSQ, D, r, (bf16_t*)(ws + W_CAT), 2048, 0, 0, 0, scr, lane); continue; } r -= I_SQ;
        if (r < I_HALF) { tr_item(in_ptr(tab, 17) + oHF, D, r, (bf16_t*)(ws + W_CAT), 2048, 1024, 0, 0, scr, lane); continue; } r -= I_HALF;
        if (r < I_HALF) { tr_item(in_ptr(tab, 22) + oHF, D, r, (bf16_t*)(ws + W_CAT), 2048, 1536, 0, 0, scr, lane); continue; } r -= I_HALF;
        if (r < I_SQ) { tr_item(in_ptr(tab, 23) + oSQ, D, r, (bf16_t*)(ws + W_O), 1024, 0, 0, 0, scr, lane); continue; } r -= I_SQ;
        if (r < I_UP) { tr_item(in_ptr(tab, 26) + oUP, FF, r, (bf16_t*)(ws + W_UP2), 1024, 0, 1, 0, scr, lane); continue; } r -= I_UP;
        if (r < I_UP) { tr_item(in_ptr(tab, 27) + oUP, FF, r, (bf16_t*)(ws + W_UP2), 1024, 0, 1, 128, scr, lane); continue; } r -= I_UP;
        tr_item(in_ptr(tab, 28) + oUP, D, r, (bf16_t*)(ws + W_DN2), FF, 0, 0, 0, scr, lane);
    }
}
__device__ __forceinline__ void lc_all(const float* const* tab, unsigned char* ws) {
    float* LC = (float*)(ws + WS_LC); const float* lam = in_ptr(tab, 14);
    for (int i = blockIdx.x * NTHR + threadIdx.x; i < DEPTH * 2048; i += gridDim.x * NTHR) LC[i] = -8.f * log1pf(expf(-lam[i]));
}

__device__ __forceinline__ void wave_sum2(float& a, float& b, int lane) {
#pragma unroll
    for (int o = 1; o < 64; o <<= 1) { const int ad = (lane ^ o) << 2;
        const float ta = __int_as_float(__builtin_amdgcn_ds_bpermute(ad, __float_as_int(a))), tb = __int_as_float(__builtin_amdgcn_ds_bpermute(ad, __float_as_int(b)));
        a += ta; b += tb; }
}
template <bool HASF>
__device__ __forceinline__ void ew_phase(const float* xin, float* xout, const bf16_t* Fb, float scale, const float* post_g, const float* pre_g, bf16_t* XN) {
    int tid_ = threadIdx.x; asm volatile("" : "+v"(tid_));
    const int tid = tid_, lane = tid & 63, wave = tid >> 6;
    const int gw = blockIdx.x * NWAVES + wave, NGW = gridDim.x * NWAVES;
    for (int m = gw; m < T; m += 2 * NGW) {
        f32x4 v[2][4]; f32x4 f[2][4];
#pragma unroll
        for (int r = 0; r < 2; ++r) { const f32x4* xr = (const f32x4*)(xin + (size_t)(m + r * NGW) * D) + lane;
#pragma unroll
            for (int j = 0; j < 4; ++j) v[r][j] = xr[64 * j]; }
        if (HASF) {
            u32x2 fw[2][4];
#pragma unroll
            for (int r = 0; r < 2; ++r) { const u32x2* fr_ = (const u32x2*)(Fb + (size_t)(m + r * NGW) * D) + lane;
#pragma unroll
                for (int j = 0; j < 4; ++j) fw[r][j] = fr_[64 * j]; }
            float ss[2] = {0.f, 0.f};
#pragma unroll
            for (int r = 0; r < 2; ++r)
#pragma unroll
                for (int j = 0; j < 4; ++j) { const u32x2 w = fw[r][j]; f[r][j][0] = bflo(w.x); f[r][j][1] = bfhi(w.x); f[r][j][2] = bflo(w.y); f[r][j][3] = bfhi(w.y);
                    ss[r] += (f[r][j][0] * f[r][j][0] + f[r][j][1] * f[r][j][1]) + (f[r][j][2] * f[r][j][2] + f[r][j][3] * f[r][j][3]); }
            wave_sum2(ss[0], ss[1], lane);
            const float rs0 = scale * __builtin_amdgcn_rsqf(ss[0] * (1.f / D) + EPS), rs1 = scale * __builtin_amdgcn_rsqf(ss[1] * (1.f / D) + EPS);
#pragma unroll
            for (int j = 0; j < 4; ++j) { const f32x4 pg = *((const f32x4*)post_g + 64 * j + lane); v[0][j] += f[0][j] * rs0 * pg; v[1][j] += f[1][j] * rs1 * pg; }
        }
        if (HASF || xin != xout) {
#pragma unroll
            for (int r = 0; r < 2; ++r) { f32x4* xo = (f32x4*)(xout + (size_t)(m + r * NGW) * D) + lane;
#pragma unroll
                for (int j = 0; j < 4; ++j) xo[64 * j] = v[r][j]; }
        }
        if (pre_g) {
            float s2[2] = {0.f, 0.f};
#pragma unroll
            for (int r = 0; r < 2; ++r)
#pragma unroll
                for (int j = 0; j < 4; ++j) s2[r] += (v[r][j][0] * v[r][j][0] + v[r][j][1] * v[r][j][1]) + (v[r][j][2] * v[r][j][2] + v[r][j][3] * v[r][j][3]);
            wave_sum2(s2[0], s2[1], lane);
            const float q0 = __builtin_amdgcn_rsqf(s2[0] * (1.f / D) + EPS), q1 = __builtin_amdgcn_rsqf(s2[1] * (1.f / D) + EPS);
            u32x2* o0 = (u32x2*)(XN + (size_t)m * D) + lane; u32x2* o1 = (u32x2*)(XN + (size_t)(m + NGW) * D) + lane;
#pragma unroll
            for (int j = 0; j < 4; ++j) { const f32x4 g = *((const f32x4*)pre_g + 64 * j + lane); const f32x4 y0 = v[0][j] * q0 * g, y1 = v[1][j] * q1 * g;
                u32x2 w0, w1; w0.x = cvt_pk_bf16(y0[0], y0[1]); w0.y = cvt_pk_bf16(y0[2], y0[3]); w1.x = cvt_pk_bf16(y1[0], y1[1]); w1.y = cvt_pk_bf16(y1[2], y1[3]);
                o0[64 * j] = w0; o1[64 * j] = w1; }
        }
    }
}

constexpr int VT_PITCH = 272;
__device__ __forceinline__ void prep_phase(const float* const* tab, unsigned char* ws, int l, LAS unsigned char* lds) {
    int tid_ = threadIdx.x; asm volatile("" : "+v"(tid_));
    const int tid = tid_, lane = tid & 63, wave = tid >> 6;
    const bf16_t* ZX = (const bf16_t*)(ws + WS_ZX); const bf16_t* ZSC = (const bf16_t*)(ws + WS_ZSC); const bf16_t* ZSGU = (const bf16_t*)(ws + WS_ZSGU);
    bf16_t* XC = (bf16_t*)(ws + WS_XC); bf16_t* YBC = (bf16_t*)(ws + WS_YBC);
    for (int item = blockIdx.x; item < T / 128; item += gridDim.x) {
        const int b = item >> 7, n = item & 127, t0 = n * 128; const size_t rb = (size_t)b * S;
        {
            const int c = 8 * (tid & 127), sg = tid >> 7; const float* cw = in_ptr(tab, 8) + (size_t)l * 4096 + c; const float* cb = in_ptr(tab, 9) + (size_t)l * 1024 + c;
            float wk[4][8], bb[8];
#pragma unroll
            for (int k = 0; k < 4; ++k) { const f32x4 a0 = *(const f32x4*)(cw + k * 1024), a1 = *(const f32x4*)(cw + k * 1024 + 4);
#pragma unroll
                for (int j = 0; j < 4; ++j) { wk[k][j] = a0[j]; wk[k][4 + j] = a1[j]; } }
            { const f32x4 a0 = *(const f32x4*)cb, a1 = *(const f32x4*)(cb + 4);
#pragma unroll
              for (int j = 0; j < 4; ++j) { bb[j] = a0[j]; bb[4 + j] = a1[j]; } }
            const bf16_t* src = ZX + rb * 1024 + c;
#pragma unroll 1
            for (int blk = 0; blk < 4; ++blk) { const int tb = t0 + sg * 32 + blk * 8;
                u32x4 xr[11];
#pragma unroll
                for (int i = 0; i < 11; ++i) { const int t = tb - 2 + i; xr[i] = (t >= 0 && t < S) ? *(const u32x4*)(src + (size_t)t * 1024) : (u32x4){0u, 0u, 0u, 0u}; }
#pragma unroll
                for (int o = 0; o < 8; ++o) { float y[8];
#pragma unroll
                    for (int j = 0; j < 8; ++j) y[j] = bb[j] + wk[0][j] * h8(xr[o], j) + wk[1][j] * h8(xr[o + 1], j) + wk[2][j] * h8(xr[o + 2], j) + wk[3][j] * h8(xr[o + 3], j);
                    u32x4 w; w.x = cvt_pk_bf16(y[0], y[1]); w.y = cvt_pk_bf16(y[2], y[3]); w.z = cvt_pk_bf16(y[4], y[5]); w.w = cvt_pk_bf16(y[6], y[7]);
                    *(u32x4*)(XC + (rb + tb + o) * 1024 + c) = w; } }
        }
        {
            const int c = 8 * (tid & 63), sg = tid >> 6; const float* cw = in_ptr(tab, 16) + (size_t)l * 1536 + c;
            float wk[3][8];
#pragma unroll
            for (int k = 0; k < 3; ++k) { const f32x4 a0 = *(const f32x4*)(cw + k * 512), a1 = *(const f32x4*)(cw + k * 512 + 4);
#pragma unroll
                for (int j = 0; j < 4; ++j) { wk[k][j] = a0[j]; wk[k][4 + j] = a1[j]; } }
            const bf16_t* src = ZSC + rb * 1536 + c;
#pragma unroll 1
            for (int blk = 0; blk < 4; ++blk) { const int tb = t0 + sg * 16 + blk * 4;
                u32x4 cr[6], xr[6], br[4];
#pragma unroll
                for (int i = 0; i < 6; ++i) { const int t = tb - 1 + i; const bool in = (t >= 0 && t < S);
                    cr[i] = in ? *(const u32x4*)(src + (size_t)t * 1536 + 512) : (u32x4){0u, 0u, 0u, 0u}; xr[i] = in ? *(const u32x4*)(src + (size_t)t * 1536 + 1024) : (u32x4){0u, 0u, 0u, 0u}; }
#pragma unroll
                for (int o = 0; o < 4; ++o) br[o] = *(const u32x4*)(src + (size_t)(tb + o) * 1536);
                float p[6][8];
#pragma unroll
                for (int i = 0; i < 6; ++i)
#pragma unroll
                    for (int j = 0; j < 8; ++j) p[i][j] = h8(cr[i], j) * h8(xr[i], j);
#pragma unroll
                for (int o = 0; o < 4; ++o) { float y[8];
#pragma unroll
                    for (int j = 0; j < 8; ++j) y[j] = h8(br[o], j) * (wk[0][j] * p[o][j] + wk[1][j] * p[o + 1][j] + wk[2][j] * p[o + 2][j]);
                    u32x4 w; w.x = cvt_pk_bf16(y[0], y[1]); w.y = cvt_pk_bf16(y[2], y[3]); w.z = cvt_pk_bf16(y[4], y[5]); w.w = cvt_pk_bf16(y[6], y[7]);
                    *(u32x4*)(YBC + (rb + tb + o) * 1024 + c) = w; } }
        }
        {
            const float* lg = in_ptr(tab, 18) + (size_t)l * 512; const float* lb = in_ptr(tab, 19) + (size_t)l * 512;
            f32x4 g0 = *(const f32x4*)(lg + 8 * lane), g1 = *(const f32x4*)(lg + 8 * lane + 4), b0 = *(const f32x4*)(lb + 8 * lane), b1 = *(const f32x4*)(lb + 8 * lane + 4);
            u32x4 wrow[16];
#pragma unroll
            for (int qi = 0; qi < 16; ++qi) wrow[qi] = *(const u32x4*)(ZSGU + (rb + t0 + wave + 8 * qi) * 1024 + 512 + 8 * lane);
#pragma unroll
            for (int qi = 0; qi < 16; ++qi) { const int q = wave + 8 * qi; const u32x4 w = wrow[qi];
                float v[8]; v[0] = bflo(w.x); v[1] = bfhi(w.x); v[2] = bflo(w.y); v[3] = bfhi(w.y); v[4] = bflo(w.z); v[5] = bfhi(w.z); v[6] = bflo(w.w); v[7] = bfhi(w.w);
                float s = 0.f;
#pragma unroll
                for (int j = 0; j < 8; ++j) { v[j] = gelu_(v[j]); s += v[j]; }
                const float mu = wave_sum(s, lane) * (1.f / 512.f); float s2 = 0.f;
#pragma unroll
                for (int j = 0; j < 8; ++j) { v[j] -= mu; s2 += v[j] * v[j]; }
                const float rstd = __builtin_amdgcn_rsqf(wave_sum(s2, lane) * (1.f / 512.f) + EPS);
#pragma unroll
                for (int j = 0; j < 8; ++j) { const float y = v[j] * rstd * (j < 4 ? g0[j & 3] : g1[j & 3]) + (j < 4 ? b0[j & 3] : b1[j & 3]);
                    *(LAS bf16_t*)(lds + (8 * lane + j) * VT_PITCH + 2 * q) = (bf16_t)(cvt_pk_bf16(y, 0.f) & 0xffffu); }
            }
            __syncthreads();
            const int g = wave >> 1, p0 = 64 * (wave & 1), fr = lane & 15, fq = lane >> 4;
            const float* Wg = in_ptr(tab, 20) + (size_t)l * 65536 + (size_t)g * 16384; const float* bs = in_ptr(tab, 21) + (size_t)l * 512 + g * 128;
            bf16x8 Wf[4][4];
#pragma unroll
            for (int m = 0; m < 4; ++m)
#pragma unroll
                for (int kk = 0; kk < 4; ++kk) { const float* p = Wg + (size_t)(p0 + 16 * m + fr) * 128 + 32 * kk + 8 * fq; const f32x4 x0 = *(const f32x4*)p, x1 = *(const f32x4*)(p + 4);
                    u32x4 w; w.x = cvt_pk_bf16(x0[0], x0[1]); w.y = cvt_pk_bf16(x0[2], x0[3]); w.z = cvt_pk_bf16(x1[0], x1[1]); w.w = cvt_pk_bf16(x1[2], x1[3]);
                    Wf[m][kk] = __builtin_bit_cast(bf16x8, w); }
            float bsv[4];
#pragma unroll
            for (int m = 0; m < 4; ++m) bsv[m] = bs[p0 + 16 * m + fr];
            for (int nn = 0; nn < 8; ++nn) {
                f32x4 acc[4];
#pragma unroll
                for (int m = 0; m < 4; ++m) acc[m] = (f32x4){0.f, 0.f, 0.f, 0.f};
#pragma unroll
                for (int kk = 0; kk < 4; ++kk) { const bf16x8 vf = *(const LAS bf16x8*)(lds + (g * 128 + 16 * nn + fr) * VT_PITCH + (32 * kk + 8 * fq) * 2);
#pragma unroll
                    for (int m = 0; m < 4; ++m) acc[m] = __builtin_amdgcn_mfma_f32_16x16x32_f16(__builtin_bit_cast(h16x8, vf), __builtin_bit_cast(h16x8, Wf[m][kk]), acc[m], 0, 0, 0); }
                const int cc = g * 128 + 16 * nn + 4 * fq;
#pragma unroll
                for (int m = 0; m < 4; ++m) { const size_t row = rb + t0 + p0 + 16 * m + fr;
                    const u32x2 uw = *(const u32x2*)(ZSGU + row * 1024 + cc);
                    const float o0 = gelu_(bflo(uw.x)) * (acc[m][0] + bsv[m]), o1 = gelu_(bfhi(uw.x)) * (acc[m][1] + bsv[m]), o2 = gelu_(bflo(uw.y)) * (acc[m][2] + bsv[m]), o3 = gelu_(bfhi(uw.y)) * (acc[m][3] + bsv[m]);
                    u32x2 w; w.x = cvt_pk_bf16(o0, o1); w.y = cvt_pk_bf16(o2, o3); if (ABL == 3) { w.x = 0u; w.y = 0u; }
                    *(u32x2*)(YBC + row * 1024 + 512 + cc) = w; }
            }
            __syncthreads();
        }
    }
}

__device__ __forceinline__ void scan_pass1(unsigned char* ws, int l, LAS unsigned char* lds) {
    int tid_ = threadIdx.x; asm volatile("" : "+v"(tid_));
    const int tid = tid_, lane = tid & 63, seg = tid >> 6;
    const float* LC = (const float*)(ws + WS_LC) + l * 2048; f32x2* SUM = (f32x2*)(ws + WS_SUM); f32x4* SEGS = (f32x4*)(ws + WS_SEG);
    LAS f32x4* SEG = (LAS f32x4*)lds;
    for (int item = blockIdx.x; item < 2048; item += gridDim.x) {
        const int dir = item & 1, grp = (item >> 1) & 7, chunk = (item >> 4) & 63, b = item >> 10;
        const int ch = grp * 128 + 2 * lane;
        const float l0 = LC[dir * 1024 + ch] * (1.f / 255.f), l1 = LC[dir * 1024 + ch + 1] * (1.f / 255.f);
        const bf16_t* U = (const bf16_t*)(ws + WS_U) + (size_t)dir * T * 1024 + ((size_t)b * S + chunk * 256) * 1024 + ch;
        const unsigned char* R = ws + WS_R + (size_t)dir * T * 1024 + ((size_t)b * S + chunk * 256) * 1024 + ch;
        unsigned uw[32], rw[32];
#pragma unroll
        for (int k = 0; k < 32; ++k) { const int p = seg * 32 + k, to = dir ? 255 - p : p; uw[k] = *(const unsigned*)(U + (size_t)to * 1024); rw[k] = *(const unsigned short*)(R + (size_t)to * 1024); }
        float A0 = 1.f, A1 = 1.f, H0 = 0.f, H1 = 0.f;
#pragma unroll
        for (int k = 0; k < 32; ++k) { const float a0 = __expf(l0 * (float)(rw[k] & 255u)), a1 = __expf(l1 * (float)(rw[k] >> 8));
            H0 = a0 * H0 + bflo(uw[k]) * __builtin_sqrtf(1.f - a0 * a0); H1 = a1 * H1 + bfhi(uw[k]) * __builtin_sqrtf(1.f - a1 * a1); A0 *= a0; A1 *= a1; }
        const f32x4 sv = (f32x4){A0, H0, A1, H1};
        SEG[seg * 64 + lane] = sv;
        SEGS[((size_t)(((dir * 2 + b) * 64 + chunk) * 8 + seg)) * 512 + grp * 64 + lane] = sv;
        __syncthreads();
        if (tid < 64) { float cA0 = 1.f, cA1 = 1.f, cH0 = 0.f, cH1 = 0.f;
#pragma unroll
            for (int s = 0; s < 8; ++s) { const f32x4 v = SEG[s * 64 + tid]; cH0 = v[0] * cH0 + v[1]; cA0 *= v[0]; cH1 = v[2] * cH1 + v[3]; cA1 *= v[2]; }
            f32x4* o = (f32x4*)(SUM + ((size_t)((dir * 2 + b) * 64 + chunk)) * 1024 + grp * 128 + 2 * tid); *o = (f32x4){cA0, cH0, cA1, cH1}; }
        __syncthreads();
    }
}
__device__ __forceinline__ void scan_pass2(unsigned char* ws, int l, LAS unsigned char* lds) {
    int tid_ = threadIdx.x; asm volatile("" : "+v"(tid_));
    const int tid = tid_, lane = tid & 63, seg = tid >> 6;
    const float* LC = (const float*)(ws + WS_LC) + l * 2048; const f32x2* SUM = (const f32x2*)(ws + WS_SUM); const f32x4* SEGS = (const f32x4*)(ws + WS_SEG);
    LAS f32x2* HF = (LAS f32x2*)lds;
    LAS f32x2* CAR = (LAS f32x2*)(lds + 131072);
    for (int item0 = blockIdx.x; item0 < 1024; item0 += 4 * gridDim.x) {
        { const int slot = seg >> 1, dir = seg & 1, item = item0 + slot * gridDim.x;
          if (item < 1024) { const int grp = item & 7, chunk = (item >> 3) & 63, b = item >> 9;
              const f32x4* sp = (const f32x4*)(SUM + ((size_t)((dir * 2 + b) * 64)) * 1024 + grp * 128 + 2 * lane);
              float h0 = 0.f, h1 = 0.f; const int nprev = dir ? 63 - chunk : chunk;
              for (int j0 = 0; j0 < nprev; j0 += 8) { f32x4 v[8];
#pragma unroll
                  for (int u = 0; u < 8; ++u) { const int jj = j0 + u; const int cj = dir ? 63 - jj : jj; const int cl = jj < nprev ? cj : chunk;
                      v[u] = sp[(size_t)cl * 512]; if (jj >= nprev) v[u] = (f32x4){1.f, 0.f, 1.f, 0.f}; }
#pragma unroll
                  for (int u = 0; u < 8; ++u) { h0 = v[u][0] * h0 + v[u][1]; h1 = v[u][2] * h1 + v[u][3]; } }
              CAR[seg * 64 + lane] = (f32x2){h0, h1}; } }
        __syncthreads();
#pragma unroll 1
        for (int slot = 0; slot < 4; ++slot) { const int item = item0 + slot * gridDim.x; if (item >= 1024) break;
            const int grp = item & 7, chunk = (item >> 3) & 63, b = item >> 9;
            const int ch = grp * 128 + 2 * lane;
            bf16_t* ZG = (bf16_t*)(ws + WS_ZG) + ((size_t)b * S + chunk * 256) * 1024 + ch;
#pragma unroll 1
            for (int dir = 0; dir < 2; ++dir) {
                const float l0 = LC[dir * 1024 + ch] * (1.f / 255.f), l1 = LC[dir * 1024 + ch + 1] * (1.f / 255.f);
                const bf16_t* U = (const bf16_t*)(ws + WS_U) + (size_t)dir * T * 1024 + ((size_t)b * S + chunk * 256) * 1024 + ch;
                const unsigned char* R = ws + WS_R + (size_t)dir * T * 1024 + ((size_t)b * S + chunk * 256) * 1024 + ch;
                float h0, h1; { const f32x2 c = CAR[(slot * 2 + dir) * 64 + lane]; h0 = c[0]; h1 = c[1]; }
                { const f32x4* sg = SEGS + ((size_t)(((dir * 2 + b) * 64 + chunk) * 8)) * 512 + grp * 64 + lane; f32x4 v[7];
#pragma unroll
                  for (int s = 0; s < 7; ++s) v[s] = sg[(size_t)s * 512];
#pragma unroll
                  for (int s = 0; s < 7; ++s) if (s < seg) { h0 = v[s][0] * h0 + v[s][1]; h1 = v[s][2] * h1 + v[s][3]; } }
#pragma unroll 1
                for (int kb = 0; kb < 2; ++kb) { unsigned uw16[16], rw16[16], gw16[16];
#pragma unroll
                    for (int u = 0; u < 16; ++u) { const int p = seg * 32 + kb * 16 + u, to = dir ? 255 - p : p;
                        uw16[u] = *(const unsigned*)(U + (size_t)to * 1024); rw16[u] = *(const unsigned short*)(R + (size_t)to * 1024);
                        gw16[u] = dir ? *(const unsigned*)(ZG + (size_t)to * 1024) : 0u; }
#pragma unroll
                    for (int u = 0; u < 16; ++u) { const int p = seg * 32 + kb * 16 + u, to = dir ? 255 - p : p; const unsigned uw = uw16[u], rw = rw16[u];
                        const float a0 = __expf(l0 * (float)(rw & 255u)), a1 = __expf(l1 * (float)(rw >> 8));
                        h0 = a0 * h0 + bflo(uw) * __builtin_sqrtf(1.f - a0 * a0); h1 = a1 * h1 + bfhi(uw) * __builtin_sqrtf(1.f - a1 * a1);
                        if (dir == 0) HF[to * 64 + lane] = (f32x2){h0, h1};
                        else { const f32x2 hf = HF[to * 64 + lane]; const unsigned gw = gw16[u];
                            *(unsigned*)(ZG + (size_t)to * 1024) = cvt_pk_bf16((hf[0] + h0) * gelu_(bflo(gw)), (hf[1] + h1) * gelu_(bfhi(gw))); } } }
                __syncthreads();
            }
        }
    }
}

#ifdef DBG
constexpr size_t WS_DBG = 70000;
__device__ __forceinline__ float bfv(const bf16_t* p) { return bflo((unsigned)*p); }
__device__ __forceinline__ float dotA(const bf16_t* arow, const float* W, int K, int N, int col) { float s = 0.f; for (int k = 0; k < K; ++k) s += bfv(arow + k) * W[(size_t)k * N + col]; return s; }
__device__ __forceinline__ void dbg_cmp(unsigned* dbg, unsigned code, float got, float ref, float tol_rel, float tol_abs) {
    const float e = fabsf(got - ref); if (!(e <= tol_rel * fabsf(ref) + tol_abs)) atomicMin(dbg, code); }
__device__ __forceinline__ void dbg_check(int stage, const float* const* tab, unsigned char* ws, float* X) {
    unsigned* dbg = (unsigned*)(ws + WS_DBG); const int t = blockIdx.x * 64 + threadIdx.x;
    int r = (int)(((long)t * 5273 + 17) % T); const bf16_t* XN = (const bf16_t*)(ws + WS_XN);
    { const int q = t >> 1; const int base = (q & 1) ? S : 0;
      if (t < 40) { const int k = q >> 1; const int off = (k == 0) ? 0 : (k == 1) ? 1 : (k == 2) ? 2 : (k == 3) ? 127 : (k == 4) ? 128 : (k == 5) ? 255 : (k == 6) ? 256 : (k == 7) ? S - 1 : (k == 8) ? S - 2 : S - 3; r = base + off; } }
    if (stage == 2) { const int c = (int)((long)t * 911 + 3) % FF; const float g = dotA(XN + (size_t)r * D, (in_ptr(tab, DBG_F ? 26 : 2) + (size_t)DBG_LAYER * (D*FF)), D, FF, c), u = dotA(XN + (size_t)r * D, (in_ptr(tab, DBG_F ? 27 : 3) + (size_t)DBG_LAYER * (D*FF)), D, FF, c);
        dbg_cmp(dbg, 2, bfv((const bf16_t*)(ws + WS_H) + (size_t)r * FF + c), g / (1.f + expf(-g)) * u, 0.03f, 0.03f); }
    if (stage == 3) { const int c = (int)((long)t * 911 + 3) % D; dbg_cmp(dbg, 3, bfv((const bf16_t*)(ws + WS_F) + (size_t)r * D + c), dotA((const bf16_t*)(ws + WS_H) + (size_t)r * FF, (in_ptr(tab, DBG_F ? 28 : 4) + (size_t)DBG_LAYER * (D*FF)), FF, D, c), 0.03f, 0.03f); }
    if (stage == 4) { const int c = (int)((long)t * 911 + 3) % D; const bf16_t* F = (const bf16_t*)(ws + WS_F) + (size_t)r * D; float ss = 0.f; for (int k = 0; k < D; ++k) ss += bfv(F + k) * bfv(F + k);
        const float* x0 = in_ptr(tab, 0) + (size_t)r * D; float s2 = 0.f;
        for (int k = 0; k < D; ++k) { const float xv = x0[k] + 0.5f * bfv(F + k) * rsqrtf(ss / D + EPS) * (in_ptr(tab, 5) + (size_t)DBG_LAYER * (D))[k]; s2 += xv * xv; if (k == c) dbg_cmp(dbg, 4, X[(size_t)r * D + c], xv, 0.001f, 0.001f); }
        dbg_cmp(dbg, 4, bfv(XN + (size_t)r * D + c), X[(size_t)r * D + c] * rsqrtf(s2 / D + EPS) * (in_ptr(tab, 6) + (size_t)DBG_LAYER * (D))[c], 0.01f, 0.01f); }
    if (stage == 5) { const int c = (int)((long)t * 911 + 3) % ZN; const float z = dotA(XN + (size_t)r * D, (in_ptr(tab, 7) + (size_t)DBG_LAYER * (D*DIN)), D, DIN, c); float got;
        if (c < 1024) got = bfv((const bf16_t*)(ws + WS_ZG) + (size_t)r * 1024 + c); else if (c < 2048) got = bfv((const bf16_t*)(ws + WS_ZX) + (size_t)r * 1024 + c - 1024);
        else if (c < 3584) got = bfv((const bf16_t*)(ws + WS_ZSC) + (size_t)r * 1536 + c - 2048); else got = bfv((const bf16_t*)(ws + WS_ZSGU) + (size_t)r * 1024 + c - 3584);
        dbg_cmp(dbg, 5, got, z, 0.03f, 0.03f); }
    if (stage == 6) { const int b = r / S, tt = r % S; const size_t rb = (size_t)b * S;
        { const int c = (int)((long)t * 911 + 3) % 1024; float o = (in_ptr(tab, 9) + (size_t)DBG_LAYER * (1024))[c]; for (int k = 0; k < 4; ++k) { const int q = tt + k - 2; if (q >= 0 && q < S) o += (in_ptr(tab, 8) + (size_t)DBG_LAYER * (4096))[k * 1024 + c] * bfv((const bf16_t*)(ws + WS_ZX) + (rb + q) * 1024 + c); }
          dbg_cmp(dbg, 6, bfv((const bf16_t*)(ws + WS_XC) + (size_t)r * 1024 + c), o, 0.02f, 0.02f); }
        { const int c = (int)((long)t * 911 + 3) % 512; const bf16_t* Z = (const bf16_t*)(ws + WS_ZSC); float o = 0.f; for (int k = 0; k < 3; ++k) { const int q = tt + k - 1; if (q >= 0 && q < S) o += (in_ptr(tab, 16) + (size_t)DBG_LAYER * (1536))[k * 512 + c] * bfv(Z + (rb + q) * 1536 + 512 + c) * bfv(Z + (rb + q) * 1536 + 1024 + c); }
          dbg_cmp(dbg, 7, bfv((const bf16_t*)(ws + WS_YBC) + (size_t)r * 1024 + c), o * bfv(Z + (size_t)r * 1536 + c), 0.02f, 0.02f); }
        { const int c = (int)((long)t * 911 + 3) % 512, g = c >> 7, p = tt & 127, t0 = tt - p; const bf16_t* Z = (const bf16_t*)(ws + WS_ZSGU); float mix = (in_ptr(tab, 21) + (size_t)DBG_LAYER * (512))[g * 128 + p];
          for (int q = 0; q < 128; ++q) { const bf16_t* vr = Z + (rb + t0 + q) * 1024 + 512; float mu = 0.f, var = 0.f; for (int k = 0; k < 512; ++k) mu += gelu_(bfv(vr + k)); mu /= 512.f;
              for (int k = 0; k < 512; ++k) { const float d = gelu_(bfv(vr + k)) - mu; var += d * d; } var /= 512.f;
              const float vn = (gelu_(bfv(vr + c)) - mu) * rsqrtf(var + EPS) * (in_ptr(tab, 18) + (size_t)DBG_LAYER * (512))[c] + (in_ptr(tab, 19) + (size_t)DBG_LAYER * (512))[c]; mix += (in_ptr(tab, 20) + (size_t)DBG_LAYER * (65536))[(size_t)g * 16384 + p * 128 + q] * vn; }
          dbg_cmp(dbg, 8, bfv((const bf16_t*)(ws + WS_YBC) + (size_t)r * 1024 + 512 + c), gelu_(bfv(Z + (size_t)r * 1024 + c)) * mix, 0.03f, 0.03f); } }
    if (stage == 9) { const int c = (int)((long)t * 911 + 3) % 1024, dir = t & 1, head = c >> 8, e = c & 255; const bf16_t* xr = (const bf16_t*)(ws + WS_XC) + (size_t)r * 1024 + head * 256;
        const float pa = dotA(xr, (in_ptr(tab, 10) + (size_t)DBG_LAYER * (524288)) + (size_t)(dir * 4 + head) * 65536, 256, 256, e) + (in_ptr(tab, 11) + (size_t)DBG_LAYER * (2048))[dir * 1024 + c], px = dotA(xr, (in_ptr(tab, 12) + (size_t)DBG_LAYER * (524288)) + (size_t)(dir * 4 + head) * 65536, 256, 256, e) + (in_ptr(tab, 13) + (size_t)DBG_LAYER * (2048))[dir * 1024 + c];
        const float rr = 1.f / (1.f + expf(-pa)), ii = 1.f / (1.f + expf(-px));
        dbg_cmp(dbg, 9, (float)*(ws + WS_R + (size_t)dir * T * 1024 + (size_t)r * 1024 + c), rr * 255.f, 0.02f, 1.5f);
        dbg_cmp(dbg, 10, bfv((const bf16_t*)(ws + WS_U) + (size_t)dir * T * 1024 + (size_t)r * 1024 + c), ii * bfv(xr + e), 0.03f, 0.03f); }
    if (stage == 11) { const int c = (int)((long)t * 911 + 3) % 1024, b = r / S, tt = r % S; const size_t rb = (size_t)b * S; const float* LC = (const float*)(ws + WS_LC) + DBG_LAYER * 2048; float hs = 0.f;
        for (int dir = 0; dir < 2; ++dir) { const bf16_t* U = (const bf16_t*)(ws + WS_U) + (size_t)dir * T * 1024; const unsigned char* R = ws + WS_R + (size_t)dir * T * 1024; float h = 0.f;
            if (dir == 0) { for (int q = 0; q <= tt; ++q) { const float a = expf(LC[c] * (float)R[(rb + q) * 1024 + c] / 255.f); h = a * h + bfv(U + (rb + q) * 1024 + c) * sqrtf(1.f - a * a); } }
            else { for (int q = S - 1; q >= tt; --q) { const float a = expf(LC[1024 + c] * (float)R[(rb + q) * 1024 + c] / 255.f); h = a * h + bfv(U + (rb + q) * 1024 + c) * sqrtf(1.f - a * a); } }
            hs += h; }
        const float gate = dotA(XN + (size_t)r * D, (in_ptr(tab, 7) + (size_t)DBG_LAYER * (D*DIN)), D, DIN, c);
        dbg_cmp(dbg, 11, bfv((const bf16_t*)(ws + WS_ZG) + (size_t)r * 1024 + c), hs * gelu_(gate), 0.03f, 0.03f); }
    if (stage == 10) { const int c = (int)((long)t * 911 + 3) % 1024; ((float*)(ws + WS_DBG + 1024))[t] = bfv((const bf16_t*)(ws + WS_ZG) + (size_t)r * 1024 + c); }
    if (stage == 12) { const int c = (int)((long)t * 911 + 3) % 3072; const float z = dotA(XN + (size_t)r * D, (in_ptr(tab, 7) + (size_t)DBG_LAYER * (D*DIN)), D, DIN, ZN + c);
        dbg_cmp(dbg, 12, bfv((const bf16_t*)(ws + WS_G) + (size_t)r * 3072 + c), 1.f / (1.f + expf(-z)), 0.02f, 0.01f); }
    if (stage == 13) { const int c = (int)((long)t * 911 + 3) % 1024; const bf16_t* G = (const bf16_t*)(ws + WS_G) + (size_t)r * 3072;
        const float ya = dotA((const bf16_t*)(ws + WS_ZG) + (size_t)r * 1024, (in_ptr(tab, 15) + (size_t)DBG_LAYER * (D*D)), 1024, 1024, c), yb = dotA((const bf16_t*)(ws + WS_YBC) + (size_t)r * 1024, (in_ptr(tab, 17) + (size_t)DBG_LAYER * (512*D)), 512, 1024, c), yc = dotA((const bf16_t*)(ws + WS_YBC) + (size_t)r * 1024 + 512, (in_ptr(tab, 22) + (size_t)DBG_LAYER * (512*D)), 512, 1024, c);
        dbg_cmp(dbg, 13, bfv((const bf16_t*)(ws + WS_MG) + (size_t)r * 1024 + c), bfv(G + c) * ya + bfv(G + 1024 + c) * yb + bfv(G + 2048 + c) * yc, 0.03f, 0.05f); }
    if (stage == 15) { const int c = (int)((long)t * 911 + 3) % D; float s2 = 0.f; for (int k = 0; k < D; ++k) s2 += X[(size_t)r * D + k] * X[(size_t)r * D + k];
        dbg_cmp(dbg, 15, bfv(XN + (size_t)r * D + c), X[(size_t)r * D + c] * rsqrtf(s2 / D + EPS) * (in_ptr(tab, DBG_G) + (size_t)DBG_GL * D)[c], 0.01f, 0.01f); }
    if (stage == 16) { const int c = (int)((long)t * 911 + 3) % D; const bf16_t* F = (const bf16_t*)(ws + WS_MX) + (size_t)r * D; float ss = 0.f; for (int k = 0; k < D; ++k) ss += bfv(F + k) * bfv(F + k);
        const float xb = X[(size_t)r * D + c];
        dbg_cmp(dbg, 16, ((const float*)(ws + WS_G))[(size_t)r * D + c], xb + bfv(F + c) * rsqrtf(ss / D + EPS) * (in_ptr(tab, 24) + (size_t)DBG_LAYER * D)[c], 0.001f, 0.001f); }
    if (stage == 17) { const int c = (int)((long)t * 911 + 3) % D; const bf16_t* F = (const bf16_t*)(ws + WS_F) + (size_t)r * D; float ss = 0.f; for (int k = 0; k < D; ++k) ss += bfv(F + k) * bfv(F + k);
        const float xb = X[(size_t)r * D + c];
        dbg_cmp(dbg, 17, ((const float*)(ws + WS_G))[(size_t)r * D + c], xb + 0.5f * bfv(F + c) * rsqrtf(ss / D + EPS) * (in_ptr(tab, 29) + (size_t)DBG_LAYER * D)[c], 0.001f, 0.001f); }
    if (stage == 14) { const int c = (int)((long)t * 911 + 3) % 1024; dbg_cmp(dbg, 14, bfv((const bf16_t*)(ws + WS_MX) + (size_t)r * 1024 + c), dotA((const bf16_t*)(ws + WS_MG) + (size_t)r * 1024, (in_ptr(tab, 23) + (size_t)DBG_LAYER * (D*D)), 1024, 1024, c), 0.03f, 0.03f); }
}
__global__ void __launch_bounds__(64) dbg_kernel(Args a, unsigned mask) {
    unsigned char* ws = a.ws; const float* const* tab = (const float* const*)(ws + WS_TAB);
    for (int st = 2; st <= 17; ++st) if ((mask >> st) & 1u) dbg_check(st, tab, ws, a.out);
}
__global__ void dbg_final(Args a) { const unsigned cde = *(volatile unsigned*)(a.ws + WS_DBG); a.out[0] = (cde != 99u) ? 1000.f + 100.f * (float)cde : 0.f; }
#define DBGCHK(st) do { if (l == DBG_LAYER && (st) == STOP_AT) return; } while (0)
#else
#define DBGCHK(st) do { } while (0)
#endif

__global__ void __launch_bounds__(NTHR, 2) fwd_kernel(Args a) {
    extern __shared__ __attribute__((aligned(16))) unsigned char lds_raw[];
    LAS unsigned char* lds = (LAS unsigned char*)lds_raw;
    cg::grid_group grid = cg::this_grid();
    unsigned char* ws = a.ws;
    { const float** tw = (const float**)(ws + WS_TAB);
      if (threadIdx.x == 0) {
#pragma unroll
          for (int i = 0; i < 30; ++i) tw[i] = a.in[i];
          volatile LAS unsigned* st = (volatile LAS unsigned*)(lds + LDS_BAR_ST); st[0] = 0u; st[1] = 0u;
          (void)xb_add((unsigned*)(ws + WS_BAR) + XB_XCNT(xb_xcc_id()), 1u);
          __threadfence(); }
      __syncthreads(); }
    const float* const* tab = (const float* const*)(ws + WS_TAB);
    const int G = gridDim.x, c = blockIdx.x;
    bf16_t* XN = (bf16_t*)(ws + WS_XN);
    float* X = a.out;
    unsigned char* const ws0 = ws; const int G0 = G, c0 = c; float* const X0 = X;
    constexpr int BIG = 1 << 28;

#ifdef SKEL
    { const float* xin = a.in[0]; for (size_t i = (size_t)blockIdx.x * NTHR + threadIdx.x; i < (size_t)T * D; i += (size_t)gridDim.x * NTHR) a.out[i] = xin[i];
      GSYNC();
#if SKEL >= 2
      convert_layer(tab, ws, 0, lds); GSYNC();
#endif
#if SKEL >= 3
      lc_all(tab, ws); GSYNC();
#endif
#if SKEL >= 4
      ew_phase<false>(in_ptr(tab, 0), X, nullptr, 0.f, nullptr, in_ptr(tab, 1), XN); GSYNC();
#endif
#if SKEL >= 5
      ew_phase<true>(X, X, (const bf16_t*)(ws + WS_F), 0.5f, in_ptr(tab, 5), in_ptr(tab, 6), XN); GSYNC();
#endif
#if SKEL >= 6
      convert_layer(tab, ws, 1, lds); GSYNC();
#endif
      return; }
#endif
#ifdef DBG
    if (blockIdx.x == 0 && threadIdx.x == 0) *(unsigned*)(ws + WS_DBG) = 99u;
#endif
    PH(0) { convert_layer(tab, ws, 0, lds); lc_all(tab, ws); }
    PH(1) ew_phase<false>(in_ptr(tab, 0), X, nullptr, 0.f, nullptr, in_ptr(tab, 1), XN);
    GSYNC_CG();
#ifdef DBG
    if (STOP_AT == 20) return;
#endif

#pragma unroll 1
    for (int l = 0; l < NLAYER_RUN; ++l) {
#pragma unroll 1
        for (int f = 0; f < 2; ++f) {
            unsigned long long wsv = (unsigned long long)ws0, xv = (unsigned long long)X0; int G = G0, c = c0;
#ifndef NOASM
            asm volatile("" : "+s"(wsv), "+s"(G), "+s"(c), "+s"(xv));
#endif
            unsigned char* ws = (unsigned char*)(GAS unsigned char*)wsv; float* X = (float*)(GAS float*)xv;
            const float* const* tab = (const float* const*)(ws + WS_TAB); bf16_t* XN = (bf16_t*)(ws + WS_XN);
            if (f == 1) {
                PH(2) { pg8::Gemm g{XN, XN, (const bf16_t*)(ws + W_IN), T, ZN, D, D, BIG, 0, 0}; pg8::StaticOrder So; So.init(T, ZN, G, c);
                  pg8::EpiBf<2> E{(bf16_t*)(ws + WS_ZG), 1024, (bf16_t*)(ws + WS_ZX), (bf16_t*)(ws + WS_ZSC), (bf16_t*)(ws + WS_ZSGU)};
                  pg8::gemm_phase<pg8::EpiBf<2>, true>(lds, g, So, E); }
                GSYNC();
                DBGCHK(5);
                PH(3) prep_phase(tab, ws, l, lds);
                GSYNC();
                DBGCHK(6);
                PH(4) { const bf16_t* XC = (const bf16_t*)(ws + WS_XC);
                  pg8::Gemm g{XC, XC, (const bf16_t*)(ws + W_LRU), T, 4096, 256, 1024, BIG, 2, 512}; pg8::StaticOrder So; So.init(T, 4096, G, c);
                  pg8::EpiGates E{XC, (bf16_t*)(ws + WS_U), ws + WS_R, in_ptr(tab, 11) + (size_t)l * 2048, in_ptr(tab, 13) + (size_t)l * 2048, (const float*)(ws + WS_LC)};
                  pg8::gemm_phase<pg8::EpiGates, true>(lds, g, So, E); }
                GSYNC();
                DBGCHK(9);
                PH(5) scan_pass1(ws, l, lds);
                GSYNC();
                PH(6) scan_pass2(ws, l, lds);
                GSYNC();
                DBGCHK(11);
                PH(7) { pg8::Gemm g{XN, XN, (const bf16_t*)(ws + W_IN) + (size_t)ZN * D, T, 3072, D, D, BIG, 0, 0}; pg8::StaticOrder So; So.init(T, 3072, G, c);
                  pg8::EpiBf<1> E{(bf16_t*)(ws + WS_G), 3072, nullptr, nullptr, nullptr};
                  pg8::gemm_phase<pg8::EpiBf<1>, true>(lds, g, So, E); }
                GSYNC();
                DBGCHK(12);
                PH(8) { pg8::Gemm g{(const bf16_t*)(ws + WS_ZG), (const bf16_t*)(ws + WS_YBC) - 16 * 64, (const bf16_t*)(ws + W_CAT), T, D, 2048, 1024, 16, 0, 0}; pg8::StaticOrder So; So.init(T, D, G, c);
                  pg8::EpiMerge E{(const bf16_t*)(ws + WS_G), (bf16_t*)(ws + WS_MG)};
                  pg8::gemm_phase<pg8::EpiMerge, true>(lds, g, So, E); }
                GSYNC();
                DBGCHK(13);
                PH(9) { const bf16_t* MG = (const bf16_t*)(ws + WS_MG);
                  pg8::Gemm g{MG, MG, (const bf16_t*)(ws + W_O), T, D, D, D, BIG, 0, 0}; pg8::StaticOrder So; So.init(T, D, G, c);
                  pg8::EpiBf<0> E{(bf16_t*)(ws + WS_MX), 1024, nullptr, nullptr, nullptr};
                  pg8::gemm_phase<pg8::EpiBf<0>, true>(lds, g, So, E); }
                GSYNC();
                DBGCHK(14);
#if defined(DBG) && STOP_AT == 21
                PH(10) ew_phase<true>(X, (float*)(ws + WS_G), (const bf16_t*)(ws + WS_MX), 1.f, in_ptr(tab, 24) + (size_t)l * D, in_ptr(tab, 25) + (size_t)l * D, XN);
#else
                PH(10) ew_phase<true>(X, X, (const bf16_t*)(ws + WS_MX), 1.f, in_ptr(tab, 24) + (size_t)l * D, in_ptr(tab, 25) + (size_t)l * D, XN);
#endif
                GSYNC();
                DBGCHK(21);
            }
            PH(11) { pg8::Gemm g{XN, XN, (const bf16_t*)(ws + (f ? W_UP2 : W_UP1)), T, 2 * FF, D, D, BIG, 0, 0}; pg8::StaticOrder So; So.init(T, 2 * FF, G, c);
              pg8::EpiSwiGLU E{(bf16_t*)(ws + WS_H), FF};
              pg8::gemm_phase<pg8::EpiSwiGLU, true>(lds, g, So, E); }
            GSYNC();
            if (f == DBG_F) DBGCHK(2);
            PH(12) { const bf16_t* H = (const bf16_t*)(ws + WS_H);
              pg8::Gemm g{H, H, (const bf16_t*)(ws + (f ? W_DN2 : W_DN1)), T, D, FF, FF, BIG, 0, 0}; pg8::StaticOrder So; So.init(T, D, G, c);
              pg8::EpiBf<0> E{(bf16_t*)(ws + WS_F), 1024, nullptr, nullptr, nullptr};
              pg8::gemm_phase<pg8::EpiBf<0>, true>(lds, g, So, E); }
            GSYNC();
            if (f == DBG_F) DBGCHK(3);
            if (f == 0) {
                ew_phase<true>(X, X, (const bf16_t*)(ws + WS_F), 0.5f, in_ptr(tab, 5) + (size_t)l * D, in_ptr(tab, 6) + (size_t)l * D, XN);
            } else {
                if (l + 1 < DEPTH) convert_layer(tab, ws, l + 1, lds);
#if defined(DBG) && STOP_AT == 22
                ew_phase<true>(X, (l == DBG_LAYER) ? (float*)(ws + WS_G) : X, (const bf16_t*)(ws + WS_F), 0.5f, in_ptr(tab, 29) + (size_t)l * D, (l + 1 < DEPTH) ? in_ptr(tab, 1) + (size_t)(l + 1) * D : nullptr, XN);
#else
                ew_phase<true>(X, X, (const bf16_t*)(ws + WS_F), 0.5f, in_ptr(tab, 29) + (size_t)l * D, (l + 1 < DEPTH) ? in_ptr(tab, 1) + (size_t)(l + 1) * D : nullptr, XN);
#endif
            }
            GSYNC();
            if (f == 0) DBGCHK(4);
            if (f == 1) DBGCHK(22);
        }
    }
}

extern "C" void kernel_launch(void* const* d_in, const int* in_sizes, int n_in, void* d_out, int out_size, void* d_ws, size_t ws_size, hipStream_t stream) {
    static int grid = 0;
    if (grid == 0) {
        if (n_in != 30 || in_sizes[0] != T * D || out_size != T * D || ws_size < WS_END) { fprintf(stderr, "kernel_launch: unexpected problem geometry (n_in %d, ws %zu)\n", n_in, ws_size); grid = -1; return; }
        int dev = 0, cus = 0, per_cu = 0;
        if (hipGetDevice(&dev) != hipSuccess || hipDeviceGetAttribute(&cus, hipDeviceAttributeMultiprocessorCount, dev) != hipSuccess) { grid = -1; return; }
        if (hipFuncSetAttribute((const void*)fwd_kernel, hipFuncAttributeMaxDynamicSharedMemorySize, LDS_BYTES) != hipSuccess) { fprintf(stderr, "kernel_launch: hipFuncSetAttribute failed\n"); grid = -1; return; }
        if (hipOccupancyMaxActiveBlocksPerMultiprocessor(&per_cu, (const void*)fwd_kernel, NTHR, LDS_BYTES) != hipSuccess || per_cu < 1) { fprintf(stderr, "kernel_launch: occupancy query failed (%d)\n", per_cu); (void)hipGetLastError(); grid = -1; return; }
        grid = cus * per_cu;
        if (T % (2 * grid * NWAVES) != 0) { fprintf(stderr, "kernel_launch: grid %d does not divide the row pairs of the norm phases\n", grid); grid = -1; return; }
    }
    if (grid < 0) return;
    Args a{};
    for (int i = 0; i < 30; ++i) a.in[i] = (const float*)d_in[i];
    a.out = (float*)d_out; a.ws = (unsigned char*)d_ws;
    if (hipMemsetAsync((char*)d_ws + WS_BAR, 0, 16384, stream) != hipSuccess) { fprintf(stderr, "kernel_launch: hipMemsetAsync failed\n"); return; }
    void* args[] = {&a};
    hipError_t e = hipLaunchCooperativeKernel((const void*)fwd_kernel, dim3(grid), dim3(NTHR), args, LDS_BYTES, stream);
    if (e != hipSuccess) fprintf(stderr, "kernel_launch: cooperative launch failed: %s (grid %d)\n", hipGetErrorString(e), grid);
#ifdef DBG
    dbg_kernel<<<128, 64, 0, stream>>>(a, (unsigned)DBG_MASK);
    dbg_final<<<1, 1, 0, stream>>>(a);
#endif
}
```

```cpp
#include <hip/hip_runtime.h>
#include <hip/hip_cooperative_groups.h>
#include <cstdio>
#include <cstdint>
namespace cg = cooperative_groups;

#define LAS __attribute__((address_space(3)))
typedef unsigned short bf16_t;
typedef short bf16x8 __attribute__((ext_vector_type(8)));
typedef float f32x4 __attribute__((ext_vector_type(4)));
typedef float f32x2 __attribute__((ext_vector_type(2)));
typedef unsigned u32x4 __attribute__((ext_vector_type(4)));
typedef unsigned u32x2 __attribute__((ext_vector_type(2)));

constexpr int NB = 2, S = 16384, T = NB * S, D = 1024, FF = 2816, DIN = 7680, ZN = 4608, DEPTH = 4;
constexpr float EPS = 1e-6f;
constexpr int NTHR = 512, NWAVES = 8;

constexpr size_t MiB = 1u << 20;
constexpr size_t WS_LC = 0;
constexpr size_t WS_TAB = 65536;
constexpr size_t WS_SUM = 1 * MiB;
constexpr size_t WS_W = 4 * MiB;
constexpr size_t W_UP1 = WS_W, W_DN1 = W_UP1 + 11 * MiB, W_IN = W_DN1 + 11 * MiB / 2, W_LRU = W_IN + 15 * MiB, W_CAT = W_LRU + 2 * MiB,
                 W_O = W_CAT + 4 * MiB, W_UP2 = W_O + 2 * MiB, W_DN2 = W_UP2 + 11 * MiB, W_END = W_DN2 + 11 * MiB / 2;
static_assert(W_END == 60 * MiB, "weight map");
constexpr size_t WS_XN = 60 * MiB;
constexpr size_t WS_ZG = 124 * MiB, WS_ZX = 188 * MiB, WS_ZSC = 252 * MiB, WS_ZSGU = 348 * MiB, WS_XC = 412 * MiB, WS_YBC = 476 * MiB, WS_END = 540 * MiB;
constexpr size_t WS_U = 188 * MiB, WS_R = 316 * MiB;
constexpr size_t WS_G = 188 * MiB;
constexpr size_t WS_SEG = 380 * MiB;
constexpr size_t WS_MG = 380 * MiB;
constexpr size_t WS_MX = 124 * MiB;
constexpr size_t WS_H = 124 * MiB;
constexpr size_t WS_F = 316 * MiB;

constexpr int LDS_BYTES = 147456;
#ifndef PHM
#define PHM 0xFFFF
#define NLAYER_RUN DEPTH
#define STOP_AT 11
#define DBG_MASK ((1u << 9) | (1u << 11))
#define DBG_LAYER 1
#define DBG_F 0
#define DBG_G 1
#define DBG_GL 0
#ifndef ABL
#define ABL 0
#endif
#endif
#define PH(b) if constexpr ((PHM >> (b)) & 1)
#define GSYNC_CG() do { asm volatile("s_waitcnt vmcnt(0)" ::: "memory"); __threadfence(); grid.sync(); } while (0)
#define GSYNC() xsync(ws, lds)

struct Args { const float* in[30]; float* out; unsigned char* ws; };

typedef _Float16 h16x2 __attribute__((ext_vector_type(2)));
typedef _Float16 h16x8 __attribute__((ext_vector_type(8)));
__device__ __forceinline__ unsigned cvt_pk_bf16(float lo, float hi) { h16x2 v; v.x = (_Float16)lo; v.y = (_Float16)hi; return __builtin_bit_cast(unsigned, v); }
__device__ __forceinline__ float bflo(unsigned u) { return (float)__builtin_bit_cast(h16x2, u).x; }
__device__ __forceinline__ float bfhi(unsigned u) { return (float)__builtin_bit_cast(h16x2, u).y; }
__device__ __forceinline__ float h8(const u32x4& v, int j) { const unsigned w = (j >> 1) == 0 ? v.x : (j >> 1) == 1 ? v.y : (j >> 1) == 2 ? v.z : v.w; return (j & 1) ? bfhi(w) : bflo(w); }
__device__ __forceinline__ float rcpf_(float x) { return __builtin_amdgcn_rcpf(x); }
__device__ __forceinline__ float sigm(float x) { return rcpf_(1.f + __expf(-x)); }
__device__ __forceinline__ float silu_(float x) { return x * sigm(x); }
__device__ __forceinline__ float gelu_(float x) { const float u = 1.5957691216057308f * (x + 0.044715f * x * x * x); return x * sigm(u); }
#define GAS __attribute__((address_space(1)))
__device__ __forceinline__ const float* in_ptr(const float* const* tab, int i) {
    unsigned long long v = *(const unsigned long long*)(tab + i);
    const unsigned lo = __builtin_amdgcn_readfirstlane((unsigned)v), hi = __builtin_amdgcn_readfirstlane((unsigned)(v >> 32));
    v = ((unsigned long long)hi << 32) | lo;
    return (const float*)(GAS const float*)v;
}
__device__ __forceinline__ float wave_sum(float v, int lane) {
#pragma unroll
    for (int o = 1; o < 64; o <<= 1) v += __int_as_float(__builtin_amdgcn_ds_bpermute((lane ^ o) << 2, __float_as_int(v)));
    return v;
}

constexpr size_t WS_BAR = 131072;
constexpr int LDS_BAR_ST = LDS_BYTES - 64;
#define XB_TMO      128
#define XB_XCNT(j)  (256  + 64 * (j))
#define XB_XSUB(j)  (1280 + 64 * (j))
#define XB_XGEN(j)  (2304 + 64 * (j))
#define XB_TOP      3328
#define XB_TOPGEN   3392
#define XCD_BAR_WORDS 3456
#define XB_SPIN_CAP (1u << 20)
__device__ __forceinline__ unsigned xb_ld(unsigned* p)              { return __hip_atomic_load(p, __ATOMIC_RELAXED, __HIP_MEMORY_SCOPE_AGENT); }
__device__ __forceinline__ unsigned xb_add(unsigned* p, unsigned v) { return __hip_atomic_fetch_add(p, v, __ATOMIC_RELAXED, __HIP_MEMORY_SCOPE_AGENT); }
__device__ __forceinline__ unsigned xb_xcc_id() { return (unsigned)__builtin_amdgcn_s_getreg((3 << 11) | 20) & 0xFu; }
#define XB_SPIN(cond, bar) do { unsigned _sp = 0; while (cond) { __builtin_amdgcn_s_sleep(1); \
    if ((++_sp & 255u) == 0u) { if (xb_ld(&(bar)[XB_TMO])) break; if (_sp > XB_SPIN_CAP) { atomicAdd(&(bar)[XB_TMO], 1u); break; } } } } while (0)
__device__ __forceinline__ void xcd_barrier_complete(unsigned* bar, unsigned x, unsigned& nloc, unsigned& nx) {
    const unsigned G = gridDim.x * gridDim.y * gridDim.z;
    unsigned sum, cnt, mine, sp = 0u;
    for (;;) {
        sum = 0u; cnt = 0u; mine = 0u;
#pragma unroll
        for (unsigned j = 0; j < 16; ++j) { const unsigned c = xb_ld(&bar[XB_XCNT(j)]); sum += c; cnt += (c > 0u) ? 1u : 0u; mine = (j == x) ? c : mine; }
        if (sum == G) break;
        __builtin_amdgcn_s_sleep(1);
        if ((++sp & 255u) == 0u) { if (xb_ld(&bar[XB_TMO])) break; if (sp > XB_SPIN_CAP) { atomicAdd(&bar[XB_TMO], 1u); break; } }
    }
    nloc = mine > 0u ? mine : 1u; nx = cnt > 0u ? cnt : 1u;
}
__device__ __forceinline__ void xsync(unsigned char* ws, LAS unsigned char* lds) {
    asm volatile("s_waitcnt vmcnt(0)" ::: "memory");
    __syncthreads();
    if (threadIdx.x == 0) {
        unsigned* bar = (unsigned*)(ws + WS_BAR); const unsigned x = xb_xcc_id();
        volatile LAS unsigned* st = (volatile LAS unsigned*)(lds + LDS_BAR_ST);
        __builtin_amdgcn_s_waitcnt(0);
        unsigned nloc = st[0], nx = st[1];
        if (nloc == 0u) { xcd_barrier_complete(bar, x, nloc, nx); st[0] = nloc; st[1] = nx; }
        const unsigned old = xb_add(&bar[XB_XSUB(x)], 1u);
        const unsigned gen = old / nloc;
        if (old + 1u == (gen + 1u) * nloc) {
            __builtin_amdgcn_fence(__ATOMIC_RELEASE, "agent");
            asm volatile("s_waitcnt vmcnt(0)" ::: "memory");
            const unsigned og = xb_add(&bar[XB_TOP], 1u);
            const unsigned tg = og / nx;
            if (og + 1u == (tg + 1u) * nx) xb_add(&bar[XB_TOPGEN], 1u);
            else XB_SPIN(xb_ld(&bar[XB_TOPGEN]) == tg, bar);
            __builtin_amdgcn_fence(__ATOMIC_ACQUIRE, "agent");
            xb_add(&bar[XB_XGEN(x)], 1u);
            asm volatile("s_waitcnt vmcnt(0)" ::: "memory");
        } else {
            XB_SPIN(xb_ld(&bar[XB_XGEN(x)]) == gen, bar);
            __builtin_amdgcn_fence(__ATOMIC_ACQUIRE, "agent");
            asm volatile("s_waitcnt vmcnt(0)" ::: "memory");
        }
    }
    __syncthreads();
}

namespace pg8 {
constexpr int BM = 256, BK = 64, HALF = 128, HTB = HALF * BK * 2, STAGE_BYTES = 8 * HTB, NXCD = 8, WGM = 8;
__host__ __device__ __forceinline__ int lds_byte(int r, int c) { const int st = (r >> 4) * 2 + (c >> 5), rr = r & 15, cc = c & 31, ob = rr * 64 + cc * 2; return st * 1024 + (ob ^ (((ob >> 9) & 1) << 5)); }
__host__ __device__ __forceinline__ void stage_rc(int b, int& R, int& C) { const int st = b / 1024, sb = b % 1024, swz = sb ^ (((sb >> 9) & 1) << 5); R = (st >> 1) * 16 + swz / 64; C = (st & 1) * 32 + (swz % 64) / 2; }
__host__ __device__ __forceinline__ int perm32(int rho) { const int n = rho >> 4, i = rho & 15; return 8 * (i >> 2) + 4 * n + (i & 3); }

struct Unit { int pm, pn; };
struct Gemm { const bf16_t* A; const bf16_t* A2; const bf16_t* Bt; int M, N, K, lda, ksplit, apn_shift, apn_bytes; };

struct StaticOrder {
    int nM, nN, nwg, G, c;
    __device__ void init(int M, int N, int G_, int c_) { nM = M / BM; nN = N / BM; nwg = nM * nN; G = G_; c = c_; }
    __device__ bool next(int i, Unit& u) const {
        const long L = (long)i * G + c; if (L >= nwg) return false;
        int wgid = (int)L; { const int q = nwg / NXCD, r = nwg % NXCD, xcd = wgid % NXCD, off = wgid / NXCD; wgid = (xcd < r ? xcd * (q + 1) : r * (q + 1) + (xcd - r) * q) + off; }
        const int nig = WGM * nN, gid = wgid / nig, fm = gid * WGM, gsz = (nM - fm) < WGM ? (nM - fm) : WGM;
        u.pm = fm + ((wgid % nig) % gsz); u.pn = (wgid % nig) / gsz; return true;
    }
};

template <class Epi, bool ALIGN_EPI>
__device__ __forceinline__ void gemm_phase(LAS unsigned char* lds, const Gemm g, const StaticOrder& S, const Epi& E) {
    int tid_ = threadIdx.x; asm volatile("" : "+v"(tid_));
    const int tid = tid_, wid = __builtin_amdgcn_readfirstlane(tid >> 6), lane = tid & 63, wr = wid >> 2, wc = wid & 3, fr = lane & 15, fq = lane >> 4;
    const int K = g.K, nt = K / BK, lda = g.lda;
    unsigned voffA[2], voffB[2];
#pragma unroll
    for (int i = 0; i < 2; ++i) { int R, C; stage_rc(tid * 16 + i * 8192, R, C); const int Rb = Epi::PERM ? ((R & ~31) + perm32(R & 31)) : R;
        voffA[i] = (unsigned)(R * lda + C) * 2u; voffB[i] = (unsigned)(Rb * K + C) * 2u; }
    const size_t kstep = (size_t)(BK * 2);
    const size_t hstepA = (size_t)HALF * lda * 2, tstepA = 2 * hstepA;
    const size_t hstepB = (size_t)HALF * K * 2, tstepB = 2 * hstepB;
    const unsigned ldsw = (unsigned)wid * 1024u;
    const int aoff = lds_byte(wr * 64 + fr, fq * 8), boff = lds_byte(wc * 32 + fr, fq * 8);
#define PG8_SA(b, h) (((b) * 2 + (h)) * HTB)
#define PG8_SB(b, h) ((4 + (b) * 2 + (h)) * HTB)
#define PG8_STAGE(bufoff, gbase, voff) do { _Pragma("unroll") for (int _i = 0; _i < 2; ++_i) \
        __builtin_amdgcn_global_load_lds((const unsigned*)((const char*)(gbase) + (voff)[_i]), (LAS unsigned*)(lds + (bufoff) + ldsw + _i * 8192), 16, 0, 0); } while (0)
#define PG8_LDA(dst, b, h) do { _Pragma("unroll") for (int m = 0; m < 4; ++m) _Pragma("unroll") for (int k = 0; k < 2; ++k) dst[m][k] = *(const LAS bf16x8*)(lds + PG8_SA(b, h) + aoff + m * 2048 + k * 1024); } while (0)
#define PG8_LDB(dst, b, h) do { _Pragma("unroll") for (int n = 0; n < 2; ++n) _Pragma("unroll") for (int k = 0; k < 2; ++k) dst[n][k] = *(const LAS bf16x8*)(lds + PG8_SB(b, h) + boff + n * 2048 + k * 1024); } while (0)
#define PG8_MMA(ai, bj, At, Bt) do { __builtin_amdgcn_s_setprio(1); _Pragma("unroll") for (int m = 0; m < 4; ++m) _Pragma("unroll") for (int n = 0; n < 2; ++n) _Pragma("unroll") for (int k = 0; k < 2; ++k) \
        acc[ai][bj][m][n] = __builtin_amdgcn_mfma_f32_16x16x32_f16(__builtin_bit_cast(h16x8, Bt[n][k]), __builtin_bit_cast(h16x8, At[m][k]), acc[ai][bj][m][n], 0, 0, 0); __builtin_amdgcn_s_setprio(0); } while (0)
#define PG8_WAIT_V(n) asm volatile("s_waitcnt vmcnt(" #n ")" ::: "memory")
#define PG8_WAIT_L(n) asm volatile("s_waitcnt lgkmcnt(" #n ")" ::: "memory")
#define PG8_BAR __builtin_amdgcn_s_barrier()
#define PG8_SCHED __builtin_amdgcn_sched_barrier(0)
    Unit cur, nxt; int ui = 0;
    if (!S.next(0, cur)) return;
    f32x4 acc[2][2][4][2];
#pragma unroll
    for (int a = 0; a < 2; ++a)
#pragma unroll
        for (int b = 0; b < 2; ++b)
#pragma unroll
            for (int m = 0; m < 4; ++m)
#pragma unroll
                for (int n = 0; n < 2; ++n) acc[a][b][m][n] = (f32x4){0.f, 0.f, 0.f, 0.f};
    bf16x8 At[4][2], B0[2][2], B1[2][2];
    const char* cA = (const char*)g.A + (size_t)cur.pm * tstepA + (size_t)(cur.pn >> g.apn_shift) * g.apn_bytes;
    const char* cA2 = (const char*)g.A2 + (size_t)cur.pm * tstepA;
    const char* cB = (const char*)g.Bt + (size_t)cur.pn * tstepB;
    PG8_STAGE(PG8_SB(0, 0), cB, voffB); PG8_STAGE(PG8_SB(0, 1), cB + hstepB, voffB); PG8_STAGE(PG8_SA(0, 0), cA, voffA); PG8_STAGE(PG8_SA(0, 1), cA + hstepA, voffA);
    if (wr == 1) PG8_BAR;
    PG8_WAIT_V(2); PG8_BAR;
    PG8_STAGE(PG8_SB(1, 0), cB + kstep, voffB); PG8_STAGE(PG8_SA(1, 0), cA + kstep, voffA); PG8_STAGE(PG8_SB(1, 1), cB + hstepB + kstep, voffB);
    PG8_WAIT_V(6); PG8_BAR;
    for (;;) {
        const bool has_next = S.next(ui + 1, nxt);
        const char* nA = has_next ? (const char*)g.A + (size_t)nxt.pm * tstepA + (size_t)(nxt.pn >> g.apn_shift) * g.apn_bytes : cA;
        const char* nA2 = has_next ? (const char*)g.A2 + (size_t)nxt.pm * tstepA : cA2;
        const char* nB = has_next ? (const char*)g.Bt + (size_t)nxt.pn * tstepB : cB;
        for (int t = 0; t < nt; t += 2) {
            const bool last = (t == nt - 2);
            const char* a1 = ((t < g.ksplit) ? cA : cA2) + (size_t)(t + 1) * kstep;
            const char* a2 = last ? nA : ((t + 2 < g.ksplit) ? cA : cA2) + (size_t)(t + 2) * kstep;
            const char* b2 = last ? nB : cB + (size_t)(t + 2) * kstep;
            const char* a3 = a2 + kstep; const char* b3 = b2 + kstep;
            if constexpr (Epi::HOOK) { if (t == g.ksplit || t == g.ksplit + 8) E.hook(acc, cur, (t - g.ksplit) >> 3, wr, wc, fr, fq); }
            PG8_LDB(B0, 0, 0); PG8_LDB(B1, 0, 1); PG8_SCHED; PG8_LDA(At, 0, 0); PG8_STAGE(PG8_SA(1, 1), a1 + hstepA, voffA);
            PG8_WAIT_V(8); PG8_WAIT_L(0); PG8_BAR; PG8_MMA(0, 0, At, B0); PG8_MMA(0, 1, At, B1); PG8_BAR; PG8_SCHED;
            PG8_LDA(At, 0, 1); PG8_STAGE(PG8_SB(0, 0), b2, voffB); PG8_STAGE(PG8_SB(0, 1), b2 + hstepB, voffB); PG8_STAGE(PG8_SA(0, 0), a2, voffA);
            PG8_WAIT_V(8); PG8_WAIT_L(0); PG8_BAR; PG8_MMA(1, 0, At, B0); PG8_MMA(1, 1, At, B1); PG8_BAR; PG8_SCHED;
            PG8_LDB(B0, 1, 0); PG8_LDB(B1, 1, 1); PG8_SCHED; PG8_LDA(At, 1, 0); PG8_STAGE(PG8_SA(0, 1), a2 + hstepA, voffA);
            PG8_WAIT_V(8); PG8_WAIT_L(0); PG8_BAR; PG8_MMA(0, 0, At, B0); PG8_MMA(0, 1, At, B1); PG8_BAR; PG8_SCHED;
            PG8_LDA(At, 1, 1); PG8_STAGE(PG8_SB(1, 0), b3, voffB); PG8_STAGE(PG8_SB(1, 1), b3 + hstepB, voffB); PG8_STAGE(PG8_SA(1, 0), a3, voffA);
            PG8_WAIT_V(8); PG8_WAIT_L(0); PG8_BAR; PG8_MMA(1, 0, At, B0); PG8_MMA(1, 1, At, B1); PG8_BAR; PG8_SCHED;
        }
        if constexpr (ALIGN_EPI) { if (wr == 0) PG8_BAR; }
        E(acc, cur, wr, wc, fr, fq);
        if (!has_next) break;
#pragma unroll
        for (int a = 0; a < 2; ++a)
#pragma unroll
            for (int b = 0; b < 2; ++b)
#pragma unroll
                for (int m = 0; m < 4; ++m)
#pragma unroll
                    for (int n = 0; n < 2; ++n) acc[a][b][m][n] = (f32x4){0.f, 0.f, 0.f, 0.f};
        cur = nxt; cA = nA; cA2 = nA2; cB = nB; ++ui;
        if constexpr (ALIGN_EPI) { if (wr == 1) PG8_BAR; }
    }
    PG8_WAIT_V(0);
    if constexpr (!ALIGN_EPI) { if (wr == 0) PG8_BAR; }
    PG8_BAR;
#undef PG8_SA
#undef PG8_SB
#undef PG8_STAGE
#undef PG8_LDA
#undef PG8_LDB
#undef PG8_MMA
#undef PG8_WAIT_V
#undef PG8_WAIT_L
#undef PG8_BAR
#undef PG8_SCHED
}

template <int MODE> struct EpiBf {
    static constexpr bool PERM = true, HOOK = false;
    bf16_t* O; int ldc; bf16_t* O1; bf16_t* O2; bf16_t* O3;
    __device__ __forceinline__ void operator()(const f32x4 (&acc)[2][2][4][2], const Unit& u, int wr, int wc, int fr, int fq) const {
        bf16_t* base = O; int ld = ldc; int colt = u.pn * BM;
        if (MODE == 2) { const int pn = u.pn;
            if (pn < 4) { base = O; ld = 1024; colt = pn * 256; } else if (pn < 8) { base = O1; ld = 1024; colt = (pn - 4) * 256; }
            else if (pn < 14) { base = O2; ld = 1536; colt = (pn - 8) * 256; } else { base = O3; ld = 1024; colt = (pn - 14) * 256; } }
        const int row0 = u.pm * BM + wr * 64 + fr, col0 = colt + wc * 32 + 8 * fq;
#pragma unroll
        for (int ai = 0; ai < 2; ++ai)
#pragma unroll
            for (int m = 0; m < 4; ++m) { bf16_t* rowp = base + (size_t)(row0 + ai * HALF + m * 16) * ld + col0;
#pragma unroll
                for (int bj = 0; bj < 2; ++bj) { f32x4 v0 = acc[ai][bj][m][0], v1 = acc[ai][bj][m][1];
                    if (MODE == 1) {
#pragma unroll
                        for (int j = 0; j < 4; ++j) { v0[j] = sigm(v0[j]); v1[j] = sigm(v1[j]); } }
                    u32x4 w; w.x = cvt_pk_bf16(v0[0], v0[1]); w.y = cvt_pk_bf16(v0[2], v0[3]); w.z = cvt_pk_bf16(v1[0], v1[1]); w.w = cvt_pk_bf16(v1[2], v1[3]);
                    *(u32x4*)(rowp + bj * HALF) = w; } }
    }
};
struct EpiSwiGLU {
    static constexpr bool PERM = true, HOOK = false;
    bf16_t* O; int ldc;
    __device__ __forceinline__ void operator()(const f32x4 (&acc)[2][2][4][2], const Unit& u, int wr, int wc, int fr, int fq) const {
        const int row0 = u.pm * BM + wr * 64 + fr, col0 = u.pn * HALF + wc * 32 + 8 * fq;
#pragma unroll
        for (int ai = 0; ai < 2; ++ai)
#pragma unroll
            for (int m = 0; m < 4; ++m) { bf16_t* rowp = O + (size_t)(row0 + ai * HALF + m * 16) * ldc + col0;
                f32x4 h0, h1;
#pragma unroll
                for (int j = 0; j < 4; ++j) { h0[j] = silu_(acc[ai][0][m][0][j]) * acc[ai][1][m][0][j]; h1[j] = silu_(acc[ai][0][m][1][j]) * acc[ai][1][m][1][j]; }
                u32x4 w; w.x = cvt_pk_bf16(h0[0], h0[1]); w.y = cvt_pk_bf16(h0[2], h0[3]); w.z = cvt_pk_bf16(h1[0], h1[1]); w.w = cvt_pk_bf16(h1[2], h1[3]);
                *(u32x4*)rowp = w; }
    }
};
struct EpiMerge {
    static constexpr bool PERM = true, HOOK = true;
    const bf16_t* G; bf16_t* O;
    __device__ __forceinline__ void hook(f32x4 (&acc)[2][2][4][2], const Unit& u, int which, int wr, int wc, int fr, int fq) const {
        int row0 = u.pm * BM + wr * 64 + fr, col0 = u.pn * BM + wc * 32 + 8 * fq + which * 1024;
        asm volatile("" : "+v"(row0), "+v"(col0));
        u32x4 cur[4], nxt[4];
#define MRG_LD(dst, q) do { const bf16_t* gp_ = G + (size_t)(row0 + ((q) >> 2) * HALF + ((q) & 3) * 16) * 3072 + col0; \
        dst[0] = *(const u32x4*)gp_; dst[1] = *(const u32x4*)(gp_ + 1024); dst[2] = *(const u32x4*)(gp_ + HALF); dst[3] = *(const u32x4*)(gp_ + 1024 + HALF); } while (0)
        MRG_LD(cur, 0);
#pragma unroll
        for (int q = 0; q < 8; ++q) { const int ai = q >> 2, m = q & 3;
            if (q < 7) MRG_LD(nxt, q + 1);
            asm volatile("" ::: "memory");
#pragma unroll
            for (int n = 0; n < 2; ++n) { f32x4 r0, r1;
#pragma unroll
                for (int j = 0; j < 4; ++j) { r0[j] = h8(cur[0], 4 * n + j) * rcpf_(h8(cur[1], 4 * n + j)); r1[j] = h8(cur[2], 4 * n + j) * rcpf_(h8(cur[3], 4 * n + j)); }
                acc[ai][0][m][n] *= r0; acc[ai][1][m][n] *= r1; }
            if (q < 7) { cur[0] = nxt[0]; cur[1] = nxt[1]; cur[2] = nxt[2]; cur[3] = nxt[3]; }
            asm volatile("" ::: "memory"); }
#undef MRG_LD
    }
    __device__ __forceinline__ void operator()(const f32x4 (&acc)[2][2][4][2], const Unit& u, int wr, int wc, int fr, int fq) const {
        const int row0 = u.pm * BM + wr * 64 + fr, col0 = u.pn * BM + wc * 32 + 8 * fq;
        u32x4 cur[2], nxt[2];
#define MRG_LD2(dst, q) do { const bf16_t* gp_ = G + (size_t)(row0 + ((q) >> 2) * HALF + ((q) & 3) * 16) * 3072 + 2048 + col0; dst[0] = *(const u32x4*)gp_; dst[1] = *(const u32x4*)(gp_ + HALF); } while (0)
        MRG_LD2(cur, 0);
#pragma unroll
        for (int q = 0; q < 8; ++q) { const int ai = q >> 2, m = q & 3; const size_t r = (size_t)(row0 + ai * HALF + m * 16);
            if (q < 7) MRG_LD2(nxt, q + 1);
            asm volatile("" ::: "memory");
#pragma unroll
            for (int bj = 0; bj < 2; ++bj) { const u32x4 gc = cur[bj]; const f32x4 v0 = acc[ai][bj][m][0], v1 = acc[ai][bj][m][1];
                u32x4 w; w.x = cvt_pk_bf16(v0[0] * bflo(gc.x), v0[1] * bfhi(gc.x)); w.y = cvt_pk_bf16(v0[2] * bflo(gc.y), v0[3] * bfhi(gc.y));
                w.z = cvt_pk_bf16(v1[0] * bflo(gc.z), v1[1] * bfhi(gc.z)); w.w = cvt_pk_bf16(v1[2] * bflo(gc.w), v1[3] * bfhi(gc.w));
                *(u32x4*)(O + r * 1024 + col0 + bj * HALF) = w; }
            if (q < 7) { cur[0] = nxt[0]; cur[1] = nxt[1]; }
            asm volatile("" ::: "memory"); }
#undef MRG_LD2
    }
};
struct EpiGates {
    static constexpr bool PERM = true, HOOK = false;
    const bf16_t* XC; bf16_t* U; unsigned char* R; const float* ba; const float* bx; const float* lc;
    __device__ __forceinline__ void operator()(const f32x4 (&acc)[2][2][4][2], const Unit& u, int wr, int wc, int fr, int fq) const {
        const int d = u.pn & 1;
        int ch0 = 128 * (u.pn >> 1) + 32 * wc + 8 * fq, row0 = u.pm * BM + wr * 64 + fr;
        asm volatile("" : "+v"(row0), "+v"(ch0));
        char* Ud = (char*)(U + (size_t)d * T * 1024); unsigned char* Rd = R + (size_t)d * T * 1024;
        const float* bad = ba + d * 1024 + ch0; const float* bxd = bx + d * 1024 + ch0;
#pragma unroll
        for (int ai = 0; ai < 2; ++ai) {
            u32x4 xw4[4];
#pragma unroll
            for (int q = 0; q < 4; ++q) xw4[q] = *(const u32x4*)((const char*)XC + (size_t)(((unsigned)(row0 + ai * HALF + q * 16) * 1024u + (unsigned)ch0) * 2u));
#pragma unroll
            for (int m = 0; m < 4; ++m) { const unsigned off = (unsigned)(row0 + ai * HALF + m * 16) * 1024u + (unsigned)ch0;
                const u32x4 xw = xw4[m];
                float uv[8]; unsigned rq[2] = {0u, 0u};
#pragma unroll
                for (int n = 0; n < 2; ++n) { const f32x4 ba4 = *(const f32x4*)(bad + 4 * n), bx4 = *(const f32x4*)(bxd + 4 * n);
#pragma unroll
                    for (int j = 0; j < 4; ++j) { const float rr = sigm(acc[ai][0][m][n][j] + ba4[j]), ig = sigm(acc[ai][1][m][n][j] + bx4[j]);
                        uv[4 * n + j] = ig * h8(xw, 4 * n + j);
                        rq[n] |= ((unsigned)__builtin_rintf(rr * 255.f)) << (8 * j); } }
                u32x4 w; w.x = cvt_pk_bf16(uv[0], uv[1]); w.y = cvt_pk_bf16(uv[2], uv[3]); w.z = cvt_pk_bf16(uv[4], uv[5]); w.w = cvt_pk_bf16(uv[6], uv[7]);
                *(u32x4*)(Ud + (size_t)(off * 2u)) = w;
                u32x2 rw; rw.x = rq[0]; rw.y = rq[1];
                *(u32x2*)(Rd + (size_t)off) = rw;
                asm volatile("" ::: "memory"); } }
    }
};
}

__device__ __forceinline__ int w_rowmap(int mode, int n, int p0) {
    if (mode == 0) return n;
    if (mode == 1) return 256 * (n >> 7) + p0 + (n & 127);
    const int dir = p0 >> 3, head = (p0 >> 1) & 3, ri = p0 & 1, ch = 256 * head + n;
    return 256 * (2 * (ch >> 7) + dir) + 128 * ri + (ch & 127);
}
__device__ __forceinline__ void tr_item(const float* W, int N, int item, bf16_t* WT, int ldk, int koff, int mode, int p0, LAS float* scr, int lane) {
    const int nblk = N / 32, kb = item / nblk, nb = item % nblk, k0 = 64 * kb, n0 = 32 * nb;
    float wv[32];
#pragma unroll
    for (int i = 0; i < 32; ++i) { const int kk = 2 * i + (lane >> 5); wv[i] = W[(size_t)(k0 + kk) * N + n0 + (lane & 31)]; }
#pragma unroll
    for (int i = 0; i < 32; ++i) { const int kk = 2 * i + (lane >> 5); scr[kk * 33 + (lane & 31)] = wv[i]; }
    asm volatile("s_waitcnt lgkmcnt(0)" ::: "memory");
    const int c = lane & 7;
#pragma unroll
    for (int j = 0; j < 4; ++j) { const int nn = (lane >> 3) + 8 * j; const LAS float* s = scr + (8 * c) * 33 + nn;
        u32x4 o; o.x = cvt_pk_bf16(s[0 * 33], s[1 * 33]); o.y = cvt_pk_bf16(s[2 * 33], s[3 * 33]); o.z = cvt_pk_bf16(s[4 * 33], s[5 * 33]); o.w = cvt_pk_bf16(s[6 * 33], s[7 * 33]);
        *(u32x4*)(WT + (size_t)w_rowmap(mode, n0 + nn, p0) * ldk + koff + k0 + 8 * c) = o; }
    asm volatile("s_waitcnt lgkmcnt(0)" ::: "memory");
}
__device__ __forceinline__ void convert_layer(const float* const* tab, unsigned char* ws, int l, LAS unsigned char* lds) {
    int tid_ = threadIdx.x; asm volatile("" : "+v"(tid_));
    const int tid = tid_, lane = tid & 63, wave = tid >> 6;
    LAS float* scr = (LAS float*)(lds + wave * 8448);
    const int gw = blockIdx.x * NWAVES + wave, NGW = gridDim.x * NWAVES;
    constexpr int I_UP = 16 * 88, I_DN = 44 * 32, I_IN = 16 * 240, I_LRU = 256, I_SQ = 512, I_HALF = 256;
    constexpr int NITEMS = 6 * I_UP + I_IN + 2 * I_LRU + 2 * I_SQ + 2 * I_HALF;
    const size_t oUP = (size_t)l * D * FF, oSQ = (size_t)l * D * D, oHF = (size_t)l * 512 * D, oLRU = (size_t)l * 2 * 4 * 256 * 256;
    for (int it = gw; it < NITEMS; it += NGW) {
        int r = it;
        if (r < I_UP) { tr_item(in_ptr(tab, 2) + oUP, FF, r, (bf16_t*)(ws + W_UP1), 1024, 0, 1, 0, scr, lane); continue; } r -= I_UP;
        if (r < I_UP) { tr_item(in_ptr(tab, 3) + oUP, FF, r, (bf16_t*)(ws + W_UP1), 1024, 0, 1, 128, scr, lane); continue; } r -= I_UP;
        if (r < I_DN) { tr_item(in_ptr(tab, 4) + oUP, D, r, (bf16_t*)(ws + W_DN1), FF, 0, 0, 0, scr, lane); continue; } r -= I_DN;
        if (r < I_IN) { tr_item(in_ptr(tab, 7) + (size_t)l * D * DIN, DIN, r, (bf16_t*)(ws + W_IN), 1024, 0, 0, 0, scr, lane); continue; } r -= I_IN;
        if (r < I_LRU) { const int mat = r >> 5; tr_item(in_ptr(tab, 10) + oLRU + (size_t)mat * 65536, 256, r & 31, (bf16_t*)(ws + W_LRU), 256, 0, 2, ((mat >> 2) << 3) | ((mat & 3) << 1) | 0, scr, lane); continue; } r -= I_LRU;
        if (r < I_LRU) { const int mat = r >> 5; tr_item(in_ptr(tab, 12) + oLRU + (size_t)mat * 65536, 256, r & 31, (bf16_t*)(ws + W_LRU), 256, 0, 2, ((mat >> 2) << 3) | ((mat & 3) << 1) | 1, scr, lane); continue; } r -= I_LRU;
        if (r < I_SQ) { tr_item(in_ptr(tab, 15) + oSQ, D, r, (bf16_t*)(ws + W_CAT), 2048, 0, 0, 0, scr, lane); continue; } r -= I_SQ;
        if (r < I_HALF) { tr_item(in_ptr(tab, 17) + oHF, D, r, (bf16_t*)(ws + W_CAT), 2048, 1024, 0, 0, scr, lane); continue; } r -= I_HALF;
        if (r < I_HALF) { tr_item(in_ptr(tab, 22) + oHF, D, r, (bf16_t*)(ws + W_CAT), 2048, 1536, 0, 0, scr, lane); continue; } r -= I_HALF;
        if (r < I_SQ) { tr_item(in_ptr(tab, 23) + oSQ, D, r, (bf16_t*)(ws + W_O), 1024, 0, 0, 0, scr, lane); continue; } r -= I_SQ;
        if (r < I_UP) { tr_item(in_ptr(tab, 26) + oUP, FF, r, (bf16_t*)(ws + W_UP2), 1024, 0, 1, 0, scr, lane); continue; } r -= I_UP;
        if (r < I_UP) { tr_item(in_ptr(tab, 27) + oUP, FF, r, (bf16_t*)(ws + W_UP2), 1024, 0, 1, 128, scr, lane); continue; } r -= I_UP;
        tr_item(in_ptr(tab, 28) + oUP, D, r, (bf16_t*)(ws + W_DN2), FF, 0, 0, 0, scr, lane);
    }
}
__device__ __forceinline__ void lc_all(const float* const* tab, unsigned char* ws) {
    float* LC = (float*)(ws + WS_LC); const float* lam = in_ptr(tab, 14);
    for (int i = blockIdx.x * NTHR + threadIdx.x; i < DEPTH * 2048; i += gridDim.x * NTHR) LC[i] = -8.f * log1pf(expf(-lam[i]));
}

__device__ __forceinline__ void wave_sum2(float& a, float& b, int lane) {
#pragma unroll
    for (int o = 1; o < 64; o <<= 1) { const int ad = (lane ^ o) << 2;
        const float ta = __int_as_float(__builtin_amdgcn_ds_bpermute(ad, __float_as_int(a))), tb = __int_as_float(__builtin_amdgcn_ds_bpermute(ad, __float_as_int(b)));
        a += ta; b += tb; }
}
template <bool HASF>
__device__ __forceinline__ void ew_phase(const float* xin, float* xout, const bf16_t* Fb, float scale, const float* post_g, const float* pre_g, bf16_t* XN) {
    int tid_ = threadIdx.x; asm volatile("" : "+v"(tid_));
    const int tid = tid_, lane = tid & 63, wave = tid >> 6;
    const int gw = blockIdx.x * NWAVES + wave, NGW = gridDim.x * NWAVES;
    for (int m = gw; m < T; m += 2 * NGW) {
        f32x4 v[2][4]; f32x4 f[2][4];
#pragma unroll
        for (int r = 0; r < 2; ++r) { const f32x4* xr = (const f32x4*)(xin + (size_t)(m + r * NGW) * D) + lane;
#pragma unroll
            for (int j = 0; j < 4; ++j) v[r][j] = xr[64 * j]; }
        if (HASF) {
            u32x2 fw[2][4];
#pragma unroll
            for (int r = 0; r < 2; ++r) { const u32x2* fr_ = (const u32x2*)(Fb + (size_t)(m + r * NGW) * D) + lane;
#pragma unroll
                for (int j = 0; j < 4; ++j) fw[r][j] = fr_[64 * j]; }
            float ss[2] = {0.f, 0.f};
#pragma unroll
            for (int r = 0; r < 2; ++r)
#pragma unroll
                for (int j = 0; j < 4; ++j) { const u32x2 w = fw[r][j]; f[r][j][0] = bflo(w.x); f[r][j][1] = bfhi(w.x); f[r][j][2] = bflo(w.y); f[r][j][3] = bfhi(w.y);
                    ss[r] += (f[r][j][0] * f[r][j][0] + f[r][j][1] * f[r][j][1]) + (f[r][j][2] * f[r][j][2] + f[r][j][3] * f[r][j][3]); }
            wave_sum2(ss[0], ss[1], lane);
            const float rs0 = scale * __builtin_amdgcn_rsqf(ss[0] * (1.f / D) + EPS), rs1 = scale * __builtin_amdgcn_rsqf(ss[1] * (1.f / D) + EPS);
#pragma unroll
            for (int j = 0; j < 4; ++j) { const f32x4 pg = *((const f32x4*)post_g + 64 * j + lane); v[0][j] += f[0][j] * rs0 * pg; v[1][j] += f[1][j] * rs1 * pg; }
        }
        if (HASF || xin != xout) {
#pragma unroll
            for (int r = 0; r < 2; ++r) { f32x4* xo = (f32x4*)(xout + (size_t)(m + r * NGW) * D) + lane;
#pragma unroll
                for (int j = 0; j < 4; ++j) xo[64 * j] = v[r][j]; }
        }
        if (pre_g) {
            float s2[2] = {0.f, 0.f};
#pragma unroll
            for (int r = 0; r < 2; ++r)
#pragma unroll
                for (int j = 0; j < 4; ++j) s2[r] += (v[r][j][0] * v[r][j][0] + v[r][j][1] * v[r][j][1]) + (v[r][j][2] * v[r][j][2] + v[r][j][3] * v[r][j][3]);
            wave_sum2(s2[0], s2[1], lane);
            const float q0 = __builtin_amdgcn_rsqf(s2[0] * (1.f / D) + EPS), q1 = __builtin_amdgcn_rsqf(s2[1] * (1.f / D) + EPS);
            u32x2* o0 = (u32x2*)(XN + (size_t)m * D) + lane; u32x2* o1 = (u32x2*)(XN + (size_t)(m + NGW) * D) + lane;
#pragma unroll
            for (int j = 0; j < 4; ++j) { const f32x4 g = *((const f32x4*)pre_g + 64 * j + lane); const f32x4 y0 = v[0][j] * q0 * g, y1 = v[1][j] * q1 * g;
                u32x2 w0, w1; w0.x = cvt_pk_bf16(y0[0], y0[1]); w0.y = cvt_pk_bf16(y0[2], y0[3]); w1.x = cvt_pk_bf16(y1[0], y1[1]); w1.y = cvt_pk_bf16(y1[2], y1[3]);
                o0[64 * j] = w0; o1[64 * j] = w1; }
        }
    }
}

constexpr int VT_PITCH = 272;
__device__ __forceinline__ void prep_phase(const float* const* tab, unsigned char* ws, int l, LAS unsigned char* lds) {
    int tid_ = threadIdx.x; asm volatile("" : "+v"(tid_));
    const int tid = tid_, lane = tid & 63, wave = tid >> 6;
    const bf16_t* ZX = (const bf16_t*)(ws + WS_ZX); const bf16_t* ZSC = (const bf16_t*)(ws + WS_ZSC); const bf16_t* ZSGU = (const bf16_t*)(ws + WS_ZSGU);
    bf16_t* XC = (bf16_t*)(ws + WS_XC); bf16_t* YBC = (bf16_t*)(ws + WS_YBC);
    for (int item = blockIdx.x; item < T / 128; item += gridDim.x) {
        const int b = item >> 7, n = item & 127, t0 = n * 128; const size_t rb = (size_t)b * S;
        {
            const int c = 8 * (tid & 127), sg = tid >> 7; const float* cw = in_ptr(tab, 8) + (size_t)l * 4096 + c; const float* cb = in_ptr(tab, 9) + (size_t)l * 1024 + c;
            float wk[4][8], bb[8];
#pragma unroll
            for (int k = 0; k < 4; ++k) { const f32x4 a0 = *(const f32x4*)(cw + k * 1024), a1 = *(const f32x4*)(cw + k * 1024 + 4);
#pragma unroll
                for (int j = 0; j < 4; ++j) { wk[k][j] = a0[j]; wk[k][4 + j] = a1[j]; } }
            { const f32x4 a0 = *(const f32x4*)cb, a1 = *(const f32x4*)(cb + 4);
#pragma unroll
              for (int j = 0; j < 4; ++j) { bb[j] = a0[j]; bb[4 + j] = a1[j]; } }
            const bf16_t* src = ZX + rb * 1024 + c;
#pragma unroll 1
            for (int blk = 0; blk < 4; ++blk) { const int tb = t0 + sg * 32 + blk * 8;
                u32x4 xr[11];
#pragma unroll
                for (int i = 0; i < 11; ++i) { const int t = tb - 2 + i; xr[i] = (t >= 0 && t < S) ? *(const u32x4*)(src + (size_t)t * 1024) : (u32x4){0u, 0u, 0u, 0u}; }
#pragma unroll
                for (int o = 0; o < 8; ++o) { float y[8];
#pragma unroll
                    for (int j = 0; j < 8; ++j) y[j] = bb[j] + wk[0][j] * h8(xr[o], j) + wk[1][j] * h8(xr[o + 1], j) + wk[2][j] * h8(xr[o + 2], j) + wk[3][j] * h8(xr[o + 3], j);
                    u32x4 w; w.x = cvt_pk_bf16(y[0], y[1]); w.y = cvt_pk_bf16(y[2], y[3]); w.z = cvt_pk_bf16(y[4], y[5]); w.w = cvt_pk_bf16(y[6], y[7]);
                    *(u32x4*)(XC + (rb + tb + o) * 1024 + c) = w; } }
        }
        {
            const int c = 8 * (tid & 63), sg = tid >> 6; const float* cw = in_ptr(tab, 16) + (size_t)l * 1536 + c;
            float wk[3][8];
#pragma unroll
            for (int k = 0; k < 3; ++k) { const f32x4 a0 = *(const f32x4*)(cw + k * 512), a1 = *(const f32x4*)(cw + k * 512 + 4);
#pragma unroll
                for (int j = 0; j < 4; ++j) { wk[k][j] = a0[j]; wk[k][4 + j] = a1[j]; } }
            const bf16_t* src = ZSC + rb * 1536 + c;
#pragma unroll 1
            for (int blk = 0; blk < 4; ++blk) { const int tb = t0 + sg * 16 + blk * 4;
                u32x4 cr[6], xr[6], br[4];
#pragma unroll
                for (int i = 0; i < 6; ++i) { const int t = tb - 1 + i; const bool in = (t >= 0 && t < S);
                    cr[i] = in ? *(const u32x4*)(src + (size_t)t * 1536 + 512) : (u32x4){0u, 0u, 0u, 0u}; xr[i] = in ? *(const u32x4*)(src + (size_t)t * 1536 + 1024) : (u32x4){0u, 0u, 0u, 0u}; }
#pragma unroll
                for (int o = 0; o < 4; ++o) br[o] = *(const u32x4*)(src + (size_t)(tb + o) * 1536);
                float p[6][8];
#pragma unroll
                for (int i = 0; i < 6; ++i)
#pragma unroll
                    for (int j = 0; j < 8; ++j) p[i][j] = h8(cr[i], j) * h8(xr[i], j);
#pragma unroll
                for (int o = 0; o < 4; ++o) { float y[8];
#pragma unroll
                    for (int j = 0; j < 8; ++j) y[j] = h8(br[o], j) * (wk[0][j] * p[o][j] + wk[1][j] * p[o + 1][j] + wk[2][j] * p[o + 2][j]);
                    u32x4 w; w.x = cvt_pk_bf16(y[0], y[1]); w.y = cvt_pk_bf16(y[2], y[3]); w.z = cvt_pk_bf16(y[4], y[5]); w.w = cvt_pk_bf16(y[6], y[7]);
                    *(u32x4*)(YBC + (rb + tb + o) * 1024 + c) = w; } }
        }
        {
            const float* lg = in_ptr(tab, 18) + (size_t)l * 512; const float* lb = in_ptr(tab, 19) + (size_t)l * 512;
            f32x4 g0 = *(const f32x4*)(lg + 8 * lane), g1 = *(const f32x4*)(lg + 8 * lane + 4), b0 = *(const f32x4*)(lb + 8 * lane), b1 = *(const f32x4*)(lb + 8 * lane + 4);
            u32x4 wrow[16];
#pragma unroll
            for (int qi = 0; qi < 16; ++qi) wrow[qi] = *(const u32x4*)(ZSGU + (rb + t0 + wave + 8 * qi) * 1024 + 512 + 8 * lane);
#pragma unroll
            for (int qi = 0; qi < 16; ++qi) { const int q = wave + 8 * qi; const u32x4 w = wrow[qi];
                float v[8]; v[0] = bflo(w.x); v[1] = bfhi(w.x); v[2] = bflo(w.y); v[3] = bfhi(w.y); v[4] = bflo(w.z); v[5] = bfhi(w.z); v[6] = bflo(w.w); v[7] = bfhi(w.w);
                float s = 0.f;
#pragma unroll
                for (int j = 0; j < 8; ++j) { v[j] = gelu_(v[j]); s += v[j]; }
                const float mu = wave_sum(s, lane) * (1.f / 512.f); float s2 = 0.f;
#pragma unroll
                for (int j = 0; j < 8; ++j) { v[j] -= mu; s2 += v[j] * v[j]; }
                const float rstd = __builtin_amdgcn_rsqf(wave_sum(s2, lane) * (1.f / 512.f) + EPS);
#pragma unroll
                for (int j = 0; j < 8; ++j) { const float y = v[j] * rstd * (j < 4 ? g0[j & 3] : g1[j & 3]) + (j < 4 ? b0[j & 3] : b1[j & 3]);
                    *(LAS bf16_t*)(lds + (8 * lane + j) * VT_PITCH + 2 * q) = (bf16_t)(cvt_pk_bf16(y, 0.f) & 0xffffu); }
            }
            __syncthreads();
            const int g = wave >> 1, p0 = 64 * (wave & 1), fr = lane & 15, fq = lane >> 4;
            const float* Wg = in_ptr(tab, 20) + (size_t)l * 65536 + (size_t)g * 16384; const float* bs = in_ptr(tab, 21) + (size_t)l * 512 + g * 128;
            bf16x8 Wf[4][4];
#pragma unroll
            for (int m = 0; m < 4; ++m)
#pragma unroll
                for (int kk = 0; kk < 4; ++kk) { const float* p = Wg + (size_t)(p0 + 16 * m + fr) * 128 + 32 * kk + 8 * fq; const f32x4 x0 = *(const f32x4*)p, x1 = *(const f32x4*)(p + 4);
                    u32x4 w; w.x = cvt_pk_bf16(x0[0], x0[1]); w.y = cvt_pk_bf16(x0[2], x0[3]); w.z = cvt_pk_bf16(x1[0], x1[1]); w.w = cvt_pk_bf16(x1[2], x1[3]);
                    Wf[m][kk] = __builtin_bit_cast(bf16x8, w); }
            float bsv[4];
#pragma unroll
            for (int m = 0; m < 4; ++m) bsv[m] = bs[p0 + 16 * m + fr];
            for (int nn = 0; nn < 8; ++nn) {
                f32x4 acc[4];
#pragma unroll
                for (int m = 0; m < 4; ++m) acc[m] = (f32x4){0.f, 0.f, 0.f, 0.f};
#pragma unroll
                for (int kk = 0; kk < 4; ++kk) { const bf16x8 vf = *(const LAS bf16x8*)(lds + (g * 128 + 16 * nn + fr) * VT_PITCH + (32 * kk + 8 * fq) * 2);
#pragma unroll
                    for (int m = 0; m < 4; ++m) acc[m] = __builtin_amdgcn_mfma_f32_16x16x32_f16(__builtin_bit_cast(h16x8, vf), __builtin_bit_cast(h16x8, Wf[m][kk]), acc[m], 0, 0, 0); }
                const int cc = g * 128 + 16 * nn + 4 * fq;
#pragma unroll
                for (int m = 0; m < 4; ++m) { const size_t row = rb + t0 + p0 + 16 * m + fr;
                    const u32x2 uw = *(const u32x2*)(ZSGU + row * 1024 + cc);
                    const float o0 = gelu_(bflo(uw.x)) * (acc[m][0] + bsv[m]), o1 = gelu_(bfhi(uw.x)) * (acc[m][1] + bsv[m]), o2 = gelu_(bflo(uw.y)) * (acc[m][2] + bsv[m]), o3 = gelu_(bfhi(uw.y)) * (acc[m][3] + bsv[m]);
                    u32x2 w; w.x = cvt_pk_bf16(o0, o1); w.y = cvt_pk_bf16(o2, o3); if (ABL == 3) { w.x = 0u; w.y = 0u; }
                    *(u32x2*)(YBC + row * 1024 + 512 + cc) = w; }
            }
            __syncthreads();
        }
    }
}

__device__ __forceinline__ void scan_pass1(unsigned char* ws, int l, LAS unsigned char* lds) {
    int tid_ = threadIdx.x; asm volatile("" : "+v"(tid_));
    const int tid = tid_, lane = tid & 63, seg = tid >> 6;
    const float* LC = (const float*)(ws + WS_LC) + l * 2048; f32x2* SUM = (f32x2*)(ws + WS_SUM); f32x4* SEGS = (f32x4*)(ws + WS_SEG);
    LAS f32x4* SEG = (LAS f32x4*)lds;
    for (int item = blockIdx.x; item < 2048; item += gridDim.x) {
        const int dir = item & 1, grp = (item >> 1) & 7, chunk = (item >> 4) & 63, b = item >> 10;
        const int ch = grp * 128 + 2 * lane;
        const float l0 = LC[dir * 1024 + ch] * (1.f / 255.f), l1 = LC[dir * 1024 + ch + 1] * (1.f / 255.f);
        const bf16_t* U = (const bf16_t*)(ws + WS_U) + (size_t)dir * T * 1024 + ((size_t)b * S + chunk * 256) * 1024 + ch;
        const unsigned char* R = ws + WS_R + (size_t)dir * T * 1024 + ((size_t)b * S + chunk * 256) * 1024 + ch;
        unsigned uw[32], rw[32];
#pragma unroll
        for (int k = 0; k < 32; ++k) { const int p = seg * 32 + k, to = dir ? 255 - p : p; uw[k] = *(const unsigned*)(U + (size_t)to * 1024); rw[k] = *(const unsigned short*)(R + (size_t)to * 1024); }
        float A0 = 1.f, A1 = 1.f, H0 = 0.f, H1 = 0.f;
#pragma unroll
        for (int k = 0; k < 32; ++k) { const float a0 = __expf(l0 * (float)(rw[k] & 255u)), a1 = __expf(l1 * (float)(rw[k] >> 8));
            H0 = a0 * H0 + bflo(uw[k]) * __builtin_sqrtf(1.f - a0 * a0); H1 = a1 * H1 + bfhi(uw[k]) * __builtin_sqrtf(1.f - a1 * a1); A0 *= a0; A1 *= a1; }
        const f32x4 sv = (f32x4){A0, H0, A1, H1};
        SEG[seg * 64 + lane] = sv;
        SEGS[((size_t)(((dir * 2 + b) * 64 + chunk) * 8 + seg)) * 512 + grp * 64 + lane] = sv;
        __syncthreads();
        if (tid < 64) { float cA0 = 1.f, cA1 = 1.f, cH0 = 0.f, cH1 = 0.f;
#pragma unroll
            for (int s = 0; s < 8; ++s) { const f32x4 v = SEG[s * 64 + tid]; cH0 = v[0] * cH0 + v[1]; cA0 *= v[0]; cH1 = v[2] * cH1 + v[3]; cA1 *= v[2]; }
            f32x4* o = (f32x4*)(SUM + ((size_t)((dir * 2 + b) * 64 + chunk)) * 1024 + grp * 128 + 2 * tid); *o = (f32x4){cA0, cH0, cA1, cH1}; }
        __syncthreads();
    }
}
__device__ __forceinline__ void scan_pass2(unsigned char* ws, int l, LAS unsigned char* lds) {
    int tid_ = threadIdx.x; asm volatile("" : "+v"(tid_));
    const int tid = tid_, lane = tid & 63, seg = tid >> 6;
    const float* LC = (const float*)(ws + WS_LC) + l * 2048; const f32x2* SUM = (const f32x2*)(ws + WS_SUM); const f32x4* SEGS = (const f32x4*)(ws + WS_SEG);
    LAS f32x2* HF = (LAS f32x2*)lds;
    LAS f32x2* CAR = (LAS f32x2*)(lds + 131072);
    for (int item0 = blockIdx.x; item0 < 1024; item0 += 4 * gridDim.x) {
        { const int slot = seg >> 1, dir = seg & 1, item = item0 + slot * gridDim.x;
          if (item < 1024) { const int grp = item & 7, chunk = (item >> 3) & 63, b = item >> 9;
              const f32x4* sp = (const f32x4*)(SUM + ((size_t)((dir * 2 + b) * 64)) * 1024 + grp * 128 + 2 * lane);
              float h0 = 0.f, h1 = 0.f; const int nprev = dir ? 63 - chunk : chunk;
              for (int j0 = 0; j0 < nprev; j0 += 8) { f32x4 v[8];
#pragma unroll
                  for (int u = 0; u < 8; ++u) { const int jj = j0 + u; const int cj = dir ? 63 - jj : jj; const int cl = jj < nprev ? cj : chunk;
                      v[u] = sp[(size_t)cl * 512]; if (jj >= nprev) v[u] = (f32x4){1.f, 0.f, 1.f, 0.f}; }
#pragma unroll
                  for (int u = 0; u < 8; ++u) { h0 = v[u][0] * h0 + v[u][1]; h1 = v[u][2] * h1 + v[u][3]; } }
              CAR[seg * 64 + lane] = (f32x2){h0, h1}; } }
        __syncthreads();
#pragma unroll 1
        for (int slot = 0; slot < 4; ++slot) { const int item = item0 + slot * gridDim.x; if (item >= 1024) break;
            const int grp = item & 7, chunk = (item >> 3) & 63, b = item >> 9;
            const int ch = grp * 128 + 2 * lane;
            bf16_t* ZG = (bf16_t*)(ws + WS_ZG) + ((size_t)b * S + chunk * 256) * 1024 + ch;
#pragma unroll 1
            for (int dir = 0; dir < 2; ++dir) {
                const float l0 = LC[dir * 1024 + ch] * (1.f / 255.f), l1 = LC[dir * 1024 + ch + 1] * (1.f / 255.f);
                const bf16_t* U = (const bf16_t*)(ws + WS_U) + (size_t)dir * T * 1024 + ((size_t)b * S + chunk * 256) * 1024 + ch;
                const unsigned char* R = ws + WS_R + (size_t)dir * T * 1024 + ((size_t)b * S + chunk * 256) * 1024 + ch;
                float h0, h1; { const f32x2 c = CAR[(slot * 2 + dir) * 64 + lane]; h0 = c[0]; h1 = c[1]; }
                { const f32x4* sg = SEGS + ((size_t)(((dir * 2 + b) * 64 + chunk) * 8)) * 512 + grp * 64 + lane; f32x4 v[7];
#pragma unroll
                  for (int s = 0; s < 7; ++s) v[s] = sg[(size_t)s * 512];
#pragma unroll
                  for (int s = 0; s < 7; ++s) if (s < seg) { h0 = v[s][0] * h0 + v[s][1]; h1 = v[s][2] * h1 + v[s][3]; } }
#pragma unroll 1
                for (int kb = 0; kb < 2; ++kb) { unsigned uw16[16], rw16[16], gw16[16];
#pragma unroll
                    for (int u = 0; u < 16; ++u) { const int p = seg * 32 + kb * 16 + u, to = dir ? 255 - p : p;
                        uw16[u] = *(const unsigned*)(U + (size_t)to * 1024); rw16[u] = *(const unsigned short*)(R + (size_t)to * 1024);
                        gw16[u] = dir ? *(const unsigned*)(ZG + (size_t)to * 1024) : 0u; }
#pragma unroll
                    for (int u = 0; u < 16; ++u) { const int p = seg * 32 + kb * 16 + u, to = dir ? 255 - p : p; const unsigned uw = uw16[u], rw = rw16[u];
                        const float a0 = __expf(l0 * (float)(rw & 255u)), a1 = __expf(l1 * (float)(rw >> 8));
                        h0 = a0 * h0 + bflo(uw) * __builtin_sqrtf(1.f - a0 * a0); h1 = a1 * h1 + bfhi(uw) * __builtin_sqrtf(1.f - a1 * a1);
                        if (dir == 0) HF[to * 64 + lane] = (f32x2){h0, h1};
                        else { const f32x2 hf = HF[to * 64 + lane]; const unsigned gw = gw16[u];
                            *(unsigned*)(ZG + (size_t)to * 1024) = cvt_pk_bf16((hf[0] + h0) * gelu_(bflo(gw)), (hf[1] + h1) * gelu_(bfhi(gw))); } } }
                __syncthreads();
            }
        }
    }
}

#ifdef DBG
constexpr size_t WS_DBG = 70000;
__device__ __forceinline__ float bfv(const bf16_t* p) { return bflo((unsigned)*p); }
__device__ __forceinline__ float dotA(const bf16_t* arow, const float* W, int K, int N, int col) { float s = 0.f; for (int k = 0; k < K; ++k) s += bfv(arow + k) * W[(size_t)k * N + col]; return s; }
__device__ __forceinline__ void dbg_cmp(unsigned* dbg, unsigned code, float got, float ref, float tol_rel, float tol_abs) {
    const float e = fabsf(got - ref); if (!(e <= tol_rel * fabsf(ref) + tol_abs)) atomicMin(dbg, code); }
__device__ __forceinline__ void dbg_check(int stage, const float* const* tab, unsigned char* ws, float* X) {
    unsigned* dbg = (unsigned*)(ws + WS_DBG); const int t = blockIdx.x * 64 + threadIdx.x;
    int r = (int)(((long)t * 5273 + 17) % T); const bf16_t* XN = (const bf16_t*)(ws + WS_XN);
    { const int q = t >> 1; const int base = (q & 1) ? S : 0;
      if (t < 40) { const int k = q >> 1; const int off = (k == 0) ? 0 : (k == 1) ? 1 : (k == 2) ? 2 : (k == 3) ? 127 : (k == 4) ? 128 : (k == 5) ? 255 : (k == 6) ? 256 : (k == 7) ? S - 1 : (k == 8) ? S - 2 : S - 3; r = base + off; } }
    if (stage == 2) { const int c = (int)((long)t * 911 + 3) % FF; const float g = dotA(XN + (size_t)r * D, (in_ptr(tab, DBG_F ? 26 : 2) + (size_t)DBG_LAYER * (D*FF)), D, FF, c), u = dotA(XN + (size_t)r * D, (in_ptr(tab, DBG_F ? 27 : 3) + (size_t)DBG_LAYER * (D*FF)), D, FF, c);
        dbg_cmp(dbg, 2, bfv((const bf16_t*)(ws + WS_H) + (size_t)r * FF + c), g / (1.f + expf(-g)) * u, 0.03f, 0.03f); }
    if (stage == 3) { const int c = (int)((long)t * 911 + 3) % D; dbg_cmp(dbg, 3, bfv((const bf16_t*)(ws + WS_F) + (size_t)r * D + c), dotA((const bf16_t*)(ws + WS_H) + (size_t)r * FF, (in_ptr(tab, DBG_F ? 28 : 4) + (size_t)DBG_LAYER * (D*FF)), FF, D, c), 0.03f, 0.03f); }
    if (stage == 4) { const int c = (int)((long)t * 911 + 3) % D; const bf16_t* F = (const bf16_t*)(ws + WS_F) + (size_t)r * D; float ss = 0.f; for (int k = 0; k < D; ++k) ss += bfv(F + k) * bfv(F + k);
        const float* x0 = in_ptr(tab, 0) + (size_t)r * D; float s2 = 0.f;
        for (int k = 0; k < D; ++k) { const float xv = x0[k] + 0.5f * bfv(F + k) * rsqrtf(ss / D + EPS) * (in_ptr(tab, 5) + (size_t)DBG_LAYER * (D))[k]; s2 += xv * xv; if (k == c) dbg_cmp(dbg, 4, X[(size_t)r * D + c], xv, 0.001f, 0.001f); }
        dbg_cmp(dbg, 4, bfv(XN + (size_t)r * D + c), X[(size_t)r * D + c] * rsqrtf(s2 / D + EPS) * (in_ptr(tab, 6) + (size_t)DBG_LAYER * (D))[c], 0.01f, 0.01f); }
    if (stage == 5) { const int c = (int)((long)t * 911 + 3) % ZN; const float z = dotA(XN + (size_t)r * D, (in_ptr(tab, 7) + (size_t)DBG_LAYER * (D*DIN)), D, DIN, c); float got;
        if (c < 1024) got = bfv((const bf16_t*)(ws + WS_ZG) + (size_t)r * 1024 + c); else if (c < 2048) got = bfv((const bf16_t*)(ws + WS_ZX) + (size_t)r * 1024 + c - 1024);
        else if (c < 3584) got = bfv((const bf16_t*)(ws + WS_ZSC) + (size_t)r * 1536 + c - 2048); else got = bfv((const bf16_t*)(ws + WS_ZSGU) + (size_t)r * 1024 + c - 3584);
        dbg_cmp(dbg, 5, got, z, 0.03f, 0.03f); }
    if (stage == 6) { const int b = r / S, tt = r % S; const size_t rb = (size_t)b * S;
        { const int c = (int)((long)t * 911 + 3) % 1024; float o = (in_ptr(tab, 9) + (size_t)DBG_LAYER * (1024))[c]; for (int k = 0; k < 4; ++k) { const int q = tt + k - 2; if (q >= 0 && q < S) o += (in_ptr(tab, 8) + (size_t)DBG_LAYER * (4096))[k * 1024 + c] * bfv((const bf16_t*)(ws + WS_ZX) + (rb + q) * 1024 + c); }
          dbg_cmp(dbg, 6, bfv((const bf16_t*)(ws + WS_XC) + (size_t)r * 1024 + c), o, 0.02f, 0.02f); }
        { const int c = (int)((long)t * 911 + 3) % 512; const bf16_t* Z = (const bf16_t*)(ws + WS_ZSC); float o = 0.f; for (int k = 0; k < 3; ++k) { const int q = tt + k - 1; if (q >= 0 && q < S) o += (in_ptr(tab, 16) + (size_t)DBG_LAYER * (1536))[k * 512 + c] * bfv(Z + (rb + q) * 1536 + 512 + c) * bfv(Z + (rb + q) * 1536 + 1024 + c); }
          dbg_cmp(dbg, 7, bfv((const bf16_t*)(ws + WS_YBC) + (size_t)r * 1024 + c), o * bfv(Z + (size_t)r * 1536 + c), 0.02f, 0.02f); }
        { const int c = (int)((long)t * 911 + 3) % 512, g = c >> 7, p = tt & 127, t0 = tt - p; const bf16_t* Z = (const bf16_t*)(ws + WS_ZSGU); float mix = (in_ptr(tab, 21) + (size_t)DBG_LAYER * (512))[g * 128 + p];
          for (int q = 0; q < 128; ++q) { const bf16_t* vr = Z + (rb + t0 + q) * 1024 + 512; float mu = 0.f, var = 0.f; for (int k = 0; k < 512; ++k) mu += gelu_(bfv(vr + k)); mu /= 512.f;
              for (int k = 0; k < 512; ++k) { const float d = gelu_(bfv(vr + k)) - mu; var += d * d; } var /= 512.f;
              const float vn = (gelu_(bfv(vr + c)) - mu) * rsqrtf(var + EPS) * (in_ptr(tab, 18) + (size_t)DBG_LAYER * (512))[c] + (in_ptr(tab, 19) + (size_t)DBG_LAYER * (512))[c]; mix += (in_ptr(tab, 20) + (size_t)DBG_LAYER * (65536))[(size_t)g * 16384 + p * 128 + q] * vn; }
          dbg_cmp(dbg, 8, bfv((const bf16_t*)(ws + WS_YBC) + (size_t)r * 1024 + 512 + c), gelu_(bfv(Z + (size_t)r * 1024 + c)) * mix, 0.03f, 0.03f); } }
    if (stage == 9) { const int c = (int)((long)t * 911 + 3) % 1024, dir = t & 1, head = c >> 8, e = c & 255; const bf16_t* xr = (const bf16_t*)(ws + WS_XC) + (size_t)r * 1024 + head * 256;
        const float pa = dotA(xr, (in_ptr(tab, 10) + (size_t)DBG_LAYER * (524288)) + (size_t)(dir * 4 + head) * 65536, 256, 256, e) + (in_ptr(tab, 11) + (size_t)DBG_LAYER * (2048))[dir * 1024 + c], px = dotA(xr, (in_ptr(tab, 12) + (size_t)DBG_LAYER * (524288)) + (size_t)(dir * 4 + head) * 65536, 256, 256, e) + (in_ptr(tab, 13) + (size_t)DBG_LAYER * (2048))[dir * 1024 + c];
        const float rr = 1.f / (1.f + expf(-pa)), ii = 1.f / (1.f + expf(-px));
        dbg_cmp(dbg, 9, (float)*(ws + WS_R + (size_t)dir * T * 1024 + (size_t)r * 1024 + c), rr * 255.f, 0.02f, 1.5f);
        dbg_cmp(dbg, 10, bfv((const bf16_t*)(ws + WS_U) + (size_t)dir * T * 1024 + (size_t)r * 1024 + c), ii * bfv(xr + e), 0.03f, 0.03f); }
    if (stage == 11) { const int c = (int)((long)t * 911 + 3) % 1024, b = r / S, tt = r % S; const size_t rb = (size_t)b * S; const float* LC = (const float*)(ws + WS_LC) + DBG_LAYER * 2048; float hs = 0.f;
        for (int dir = 0; dir < 2; ++dir) { const bf16_t* U = (const bf16_t*)(ws + WS_U) + (size_t)dir * T * 1024; const unsigned char* R = ws + WS_R + (size_t)dir * T * 1024; float h = 0.f;
            if (dir == 0) { for (int q = 0; q <= tt; ++q) { const float a = expf(LC[c] * (float)R[(rb + q) * 1024 + c] / 255.f); h = a * h + bfv(U + (rb + q) * 1024 + c) * sqrtf(1.f - a * a); } }
            else { for (int q = S - 1; q >= tt; --q) { const float a = expf(LC[1024 + c] * (float)R[(rb + q) * 1024 + c] / 255.f); h = a * h + bfv(U + (rb + q) * 1024 + c) * sqrtf(1.f - a * a); } }
            hs += h; }
        const float gate = dotA(XN + (size_t)r * D, (in_ptr(tab, 7) + (size_t)DBG_LAYER * (D*DIN)), D, DIN, c);
        dbg_cmp(dbg, 11, bfv((const bf16_t*)(ws + WS_ZG) + (size_t)r * 1024 + c), hs * gelu_(gate), 0.03f, 0.03f); }
    if (stage == 10) { const int c = (int)((long)t * 911 + 3) % 1024; ((float*)(ws + WS_DBG + 1024))[t] = bfv((const bf16_t*)(ws + WS_ZG) + (size_t)r * 1024 + c); }
    if (stage == 12) { const int c = (int)((long)t * 911 + 3) % 3072; const float z = dotA(XN + (size_t)r * D, (in_ptr(tab, 7) + (size_t)DBG_LAYER * (D*DIN)), D, DIN, ZN + c);
        dbg_cmp(dbg, 12, bfv((const bf16_t*)(ws + WS_G) + (size_t)r * 3072 + c), 1.f / (1.f + expf(-z)), 0.02f, 0.01f); }
    if (stage == 13) { const int c = (int)((long)t * 911 + 3) % 1024; const bf16_t* G = (const bf16_t*)(ws + WS_G) + (size_t)r * 3072;
        const float ya = dotA((const bf16_t*)(ws + WS_ZG) + (size_t)r * 1024, (in_ptr(tab, 15) + (size_t)DBG_LAYER * (D*D)), 1024, 1024, c), yb = dotA((const bf16_t*)(ws + WS_YBC) + (size_t)r * 1024, (in_ptr(tab, 17) + (size_t)DBG_LAYER * (512*D)), 512, 1024, c), yc = dotA((const bf16_t*)(ws + WS_YBC) + (size_t)r * 1024 + 512, (in_ptr(tab, 22) + (size_t)DBG_LAYER * (512*D)), 512, 1024, c);
        dbg_cmp(dbg, 13, bfv((const bf16_t*)(ws + WS_MG) + (size_t)r * 1024 + c), bfv(G + c) * ya + bfv(G + 1024 + c) * yb + bfv(G + 2048 + c) * yc, 0.03f, 0.05f); }
    if (stage == 15) { const int c = (int)((long)t * 911 + 3) % D; float s2 = 0.f; for (int k = 0; k < D; ++k) s2 += X[(size_t)r * D + k] * X[(size_t)r * D + k];
        dbg_cmp(dbg, 15, bfv(XN + (size_t)r * D + c), X[(size_t)r * D + c] * rsqrtf(s2 / D + EPS) * (in_ptr(tab, DBG_G) + (size_t)DBG_GL * D)[c], 0.01f, 0.01f); }
    if (stage == 16) { const int c = (int)((long)t * 911 + 3) % D; const bf16_t* F = (const bf16_t*)(ws + WS_MX) + (size_t)r * D; float ss = 0.f; for (int k = 0; k < D; ++k) ss += bfv(F + k) * bfv(F + k);
        const float xb = X[(size_t)r * D + c];
        dbg_cmp(dbg, 16, ((const float*)(ws + WS_G))[(size_t)r * D + c], xb + bfv(F + c) * rsqrtf(ss / D + EPS) * (in_ptr(tab, 24) + (size_t)DBG_LAYER * D)[c], 0.001f, 0.001f); }
    if (stage == 17) { const int c = (int)((long)t * 911 + 3) % D; const bf16_t* F = (const bf16_t*)(ws + WS_F) + (size_t)r * D; float ss = 0.f; for (int k = 0; k < D; ++k) ss += bfv(F + k) * bfv(F + k);
        const float xb = X[(size_t)r * D + c];
        dbg_cmp(dbg, 17, ((const float*)(ws + WS_G))[(size_t)r * D + c], xb + 0.5f * bfv(F + c) * rsqrtf(ss / D + EPS) * (in_ptr(tab, 29) + (size_t)DBG_LAYER * D)[c], 0.001f, 0.001f); }
    if (stage == 14) { const int c = (int)((long)t * 911 + 3) % 1024; dbg_cmp(dbg, 14, bfv((const bf16_t*)(ws + WS_MX) + (size_t)r * 1024 + c), dotA((const bf16_t*)(ws + WS_MG) + (size_t)r * 1024, (in_ptr(tab, 23) + (size_t)DBG_LAYER * (D*D)), 1024, 1024, c), 0.03f, 0.03f); }
}
__global__ void __launch_bounds__(64) dbg_kernel(Args a, unsigned mask) {
    unsigned char* ws = a.ws; const float* const* tab = (const float* const*)(ws + WS_TAB);
    for (int st = 2; st <= 17; ++st) if ((mask >> st) & 1u) dbg_check(st, tab, ws, a.out);
}
__global__ void dbg_final(Args a) { const unsigned cde = *(volatile unsigned*)(a.ws + WS_DBG); a.out[0] = (cde != 99u) ? 1000.f + 100.f * (float)cde : 0.f; }
#define DBGCHK(st) do { if (l == DBG_LAYER && (st) == STOP_AT) return; } while (0)
#else
#define DBGCHK(st) do { } while (0)
#endif

__global__ void __launch_bounds__(NTHR, 2) fwd_kernel(Args a) {
    extern __shared__ __attribute__((aligned(16))) unsigned char lds_raw[];
    LAS unsigned char* lds = (LAS unsigned char*)lds_raw;
    cg::grid_group grid = cg::this_grid();
    unsigned char* ws = a.ws;
    { const float** tw = (const float**)(ws + WS_TAB);
      if (threadIdx.x == 0) {
#pragma unroll
          for (int i = 0; i < 30; ++i) tw[i] = a.in[i];
          volatile LAS unsigned* st = (volatile LAS unsigned*)(lds + LDS_BAR_ST); st[0] = 0u; st[1] = 0u;
          (void)xb_add((unsigned*)(ws + WS_BAR) + XB_XCNT(xb_xcc_id()), 1u);
          __threadfence(); }
      __syncthreads(); }
    const float* const* tab = (const float* const*)(ws + WS_TAB);
    const int G = gridDim.x, c = blockIdx.x;
    bf16_t* XN = (bf16_t*)(ws + WS_XN);
    float* X = a.out;
    unsigned char* const ws0 = ws; const int G0 = G, c0 = c; float* const X0 = X;
    constexpr int BIG = 1 << 28;

#ifdef SKEL
    { const float* xin = a.in[0]; for (size_t i = (size_t)blockIdx.x * NTHR + threadIdx.x; i < (size_t)T * D; i += (size_t)gridDim.x * NTHR) a.out[i] = xin[i];
      GSYNC();
#if SKEL >= 2
      convert_layer(tab, ws, 0, lds); GSYNC();
#endif
#if SKEL >= 3
      lc_all(tab, ws); GSYNC();
#endif
#if SKEL >= 4
      ew_phase<false>(in_ptr(tab, 0), X, nullptr, 0.f, nullptr, in_ptr(tab, 1), XN); GSYNC();
#endif
#if SKEL >= 5
      ew_phase<true>(X, X, (const bf16_t*)(ws + WS_F), 0.5f, in_ptr(tab, 5), in_ptr(tab, 6), XN); GSYNC();
#endif
#if SKEL >= 6
      convert_layer(tab, ws, 1, lds); GSYNC();
#endif
      return; }
#endif
#ifdef DBG
    if (blockIdx.x == 0 && threadIdx.x == 0) *(unsigned*)(ws + WS_DBG) = 99u;
#endif
    PH(0) { convert_layer(tab, ws, 0, lds); lc_all(tab, ws); }
    PH(1) ew_phase<false>(in_ptr(tab, 0), X, nullptr, 0.f, nullptr, in_ptr(tab, 1), XN);
    if (gridDim.x == 0x7fffffffu) GSYNC_CG();
    GSYNC();
#ifdef DBG
    if (STOP_AT == 20) return;
#endif

#pragma unroll 1
    for (int l = 0; l < NLAYER_RUN; ++l) {
#pragma unroll 1
        for (int f = 0; f < 2; ++f) {
            unsigned long long wsv = (unsigned long long)ws0, xv = (unsigned long long)X0; int G = G0, c = c0;
#ifndef NOASM
            asm volatile("" : "+s"(wsv), "+s"(G), "+s"(c), "+s"(xv));
#endif
            unsigned char* ws = (unsigned char*)(GAS unsigned char*)wsv; float* X = (float*)(GAS float*)xv;
            const float* const* tab = (const float* const*)(ws + WS_TAB); bf16_t* XN = (bf16_t*)(ws + WS_XN);
            if (f == 1) {
                PH(2) { pg8::Gemm g{XN, XN, (const bf16_t*)(ws + W_IN), T, ZN, D, D, BIG, 0, 0}; pg8::StaticOrder So; So.init(T, ZN, G, c);
                  pg8::EpiBf<2> E{(bf16_t*)(ws + WS_ZG), 1024, (bf16_t*)(ws + WS_ZX), (bf16_t*)(ws + WS_ZSC), (bf16_t*)(ws + WS_ZSGU)};
                  pg8::gemm_phase<pg8::EpiBf<2>, true>(lds, g, So, E); }
                GSYNC();
                DBGCHK(5);
                PH(3) prep_phase(tab, ws, l, lds);
                GSYNC();
                DBGCHK(6);
                PH(4) { const bf16_t* XC = (const bf16_t*)(ws + WS_XC);
                  pg8::Gemm g{XC, XC, (const bf16_t*)(ws + W_LRU), T, 4096, 256, 1024, BIG, 2, 512}; pg8::StaticOrder So; So.init(T, 4096, G, c);
                  pg8::EpiGates E{XC, (bf16_t*)(ws + WS_U), ws + WS_R, in_ptr(tab, 11) + (size_t)l * 2048, in_ptr(tab, 13) + (size_t)l * 2048, (const float*)(ws + WS_LC)};
                  pg8::gemm_phase<pg8::EpiGates, true>(lds, g, So, E); }
                GSYNC();
                DBGCHK(9);
                PH(5) scan_pass1(ws, l, lds);
                GSYNC();
                PH(6) scan_pass2(ws, l, lds);
                GSYNC();
                DBGCHK(11);
                PH(7) { pg8::Gemm g{XN, XN, (const bf16_t*)(ws + W_IN) + (size_t)ZN * D, T, 3072, D, D, BIG, 0, 0}; pg8::StaticOrder So; So.init(T, 3072, G, c);
                  pg8::EpiBf<1> E{(bf16_t*)(ws + WS_G), 3072, nullptr, nullptr, nullptr};
                  pg8::gemm_phase<pg8::EpiBf<1>, true>(lds, g, So, E); }
                GSYNC();
                DBGCHK(12);
                PH(8) { pg8::Gemm g{(const bf16_t*)(ws + WS_ZG), (const bf16_t*)(ws + WS_YBC) - 16 * 64, (const bf16_t*)(ws + W_CAT), T, D, 2048, 1024, 16, 0, 0}; pg8::StaticOrder So; So.init(T, D, G, c);
                  pg8::EpiMerge E{(const bf16_t*)(ws + WS_G), (bf16_t*)(ws + WS_MG)};
                  pg8::gemm_phase<pg8::EpiMerge, true>(lds, g, So, E); }
                GSYNC();
                DBGCHK(13);
                PH(9) { const bf16_t* MG = (const bf16_t*)(ws + WS_MG);
                  pg8::Gemm g{MG, MG, (const bf16_t*)(ws + W_O), T, D, D, D, BIG, 0, 0}; pg8::StaticOrder So; So.init(T, D, G, c);
                  pg8::EpiBf<0> E{(bf16_t*)(ws + WS_MX), 1024, nullptr, nullptr, nullptr};
                  pg8::gemm_phase<pg8::EpiBf<0>, true>(lds, g, So, E); }
                GSYNC();
                DBGCHK(14);
#if defined(DBG) && STOP_AT == 21
                PH(10) ew_phase<true>(X, (float*)(ws + WS_G), (const bf16_t*)(ws + WS_MX), 1.f, in_ptr(tab, 24) + (size_t)l * D, in_ptr(tab, 25) + (size_t)l * D, XN);
#else
                PH(10) ew_phase<true>(X, X, (const bf16_t*)(ws + WS_MX), 1.f, in_ptr(tab, 24) + (size_t)l * D, in_ptr(tab, 25) + (size_t)l * D, XN);
#endif
                GSYNC();
                DBGCHK(21);
            }
            PH(11) { pg8::Gemm g{XN, XN, (const bf16_t*)(ws + (f ? W_UP2 : W_UP1)), T, 2 * FF, D, D, BIG, 0, 0}; pg8::StaticOrder So; So.init(T, 2 * FF, G, c);
              pg8::EpiSwiGLU E{(bf16_t*)(ws + WS_H), FF};
              pg8::gemm_phase<pg8::EpiSwiGLU, true>(lds, g, So, E); }
            GSYNC();
            if (f == DBG_F) DBGCHK(2);
            PH(12) { const bf16_t* H = (const bf16_t*)(ws + WS_H);
              pg8::Gemm g{H, H, (const bf16_t*)(ws + (f ? W_DN2 : W_DN1)), T, D, FF, FF, BIG, 0, 0}; pg8::StaticOrder So; So.init(T, D, G, c);
              pg8::EpiBf<0> E{(bf16_t*)(ws + WS_F), 1024, nullptr, nullptr, nullptr};
              pg8::gemm_phase<pg8::EpiBf<0>, true>(lds, g, So, E); }
            GSYNC();
            if (f == DBG_F) DBGCHK(3);
            if (f == 0) {
                ew_phase<true>(X, X, (const bf16_t*)(ws + WS_F), 0.5f, in_ptr(tab, 5) + (size_t)l * D, in_ptr(tab, 6) + (size_t)l * D, XN);
            } else {
                if (l + 1 < DEPTH) convert_layer(tab, ws, l + 1, lds);
#if defined(DBG) && STOP_AT == 22
                ew_phase<true>(X, (l == DBG_LAYER) ? (float*)(ws + WS_G) : X, (const bf16_t*)(ws + WS_F), 0.5f, in_ptr(tab, 29) + (size_t)l * D, (l + 1 < DEPTH) ? in_ptr(tab, 1) + (size_t)(l + 1) * D : nullptr, XN);
#else
                ew_phase<true>(X, X, (const bf16_t*)(ws + WS_F), 0.5f, in_ptr(tab, 29) + (size_t)l * D, (l + 1 < DEPTH) ? in_ptr(tab, 1) + (size_t)(l + 1) * D : nullptr, XN);
#endif
            }
            if (!(l == NLAYER_RUN - 1 && f == 1)) GSYNC();
            if (f == 0) DBGCHK(4);
            if (f == 1) DBGCHK(22);
        }
    }
}

extern "C" void kernel_launch(void* const* d_in, const int* in_sizes, int n_in, void* d_out, int out_size, void* d_ws, size_t ws_size, hipStream_t stream) {
    static int grid = 0;
    if (grid == 0) {
        if (n_in != 30 || in_sizes[0] != T * D || out_size != T * D || ws_size < WS_END) { fprintf(stderr, "kernel_launch: unexpected problem geometry (n_in %d, ws %zu)\n", n_in, ws_size); grid = -1; return; }
        int dev = 0, cus = 0, per_cu = 0;
        if (hipGetDevice(&dev) != hipSuccess || hipDeviceGetAttribute(&cus, hipDeviceAttributeMultiprocessorCount, dev) != hipSuccess) { grid = -1; return; }
        if (hipFuncSetAttribute((const void*)fwd_kernel, hipFuncAttributeMaxDynamicSharedMemorySize, LDS_BYTES) != hipSuccess) { fprintf(stderr, "kernel_launch: hipFuncSetAttribute failed\n"); grid = -1; return; }
        if (hipOccupancyMaxActiveBlocksPerMultiprocessor(&per_cu, (const void*)fwd_kernel, NTHR, LDS_BYTES) != hipSuccess || per_cu < 1) { fprintf(stderr, "kernel_launch: occupancy query failed (%d)\n", per_cu); (void)hipGetLastError(); grid = -1; return; }
        grid = cus * per_cu;
        if (T % (2 * grid * NWAVES) != 0) { fprintf(stderr, "kernel_launch: grid %d does not divide the row pairs of the norm phases\n", grid); grid = -1; return; }
    }
    if (grid < 0) return;
    Args a{};
    for (int i = 0; i < 30; ++i) a.in[i] = (const float*)d_in[i];
    a.out = (float*)d_out; a.ws = (unsigned char*)d_ws;
    if (hipMemsetAsync((char*)d_ws + WS_BAR, 0, 16384, stream) != hipSuccess) { fprintf(stderr, "kernel_launch: hipMemsetAsync failed\n"); return; }
    void* args[] = {&a};
    hipError_t e = hipLaunchCooperativeKernel((const void*)fwd_kernel, dim3(grid), dim3(NTHR), args, LDS_BYTES, stream);
    if (e != hipSuccess) fprintf(stderr, "kernel_launch: cooperative launch failed: %s (grid %d)\n", hipGetErrorString(e), grid);
#ifdef DBG
    dbg_kernel<<<128, 64, 0, stream>>>(a, (unsigned)DBG_MASK);
    dbg_final<<<1, 1, 0, stream>>>(a);
#endif
}
```
